# Optimizing an MI355X kernel written in HIP

```python
import jax
import jax.numpy as jnp
from jax import lax
import numpy as np

D_MODEL = 2048
BATCH = 4
SEQ = 4096
DEPTH = 4

GRID_W = 64
CTX_LEN = 256
D_POOL = 1024
POOL_WINDOWS = (2, 4, 8, 16)
N_POOL_GROUPS = 4
POOL_GROUP = D_POOL // N_POOL_GROUPS
HG_HEADS = 8
HG_DK = 128
HG_DV = 128
HG_WIDTH = HG_HEADS * HG_DK
CHUNK = 64
N_BRANCH = 2
IN_COLS = D_POOL + 5 * HG_WIDTH + N_BRANCH * D_MODEL
N_EXPERTS = 16
N_EXPERT_GROUPS = 4
EXPERTS_PER_GROUP = N_EXPERTS // N_EXPERT_GROUPS
TOP_K = 2
D_EXPERT = 512
MOE_BLOCK = 128
EPS = 1e-6

kernel_name = 'hybrid_pool_hgrn2_moe_dit'


def rmsnorm(x, w):
    x32 = x.astype(jnp.float32)
    y = x32 * lax.rsqrt(jnp.mean(x32 * x32, axis=-1, keepdims=True) + EPS)
    return (y * w.astype(jnp.float32)).astype(x.dtype)


def window_mean(u, w):
    L = u.shape[2]
    u32 = u.astype(jnp.float32)
    cs = jnp.concatenate([jnp.zeros_like(u32[:, :, :1]), jnp.cumsum(u32, axis=2)], axis=2)
    t = jnp.arange(L)
    lo = jnp.maximum(t - w // 2, 0)
    hi = jnp.minimum(t + w // 2 - 1, L - 1)
    s = jnp.take(cs, hi + 1, axis=2) - jnp.take(cs, lo, axis=2)
    cnt = (hi - lo + 1).astype(jnp.float32)
    return (s / cnt[:, None]).astype(u.dtype)


def pool_mixer(u, w_pg, pool_scale):
    outs = []
    for g, w in enumerate(POOL_WINDOWS):
        ug = u[..., g * POOL_GROUP:(g + 1) * POOL_GROUP]
        outs.append(jnp.einsum('brlc,cd->brld', window_mean(ug, w) - ug, w_pg[g]))
    return jnp.concatenate(outs, axis=-1) * pool_scale


def heads(a):
    b, t = a.shape[:2]
    return a.reshape(b, t, HG_HEADS, -1).transpose(0, 2, 1, 3).astype(jnp.float32)


def hgrn2_inputs(zq, zf_fwd, zf_bwd, zi, lb_fwd, lb_bwd):
    q = heads(jax.nn.silu(zq.astype(jnp.float32)))
    v = heads(zi)

    def gate(zf, lb):
        f = lb + (1.0 - lb) * jax.nn.sigmoid(zf.astype(jnp.float32))
        return heads(1.0 - f), heads(jnp.log(f))

    k_f, lf_f = gate(zf_fwd, lb_fwd)
    k_b, lf_b = gate(zf_bwd, lb_bwd)
    stack = lambda a, b: jnp.stack([a, jnp.flip(b, axis=2)])
    return stack(q, q), stack(k_f, k_b), stack(lf_f, lf_b), stack(v, v)


def hgrn2_scan(q, k, log_f, v, s0):
    T = q.shape[3]
    n = T // CHUNK

    def to_chunks(a):
        return jnp.moveaxis(a.reshape(a.shape[:3] + (n, CHUNK, a.shape[-1])), 3, 0)

    lower = jnp.tril(jnp.ones((CHUNK, CHUNK), dtype=bool))

    def step(S, inp):
        qc, kc, lfc, vc = inp
        b = jnp.cumsum(lfc, axis=-2)
        diff = b[..., :, None, :] - b[..., None, :, :]
        dec = jnp.exp(jnp.where(lower[:, :, None], diff, -jnp.inf))
        attn = jnp.einsum('dbhtk,dbhtsk,dbhsk->dbhts', qc, dec, kc)
        o = (jnp.einsum('dbhtk,dbhkv->dbhtv', qc * jnp.exp(b), S)
             + jnp.einsum('dbhts,dbhsv->dbhtv', attn, vc))
        bl = b[..., -1:, :]
        S = (jnp.exp(bl[..., 0, :])[..., None] * S
             + jnp.einsum('dbhsk,dbhsv->dbhkv', kc * jnp.exp(bl - b), vc))
        return S, o

    sT, o = lax.scan(step, s0, (to_chunks(q), to_chunks(k), to_chunks(log_f), to_chunks(v)))
    o = jnp.moveaxis(o, 0, 3).reshape(v.shape)
    return o, sT


def hgrn2_readout(o2, og, w_norm):
    o = o2[0] + jnp.flip(o2[1], axis=2)
    o = o * lax.rsqrt(jnp.mean(o * o, axis=-1, keepdims=True) + EPS)
    b, _, t, _ = o.shape
    o = o.transpose(0, 2, 1, 3).reshape(b, t, HG_WIDTH)
    return (o * w_norm.astype(jnp.float32) * jax.nn.silu(og.astype(jnp.float32))).astype(og.dtype)


def split_in(z):
    cuts = [D_POOL + j * HG_WIDTH for j in range(6)] + [D_POOL + 5 * HG_WIDTH + D_MODEL]
    return jnp.split(z, cuts, axis=-1)


def branch_merge(p, o2, og, gp, gh, grid, w_pg, pool_scale, hg_norm_w, w_bp, w_bh, w_out):
    b, t, _ = p.shape
    pool = pool_mixer(p.reshape((b,) + grid + (D_POOL,)), w_pg, pool_scale).reshape(b, t, D_POOL)
    hg = hgrn2_readout(o2, og, hg_norm_w)
    m = jax.nn.sigmoid(gp) * (pool @ w_bp) + jax.nn.sigmoid(gh) * (hg @ w_bh)
    return m @ w_out


def token_mixers(hl, hc, w_in, w_pg, pool_scale, hg_norm_w, lb_fwd, lb_bwd, w_bp, w_bh, w_out, need_ctx):
    b, n, _ = hl.shape
    rows = n // GRID_W
    pl, ql, ffl, fbl, il, ogl, gpl, ghl = split_in(hl @ w_in)
    pc, qc, ffc, fbc, ic, ogc, gpc, ghc = split_in(hc @ w_in)
    s0 = jnp.zeros((2, b, HG_HEADS, HG_DK, HG_DV), jnp.float32)
    o_ctx, s_ctx = hgrn2_scan(*hgrn2_inputs(qc, ffc, fbc, ic, lb_fwd, lb_bwd), s0)
    o_lat, _ = hgrn2_scan(*hgrn2_inputs(ql, ffl, fbl, il, lb_fwd, lb_bwd), s_ctx)
    yl = branch_merge(pl, o_lat, ogl, gpl, ghl, (rows, GRID_W), w_pg, pool_scale, hg_norm_w, w_bp, w_bh, w_out)
    if not need_ctx:
        return yl, None
    yc = branch_merge(pc, o_ctx, ogc, gpc, ghc, (1, hc.shape[1]), w_pg, pool_scale, hg_norm_w, w_bp, w_bh, w_out)
    return yl, yc


def moe_ffn(h, w_router, router_bias, w1, w3, w2):
    T, D = h.shape
    scores = jax.nn.sigmoid(h.astype(jnp.float32) @ w_router.astype(jnp.float32))
    sel = scores + router_bias.astype(jnp.float32)
    grp = sel.reshape(T, N_EXPERT_GROUPS, EXPERTS_PER_GROUP)
    grp_score = lax.top_k(grp, 2)[0].sum(-1)
    g_idx = jnp.argmax(grp_score, axis=-1)
    in_grp = jnp.take_along_axis(grp, g_idx[:, None, None], axis=1)[:, 0]
    _, loc = lax.top_k(in_grp, TOP_K)
    e_idx = (g_idx[:, None] * EXPERTS_PER_GROUP + loc).astype(jnp.int32)
    gate = jnp.take_along_axis(scores, e_idx, axis=1)
    gate = gate / jnp.sum(gate, axis=-1, keepdims=True)
    n_assign = T * TOP_K
    flat_e = e_idx.reshape(-1)
    flat_tok = jnp.repeat(jnp.arange(T, dtype=jnp.int32), TOP_K)
    order = jnp.argsort(flat_e)
    se, stok, sgate = flat_e[order], flat_tok[order], gate.reshape(-1)[order]
    counts = jnp.bincount(flat_e, length=N_EXPERTS)
    starts = jnp.cumsum(counts) - counts
    pcounts = (counts + MOE_BLOCK - 1) // MOE_BLOCK * MOE_BLOCK
    pends = jnp.cumsum(pcounts)
    dest = (pends - pcounts)[se] + jnp.arange(n_assign) - starts[se]
    n_blocks = -(-n_assign // MOE_BLOCK) + N_EXPERTS
    buf_tok = jnp.zeros((n_blocks * MOE_BLOCK,), jnp.int32).at[dest].set(stok)
    blk_e = jnp.minimum(jnp.searchsorted(pends, jnp.arange(n_blocks) * MOE_BLOCK, side='right'), N_EXPERTS - 1)
    xb = h[buf_tok].reshape(n_blocks, MOE_BLOCK, D)

    def expert_block(args):
        xblk, e = args
        return (jax.nn.silu(xblk @ w1[e]) * (xblk @ w3[e])) @ w2[e]

    yb = lax.map(expert_block, (xb, blk_e)).reshape(n_blocks * MOE_BLOCK, D)
    return jnp.zeros_like(h).at[stok].add(yb[dest] * sgate[:, None].astype(h.dtype))


def setup_inputs(seed: int = 0) -> dict:
    key = jax.random.key(seed)
    ks = jax.random.split(key, 22)
    D = D_MODEL
    nrm = lambda k, shape, s: jax.random.normal(k, shape, jnp.float32) * s
    return {
        'x': nrm(ks[0], (BATCH, SEQ, D), 1.0),
        'c': nrm(ks[1], (BATCH, D), 1.0),
        'ctx': nrm(ks[2], (BATCH, CTX_LEN, D), 1.0),
        'c_ctx': nrm(ks[3], (D,), 1.0),
        'w_ada': nrm(ks[4], (DEPTH, D, 6 * D), 0.5 * D ** -0.5),
        'b_ada': nrm(ks[5], (DEPTH, 6 * D), 0.01),
        'norm1_w': 1.0 + nrm(ks[6], (DEPTH, D), 0.02),
        'norm2_w': 1.0 + nrm(ks[7], (DEPTH, D), 0.02),
        'w_in': nrm(ks[8], (DEPTH, D, IN_COLS), D ** -0.5),
        'w_pool_group': nrm(ks[9], (DEPTH, N_POOL_GROUPS, POOL_GROUP, POOL_GROUP), POOL_GROUP ** -0.5),
        'pool_scale': 1.0 + nrm(ks[10], (DEPTH, D_POOL), 0.02),
        'hg_norm_w': 1.0 + nrm(ks[11], (DEPTH, HG_WIDTH), 0.02),
        'lb_logits': nrm(ks[12], (2, DEPTH, HG_WIDTH), 0.1),
        'w_branch_pool': nrm(ks[13], (DEPTH, D_POOL, D), D_POOL ** -0.5),
        'w_branch_hgrn': nrm(ks[14], (DEPTH, HG_WIDTH, D), HG_WIDTH ** -0.5),
        'w_out': nrm(ks[15], (DEPTH, D, D), D ** -0.5),
        'w_router': nrm(ks[16], (D, N_EXPERTS), D ** -0.5),
        'router_bias': nrm(ks[17], (N_EXPERTS,), 0.01),
        'w_e1': nrm(ks[18], (DEPTH, N_EXPERTS, D, D_EXPERT), D ** -0.5),
        'w_e3': nrm(ks[19], (DEPTH, N_EXPERTS, D, D_EXPERT), D ** -0.5),
        'w_e2': nrm(ks[20], (DEPTH, N_EXPERTS, D_EXPERT, D), D_EXPERT ** -0.5),
        'final_norm_w': 1.0 + nrm(ks[21], (D,), 0.02),
    }


def reference(x, c, ctx, c_ctx, w_ada, b_ada, norm1_w, norm2_w, w_in, w_pool_group, pool_scale,
              hg_norm_w, lb_logits, w_branch_pool, w_branch_hgrn, w_out, w_router, router_bias,
              w_e1, w_e3, w_e2, final_norm_w):
    b, n, d = x.shape
    sc = jax.nn.silu(c)
    scc = jax.nn.silu(c_ctx)
    lbw = jax.nn.softmax(lb_logits.astype(jnp.float32), axis=1)
    lb = jnp.cumsum(lbw, axis=1) - lbw[:, :1]
    xl, xc = x, ctx
    for i in range(DEPTH):
        last = i == DEPTH - 1
        mod_l = jnp.split((sc @ w_ada[i] + b_ada[i])[:, None, :], 6, axis=-1)
        mod_c = jnp.split(scc @ w_ada[i] + b_ada[i], 6, axis=-1)
        hl = rmsnorm(xl, norm1_w[i]) * (1 + mod_l[1]) + mod_l[0]
        hc = rmsnorm(xc, norm1_w[i]) * (1 + mod_c[1]) + mod_c[0]
        yl, yc = token_mixers(hl, hc, w_in[i], w_pool_group[i], pool_scale[i], hg_norm_w[i],
                              lb[0, i], lb[1, i], w_branch_pool[i], w_branch_hgrn[i], w_out[i], not last)
        xl = xl + mod_l[2] * yl
        hl2 = rmsnorm(xl, norm2_w[i]) * (1 + mod_l[4]) + mod_l[3]
        if last:
            f = moe_ffn(hl2.reshape(-1, d), w_router, router_bias, w_e1[i], w_e3[i], w_e2[i])
            xl = xl + mod_l[5] * f.reshape(xl.shape)
        else:
            xc = xc + mod_c[2] * yc
            hc2 = rmsnorm(xc, norm2_w[i]) * (1 + mod_c[4]) + mod_c[3]
            tokens = jnp.concatenate([hl2.reshape(-1, d), hc2.reshape(-1, d)], axis=0)
            f = moe_ffn(tokens, w_router, router_bias, w_e1[i], w_e3[i], w_e2[i])
            xl = xl + mod_l[5] * f[:b * n].reshape(xl.shape)
            xc = xc + mod_c[5] * f[b * n:].reshape(xc.shape)
    return rmsnorm(xl, final_norm_w)
```

```cpp
#include <hip/hip_runtime.h>
#include <cstdio>
#include <cstdint>

#ifndef MK_ONE_LAUNCH
#define MK_ONE_LAUNCH 1
#endif

constexpr int D = 2048, NBATCH = 4, SEQ = 4096, DEPTH = 4, CTXL = 256;
constexpr int NLAT = NBATCH * SEQ, NCTX = NBATCH * CTXL, MTOK = NLAT + NCTX;
constexpr int DPOOL = 1024, HGW = 1024, NHEAD = 8, HDK = 128;
constexpr int INC = 10240;
constexpr int NEXP = 16, DEXP = 512;
constexpr int MAXSLOT = 38912;
constexpr float EPS = 1e-6f;
constexpr int ZC_POOL = 0, ZC_Q = 1024, ZC_FF = 2048, ZC_FB = 3072, ZC_I = 4096, ZC_OG = 5120, ZC_GP = 6144, ZC_GH = 8192;

#define GAS __attribute__((address_space(1)))
#define LAS __attribute__((address_space(3)))
typedef unsigned short bf16_t;
typedef short bf16x8 __attribute__((ext_vector_type(8)));
typedef float f32x4 __attribute__((ext_vector_type(4)));
typedef float f32x2 __attribute__((ext_vector_type(2)));
typedef unsigned u32x4 __attribute__((ext_vector_type(4)));
typedef unsigned u32x2 __attribute__((ext_vector_type(2)));
typedef int i32x4 __attribute__((ext_vector_type(4)));
typedef int i32x8 __attribute__((ext_vector_type(8)));
constexpr float W8_SCALE = 32.f;

constexpr size_t MiB = 1u << 20;
constexpr size_t align_up(size_t x) { return (x + 255) & ~(size_t)255; }
constexpr size_t WS_CTL = 0, CTL_BYTES = 1 * MiB;
constexpr size_t WS_MOD = WS_CTL + CTL_BYTES;
constexpr size_t WS_LB = WS_MOD + align_up((size_t)DEPTH * 5 * 6 * D * 4);
constexpr size_t WS_ROUTE_I = WS_LB + align_up((size_t)DEPTH * 2 * 1024 * 4);
constexpr size_t WS_ROUTE_G = WS_ROUTE_I + align_up((size_t)MTOK * 8);
constexpr size_t WS_SLOTTOK = WS_ROUTE_G + align_up((size_t)MTOK * 8);
constexpr size_t WS_PADBASE = WS_SLOTTOK + align_up((size_t)NEXP * MTOK * 4);
constexpr size_t WS_WIN = WS_PADBASE + align_up((size_t)DEPTH * 16 * 4);
constexpr size_t WS_WPG = WS_WIN + (size_t)DEPTH * INC * D * 2;
constexpr size_t WS_WBP = WS_WPG + (size_t)DEPTH * 1024 * 256 * 2;
constexpr size_t WS_WBH = WS_WBP + (size_t)DEPTH * D * 1024 * 2;
constexpr size_t WS_WOUT = WS_WBH + (size_t)DEPTH * D * 1024 * 2;
constexpr size_t WS_WE13 = WS_WOUT + (size_t)DEPTH * D * D * 2;
constexpr size_t WS_WE2 = WS_WE13 + (size_t)DEPTH * NEXP * 1024 * D * 2;
constexpr size_t WS_X = WS_WE2 + (size_t)DEPTH * NEXP * D * DEXP * 2;
constexpr size_t WS_H = WS_X + (size_t)MTOK * D * 4;
constexpr size_t WS_Z = WS_H + (size_t)MTOK * D * 2;
constexpr size_t WS_ACT = WS_Z;
constexpr size_t WS_Y2 = WS_ACT + (size_t)MAXSLOT * DEXP * 2;
constexpr size_t WS_PD = WS_Z + (size_t)MTOK * INC * 2;
constexpr size_t WS_P = WS_PD + (size_t)MTOK * 1024 * 2;
constexpr size_t WS_HG = WS_P + (size_t)MTOK * 1024 * 2;
constexpr size_t WS_O2 = WS_HG + (size_t)MTOK * 1024 * 2;
constexpr size_t WS_QSG = WS_O2 + (size_t)2 * MTOK * 1024 * 2;
constexpr size_t WS_SMID = WS_QSG + (size_t)64 * 3 * 17 * 17408;
constexpr size_t WS_CORRV = WS_SMID + (size_t)64 * 3 * 128 * 128 * 4;
constexpr size_t WS_TOTSEG = WS_CORRV + (size_t)64 * 3 * 17 * 128 * 4;
static_assert(WS_TOTSEG + (size_t)64 * 4 * 128 * 4 <= WS_O2 + (size_t)2 * MTOK * 1024 * 4, "scan hand-off buffers fit in the O2 region");
constexpr size_t WS_M1 = WS_O2 + (size_t)2 * MTOK * 1024 * 4;
constexpr size_t WS_MX = WS_M1 + (size_t)MTOK * D * 2;
constexpr size_t WS_END = WS_MX + (size_t)MTOK * D * 2;
static_assert(WS_Y2 + (size_t)MAXSLOT * D * 2 <= WS_PD, "ACT|Y2 overlay fits in Z");

constexpr int CW_BAR = 4096;
constexpr int CW_CNT = 16384;

constexpr int LDS_STAGE = 131072;
constexpr int LDS_MISC = 149504;
constexpr int LDS_BYTES = LDS_MISC + 8192;

__device__ __forceinline__ unsigned f2bf(float f) { unsigned u = __builtin_bit_cast(unsigned, f); return (u + 0x7fffu + ((u >> 16) & 1u)) >> 16; }
typedef __bf16 bf16x2_t __attribute__((ext_vector_type(2)));
__device__ __forceinline__ unsigned pk2(float lo, float hi) { const f32x2 v = {lo, hi}; const bf16x2_t b = __builtin_convertvector(v, bf16x2_t); return __builtin_bit_cast(unsigned, b); }
__device__ __forceinline__ float bflo(unsigned w) { return __builtin_bit_cast(float, w << 16); }
__device__ __forceinline__ float bfhi(unsigned w) { return __builtin_bit_cast(float, w & 0xffff0000u); }
__device__ __forceinline__ float bf1(bf16_t h) { return __builtin_bit_cast(float, ((unsigned)h) << 16); }
__device__ __forceinline__ float fsigmoid(float x) { return __builtin_amdgcn_rcpf(1.f + __builtin_amdgcn_exp2f(-1.44269504f * x)); }
__device__ __forceinline__ float fsilu(float x) { return x * fsigmoid(x); }
__device__ __forceinline__ float wave_sum(float v) {
#pragma unroll
    for (int o = 1; o < 64; o <<= 1) v += __shfl_xor(v, o);
    return v;
}
#define LDS_WAIT() asm volatile("s_waitcnt lgkmcnt(0)" ::: "memory")
#define VM_WAIT() asm volatile("s_waitcnt vmcnt(0)" ::: "memory")

__device__ __forceinline__ unsigned pk4_fp8(float a, float b, float c, float d) { int w = 0; w = __builtin_amdgcn_cvt_pk_fp8_f32(a, b, w, false); w = __builtin_amdgcn_cvt_pk_fp8_f32(c, d, w, true); return (unsigned)w; }
constexpr float HG8_SCALE = 4.f, ACT8_SCALE = 4.f;
#define XB_TMO      128
#define XB_XCNT(j)  (256  + 64 * (j))
#define XB_XSUB(j)  (1280 + 64 * (j))
#define XB_XGEN(j)  (2304 + 64 * (j))
#define XB_TOP      3328
#define XB_TOPGEN   3392
#define XCD_BAR_WORDS 3456
#define XB_SPIN_CAP (1u << 18)
__device__ __forceinline__ unsigned xb_ld(unsigned* p)              { return __hip_atomic_load(p, __ATOMIC_RELAXED, __HIP_MEMORY_SCOPE_AGENT); }
__device__ __forceinline__ unsigned xb_add(unsigned* p, unsigned v) { return __hip_atomic_fetch_add(p, v, __ATOMIC_RELAXED, __HIP_MEMORY_SCOPE_AGENT); }
__device__ __forceinline__ unsigned xb_xcc_id() { return (unsigned)__builtin_amdgcn_s_getreg((3 << 11) | 20) & 0xFu; }
#define XB_SPIN(cond, bar) do { unsigned _sp = 0; while (cond) { __builtin_amdgcn_s_sleep(1); \
    if ((++_sp & 255u) == 0u) { if (xb_ld(&(bar)[XB_TMO])) break; if (_sp > XB_SPIN_CAP) { atomicAdd(&(bar)[XB_TMO], 1u); break; } } } } while (0)
struct XcdBarrier { unsigned* bar; unsigned x; volatile LAS unsigned* st; };
__device__ __forceinline__ XcdBarrier xcd_barrier_post(unsigned* bar, volatile LAS unsigned* st) {
    XcdBarrier b; b.bar = bar; b.x = xb_xcc_id(); b.st = st;
    if (threadIdx.x == 0) (void)xb_add(&bar[XB_XCNT(b.x)], 1u);
    return b;
}
__device__ __forceinline__ void xcd_barrier_complete(unsigned* bar, unsigned x, unsigned& nloc, unsigned& nx) {
    const unsigned G = gridDim.x * gridDim.y * gridDim.z;
    unsigned sum, cnt, mine, sp = 0u;
    for (;;) {
        sum = 0u; cnt = 0u; mine = 0u;
#pragma unroll
        for (unsigned j = 0; j < 16; ++j) { const unsigned c = xb_ld(&bar[XB_XCNT(j)]); sum += c; cnt += (c > 0u) ? 1u : 0u; mine = (j == x) ? c : mine; }
        if (sum == G) break;
        __builtin_amdgcn_s_sleep(1);
        if ((++sp & 255u) == 0u) { if (xb_ld(&bar[XB_TMO])) break; if (sp > XB_SPIN_CAP) { atomicAdd(&bar[XB_TMO], 1u); break; } }
    }
    nloc = mine > 0u ? mine : 1u; nx = cnt > 0u ? cnt : 1u;
}
__device__ __forceinline__ void xcd_barrier(const XcdBarrier& b) {
    asm volatile("s_waitcnt vmcnt(0)" ::: "memory");
    __syncthreads();
    if (threadIdx.x == 0) {
        unsigned* bar = b.bar;
        __builtin_amdgcn_s_waitcnt(0);
        unsigned nloc = b.st[0], nx = b.st[1];
        if (nloc == 0u) { xcd_barrier_complete(bar, b.x, nloc, nx); b.st[0] = nloc; b.st[1] = nx; }
        const unsigned old = xb_add(&bar[XB_XSUB(b.x)], 1u);
        const unsigned gen = old / nloc;
        if (old + 1u == (gen + 1u) * nloc) {
            __builtin_amdgcn_fence(__ATOMIC_RELEASE, "agent");
            asm volatile("s_waitcnt vmcnt(0)" ::: "memory");
            const unsigned og = xb_add(&bar[XB_TOP], 1u);
            const unsigned tg = og / nx;
            if (og + 1u == (tg + 1u) * nx) xb_add(&bar[XB_TOPGEN], 1u);
            else XB_SPIN(xb_ld(&bar[XB_TOPGEN]) == tg, bar);
            __builtin_amdgcn_fence(__ATOMIC_ACQUIRE, "agent");
            xb_add(&bar[XB_XGEN(b.x)], 1u);
            asm volatile("s_waitcnt vmcnt(0)" ::: "memory");
        } else {
            XB_SPIN(xb_ld(&bar[XB_XGEN(b.x)]) == gen, bar);
            __builtin_amdgcn_fence(__ATOMIC_ACQUIRE, "agent");
            asm volatile("s_waitcnt vmcnt(0)" ::: "memory");
        }
    }
    __syncthreads();
}

namespace pg8 {
constexpr int BM = 256, BK = 64, HALF = 128, HTB = HALF * BK * 2, NXCD = 8, WGM = 8;
__host__ __device__ __forceinline__ int lds_byte(int r, int c) { const int st = (r >> 4) * 2 + (c >> 5), rr = r & 15, cc = c & 31, ob = rr * 64 + cc * 2; return st * 1024 + (ob ^ (((ob >> 9) & 1) << 5)); }
__host__ __device__ __forceinline__ void stage_rc(int b, int& R, int& C) { const int st = b / 1024, sb = b % 1024, swz = sb ^ (((sb >> 9) & 1) << 5); R = (st >> 1) * 16 + swz / 64; C = (st & 1) * 32 + (swz % 64) / 2; }
__host__ __device__ __forceinline__ int perm32(int rho) { const int n = rho >> 4, i = rho & 15; return 8 * (i >> 2) + 4 * n + (i & 3); }

struct Unit { int pm, pn; };

struct DenseOrder {
    static constexpr bool GATHER = false;
    int nM, nN, nwg, G, c, lda_b, acol_b;
    __device__ void init(int M, int N, int G_, int c_, int lda_b_, int acol_b_) { nM = M / BM; nN = N / BM; nwg = nM * nN; G = G_; c = c_; lda_b = lda_b_; acol_b = acol_b_; }
    __device__ __forceinline__ bool next(int i, Unit& u) const {
        const long L = (long)i * G + c; if (L >= nwg) return false;
        int wgid = (int)L; { const int q = nwg / NXCD, r = nwg % NXCD, xcd = wgid % NXCD, off = wgid / NXCD; wgid = (xcd < r ? xcd * (q + 1) : r * (q + 1) + (xcd - r) * q) + off; }
        const int nig = WGM * nN, gid = wgid / nig, fm = gid * WGM, gsz = (nM - fm) < WGM ? (nM - fm) : WGM;
        u.pm = fm + ((wgid % nig) % gsz); u.pn = (wgid % nig) / gsz; return true;
    }
    __device__ __forceinline__ size_t a_base(const Unit& u) const { return (size_t)u.pm * BM * lda_b + (size_t)u.pn * acol_b; }
    __device__ __forceinline__ void a_offs(const Unit&, unsigned (&)[2][2]) const {}
    __device__ __forceinline__ size_t b_off(const Unit& u, int ldb_b) const { return (size_t)u.pn * BM * ldb_b; }
};
template <bool GATHER_> struct MoeOrder {
    static constexpr bool GATHER = GATHER_;
    int nN, nunits, G, c, lda_b; const LAS int* tbl;
    const int* slottok; size_t b_estride;
    __device__ __forceinline__ bool next(int i, Unit& u) const {
        const int L = i * G + c; if (L >= nunits) return false;
        u.pm = L / nN; u.pn = L % nN; return true;
    }
    __device__ __forceinline__ size_t a_base(const Unit& u) const { return (size_t)u.pm * BM * lda_b; }
    __device__ __forceinline__ void a_offs(const Unit& u, unsigned (&v)[2][2]) const {
        const int e = __builtin_amdgcn_readfirstlane(tbl[64 + u.pm]), j0 = __builtin_amdgcn_readfirstlane((u.pm - tbl[16 + e]) * BM), cnt = __builtin_amdgcn_readfirstlane(tbl[e]);
#pragma unroll
        for (int i = 0; i < 2; ++i) { int R, C; stage_rc((int)threadIdx.x * 16 + i * 8192, R, C);
#pragma unroll
            for (int h = 0; h < 2; ++h) { const int j = j0 + h * HALF + R; const int tok = (j < cnt) ? slottok[(size_t)e * MTOK + j] : 0; v[h][i] = (unsigned)(tok * lda_b + C * 2); } }
    }
    __device__ __forceinline__ size_t b_off(const Unit& u, int ldb_b) const { const int e = __builtin_amdgcn_readfirstlane(tbl[64 + u.pm]); return (size_t)e * b_estride + (size_t)u.pn * BM * ldb_b; }
};

template <class Epi, class Sched, bool FP8 = false>
__device__ __forceinline__ void gemm_phase(LAS unsigned char* lds, const void* Abase, const int lda_b, const void* Bbase, const int Kb, const int ldb_b, const Sched& S, const Epi& E) {
    constexpr bool GA = Sched::GATHER;
    int tid_ = threadIdx.x; asm volatile("" : "+v"(tid_));
    const int tid = tid_, wid = __builtin_amdgcn_readfirstlane(tid >> 6), lane = tid & 63, wr = wid >> 2, wc = wid & 3, fr = lane & 15, fq = lane >> 4;
    const int nt = Kb / 128;
    unsigned voffA[2], voffB[2];
#pragma unroll
    for (int i = 0; i < 2; ++i) { int R, C; stage_rc(tid * 16 + i * 8192, R, C); const int Rb = Epi::PERM ? ((R & ~31) + perm32(R & 31)) : R; voffA[i] = (unsigned)(R * lda_b + C * 2); voffB[i] = (unsigned)(Rb * ldb_b + C * 2); }
    const size_t kstep = (size_t)(BK * 2);
    const size_t hstepA = (size_t)HALF * lda_b, hstepB = (size_t)HALF * ldb_b;
    const unsigned ldsw = (unsigned)wid * 1024u;
    const int aoff = lds_byte(wr * 64 + fr, fq * 8), boff = lds_byte(wc * 32 + fr, fq * 8);
#define PG8_SA(b, h) (((b) * 2 + (h)) * HTB)
#define PG8_SB(b, h) ((4 + (b) * 2 + (h)) * HTB)
#define PG8_STAGE2(bufoff, gbase, o0, o1) do { \
        __builtin_amdgcn_global_load_lds((const unsigned*)((const char*)(gbase) + (o0)), (LAS unsigned*)(lds + (bufoff) + ldsw), 16, 0, 0); \
        __builtin_amdgcn_global_load_lds((const unsigned*)((const char*)(gbase) + (o1)), (LAS unsigned*)(lds + (bufoff) + ldsw + 8192), 16, 0, 0); } while (0)
#define PG8_STAGEB(bufoff, gbase) PG8_STAGE2(bufoff, gbase, voffB[0], voffB[1])
#define PG8_STAGEA(bufoff, gbase, h, x0, x1) do { if constexpr (GA) PG8_STAGE2(bufoff, gbase, x0, x1); else PG8_STAGE2(bufoff, (gbase) + ((h) ? hstepA : (size_t)0), voffA[0], voffA[1]); } while (0)
#define PG8_LD32(dst, addr) do { const i32x4 lo_ = *(const LAS i32x4*)(lds + (addr)), hi_ = *(const LAS i32x4*)(lds + (addr) + 1024); dst = (i32x8){lo_[0], lo_[1], lo_[2], lo_[3], hi_[0], hi_[1], hi_[2], hi_[3]}; } while (0)
#define PG8_LDA(dst, b, h) do { _Pragma("unroll") for (int m = 0; m < 4; ++m) PG8_LD32(dst[m], PG8_SA(b, h) + aoff + m * 2048); } while (0)
#define PG8_LDB(dst, b, h) do { _Pragma("unroll") for (int n = 0; n < 2; ++n) PG8_LD32(dst[n], PG8_SB(b, h) + boff + n * 2048); } while (0)
#define PG8_HALF(v, k) __builtin_bit_cast(bf16x8, (i32x4){(v)[4 * (k)], (v)[4 * (k) + 1], (v)[4 * (k) + 2], (v)[4 * (k) + 3]})
#define PG8_MMA(ai, bj, At, Bt) do { __builtin_amdgcn_s_setprio(1); \
        if constexpr (FP8) { _Pragma("unroll") for (int m = 0; m < 4; ++m) _Pragma("unroll") for (int n = 0; n < 2; ++n) \
            asm volatile("v_mfma_scale_f32_16x16x128_f8f6f4 %0, %1, %2, %0, %3, %3 op_sel_hi:[0,0,0]" : "+v"(acc[ai][bj][m][n]) : "v"(Bt[n]), "v"(At[m]), "v"(one_scale)); } \
        else { _Pragma("unroll") for (int m = 0; m < 4; ++m) _Pragma("unroll") for (int n = 0; n < 2; ++n) _Pragma("unroll") for (int k = 0; k < 2; ++k) \
            acc[ai][bj][m][n] = __builtin_amdgcn_mfma_f32_16x16x32_bf16(PG8_HALF(Bt[n], k), PG8_HALF(At[m], k), acc[ai][bj][m][n], 0, 0, 0); } \
        __builtin_amdgcn_s_setprio(0); } while (0)
#define PG8_WAIT_V(n) asm volatile("s_waitcnt vmcnt(" #n ")" ::: "memory")
#define PG8_WAIT_L(n) asm volatile("s_waitcnt lgkmcnt(" #n ")" ::: "memory")
#define PG8_BAR __builtin_amdgcn_s_barrier()
#define PG8_SCHED __builtin_amdgcn_sched_barrier(0)
    Unit cur, nxt; int ui = 0;
    if (!S.next(0, cur)) return;
    f32x4 acc[2][2][4][2];
#pragma unroll
    for (int a = 0; a < 2; ++a)
#pragma unroll
        for (int b = 0; b < 2; ++b)
#pragma unroll
            for (int m = 0; m < 4; ++m)
#pragma unroll
                for (int n = 0; n < 2; ++n) acc[a][b][m][n] = (f32x4){0.f, 0.f, 0.f, 0.f};
    int one_scale = 0; if constexpr (FP8) asm volatile("v_mov_b32 %0, 0x7f7f7f7f" : "=v"(one_scale));
    i32x8 At[4], B0[2], B1[2];
    unsigned vA[2][2];
    if constexpr (GA) S.a_offs(cur, vA);
    const char* cA = (const char*)Abase + (GA ? (size_t)0 : S.a_base(cur));
    const char* cB = (const char*)Bbase + S.b_off(cur, ldb_b);
    PG8_STAGEB(PG8_SB(0, 0), cB); PG8_STAGEB(PG8_SB(0, 1), cB + hstepB); PG8_STAGEA(PG8_SA(0, 0), cA, 0, vA[0][0], vA[0][1]); PG8_STAGEA(PG8_SA(0, 1), cA, 1, vA[1][0], vA[1][1]);
    if (wr == 1) PG8_BAR;
    PG8_WAIT_V(2); PG8_BAR;
    PG8_STAGEB(PG8_SB(1, 0), cB + kstep); PG8_STAGEA(PG8_SA(1, 0), cA + kstep, 0, vA[0][0], vA[0][1]); PG8_STAGEB(PG8_SB(1, 1), cB + hstepB + kstep);
    PG8_WAIT_V(6); PG8_BAR;
    for (;;) {
        const bool has_next = S.next(ui + 1, nxt);
        const char* nA = (has_next && !GA) ? (const char*)Abase + S.a_base(nxt) : cA;
        const char* nB = has_next ? (const char*)Bbase + S.b_off(nxt, ldb_b) : cB;
_Pragma("nounroll")
        for (int t = 0; t < nt; t += 2) {
            const bool last = (t == nt - 2);
            const char* a1 = cA + (size_t)(t + 1) * kstep;
            const char* a2 = last ? nA : cA + (size_t)(t + 2) * kstep; const char* b2 = last ? nB : cB + (size_t)(t + 2) * kstep;
            const char* a3 = a2 + kstep; const char* b3 = b2 + kstep;
            PG8_LDB(B0, 0, 0); PG8_LDB(B1, 0, 1); PG8_SCHED; PG8_LDA(At, 0, 0); PG8_STAGEA(PG8_SA(1, 1), a1, 1, vA[1][0], vA[1][1]);
            PG8_WAIT_V(8); PG8_WAIT_L(0); PG8_BAR; PG8_MMA(0, 0, At, B0); PG8_MMA(0, 1, At, B1); PG8_BAR; PG8_SCHED;
            if constexpr (GA) { if (last && has_next) S.a_offs(nxt, vA); }
            PG8_LDA(At, 0, 1); PG8_STAGEB(PG8_SB(0, 0), b2); PG8_STAGEB(PG8_SB(0, 1), b2 + hstepB); PG8_STAGEA(PG8_SA(0, 0), a2, 0, vA[0][0], vA[0][1]);
            PG8_WAIT_V(8); PG8_WAIT_L(0); PG8_BAR; PG8_MMA(1, 0, At, B0); PG8_MMA(1, 1, At, B1); PG8_BAR; PG8_SCHED;
            PG8_LDB(B0, 1, 0); PG8_LDB(B1, 1, 1); PG8_SCHED; PG8_LDA(At, 1, 0); PG8_STAGEA(PG8_SA(0, 1), a2, 1, vA[1][0], vA[1][1]);
            PG8_WAIT_V(8); PG8_WAIT_L(0); PG8_BAR; PG8_MMA(0, 0, At, B0); PG8_MMA(0, 1, At, B1); PG8_BAR; PG8_SCHED;
            PG8_LDA(At, 1, 1); PG8_STAGEB(PG8_SB(1, 0), b3); PG8_STAGEB(PG8_SB(1, 1), b3 + hstepB); PG8_STAGEA(PG8_SA(1, 0), a3, 0, vA[0][0], vA[0][1]);
            PG8_WAIT_V(8); PG8_WAIT_L(0); PG8_BAR; PG8_MMA(1, 0, At, B0); PG8_MMA(1, 1, At, B1); PG8_BAR; PG8_SCHED;
        }
        if constexpr (FP8) asm volatile("s_nop 15\n\ts_nop 15" ::: "memory");
        if (wr == 0) PG8_BAR;
        { int t2_ = threadIdx.x; asm volatile("" : "+v"(t2_)); const int l2_ = t2_ & 63; E(acc, cur, wr, wc, l2_ & 15, l2_ >> 4); }
        if (!has_next) break;
#pragma unroll
        for (int a = 0; a < 2; ++a)
#pragma unroll
            for (int b = 0; b < 2; ++b)
#pragma unroll
                for (int m = 0; m < 4; ++m)
#pragma unroll
                    for (int n = 0; n < 2; ++n) acc[a][b][m][n] = (f32x4){0.f, 0.f, 0.f, 0.f};
        cur = nxt; cA = nA; cB = nB; ++ui;
        if (wr == 1) PG8_BAR;
    }
    PG8_WAIT_V(0);
    PG8_BAR;
#undef PG8_SA
#undef PG8_SB
#undef PG8_STAGE2
#undef PG8_STAGEB
#undef PG8_STAGEA
#undef PG8_LDA
#undef PG8_LD32
#undef PG8_HALF
#undef PG8_LDB
#undef PG8_MMA
#undef PG8_WAIT_V
#undef PG8_WAIT_L
#undef PG8_BAR
#undef PG8_SCHED
}

typedef const f32x4 (&AccRef)[2][2][4][2];
__device__ __forceinline__ u32x4 pack8(const f32x4 v0, const f32x4 v1) { u32x4 w; w.x = pk2(v0[0], v0[1]); w.y = pk2(v0[2], v0[3]); w.z = pk2(v1[0], v1[1]); w.w = pk2(v1[2], v1[3]); return w; }
__device__ __forceinline__ void unpack8(const u32x4 w, f32x4& v0, f32x4& v1) { v0 = (f32x4){bflo(w.x), bfhi(w.x), bflo(w.y), bfhi(w.y)}; v1 = (f32x4){bflo(w.z), bfhi(w.z), bflo(w.w), bfhi(w.w)}; }

struct EpiIn {
    static constexpr bool PERM = true;
    bf16_t* Z; const float* lb;
    __device__ __forceinline__ void operator()(AccRef acc, const Unit& u, int wr, int wc, int fr, int fq) const {
        constexpr float KS = 1.f / W8_SCALE, KE = -1.44269504f / W8_SCALE;
        const int row0 = u.pm * BM + wr * 64 + fr, colt = u.pn * BM, seg = colt >> 10, col0 = colt + wc * 32 + 8 * fq;
        const int mode = (seg == 0 || seg == 4) ? 0 : (seg == 1 || seg == 5) ? 1 : (seg == 2 || seg == 3) ? 2 : 3;
#pragma unroll
        for (int bj = 0; bj < 2; ++bj) {
            f32x4 l0 = (f32x4){0.f, 0.f, 0.f, 0.f}, l1 = l0;
            if (mode == 2) { l0 = *(const f32x4*)(lb + (col0 + bj * HALF - ZC_FF)); l1 = *(const f32x4*)(lb + (col0 + bj * HALF + 4 - ZC_FF)); }
#pragma unroll
            for (int ai = 0; ai < 2; ++ai)
#pragma unroll
                for (int m = 0; m < 4; ++m) { bf16_t* rowp = Z + (size_t)(row0 + ai * HALF + m * 16) * INC + col0 + bj * HALF;
                    f32x4 v0 = acc[ai][bj][m][0], v1 = acc[ai][bj][m][1];
                    if (mode == 0) { v0 = v0 * KS; v1 = v1 * KS; }
                    else { f32x4 s0, s1;
#pragma unroll
                        for (int j = 0; j < 4; ++j) { s0[j] = __builtin_amdgcn_rcpf(1.f + __builtin_amdgcn_exp2f(v0[j] * KE)); s1[j] = __builtin_amdgcn_rcpf(1.f + __builtin_amdgcn_exp2f(v1[j] * KE)); }
                        if (mode == 1) { v0 = v0 * KS * s0; v1 = v1 * KS * s1; }
                        else if (mode == 3) { v0 = s0; v1 = s1; }
                        else {
#pragma unroll
                            for (int j = 0; j < 4; ++j) { v0[j] = __builtin_amdgcn_logf(l0[j] + (1.f - l0[j]) * s0[j]); v1[j] = __builtin_amdgcn_logf(l1[j] + (1.f - l1[j]) * s1[j]); } } }
                    *(u32x4*)rowp = pack8(v0, v1);
                    __builtin_amdgcn_sched_barrier(0); } }
    }
};
struct EpiPool {
    static constexpr bool PERM = true;
    bf16_t* P; const float* scale;
    __device__ __forceinline__ void operator()(AccRef acc, const Unit& u, int wr, int wc, int fr, int fq) const {
        const int row0 = u.pm * BM + wr * 64 + fr, col0 = u.pn * BM + wc * 32 + 8 * fq;
        f32x4 sv[2][2];
#pragma unroll
        for (int bj = 0; bj < 2; ++bj)
#pragma unroll
            for (int n = 0; n < 2; ++n) sv[bj][n] = *(const f32x4*)(scale + col0 + bj * HALF + 4 * n);
#pragma unroll
        for (int ai = 0; ai < 2; ++ai)
#pragma unroll
            for (int m = 0; m < 4; ++m) { bf16_t* rowp = P + (size_t)(row0 + ai * HALF + m * 16) * DPOOL + col0;
#pragma unroll
                for (int bj = 0; bj < 2; ++bj) { const f32x4 r0 = acc[ai][bj][m][0] * sv[bj][0], r1 = acc[ai][bj][m][1] * sv[bj][1];
                    u32x2 o; o.x = pk4_fp8(r0[0], r0[1], r0[2], r0[3]); o.y = pk4_fp8(r1[0], r1[1], r1[2], r1[3]); *(u32x2*)((unsigned char*)P + (size_t)(row0 + ai * HALF + m * 16) * DPOOL + col0 + bj * HALF) = o; } }
    }
};
template <bool ADD, bool OUT8 = false> struct EpiGate {
    static constexpr bool PERM = true;
    bf16_t* O; const bf16_t* prev; const bf16_t* Z; int gcol; float ascale;
    __device__ __forceinline__ void operator()(AccRef acc, const Unit& u, int wr, int wc, int fr, int fq) const {
        const int row0 = u.pm * BM + wr * 64 + fr, col0 = u.pn * BM + wc * 32 + 8 * fq;
#pragma unroll
        for (int ai = 0; ai < 2; ++ai)
#pragma unroll
            for (int m = 0; m < 4; ++m) { const size_t row = (size_t)(row0 + ai * HALF + m * 16);
#pragma unroll
                for (int bj = 0; bj < 2; ++bj) {
                    const u32x4 gw = *(const u32x4*)(Z + row * INC + gcol + col0 + bj * HALF); f32x4 g0, g1; unpack8(gw, g0, g1);
                    f32x4 r0 = acc[ai][bj][m][0] * ascale * g0, r1 = acc[ai][bj][m][1] * ascale * g1;
                    if (ADD) { const u32x4 pw = *(const u32x4*)(prev + row * D + col0 + bj * HALF); f32x4 p0, p1; unpack8(pw, p0, p1); r0 += p0; r1 += p1; }
                    if (OUT8) { int w0 = 0, w1 = 0; w0 = __builtin_amdgcn_cvt_pk_fp8_f32(r0[0], r0[1], w0, false); w0 = __builtin_amdgcn_cvt_pk_fp8_f32(r0[2], r0[3], w0, true);
                        w1 = __builtin_amdgcn_cvt_pk_fp8_f32(r1[0], r1[1], w1, false); w1 = __builtin_amdgcn_cvt_pk_fp8_f32(r1[2], r1[3], w1, true);
                        u32x2 o; o.x = (unsigned)w0; o.y = (unsigned)w1; *(u32x2*)((unsigned char*)O + row * D + col0 + bj * HALF) = o; }
                    else *(u32x4*)(O + row * D + col0 + bj * HALF) = pack8(r0, r1); } }
    }
};
struct EpiOut {
    static constexpr bool PERM = true;
    bf16_t* X; const void* src_lat; const void* src_ctx; bool src_f32; const float* modl; float ascale;
    __device__ __forceinline__ void operator()(AccRef acc, const Unit& u, int wr, int wc, int fr, int fq) const {
        const int row0 = u.pm * BM + wr * 64 + fr, col0 = u.pn * BM + wc * 32 + 8 * fq;
        const int mrow = u.pm < 64 ? (u.pm >> 4) : 4;
        const float* g = modl + (size_t)mrow * 6 * D + 2 * D;
        const bool lat = u.pm < 64;
#pragma unroll
        for (int bj = 0; bj < 2; ++bj) { const int col = col0 + bj * HALF;
            const f32x4 g0 = *(const f32x4*)(g + col) * ascale, g1 = *(const f32x4*)(g + col + 4) * ascale;
#pragma unroll
            for (int ai = 0; ai < 2; ++ai)
#pragma unroll
                for (int m = 0; m < 4; ++m) { const int row = row0 + ai * HALF + m * 16; f32x4 s0, s1;
                    if (src_f32) { const float* sp = (lat ? (const float*)src_lat + (size_t)row * D : (const float*)src_ctx + (size_t)(row - NLAT) * D) + col; s0 = *(const f32x4*)sp; s1 = *(const f32x4*)(sp + 4); }
                    else unpack8(*(const u32x4*)((const bf16_t*)src_lat + (size_t)row * D + col), s0, s1);
                    *(u32x4*)(X + (size_t)row * D + col) = pack8(s0 + g0 * acc[ai][bj][m][0], s1 + g1 * acc[ai][bj][m][1]); } }
    }
};
struct EpiMoe1 {
    static constexpr bool PERM = true;
    bf16_t* ACT;
    __device__ __forceinline__ void operator()(AccRef acc, const Unit& u, int wr, int wc, int fr, int fq) const {
        const int row0 = u.pm * BM + wr * 64 + fr, col0 = u.pn * HALF + wc * 32 + 8 * fq;
        constexpr float KS = 1.f / W8_SCALE, KB = ACT8_SCALE / W8_SCALE;
#pragma unroll
        for (int ai = 0; ai < 2; ++ai)
#pragma unroll
            for (int m = 0; m < 4; ++m) { f32x4 r[2];
#pragma unroll
                for (int n = 0; n < 2; ++n)
#pragma unroll
                    for (int j = 0; j < 4; ++j) r[n][j] = __builtin_amdgcn_fmed3f(fsilu(acc[ai][0][m][n][j] * KS) * (acc[ai][1][m][n][j] * KB), -440.f, 440.f);
                u32x2 o; o.x = pk4_fp8(r[0][0], r[0][1], r[0][2], r[0][3]); o.y = pk4_fp8(r[1][0], r[1][1], r[1][2], r[1][3]);
                *(u32x2*)((unsigned char*)ACT + (size_t)(row0 + ai * HALF + m * 16) * DEXP + col0) = o; }
    }
};
struct EpiNone {
    static constexpr bool PERM = true;
    __device__ __forceinline__ void operator()(AccRef acc, const Unit&, int, int, int, int) const {
#pragma unroll
        for (int ai = 0; ai < 2; ++ai)
#pragma unroll
            for (int bj = 0; bj < 2; ++bj)
#pragma unroll
                for (int m = 0; m < 4; ++m)
#pragma unroll
                    for (int n = 0; n < 2; ++n) asm volatile("" :: "v"(acc[ai][bj][m][n]));
    }
};
struct EpiPlain {
    static constexpr bool PERM = true;
    bf16_t* O; int ldc; float ascale;
    __device__ __forceinline__ void operator()(AccRef acc, const Unit& u, int wr, int wc, int fr, int fq) const {
        const int row0 = u.pm * BM + wr * 64 + fr, col0 = u.pn * BM + wc * 32 + 8 * fq;
#pragma unroll
        for (int ai = 0; ai < 2; ++ai)
#pragma unroll
            for (int m = 0; m < 4; ++m) { bf16_t* rowp = O + (size_t)(row0 + ai * HALF + m * 16) * ldc + col0;
#pragma unroll
                for (int bj = 0; bj < 2; ++bj) *(u32x4*)(rowp + bj * HALF) = pack8(acc[ai][bj][m][0] * ascale, acc[ai][bj][m][1] * ascale); }
    }
};
}

struct Args { const float* in[22]; float* out; unsigned char* ws; int ph_lo, ph_hi, rep, pad; };
enum { I_X = 0, I_C, I_CTX, I_CCTX, I_WADA, I_BADA, I_N1W, I_N2W, I_WIN, I_WPG, I_PSCALE, I_HGNW, I_LBLOG, I_WBP, I_WBH, I_WOUT, I_WROUTER, I_RBIAS, I_WE1, I_WE3, I_WE2, I_FNW };

struct Frame {
    LAS unsigned char* lds;
    int tid, lane, wave, G, gw, NGW;
    unsigned char* ws;
};

__device__ __forceinline__ void transpose_item(const float* W, int K, int N, int k0, int n0, bf16_t* WT, size_t dst_row0, LAS float* scr, int lane) {
    float wv[32];
#pragma unroll
    for (int i = 0; i < 32; ++i) { const int kk = 2 * i + (lane >> 5); wv[i] = __builtin_nontemporal_load(W + (size_t)(k0 + kk) * N + n0 + (lane & 31)); }
#pragma unroll
    for (int i = 0; i < 32; ++i) { const int kk = 2 * i + (lane >> 5); scr[kk * 33 + (lane & 31)] = wv[i]; }
    LDS_WAIT(); asm volatile("" ::: "memory");
    const int c = lane & 7;
#pragma unroll
    for (int j = 0; j < 4; ++j) { const int n = (lane >> 3) + 8 * j; const LAS float* s = scr + (8 * c) * 33 + n;
        u32x4 o; o.x = pk2(s[0 * 33], s[1 * 33]); o.y = pk2(s[2 * 33], s[3 * 33]); o.z = pk2(s[4 * 33], s[5 * 33]); o.w = pk2(s[6 * 33], s[7 * 33]);
        *(u32x4*)(WT + (dst_row0 + n) * K + k0 + 8 * c) = o; }
    LDS_WAIT(); asm volatile("" ::: "memory");
}
__device__ __forceinline__ void transpose_item_fp8(const float* W, int K, int N, int k0, int n0, unsigned char* WT, size_t dst_row0, LAS float* scr, int lane) {
    float wv[32];
#pragma unroll
    for (int i = 0; i < 32; ++i) { const int kk = 2 * i + (lane >> 5); wv[i] = __builtin_nontemporal_load(W + (size_t)(k0 + kk) * N + n0 + (lane & 31)); }
#pragma unroll
    for (int i = 0; i < 32; ++i) { const int kk = 2 * i + (lane >> 5); scr[kk * 33 + (lane & 31)] = wv[i] * W8_SCALE; }
    LDS_WAIT(); asm volatile("" ::: "memory");
    const int c = lane & 7;
#pragma unroll
    for (int j = 0; j < 4; ++j) { const int n = (lane >> 3) + 8 * j; const LAS float* sp = scr + (8 * c) * 33 + n;
        int w0 = 0, w1 = 0; w0 = __builtin_amdgcn_cvt_pk_fp8_f32(sp[0 * 33], sp[1 * 33], w0, false); w0 = __builtin_amdgcn_cvt_pk_fp8_f32(sp[2 * 33], sp[3 * 33], w0, true);
        w1 = __builtin_amdgcn_cvt_pk_fp8_f32(sp[4 * 33], sp[5 * 33], w1, false); w1 = __builtin_amdgcn_cvt_pk_fp8_f32(sp[6 * 33], sp[7 * 33], w1, true);
        u32x2 o; o.x = (unsigned)w0; o.y = (unsigned)w1;
        *(u32x2*)(WT + (dst_row0 + n) * K + k0 + 8 * c) = o; }
    LDS_WAIT(); asm volatile("" ::: "memory");
}
__device__ __forceinline__ void transpose_family(Frame& F, const float* W, int mats, int K, int N, bf16_t* WT, int mode, int& itbase, int it_lo, int it_step) {
    const int nblk = N / 32, kblk = K / 64, per = nblk * kblk, total = mats * per;
    LAS float* scr = (LAS float*)(F.lds + F.wave * 16384);
    int first = (it_lo - itbase) % it_step; if (first < 0) first += it_step;
    for (int it = first; it < total; it += it_step) {
        const int mat = it / per, r = it % per, kb = r / nblk, nb = r % nblk, n0 = 32 * nb, k0 = 64 * kb;
        size_t dst_row0; bf16_t* dstm;
        if (mode == 3) { transpose_item_fp8(W + (size_t)mat * K * N, K, N, k0, n0, (unsigned char*)WT + (size_t)mat * N * K, n0, scr, F.lane); continue; }
        if (mode == 4 || mode == 5) { transpose_item_fp8(W + (size_t)mat * K * N, K, N, k0, n0, (unsigned char*)WT + (size_t)mat * 1024 * K, (size_t)(n0 >> 7) * 256 + (mode == 5 ? 128 : 0) + (n0 & 127), scr, F.lane); continue; }
        if (mode == 0) { dstm = WT + (size_t)mat * N * K; dst_row0 = n0; }
        else { dstm = WT + (size_t)mat * 1024 * K; dst_row0 = (size_t)(n0 >> 7) * 256 + (mode == 2 ? 128 : 0) + (n0 & 127); }
        transpose_item(W + (size_t)mat * K * N, K, N, k0, n0, dstm, dst_row0, scr, F.lane);
    }
    itbase += total;
}

struct ConvJob { const float* src; unsigned char* dst; int N; };
__device__ __forceinline__ ConvJob conv_decode(const Args& a, unsigned char* ws, int L, int s, int lane) {
    const float* W; unsigned char* T; int K, N, t, map = 0, lk, ln;
    if (s < 20480) { t = s; W = a.in[I_WIN] + (size_t)L * D * INC; T = ws + WS_WIN + (size_t)L * INC * D; K = D; N = INC; lk = 7; ln = 8; }
    else if (s < 22528) { t = s - 20480; W = a.in[I_WBP] + (size_t)L * 1024 * D; T = ws + WS_WBP + (size_t)L * D * 1024; K = 1024; N = D; lk = 6; ln = 5; }
    else if (s < 24576) { t = s - 22528; W = a.in[I_WBH] + (size_t)L * 1024 * D; T = ws + WS_WBH + (size_t)L * D * 1024; K = 1024; N = D; lk = 6; ln = 5; }
    else if (s < 28672) { t = s - 24576; W = a.in[I_WOUT] + (size_t)L * D * D; T = ws + WS_WOUT + (size_t)L * D * D; K = D; N = D; lk = 7; ln = 5; }
    else if (s < 45056) { t = s - 28672; W = a.in[I_WE1] + (size_t)L * NEXP * D * DEXP; T = ws + WS_WE13 + (size_t)L * NEXP * 1024 * D; K = D; N = DEXP; map = 1; lk = 7; ln = 3; }
    else if (s < 61440) { t = s - 45056; W = a.in[I_WE3] + (size_t)L * NEXP * D * DEXP; T = ws + WS_WE13 + (size_t)L * NEXP * 1024 * D; K = D; N = DEXP; map = 2; lk = 7; ln = 3; }
    else { t = s - 61440; W = a.in[I_WE2] + (size_t)L * NEXP * DEXP * D; T = ws + WS_WE2 + (size_t)L * NEXP * D * DEXP; K = DEXP; N = D; lk = 5; ln = 5; }
    const int kb = t & ((1 << lk) - 1), nb = (t >> lk) & ((1 << ln) - 1), mat = t >> (lk + ln);
    const int n = nb * 64 + lane, k0 = kb * 16;
    const size_t drow = map ? (size_t)mat * 1024 + (size_t)(n >> 7) * 256 + (map == 2 ? 128 : 0) + (n & 127) : (size_t)mat * N + n;
    ConvJob J; J.src = W + (size_t)mat * K * N + (size_t)k0 * N + n; J.dst = T + drow * K + k0; J.N = N; return J;
}
constexpr int CONV_ITEMS = 77824;
__device__ __forceinline__ void convert_range(Frame& F, const Args& a, int L, int lo, int hi, int rank, int n) {
    if (rank < 0 || L >= DEPTH || F.G != 256) return;
    for (int s0 = lo + (rank * 8 + F.wave) * 2; s0 < hi; s0 += n * 16) {
        const bool has2 = s0 + 1 < hi;
        const ConvJob J0 = conv_decode(a, F.ws, L, s0, F.lane), J1 = conv_decode(a, F.ws, L, has2 ? s0 + 1 : s0, F.lane);
        float v0[16], v1[16];
#pragma unroll
        for (int i = 0; i < 16; ++i) { v0[i] = __builtin_nontemporal_load(J0.src + (size_t)i * J0.N); v1[i] = __builtin_nontemporal_load(J1.src + (size_t)i * J1.N); }
        u32x4 o; o.x = pk4_fp8(v0[0] * W8_SCALE, v0[1] * W8_SCALE, v0[2] * W8_SCALE, v0[3] * W8_SCALE); o.y = pk4_fp8(v0[4] * W8_SCALE, v0[5] * W8_SCALE, v0[6] * W8_SCALE, v0[7] * W8_SCALE);
        o.z = pk4_fp8(v0[8] * W8_SCALE, v0[9] * W8_SCALE, v0[10] * W8_SCALE, v0[11] * W8_SCALE); o.w = pk4_fp8(v0[12] * W8_SCALE, v0[13] * W8_SCALE, v0[14] * W8_SCALE, v0[15] * W8_SCALE);
        *(u32x4*)J0.dst = o;
        if (has2) { o.x = pk4_fp8(v1[0] * W8_SCALE, v1[1] * W8_SCALE, v1[2] * W8_SCALE, v1[3] * W8_SCALE); o.y = pk4_fp8(v1[4] * W8_SCALE, v1[5] * W8_SCALE, v1[6] * W8_SCALE, v1[7] * W8_SCALE);
            o.z = pk4_fp8(v1[8] * W8_SCALE, v1[9] * W8_SCALE, v1[10] * W8_SCALE, v1[11] * W8_SCALE); o.w = pk4_fp8(v1[12] * W8_SCALE, v1[13] * W8_SCALE, v1[14] * W8_SCALE, v1[15] * W8_SCALE);
            *(u32x4*)J1.dst = o; }
    }
}
__device__ __forceinline__ void idle_rank(int nunits, int G, int c, int& rank, int& n) {
    const int rem = nunits % G;
    if (rem == 0 || G - rem < 64) { rank = c; n = G; } else { rank = c >= rem ? c - rem : -1; n = G - rem; }
}

__device__ __forceinline__ void phase_prologue(Frame& F, const Args& a) {
    unsigned char* ws = F.ws;
    int itbase = 0; const int nl = (F.G == 256) ? 0 : DEPTH;
    convert_range(F, a, 0, 0, CONV_ITEMS, (int)blockIdx.x, F.G);
    transpose_family(F, a.in[I_WIN], nl, D, INC, (bf16_t*)(ws + WS_WIN), 3, itbase, F.gw, F.NGW);
    transpose_family(F, a.in[I_WPG], DEPTH * 4, 256, 256, (bf16_t*)(ws + WS_WPG), 0, itbase, F.gw, F.NGW);
    transpose_family(F, a.in[I_WBP], nl, 1024, D, (bf16_t*)(ws + WS_WBP), 3, itbase, F.gw, F.NGW);
    transpose_family(F, a.in[I_WBH], nl, 1024, D, (bf16_t*)(ws + WS_WBH), 3, itbase, F.gw, F.NGW);
    transpose_family(F, a.in[I_WOUT], nl, D, D, (bf16_t*)(ws + WS_WOUT), 3, itbase, F.gw, F.NGW);
    transpose_family(F, a.in[I_WE1], nl * NEXP, D, DEXP, (bf16_t*)(ws + WS_WE13), 4, itbase, F.gw, F.NGW);
    transpose_family(F, a.in[I_WE3], nl * NEXP, D, DEXP, (bf16_t*)(ws + WS_WE13), 5, itbase, F.gw, F.NGW);
    transpose_family(F, a.in[I_WE2], nl * NEXP, DEXP, D, (bf16_t*)(ws + WS_WE2), 3, itbase, F.gw, F.NGW);
    if (blockIdx.x == 0) {
        const float* lg = a.in[I_LBLOG]; float* LB = (float*)(ws + WS_LB);
        for (int i = F.tid; i < 2 * 1024; i += 512) { const int dir = i >> 10, ch = i & 1023;
            float l[DEPTH], mx = -1e30f;
#pragma unroll
            for (int j = 0; j < DEPTH; ++j) { l[j] = lg[((size_t)dir * DEPTH + j) * 1024 + ch]; mx = fmaxf(mx, l[j]); }
            float s = 0.f;
#pragma unroll
            for (int j = 0; j < DEPTH; ++j) { l[j] = __expf(l[j] - mx); s += l[j]; }
            float cum = 0.f;
#pragma unroll
            for (int j = 0; j < DEPTH; ++j) { if (j > 0) cum += l[j] / s; LB[((size_t)j * 2 + dir) * 1024 + ch] = cum; } }
    }
    __syncthreads();
    {
        LAS float* sv = (LAS float*)F.lds;
        LAS float* red = (LAS float*)(F.lds + 5 * D * 4);
        for (int i = F.tid; i < 5 * D; i += 512) { const int r = i / D, k = i % D; const float v = r < 4 ? a.in[I_C][r * D + k] : a.in[I_CCTX][k]; sv[i] = fsilu(v); }
        __syncthreads();
        const float* wada = a.in[I_WADA]; const float* bada = a.in[I_BADA]; float* MOD = (float*)(ws + WS_MOD);
        constexpr int JB = 6 * D / 192;
        const int cg = F.tid % 48, kg = F.tid / 48;
        for (int it = blockIdx.x; it < DEPTH * JB; it += F.G) {
            const int layer = it / JB, j0 = (it % JB) * 192;
            if (kg < 10) {
                const float* w = wada + (size_t)layer * D * 6 * D + j0 + 4 * cg;
                f32x4 acc[5];
#pragma unroll
                for (int r = 0; r < 5; ++r) acc[r] = (f32x4){0.f, 0.f, 0.f, 0.f};
#pragma unroll 8
                for (int k = kg; k < D; k += 10) { const f32x4 wv = *(const f32x4*)(w + (size_t)k * 6 * D);
#pragma unroll
                    for (int r = 0; r < 5; ++r) acc[r] += wv * sv[r * D + k]; }
#pragma unroll
                for (int r = 0; r < 5; ++r) *(LAS f32x4*)(red + (kg * 5 + r) * 192 + 4 * cg) = acc[r];
            }
            __syncthreads();
            for (int o = F.tid; o < 5 * 192; o += 512) { const int r = o / 192, jj = o % 192; float t = bada[(size_t)layer * 6 * D + j0 + jj];
#pragma unroll
                for (int q = 0; q < 10; ++q) t += red[(q * 5 + r) * 192 + jj];
                MOD[((size_t)layer * 5 + r) * 6 * D + j0 + jj] = t; }
            __syncthreads();
        }
    }
    __syncthreads();
}

__device__ __forceinline__ void wave_rows(const Frame& F, int M, int& r0, int& r1) { r0 = (int)(((long)F.gw * M) / F.NGW); r1 = (int)(((long)(F.gw + 1) * M) / F.NGW); }
__device__ __forceinline__ int mod_row(int r) { return r < NLAT ? (r >> 12) : 4; }

__device__ __forceinline__ void xrow_load(const bf16_t* X, int r, int lane, f32x4 (&x)[8]) { const u32x2* xr = (const u32x2*)(X + (size_t)r * D) + lane;
#pragma unroll
    for (int j = 0; j < 8; ++j) { const u32x2 w = xr[64 * j]; x[j] = (f32x4){bflo(w.x), bfhi(w.x), bflo(w.y), bfhi(w.y)}; } }
__device__ __forceinline__ void xrow_store(bf16_t* X, int r, int lane, const f32x4 (&x)[8]) { u32x2* xr = (u32x2*)(X + (size_t)r * D) + lane;
#pragma unroll
    for (int j = 0; j < 8; ++j) { u32x2 w; w.x = pk2(x[j][0], x[j][1]); w.y = pk2(x[j][2], x[j][3]); xr[64 * j] = w; } }
template <int NR>
__device__ __forceinline__ void moe_combine_rows(f32x4 (&x)[NR][8], const int (&r)[NR], int lane, const unsigned char* ws, int player, const float* mod5) {
    const int* pb = (const int*)(ws + WS_PADBASE) + player * 16; const bf16_t* Y2 = (const bf16_t*)(ws + WS_Y2);
    int2 ri[NR]; float2 rg[NR]; const u32x2* y0[NR]; const u32x2* y1[NR];
#pragma unroll
    for (int q = 0; q < NR; ++q) { ri[q] = ((const int2*)(ws + WS_ROUTE_I))[r[q]]; rg[q] = ((const float2*)(ws + WS_ROUTE_G))[r[q]]; }
#pragma unroll
    for (int q = 0; q < NR; ++q) { const int s0 = pb[ri[q].x >> 20] + (ri[q].x & 0xfffff), s1 = pb[ri[q].y >> 20] + (ri[q].y & 0xfffff);
        y0[q] = (const u32x2*)(Y2 + (size_t)s0 * D) + lane; y1[q] = (const u32x2*)(Y2 + (size_t)s1 * D) + lane; }
#pragma unroll
    for (int j = 0; j < 8; ++j) { const f32x4 g = *((const f32x4*)mod5 + 64 * j + lane);
#pragma unroll
        for (int q = 0; q < NR; ++q) { const u32x2 a = y0[q][64 * j], b = y1[q][64 * j];
            const f32x4 ya = (f32x4){bflo(a.x), bfhi(a.x), bflo(a.y), bfhi(a.y)}, yb = (f32x4){bflo(b.x), bfhi(b.x), bflo(b.y), bfhi(b.y)};
            x[q][j] += g * (ya * rg[q].x + yb * rg[q].y); } }
}
__device__ __forceinline__ float row_sumsq(const f32x4 (&x)[8]) { float ss = 0.f;
#pragma unroll
    for (int j = 0; j < 8; ++j) ss += (x[j][0] * x[j][0] + x[j][1] * x[j][1]) + (x[j][2] * x[j][2] + x[j][3] * x[j][3]);
    return ss; }

__device__ __forceinline__ void phase_norm1(Frame& F, const Args& a, int layer, bool combine) {
    unsigned char* ws = F.ws; bf16_t* X = (bf16_t*)(ws + WS_X); bf16_t* H = (bf16_t*)(ws + WS_H);
    const float* MOD = (const float*)(ws + WS_MOD); const float* nw = a.in[I_N1W] + (size_t)layer * D;
    int r0, r1; wave_rows(F, MTOK, r0, r1);
    int curb = -1; f32x4 av[8], sv[8];
    for (int r = r0; r < r1;) {
        const int b = mod_row(r);
        const bool two = (r + 1 < r1) && (mod_row(r + 1) == b);
        const int rr[2] = {r, two ? r + 1 : r};
        if (b != curb) { curb = b; const float* m = MOD + ((size_t)layer * 5 + b) * 6 * D;
#pragma unroll
            for (int j = 0; j < 8; ++j) { const f32x4 w = *((const f32x4*)nw + 64 * j + F.lane), m1 = *((const f32x4*)(m + D) + 64 * j + F.lane); av[j] = w * (m1 + 1.f); sv[j] = *((const f32x4*)m + 64 * j + F.lane); } }
        f32x4 x[2][8];
#pragma unroll
        for (int q = 0; q < 2; ++q) {
            if (layer == 0) { const float* xs = rr[q] < NLAT ? a.in[I_X] + (size_t)rr[q] * D : a.in[I_CTX] + (size_t)(rr[q] - NLAT) * D;
                const f32x4* xr = (const f32x4*)xs + F.lane;
#pragma unroll
                for (int j = 0; j < 8; ++j) x[q][j] = xr[64 * j]; }
            else xrow_load(X, rr[q], F.lane, x[q]); }
        if (combine) { moe_combine_rows<2>(x, rr, F.lane, ws, layer - 1, MOD + ((size_t)(layer - 1) * 5 + b) * 6 * D + 5 * D);
#pragma unroll
            for (int q = 0; q < 2; ++q) if (q == 0 || two) xrow_store(X, rr[q], F.lane, x[q]); }
        float ss0 = row_sumsq(x[0]), ss1 = row_sumsq(x[1]);
#pragma unroll
        for (int o = 1; o < 64; o <<= 1) { ss0 += __shfl_xor(ss0, o); ss1 += __shfl_xor(ss1, o); }
        const float rs[2] = {1.0f / sqrtf(ss0 * (1.f / D) + EPS), 1.0f / sqrtf(ss1 * (1.f / D) + EPS)};
#pragma unroll
        for (int q = 0; q < 2; ++q) if (q == 0 || two) { unsigned* ho = (unsigned*)((unsigned char*)H + (size_t)rr[q] * D) + F.lane;
#pragma unroll
            for (int j = 0; j < 8; ++j) { const f32x4 h = x[q][j] * rs[q] * av[j] + sv[j]; int w = 0; w = __builtin_amdgcn_cvt_pk_fp8_f32(h[0], h[1], w, false); w = __builtin_amdgcn_cvt_pk_fp8_f32(h[2], h[3], w, true); ho[64 * j] = (unsigned)w; } }
        r += two ? 2 : 1;
    }
}

constexpr int RT_LCNT = LDS_MISC + 1024, RT_LBASE = LDS_MISC + 1088, RT_REC = LDS_MISC + 2048;
__device__ __forceinline__ float reduce16(const float (&s)[16], int lane) {
    float a8[8], a4[4], a2[2];
    { const bool hi = lane & 32;
#pragma unroll
      for (int e = 0; e < 8; ++e) { const float snd = hi ? s[e] : s[e + 8], kp = hi ? s[e + 8] : s[e]; a8[e] = kp + __shfl_xor(snd, 32); } }
    { const bool hi = lane & 16;
#pragma unroll
      for (int e = 0; e < 4; ++e) { const float snd = hi ? a8[e] : a8[e + 4], kp = hi ? a8[e + 4] : a8[e]; a4[e] = kp + __shfl_xor(snd, 16); } }
    { const bool hi = lane & 8;
#pragma unroll
      for (int e = 0; e < 2; ++e) { const float snd = hi ? a4[e] : a4[e + 2], kp = hi ? a4[e + 2] : a4[e]; a2[e] = kp + __shfl_xor(snd, 8); } }
    float v; { const bool hi = lane & 4; const float snd = hi ? a2[0] : a2[1], kp = hi ? a2[1] : a2[0]; v = kp + __shfl_xor(snd, 4); }
    v += __shfl_xor(v, 2); v += __shfl_xor(v, 1);
    return v;
}
struct Route { int i1, i2; float g1, g2; };
__device__ __forceinline__ Route route_row(const float (&lg)[NEXP], const float* rbias) {
    float sc[NEXP], sel[NEXP];
#pragma unroll
    for (int e = 0; e < NEXP; ++e) { sc[e] = __builtin_amdgcn_rcpf(1.f + __builtin_amdgcn_exp2f(-1.44269504f * lg[e])); sel[e] = sc[e] + rbias[e]; }
    float gsc[4];
#pragma unroll
    for (int g = 0; g < 4; ++g) { float m1 = -1e30f, m2 = -1e30f;
#pragma unroll
        for (int i = 0; i < 4; ++i) { const float v = sel[g * 4 + i]; const bool c1 = v > m1, c2 = v > m2; m2 = c1 ? m1 : (c2 ? v : m2); m1 = c1 ? v : m1; }
        gsc[g] = m1 + m2; }
    int gbest = 0; float gbs = gsc[0];
#pragma unroll
    for (int g = 1; g < 4; ++g) { const bool c = gsc[g] > gbs; gbest = c ? g : gbest; gbs = c ? gsc[g] : gbs; }
    float sl[4], sx[4];
#pragma unroll
    for (int i = 0; i < 4; ++i) { sl[i] = gbest == 0 ? sel[i] : gbest == 1 ? sel[4 + i] : gbest == 2 ? sel[8 + i] : sel[12 + i]; sx[i] = gbest == 0 ? sc[i] : gbest == 1 ? sc[4 + i] : gbest == 2 ? sc[8 + i] : sc[12 + i]; }
    int i1 = 0, i2 = 0; float v1 = -1e30f, v2 = -1e30f, s1 = 0.f, s2 = 0.f;
#pragma unroll
    for (int i = 0; i < 4; ++i) { const float v = sl[i]; const bool c1 = v > v1, c2 = v > v2;
        i2 = c1 ? i1 : (c2 ? i : i2); s2 = c1 ? s1 : (c2 ? sx[i] : s2); v2 = c1 ? v1 : (c2 ? v : v2);
        i1 = c1 ? i : i1; s1 = c1 ? sx[i] : s1; v1 = c1 ? v : v1; }
    const float inv = __builtin_amdgcn_rcpf(s1 + s2);
    Route R; R.i1 = gbest * 4 + i1; R.i2 = gbest * 4 + i2; R.g1 = s1 * inv; R.g2 = s2 * inv; return R;
}
constexpr int RT_STRIDE = 4112;
constexpr int RT_WB = 0, RT_HT = 16 * RT_STRIDE, RT_PART = 32 * RT_STRIDE;
static_assert(RT_PART + 8192 <= LDS_MISC, "router LDS map");
__device__ __forceinline__ void phase_norm2_router(Frame& F, const Args& a, int layer, int Mrows, bool publish) {
    unsigned char* ws = F.ws; const bf16_t* X = (const bf16_t*)(ws + WS_X); bf16_t* H = (bf16_t*)(ws + WS_H);
    const float* MOD = (const float*)(ws + WS_MOD); const float* nw = a.in[I_N2W] + (size_t)layer * D;
    LAS unsigned char* L = F.lds;
    const int brow0 = 2 * (int)(((long)blockIdx.x * (Mrows >> 1)) / F.G), brow1 = 2 * (int)(((long)(blockIdx.x + 1) * (Mrows >> 1)) / F.G);
    const int nround = (brow1 - brow0 + 15) >> 4;
    u32x2 xn[2][8];
#define RT_ISSUE(t_) { const int r_ = brow0 + 16 * (t_) + 2 * F.wave; const int ra_ = r_ < brow1 ? r_ : brow0, rb_ = r_ + 1 < brow1 ? r_ + 1 : brow0; \
        const u32x2* pa_ = (const u32x2*)(X + (size_t)ra_ * D) + F.lane; const u32x2* pb_ = (const u32x2*)(X + (size_t)rb_ * D) + F.lane; \
        _Pragma("unroll") for (int j = 0; j < 8; ++j) { xn[0][j] = pa_[64 * j]; xn[1][j] = pb_[64 * j]; } }
    RT_ISSUE(0)
    { const f32x4* wr4 = (const f32x4*)a.in[I_WROUTER];
#pragma unroll 1
      for (int i = 0; i < 2; ++i) { const int k = 2 * F.tid + 1024 * i; f32x4 wv[2][4];
#pragma unroll
          for (int h = 0; h < 2; ++h)
#pragma unroll
              for (int q = 0; q < 4; ++q) wv[h][q] = wr4[(size_t)(k + h) * 4 + q];
#pragma unroll
          for (int q = 0; q < 4; ++q)
#pragma unroll
              for (int ii = 0; ii < 4; ++ii) *(LAS unsigned*)(L + RT_WB + (4 * q + ii) * RT_STRIDE + k * 2) = pk2(wv[0][q][ii], wv[1][q][ii]); } }
    LAS unsigned* lcnt = (LAS unsigned*)(F.lds + RT_LCNT); LAS unsigned* lbase = (LAS unsigned*)(F.lds + RT_LBASE);
    if (F.tid < 16) lcnt[F.tid] = 0u;
    __syncthreads();
    const float* rbias = a.in[I_RBIAS];
    const int fr = F.lane & 15, fq = F.lane >> 4;
#pragma unroll 1
    for (int t = 0; t < nround; ++t) {
        const int r = brow0 + 16 * t + 2 * F.wave;
        const bool v0 = r < brow1, v1 = r + 1 < brow1;
        const int rr[2] = {v0 ? r : brow0, v1 ? r + 1 : brow0};
        const int b = mod_row(rr[0]);
        const float* m = MOD + ((size_t)layer * 5 + b) * 6 * D;
        f32x4 x[2][8];
#pragma unroll
        for (int q = 0; q < 2; ++q)
#pragma unroll
            for (int j = 0; j < 8; ++j) { const u32x2 w = xn[q][j]; x[q][j] = (f32x4){bflo(w.x), bfhi(w.x), bflo(w.y), bfhi(w.y)}; }
        float ss0 = row_sumsq(x[0]), ss1 = row_sumsq(x[1]);
#pragma unroll
        for (int o = 1; o < 64; o <<= 1) { ss0 += __shfl_xor(ss0, o); ss1 += __shfl_xor(ss1, o); }
        const float rs[2] = {1.0f / sqrtf(ss0 * (1.f / D) + EPS), 1.0f / sqrtf(ss1 * (1.f / D) + EPS)};
#pragma unroll
        for (int q = 0; q < 2; ++q) {
#pragma unroll
            for (int j = 0; j < 8; ++j) { const f32x4 w = *((const f32x4*)nw + 64 * j + F.lane), m4 = *((const f32x4*)(m + 4 * D) + 64 * j + F.lane), m3 = *((const f32x4*)(m + 3 * D) + 64 * j + F.lane);
                x[q][j] = x[q][j] * rs[q] * (w * (m4 + 1.f)) + m3; }
            if (q == 0 ? v0 : v1) { unsigned* ho = (unsigned*)((unsigned char*)H + (size_t)rr[q] * D) + F.lane;
#pragma unroll
                for (int j = 0; j < 8; ++j) ho[64 * j] = pk4_fp8(x[q][j][0], x[q][j][1], x[q][j][2], x[q][j][3]); }
            LAS unsigned char* hrow = L + RT_HT + (2 * F.wave + q) * RT_STRIDE + F.lane * 8;
#pragma unroll
            for (int j = 0; j < 8; ++j) { u32x2 w; w.x = pk2(x[q][j][0], x[q][j][1]); w.y = pk2(x[q][j][2], x[q][j][3]); *(LAS u32x2*)(hrow + j * 512) = w; } }
        __syncthreads();
        if (t + 1 < nround) RT_ISSUE(t + 1)
        f32x4 acc = (f32x4){0.f, 0.f, 0.f, 0.f};
#pragma unroll
        for (int s = 0; s < 8; ++s) { const int kb = (256 * F.wave + 32 * s + 8 * fq) * 2;
            const bf16x8 wa = *(const LAS bf16x8*)(L + RT_WB + fr * RT_STRIDE + kb), hb = *(const LAS bf16x8*)(L + RT_HT + fr * RT_STRIDE + kb);
            acc = __builtin_amdgcn_mfma_f32_16x16x32_bf16(wa, hb, acc, 0, 0, 0); }
        *(LAS f32x4*)(L + RT_PART + F.wave * 1024 + fr * 64 + fq * 16) = acc;
        __syncthreads();
        if (F.lane < 2) { const int tr = 2 * F.wave + F.lane;
            f32x4 sg[4] = {(f32x4){0.f, 0.f, 0.f, 0.f}, (f32x4){0.f, 0.f, 0.f, 0.f}, (f32x4){0.f, 0.f, 0.f, 0.f}, (f32x4){0.f, 0.f, 0.f, 0.f}};
#pragma unroll
            for (int w8 = 0; w8 < 8; ++w8)
#pragma unroll
                for (int c = 0; c < 4; ++c) sg[c] += *(const LAS f32x4*)(L + RT_PART + w8 * 1024 + tr * 64 + c * 16);
            float lg[NEXP];
#pragma unroll
            for (int e = 0; e < NEXP; ++e) lg[e] = sg[e >> 2][e & 3];
            const Route R = route_row(lg, rbias); const int i1 = R.i1, i2 = R.i2; const float g1 = R.g1, g2 = R.g2;
            if ((F.lane == 0 ? v0 : v1) && publish) {
                const unsigned k1 = __hip_atomic_fetch_add(lcnt + i1, 1u, __ATOMIC_RELAXED, __HIP_MEMORY_SCOPE_WORKGROUP), k2 = __hip_atomic_fetch_add(lcnt + i2, 1u, __ATOMIC_RELAXED, __HIP_MEMORY_SCOPE_WORKGROUP);
                LAS unsigned* rec = (LAS unsigned*)(F.lds + RT_REC + (r + F.lane - brow0) * 32);
                rec[0] = (unsigned)i1; rec[1] = k1; rec[2] = (unsigned)i2; rec[3] = k2; rec[4] = __builtin_bit_cast(unsigned, g1); rec[5] = __builtin_bit_cast(unsigned, g2);
            } }
    }
    __syncthreads();
    if (F.tid < 16 && publish) { unsigned* cntw = (unsigned*)(ws + WS_CTL) + CW_CNT + layer * 1024; const unsigned n = lcnt[F.tid]; lbase[F.tid] = n ? atomicAdd(cntw + F.tid * 64, n) : 0u; }
    __syncthreads();
    if (F.tid < brow1 - brow0 && publish) { const int r = brow0 + F.tid; const LAS unsigned* rec = (const LAS unsigned*)(F.lds + RT_REC + F.tid * 32);
        const unsigned i1 = rec[0], i2 = rec[2], k1 = lbase[i1] + rec[1], k2 = lbase[i2] + rec[3];
        int* slottok = (int*)(ws + WS_SLOTTOK); slottok[(size_t)i1 * MTOK + k1] = r; slottok[(size_t)i2 * MTOK + k2] = r;
        ((int2*)(ws + WS_ROUTE_I))[r] = make_int2((int)((i1 << 20) | k1), (int)((i2 << 20) | k2));
        ((float2*)(ws + WS_ROUTE_G))[r] = make_float2(__builtin_bit_cast(float, rec[4]), __builtin_bit_cast(float, rec[5])); }
    __syncthreads();
}

__device__ __forceinline__ void phase_pooldiff(Frame& F, int Mrows) {
    unsigned char* ws = F.ws; const bf16_t* Z = (const bf16_t*)(ws + WS_Z); bf16_t* PD = (bf16_t*)(ws + WS_PD);
    LAS unsigned char* L = F.lds;
    const int cg = F.tid & 127, rq = F.tid >> 7, hw = 1 << (cg >> 5);
    const int ntile = NLAT / 64 + (Mrows > NLAT ? NCTX / 32 : 0);
    for (int tile = blockIdx.x; tile < ntile; tile += F.G) {
        int base, Lrow, t0, nt;
        if (tile < NLAT / 64) { base = tile * 64; Lrow = 64; t0 = 0; nt = 64; }
        else { const int u = tile - NLAT / 64; base = NLAT + (u >> 3) * CTXL; Lrow = CTXL; t0 = (u & 7) * 32; nt = 32; }
        const int lo = max(t0 - 8, 0), hi = min(t0 + nt + 7, Lrow - 1), nrow = hi - lo + 1;
        u32x4 buf[16];
#pragma unroll
        for (int i = 0; i < 16; ++i) { const int sl = rq + 4 * i; buf[i] = (sl < nrow) ? *(const u32x4*)(Z + (size_t)(base + lo + sl) * INC + ZC_POOL + cg * 8) : (u32x4){0u, 0u, 0u, 0u}; }
#pragma unroll
        for (int i = 0; i < 16; ++i) { const int sl = rq + 4 * i; *(LAS u32x4*)(L + sl * 2048 + cg * 16) = buf[i]; }
        __syncthreads();
        for (int i = 0; i < nt / 4; ++i) { const int t = t0 + rq + 4 * i;
            const int wl = max(t - hw, 0), wh = min(t + hw - 1, Lrow - 1);
            float s[8] = {0.f, 0.f, 0.f, 0.f, 0.f, 0.f, 0.f, 0.f};
            for (int p = wl; p <= wh; ++p) { const u32x4 a = *(const LAS u32x4*)(L + (p - lo) * 2048 + cg * 16);
                s[0] += bflo(a.x); s[1] += bfhi(a.x); s[2] += bflo(a.y); s[3] += bfhi(a.y); s[4] += bflo(a.z); s[5] += bfhi(a.z); s[6] += bflo(a.w); s[7] += bfhi(a.w); }
            const float inv = 1.f / (float)(wh - wl + 1);
            const u32x4 a = *(const LAS u32x4*)(L + (t - lo) * 2048 + cg * 16);
            u32x4 o; o.x = pk2(s[0] * inv - bflo(a.x), s[1] * inv - bfhi(a.x)); o.y = pk2(s[2] * inv - bflo(a.y), s[3] * inv - bfhi(a.y));
            o.z = pk2(s[4] * inv - bflo(a.z), s[5] * inv - bfhi(a.z)); o.w = pk2(s[6] * inv - bflo(a.w), s[7] * inv - bfhi(a.w));
            *(u32x4*)(PD + (size_t)(base + t) * DPOOL + cg * 8) = o; }
        __syncthreads();
    }
}

constexpr int SC_QS = 0, SC_KS = 17408, SC_KST = 34816, SC_VT = 53248, SC_VEC = 71680;
constexpr int SC_ST = 73216, SC_TOT = SC_ST + 34816, SC_END = SC_TOT + 4096;
constexpr int SC_P272 = 272, SC_P144 = 144;
constexpr int SEG_CH = 17, NSEG = 4;
static_assert(SC_END <= LDS_MISC, "scan LDS map");
struct ScanCtx { const bf16_t* Z; bf16_t* O2; LAS unsigned char* L; unsigned char* qsg; float* corrv; float* smid; float* totseg; int tid, lane, w, fr, fq, rt, vp, b, h, seg, dir, colq, colf, colv; };
__device__ __forceinline__ void scan_row0(int b, int dir, int c, int& g0, int& sg) {
    if (c < 4) { const int t0 = 64 * c; g0 = NLAT + b * CTXL + (dir ? CTXL - 1 - t0 : t0); } else { const int t0 = 64 * (c - 4); g0 = b * SEQ + (dir ? SEQ - 1 - t0 : t0); }
    sg = dir ? -1 : 1;
}
__device__ __forceinline__ void scan_load_lf(const ScanCtx& C, int c, unsigned (&lfw)[8]) {
    int g0, sg; scan_row0(C.b, C.dir, c, g0, sg);
#pragma unroll
    for (int j = 0; j < 8; ++j) lfw[j] = *(const unsigned*)(C.Z + (size_t)(g0 + sg * (8 * C.w + j)) * INC + C.colf);
}
__device__ __forceinline__ void scan_load_qv(const ScanCtx& C, int c, unsigned (&qw)[8], unsigned (&vw)[8]) {
    int g0, sg; scan_row0(C.b, C.dir, c, g0, sg);
#pragma unroll
    for (int j = 0; j < 8; ++j) { const bf16_t* zr = C.Z + (size_t)(g0 + sg * (8 * C.w + j)) * INC; qw[j] = *(const unsigned*)(zr + C.colq); vw[j] = *(const unsigned*)(zr + C.colv); }
}
__device__ __forceinline__ void scan_p1(const ScanCtx& C, const unsigned (&lfw)[8]) {
    float a0 = 0.f, a1 = 0.f;
#pragma unroll
    for (int j = 0; j < 8; ++j) { a0 += bflo(lfw[j]); a1 += bfhi(lfw[j]); }
    *(LAS f32x2*)(C.L + SC_TOT + (C.w * 128 + 2 * C.lane) * 4) = (f32x2){a0, a1};
}
__device__ __forceinline__ void scan_p2(const ScanCtx& C, int cl, const unsigned (&lfw)[8], const unsigned (&qw)[8], const unsigned (&vw)[8], float& cum0, float& cum1) {
    LAS unsigned char* L = C.L; const int lane = C.lane, w = C.w;
    float c0[8], c1[8], l0[8], l1[8];
    { float a0 = 0.f, a1 = 0.f;
#pragma unroll
      for (int j = 0; j < 8; ++j) { l0[j] = bflo(lfw[j]); l1[j] = bfhi(lfw[j]); a0 += l0[j]; a1 += l1[j]; c0[j] = a0; c1[j] = a1; } }
    float P0 = 0.f, P1 = 0.f, r0 = 0.f, r1 = 0.f, bl0 = 0.f, bl1 = 0.f;
#pragma unroll
    for (int o = 0; o < 8; ++o) { const f32x2 t = *(const LAS f32x2*)(L + SC_TOT + (o * 128 + 2 * lane) * 4);
        if (o < w) { P0 += t.x; P1 += t.y; } if (o < 4) { r0 += t.x; r1 += t.y; } bl0 += t.x; bl1 += t.y; }
    float k0v[8], k1v[8]; const float P0r = P0 - r0, P1r = P1 - r1;
#pragma unroll
    for (int j = 0; j < 8; ++j) {
        const float d0 = __builtin_amdgcn_fmed3f(P0r + c0[j], -120.f, 120.f), d1 = __builtin_amdgcn_fmed3f(P1r + c1[j], -120.f, 120.f);
        const float E0 = __builtin_amdgcn_exp2f(d0), E1 = __builtin_amdgcn_exp2f(d1), I0 = __builtin_amdgcn_exp2f(-d0), I1 = __builtin_amdgcn_exp2f(-d1);
        const float f0 = __builtin_amdgcn_exp2f(l0[j]), f1 = __builtin_amdgcn_exp2f(l1[j]);
        const float q0 = bflo(qw[j]), q1 = bfhi(qw[j]);
        k0v[j] = (1.f - f0) * I0; k1v[j] = (1.f - f1) * I1;
        const int rho = 8 * w + j;
        *(LAS unsigned*)(L + SC_QS + rho * SC_P272 + 4 * lane) = pk2(q0 * E0, q1 * E1);
        *(LAS unsigned*)(L + SC_KS + rho * SC_P272 + 4 * lane) = pk2(k0v[j], k1v[j]);
    }
    { u32x4 t0, t1; t0.x = pk2(k0v[0], k0v[1]); t0.y = pk2(k0v[2], k0v[3]); t0.z = pk2(k0v[4], k0v[5]); t0.w = pk2(k0v[6], k0v[7]);
      t1.x = pk2(k1v[0], k1v[1]); t1.y = pk2(k1v[2], k1v[3]); t1.z = pk2(k1v[4], k1v[5]); t1.w = pk2(k1v[6], k1v[7]);
      *(LAS u32x4*)(L + SC_KST + (2 * lane) * SC_P144 + 16 * w) = t0; *(LAS u32x4*)(L + SC_KST + (2 * lane + 1) * SC_P144 + 16 * w) = t1; }
    if (w == 0) {
        LAS float* vec = (LAS float*)(L + SC_VEC);
        *(LAS f32x2*)(vec + 2 * lane) = (f32x2){__builtin_amdgcn_exp2f(fmaxf(r0, -120.f)), __builtin_amdgcn_exp2f(fmaxf(r1, -120.f))};
        *(LAS f32x2*)(vec + 128 + 2 * lane) = (f32x2){__builtin_amdgcn_exp2f(fmaxf(bl0, -120.f)), __builtin_amdgcn_exp2f(fmaxf(bl1, -120.f))};
        *(LAS f32x2*)(vec + 256 + 2 * lane) = (f32x2){__builtin_amdgcn_exp2f(fmaxf(bl0 - r0, -120.f)), __builtin_amdgcn_exp2f(fmaxf(bl1 - r1, -120.f))};
        if (C.seg >= 1) *(f32x2*)(C.corrv + cl * 128 + 2 * lane) = (f32x2){r0 + cum0, r1 + cum1};
    }
    cum0 += bl0; cum1 += bl1;
    { u32x4 t0, t1;
      t0.x = (vw[0] & 0xffffu) | (vw[1] << 16); t0.y = (vw[2] & 0xffffu) | (vw[3] << 16); t0.z = (vw[4] & 0xffffu) | (vw[5] << 16); t0.w = (vw[6] & 0xffffu) | (vw[7] << 16);
      t1.x = (vw[0] >> 16) | (vw[1] & 0xffff0000u); t1.y = (vw[2] >> 16) | (vw[3] & 0xffff0000u); t1.z = (vw[4] >> 16) | (vw[5] & 0xffff0000u); t1.w = (vw[6] >> 16) | (vw[7] & 0xffff0000u);
      *(LAS u32x4*)(L + SC_VT + (2 * lane) * SC_P144 + 16 * w) = t0; *(LAS u32x4*)(L + SC_VT + (2 * lane + 1) * SC_P144 + 16 * w) = t1; }
}
__device__ __forceinline__ void scan_c1(const ScanCtx& C, const f32x4 (&S)[2][4]) {
#pragma unroll
    for (int i = 0; i < 2; ++i) { const int k = ((C.w >> 1) * 2 + i) * 16 + 4 * C.fq;
        f32x4 r = *(const LAS f32x4*)(C.L + SC_TOT + k * 4);
#pragma unroll
        for (int o = 1; o < 4; ++o) r += *(const LAS f32x4*)(C.L + SC_TOT + (o * 128 + k) * 4);
        f32x4 e;
#pragma unroll
        for (int q = 0; q < 4; ++q) e[q] = __builtin_amdgcn_exp2f(fmaxf(r[q], -120.f));
#pragma unroll
        for (int u = 0; u < 4; ++u) { const int v = (4 * C.vp + u) * 16 + C.fr; const f32x4 sv = S[i][u] * e;
            u32x2 t; t.x = pk2(sv[0], sv[1]); t.y = pk2(sv[2], sv[3]); *(LAS u32x2*)(C.L + SC_ST + v * SC_P272 + k * 2) = t; } }
}
__device__ __forceinline__ void scan_c2(const ScanCtx& C, int c, f32x4 (&S)[2][4]) {
    LAS unsigned char* L = C.L; const int fr = C.fr, fq = C.fq, rt = C.rt, w = C.w;
    bf16x8 yq[4];
#pragma unroll
    for (int ks = 0; ks < 4; ++ks) yq[ks] = *(const LAS bf16x8*)(L + SC_QS + (rt * 16 + fr) * SC_P272 + (ks * 32 + fq * 8) * 2);
    f32x4 at[4];
#pragma unroll
    for (int st = 0; st < 4; ++st) { f32x4 a = (f32x4){0.f, 0.f, 0.f, 0.f};
        if (st <= rt) {
#pragma unroll
            for (int ks = 0; ks < 4; ++ks) { const bf16x8 x = *(const LAS bf16x8*)(L + SC_KS + (st * 16 + fr) * SC_P272 + (ks * 32 + fq * 8) * 2); a = __builtin_amdgcn_mfma_f32_16x16x32_bf16(x, yq[ks], a, 0, 0, 0); }
            if (st == rt) {
#pragma unroll
                for (int r = 0; r < 4; ++r) if (4 * fq + r > fr) a[r] = 0.f; } }
        at[st] = a; }
    u32x4 yw[2];
#pragma unroll
    for (int ks2 = 0; ks2 < 2; ++ks2) { yw[ks2].x = pk2(at[2 * ks2][0], at[2 * ks2][1]); yw[ks2].y = pk2(at[2 * ks2][2], at[2 * ks2][3]); yw[ks2].z = pk2(at[2 * ks2 + 1][0], at[2 * ks2 + 1][1]); yw[ks2].w = pk2(at[2 * ks2 + 1][2], at[2 * ks2 + 1][3]); }
    int g0, sg; scan_row0(C.b, C.dir, c, g0, sg);
#pragma unroll
    for (int u = 0; u < 4; ++u) { const int vt = 4 * C.vp + u; f32x4 o = (f32x4){0.f, 0.f, 0.f, 0.f};
#pragma unroll
        for (int ks = 0; ks < 4; ++ks) { const bf16x8 x = *(const LAS bf16x8*)(L + SC_ST + (vt * 16 + fr) * SC_P272 + (ks * 32 + fq * 8) * 2); o = __builtin_amdgcn_mfma_f32_16x16x32_bf16(x, yq[ks], o, 0, 0, 0); }
#pragma unroll
        for (int ks2 = 0; ks2 < 2; ++ks2) { if (2 * ks2 <= rt) {
            const u32x2 xa = *(const LAS u32x2*)(L + SC_VT + (vt * 16 + fr) * SC_P144 + (ks2 * 32 + 4 * fq) * 2), xb = *(const LAS u32x2*)(L + SC_VT + (vt * 16 + fr) * SC_P144 + (ks2 * 32 + 16 + 4 * fq) * 2);
            u32x4 xw; xw.x = xa.x; xw.y = xa.y; xw.z = xb.x; xw.w = xb.y;
            o = __builtin_amdgcn_mfma_f32_16x16x32_bf16(__builtin_bit_cast(bf16x8, xw), __builtin_bit_cast(bf16x8, yw[ks2]), o, 0, 0, 0); } }
        u32x2 ow; ow.x = pk2(o[0], o[1]); ow.y = pk2(o[2], o[3]);
        *(u32x2*)(C.O2 + ((size_t)C.dir * MTOK + (g0 + sg * (rt * 16 + fr))) * HGW + C.h * HDK + vt * 16 + 4 * fq) = ow;
        __builtin_amdgcn_sched_barrier(0); }
    bf16x8 xk[2][2];
#pragma unroll
    for (int i = 0; i < 2; ++i)
#pragma unroll
        for (int ks = 0; ks < 2; ++ks) xk[i][ks] = *(const LAS bf16x8*)(L + SC_KST + (((w >> 1) * 2 + i) * 16 + fr) * SC_P144 + (ks * 32 + fq * 8) * 2);
#pragma unroll
    for (int u = 0; u < 4; ++u) { bf16x8 yv[2];
#pragma unroll
        for (int ks = 0; ks < 2; ++ks) yv[ks] = *(const LAS bf16x8*)(L + SC_VT + ((4 * C.vp + u) * 16 + fr) * SC_P144 + (ks * 32 + fq * 8) * 2);
#pragma unroll
        for (int i = 0; i < 2; ++i) { f32x4 d = (f32x4){0.f, 0.f, 0.f, 0.f};
#pragma unroll
            for (int ks = 0; ks < 2; ++ks) d = __builtin_amdgcn_mfma_f32_16x16x32_bf16(xk[i][ks], yv[ks], d, 0, 0, 0);
            const int k = ((w >> 1) * 2 + i) * 16 + 4 * fq; const f32x4 ebl = *(const LAS f32x4*)(L + SC_VEC + (128 + k) * 4), ebr = *(const LAS f32x4*)(L + SC_VEC + (256 + k) * 4);
            S[i][u] = ebl * S[i][u] + ebr * d; }
        __builtin_amdgcn_sched_barrier(0); }
}
__device__ __forceinline__ void phase_scan_mfma(Frame& F) {
    ScanCtx C; C.Z = (const bf16_t*)(F.ws + WS_Z); C.O2 = (bf16_t*)(F.ws + WS_O2); C.L = F.lds;
    C.tid = F.tid; C.lane = F.lane; C.w = F.wave; C.fr = F.lane & 15; C.fq = F.lane >> 4; C.rt = F.wave >> 1; C.vp = F.wave & 1;
    for (int it = blockIdx.x; it < 64 * NSEG; it += F.G) {
        const int sbh = it >> 2; C.h = sbh & 7; C.b = (sbh >> 3) & 3; C.dir = sbh >> 5;
        C.seg = C.dir ? 3 - (it & 3) : (it & 3);
        C.qsg = F.ws + WS_QSG + (size_t)(sbh * 3 + (C.seg - 1)) * SEG_CH * 17408; C.corrv = (float*)(F.ws + WS_CORRV) + (size_t)(sbh * 3 + (C.seg - 1)) * SEG_CH * 128;
        C.smid = (float*)(F.ws + WS_SMID) + (size_t)(sbh * 3 + C.seg) * 128 * 128; C.totseg = (float*)(F.ws + WS_TOTSEG) + (size_t)(sbh * NSEG + C.seg) * 128;
        C.colq = ZC_Q + C.h * HDK + 2 * C.lane; C.colf = (C.dir == 0 ? ZC_FF : ZC_FB) + C.h * HDK + 2 * C.lane; C.colv = ZC_I + C.h * HDK + 2 * C.lane;
        f32x4 S[2][4];
#pragma unroll
        for (int i = 0; i < 2; ++i)
#pragma unroll
            for (int u = 0; u < 4; ++u) S[i][u] = (f32x4){0.f, 0.f, 0.f, 0.f};
        float cum0 = 0.f, cum1 = 0.f;
        unsigned lfW[8], qW[8], vW[8];
        const int c_lo = C.seg * SEG_CH;
        scan_load_lf(C, c_lo, lfW); scan_load_qv(C, c_lo, qW, vW);
        scan_p1(C, lfW);
        __syncthreads();
#define SC_STEP(cl) do { \
            scan_p2(C, (cl), lfW, qW, vW, cum0, cum1); scan_c1(C, S); \
            if ((cl) + 1 < SEG_CH) { scan_load_lf(C, c_lo + (cl) + 1, lfW); scan_load_qv(C, c_lo + (cl) + 1, qW, vW); } \
            __syncthreads(); \
            if (C.seg >= 1) { unsigned char* dst = C.qsg + (size_t)(cl) * 17408; const LAS unsigned char* src = C.L + SC_QS; for (int i_ = C.tid; i_ < 1088; i_ += 512) *(u32x4*)(dst + 16 * i_) = *(const LAS u32x4*)(src + 16 * i_); } \
            scan_c2(C, c_lo + (cl), S); \
            if ((cl) + 1 < SEG_CH) scan_p1(C, lfW); \
            __syncthreads(); } while (0)
        for (int cl = 0; cl < SEG_CH; ++cl) SC_STEP(cl);
#undef SC_STEP
        if (C.seg < 3) {
#pragma unroll
            for (int i = 0; i < 2; ++i)
#pragma unroll
                for (int u = 0; u < 4; ++u) *(f32x4*)(C.smid + ((4 * C.vp + u) * 16 + C.fr) * 128 + ((C.w >> 1) * 2 + i) * 16 + 4 * C.fq) = S[i][u]; }
        if (C.w == 0) *(f32x2*)(C.totseg + 2 * C.lane) = (f32x2){cum0, cum1};
        __syncthreads();
    }
}
__device__ __forceinline__ void phase_scan_fix(Frame& F) {
    unsigned char* ws = F.ws; bf16_t* O2 = (bf16_t*)(ws + WS_O2); LAS unsigned char* L = F.lds;
    LAS float* facv = (LAS float*)(L + 36864); LAS int* flg = (LAS int*)(L + 36864 + 512);
    const int w = F.wave, fr = F.lane & 15, fq = F.lane >> 4, rt = w >> 1, vp = w & 1;
    for (int item = blockIdx.x; item < 64 * 3; item += F.G) {
        const int j = 1 + item % 3, sbh = item / 3, dir = sbh >> 5, b = (sbh >> 3) & 3, h = sbh & 7;
        const int v = F.tid >> 2, k0 = (F.tid & 3) * 32;
        f32x4 sin[8];
        { const float* E = (const float*)(ws + WS_SMID) + ((size_t)(sbh * 3 + 0) * 128 + v) * 128 + k0;
#pragma unroll
          for (int i = 0; i < 8; ++i) sin[i] = *(const f32x4*)(E + 4 * i); }
        for (int jj = 1; jj < j; ++jj) { const float* E = (const float*)(ws + WS_SMID) + ((size_t)(sbh * 3 + jj) * 128 + v) * 128 + k0; const float* T = (const float*)(ws + WS_TOTSEG) + (size_t)(sbh * NSEG + jj) * 128 + k0;
#pragma unroll
            for (int i = 0; i < 8; ++i) { const f32x4 t = *(const f32x4*)(T + 4 * i); f32x4 d;
#pragma unroll
                for (int q = 0; q < 4; ++q) d[q] = __builtin_amdgcn_exp2f(fmaxf(t[q], -200.f));
                sin[i] = d * sin[i] + *(const f32x4*)(E + 4 * i); } }
        for (int cl = 0; cl < SEG_CH; ++cl) {
            if (F.tid == 0) flg[0] = 0;
            __syncthreads();
            if (F.tid < 128) { const float e = ((const float*)(ws + WS_CORRV))[((size_t)(sbh * 3 + (j - 1)) * SEG_CH + cl) * 128 + F.tid]; const float f = __builtin_amdgcn_exp2f(fmaxf(e, -200.f)); facv[F.tid] = f; if (f != 0.f) flg[0] = 1; }
            __syncthreads();
            if (flg[0] != 0) {
#pragma unroll
                for (int i = 0; i < 4; ++i) { const f32x4 a0 = sin[2 * i] * *(const LAS f32x4*)(facv + k0 + 8 * i), a1 = sin[2 * i + 1] * *(const LAS f32x4*)(facv + k0 + 8 * i + 4);
                    u32x4 o; o.x = pk2(a0[0], a0[1]); o.y = pk2(a0[2], a0[3]); o.z = pk2(a1[0], a1[1]); o.w = pk2(a1[2], a1[3]);
                    *(LAS u32x4*)(L + v * SC_P272 + (k0 + 8 * i) * 2) = o; }
                __syncthreads();
                const unsigned char* qs = ws + WS_QSG + ((size_t)(sbh * 3 + (j - 1)) * SEG_CH + cl) * 17408;
                bf16x8 yq[4];
#pragma unroll
                for (int ks = 0; ks < 4; ++ks) yq[ks] = *(const bf16x8*)(qs + (rt * 16 + fr) * SC_P272 + (ks * 32 + fq * 8) * 2);
                int g0, sg; scan_row0(b, dir, j * SEG_CH + cl, g0, sg);
#pragma unroll
                for (int u = 0; u < 4; ++u) { const int vt = 4 * vp + u; f32x4 o = (f32x4){0.f, 0.f, 0.f, 0.f};
#pragma unroll
                    for (int ks = 0; ks < 4; ++ks) { const bf16x8 x = *(const LAS bf16x8*)(L + (vt * 16 + fr) * SC_P272 + (ks * 32 + fq * 8) * 2); o = __builtin_amdgcn_mfma_f32_16x16x32_bf16(x, yq[ks], o, 0, 0, 0); }
                    u32x2* p = (u32x2*)(O2 + ((size_t)dir * MTOK + (g0 + sg * (rt * 16 + fr))) * HGW + h * HDK + vt * 16 + 4 * fq);
                    const u32x2 old = *p; u32x2 nw; nw.x = pk2(bflo(old.x) + o[0], bfhi(old.x) + o[1]); nw.y = pk2(bflo(old.y) + o[2], bfhi(old.y) + o[3]); *p = nw; }
            }
            __syncthreads();
        }
    }
}
__device__ __forceinline__ void phase_readout_naive(Frame& F, const Args& a, int layer, int Mrows) {
    unsigned char* ws = F.ws; const bf16_t* Z = (const bf16_t*)(ws + WS_Z); const float* O2 = (const float*)(ws + WS_O2); bf16_t* HG = (bf16_t*)(ws + WS_HG);
    const float* wn = a.in[I_HGNW] + (size_t)layer * HGW;
    int r0, r1; wave_rows(F, Mrows, r0, r1);
    const int c0 = F.lane * 16;
    float wv[16];
#pragma unroll
    for (int j = 0; j < 16; ++j) wv[j] = wn[c0 + j] * HG8_SCALE;
    for (int rb = r0; rb < r1; rb += 2) {
        const bool two = rb + 1 < r1; const int rr[2] = {rb, two ? rb + 1 : rb};
        u32x2 xw[2][4], yw[2][4]; u32x4 ga[2], gb[2];
#pragma unroll
        for (int q = 0; q < 2; ++q) {
#pragma unroll
            for (int j = 0; j < 4; ++j) { xw[q][j] = *(const u32x2*)((const bf16_t*)O2 + (size_t)rr[q] * HGW + c0 + 4 * j); yw[q][j] = *(const u32x2*)((const bf16_t*)O2 + ((size_t)MTOK + rr[q]) * HGW + c0 + 4 * j); }
            const u32x4* zp = (const u32x4*)(Z + (size_t)rr[q] * INC + ZC_OG + c0); ga[q] = zp[0]; gb[q] = zp[1]; }
#pragma unroll
        for (int q = 0; q < 2; ++q) { if (q == 0 || two) {
            float o[16]; float ss = 0.f;
#pragma unroll
            for (int j = 0; j < 4; ++j) { const f32x4 x = (f32x4){bflo(xw[q][j].x), bfhi(xw[q][j].x), bflo(xw[q][j].y), bfhi(xw[q][j].y)}, y = (f32x4){bflo(yw[q][j].x), bfhi(yw[q][j].x), bflo(yw[q][j].y), bfhi(yw[q][j].y)};
#pragma unroll
                for (int i = 0; i < 4; ++i) { o[4 * j + i] = x[i] + y[i]; ss += o[4 * j + i] * o[4 * j + i]; } }
            ss += __shfl_xor(ss, 1); ss += __shfl_xor(ss, 2); ss += __shfl_xor(ss, 4);
            const float rs = 1.0f / sqrtf(ss * (1.f / HDK) + EPS);
            const float g[16] = {bflo(ga[q].x), bfhi(ga[q].x), bflo(ga[q].y), bfhi(ga[q].y), bflo(ga[q].z), bfhi(ga[q].z), bflo(ga[q].w), bfhi(ga[q].w), bflo(gb[q].x), bfhi(gb[q].x), bflo(gb[q].y), bfhi(gb[q].y), bflo(gb[q].z), bfhi(gb[q].z), bflo(gb[q].w), bfhi(gb[q].w)};
            float y[16];
#pragma unroll
            for (int j = 0; j < 16; ++j) y[j] = o[j] * rs * wv[j] * g[j];
            u32x4 o0; o0.x = pk4_fp8(y[0], y[1], y[2], y[3]); o0.y = pk4_fp8(y[4], y[5], y[6], y[7]); o0.z = pk4_fp8(y[8], y[9], y[10], y[11]); o0.w = pk4_fp8(y[12], y[13], y[14], y[15]);
            *(u32x4*)((unsigned char*)HG + (size_t)rr[q] * HGW + c0) = o0; } }
    }
}

__device__ __forceinline__ void phase_final(Frame& F, const Args& a) {
    unsigned char* ws = F.ws; const bf16_t* X = (const bf16_t*)(ws + WS_X); const float* MOD = (const float*)(ws + WS_MOD); const float* fw = a.in[I_FNW];
    int r0, r1; wave_rows(F, NLAT, r0, r1);
    for (int r = r0; r < r1;) {
        const bool two = (r + 1 < r1) && (mod_row(r + 1) == mod_row(r));
        const int rr[2] = {r, two ? r + 1 : r};
        f32x4 x[2][8];
#pragma unroll
        for (int q = 0; q < 2; ++q) xrow_load(X, rr[q], F.lane, x[q]);
        moe_combine_rows<2>(x, rr, F.lane, ws, DEPTH - 1, MOD + ((size_t)(DEPTH - 1) * 5 + mod_row(r)) * 6 * D + 5 * D);
        float ss0 = row_sumsq(x[0]), ss1 = row_sumsq(x[1]);
#pragma unroll
        for (int o = 1; o < 64; o <<= 1) { ss0 += __shfl_xor(ss0, o); ss1 += __shfl_xor(ss1, o); }
        const float rs[2] = {1.0f / sqrtf(ss0 * (1.f / D) + EPS), 1.0f / sqrtf(ss1 * (1.f / D) + EPS)};
#pragma unroll
        for (int q = 0; q < 2; ++q) if (q == 0 || two) { f32x4* o = (f32x4*)(a.out + (size_t)rr[q] * D) + F.lane;
#pragma unroll
            for (int j = 0; j < 8; ++j) o[64 * j] = x[q][j] * rs[q] * *((const f32x4*)fw + 64 * j + F.lane); }
        r += two ? 2 : 1;
    }
}

__device__ __forceinline__ int moe_tables(Frame& F, int layer) {
    LAS int* tbl = (LAS int*)(F.lds + LDS_MISC + 64);
    const unsigned* cntw = (const unsigned*)(F.ws + WS_CTL) + CW_CNT + layer * 1024;
    if (F.tid < NEXP) tbl[F.tid] = (int)__hip_atomic_load(cntw + F.tid * 64, __ATOMIC_RELAXED, __HIP_MEMORY_SCOPE_AGENT);
    __syncthreads();
    if (F.tid == 0) {
        int blk = 0;
#pragma unroll 1
        for (int e = 0; e < NEXP; ++e) { const int c = tbl[e]; const int nb = (c + 255) >> 8;
            tbl[16 + e] = blk; for (int j = 0; j < nb; ++j) tbl[64 + blk + j] = e;
            if (blockIdx.x == 0) ((int*)(F.ws + WS_PADBASE))[layer * 16 + e] = blk * 256;
            blk += nb; }
        tbl[32] = blk;
    }
    __syncthreads();
    return tbl[32];
}

constexpr int PH_PER_LAYER = 10;
constexpr int N_PHASES = 1 + DEPTH * PH_PER_LAYER + 1;

__global__ void __launch_bounds__(512, 2) mk_fwd(Args args) {
    extern __shared__ __attribute__((aligned(16))) unsigned char lds_raw[];
    Frame F;
    F.lds = (LAS unsigned char*)lds_raw;
    F.tid = threadIdx.x; F.lane = F.tid & 63; F.wave = __builtin_amdgcn_readfirstlane(F.tid >> 6);
    F.G = gridDim.x; F.gw = blockIdx.x * 8 + F.wave; F.NGW = F.G * 8; F.ws = args.ws;
    unsigned char* ws = args.ws;
    volatile LAS unsigned* misc = (volatile LAS unsigned*)(F.lds + LDS_MISC);
    if (F.tid < 16) misc[F.tid] = 0u;
    __syncthreads();
    const int lo = args.ph_lo, hi = args.ph_hi;
#if MK_ONE_LAUNCH
    XcdBarrier bar = xcd_barrier_post((unsigned*)(ws + WS_CTL) + CW_BAR, misc);
#define GRID_BAR() xcd_barrier(bar)
#else
#define GRID_BAR() do {} while (0)
#endif
#ifndef MK_PHMASK
#define MK_PHMASK 0xFFFF
#endif
#define PHON(b) ((MK_PHMASK >> (b)) & 1)
#ifndef MK_REPMASK
#define MK_REPMASK 0
#endif
#define REPS(b) (((args.rep >> (b)) & 1) + 1)
#define IN(k) (lo <= (k) && (k) < hi)
#define LAUNDER() do { int t_ = threadIdx.x; asm volatile("" : "+v"(t_)); F.tid = t_; F.lane = t_ & 63; unsigned char* w_ = args.ws; asm volatile("" : "+s"(w_)); F.ws = w_; ws = w_; } while (0)
#define SEAM(k) do { if (IN(k) && IN((k) + 1)) { GRID_BAR(); if ((args.rep >> 15) & 1) GRID_BAR(); } } while (0)

    if (PHON(0) && IN(0)) { LAUNDER(); for (int rep_ = 0; rep_ < REPS(0); ++rep_) { if (rep_) { VM_WAIT(); __syncthreads(); } phase_prologue(F, args); } }
    SEAM(0);

    for (int layer_ = 0; layer_ < DEPTH; ++layer_) {
        int layer = layer_; asm volatile("" : "+s"(layer));
        const int pb = 1 + layer * PH_PER_LAYER;
        const bool lastl = (layer == DEPTH - 1);
        const int Mr = lastl ? NLAT : MTOK;
        if (PHON(1) && IN(pb + 0)) { LAUNDER(); for (int rep_ = 0; rep_ < REPS(1); ++rep_) { if (rep_) { VM_WAIT(); __syncthreads(); } phase_norm1(F, args, layer, layer > 0 && rep_ == 0); } }
        SEAM(pb + 0);
        if (PHON(2) && IN(pb + 1)) { LAUNDER(); for (int rep_ = 0; rep_ < REPS(2); ++rep_) { if (rep_) { VM_WAIT(); __syncthreads(); }
            pg8::DenseOrder S; S.init(MTOK, INC, F.G, (int)blockIdx.x, D, 0);
            pg8::EpiIn E{(bf16_t*)(ws + WS_Z), (const float*)(ws + WS_LB) + (size_t)layer * 2 * 1024};
            pg8::gemm_phase<pg8::EpiIn, pg8::DenseOrder, true>(F.lds, ws + WS_H, D, ws + WS_WIN + (size_t)layer * INC * D, D, D, S, E);
        } }
        SEAM(pb + 1);
        if (PHON(3) && IN(pb + 2)) { LAUNDER(); for (int rep_ = 0; rep_ < REPS(3); ++rep_) { if (rep_) { VM_WAIT(); __syncthreads(); } phase_pooldiff(F, Mr); __syncthreads(); } { VM_WAIT(); __syncthreads(); phase_scan_mfma(F); GRID_BAR(); LAUNDER(); phase_scan_fix(F); } }
        SEAM(pb + 2);
        if (PHON(4) && IN(pb + 3)) { LAUNDER(); for (int rep_ = 0; rep_ < REPS(4); ++rep_) { if (rep_) { VM_WAIT(); __syncthreads(); }
            pg8::DenseOrder S; S.init(Mr, DPOOL, F.G, (int)blockIdx.x, DPOOL * 2, 512);
            pg8::EpiPool E{(bf16_t*)(ws + WS_P), args.in[I_PSCALE] + (size_t)layer * DPOOL};
            pg8::gemm_phase(F.lds, ws + WS_PD, DPOOL * 2, ws + WS_WPG + (size_t)layer * 1024 * 256 * 2, 512, 512, S, E);
        } }
        if (PHON(4) && IN(pb + 3)) { VM_WAIT(); __syncthreads(); }
        if (PHON(5) && IN(pb + 4)) { LAUNDER(); for (int rep_ = 0; rep_ < REPS(5); ++rep_) { if (rep_) { VM_WAIT(); __syncthreads(); } phase_readout_naive(F, args, layer, Mr); } }
        SEAM(pb + 4);
        if (PHON(6) && IN(pb + 5)) { LAUNDER(); for (int rep_ = 0; rep_ < REPS(6); ++rep_) { if (rep_) { VM_WAIT(); __syncthreads(); }
            pg8::DenseOrder S; S.init(Mr, D, F.G, (int)blockIdx.x, 1024, 0);
            { pg8::EpiGate<false> E{(bf16_t*)(ws + WS_M1), nullptr, (const bf16_t*)(ws + WS_Z), ZC_GP, 1.f / W8_SCALE};
              pg8::gemm_phase<pg8::EpiGate<false>, pg8::DenseOrder, true>(F.lds, ws + WS_P, 1024, ws + WS_WBP + (size_t)layer * D * 1024, 1024, 1024, S, E); }
            VM_WAIT(); __syncthreads();
            { pg8::EpiGate<true, true> E{(bf16_t*)(ws + WS_MX), (const bf16_t*)(ws + WS_M1), (const bf16_t*)(ws + WS_Z), ZC_GH, 1.f / (W8_SCALE * HG8_SCALE)};
              pg8::gemm_phase<pg8::EpiGate<true, true>, pg8::DenseOrder, true>(F.lds, ws + WS_HG, 1024, ws + WS_WBH + (size_t)layer * D * 1024, 1024, 1024, S, E); }
            if (rep_ == 0) { int rk, nn; idle_rank((Mr / 256) * 8, F.G, (int)blockIdx.x, rk, nn); convert_range(F, args, layer + 1, 0, 36000, rk, nn); }
        } }
        SEAM(pb + 5);
        if (PHON(7) && IN(pb + 6)) { LAUNDER(); for (int rep_ = 0; rep_ < REPS(7); ++rep_) { if (rep_) { VM_WAIT(); __syncthreads(); }
            pg8::DenseOrder S; S.init(Mr, D, F.G, (int)blockIdx.x, D, 0);
            pg8::EpiOut E{(bf16_t*)(ws + (rep_ ? WS_O2 : WS_X)), layer == 0 ? (const void*)args.in[I_X] : (const void*)(ws + WS_X), layer == 0 ? (const void*)args.in[I_CTX] : (const void*)(ws + WS_X), layer == 0, (const float*)(ws + WS_MOD) + (size_t)layer * 5 * 6 * D, 1.f / W8_SCALE};
            pg8::gemm_phase<pg8::EpiOut, pg8::DenseOrder, true>(F.lds, ws + WS_MX, D, ws + WS_WOUT + (size_t)layer * D * D, D, D, S, E);
            if (rep_ == 0) { int rk, nn; idle_rank((Mr / 256) * 8, F.G, (int)blockIdx.x, rk, nn); convert_range(F, args, layer + 1, 36000, 52000, rk, nn); }
        } }
        SEAM(pb + 6);
        if (PHON(8) && IN(pb + 7)) { LAUNDER(); for (int rep_ = 0; rep_ < REPS(8); ++rep_) { if (rep_) { VM_WAIT(); __syncthreads(); } phase_norm2_router(F, args, layer, Mr, rep_ == 0); } }
        SEAM(pb + 7);
        if (PHON(9) && IN(pb + 8)) { LAUNDER(); for (int rep_ = 0; rep_ < REPS(9); ++rep_) { if (rep_) { VM_WAIT(); __syncthreads(); }
            const int nblk = moe_tables(F, layer);
            pg8::MoeOrder<true> S; S.nN = 4; S.nunits = nblk * 4; S.G = F.G; S.c = (int)blockIdx.x; S.lda_b = D; S.tbl = (const LAS int*)(F.lds + LDS_MISC + 64);
            S.slottok = (const int*)(ws + WS_SLOTTOK); S.b_estride = (size_t)1024 * D;
            pg8::EpiMoe1 E{(bf16_t*)(ws + WS_ACT)};
            pg8::gemm_phase<pg8::EpiMoe1, pg8::MoeOrder<true>, true>(F.lds, ws + WS_H, D, ws + WS_WE13 + (size_t)layer * NEXP * 1024 * D, D, D, S, E);
            if (rep_ == 0) { int rk, nn; idle_rank(nblk * 4, F.G, (int)blockIdx.x, rk, nn); convert_range(F, args, layer + 1, 52000, 70000, rk, nn); }
        } }
        SEAM(pb + 8);
        if (PHON(10) && IN(pb + 9)) { LAUNDER(); for (int rep_ = 0; rep_ < REPS(10); ++rep_) { if (rep_) { VM_WAIT(); __syncthreads(); }
            const int nblk = moe_tables(F, layer);
            pg8::MoeOrder<false> S; S.nN = 8; S.nunits = nblk * 8; S.G = F.G; S.c = (int)blockIdx.x; S.lda_b = DEXP; S.tbl = (const LAS int*)(F.lds + LDS_MISC + 64);
            S.slottok = nullptr; S.b_estride = (size_t)D * DEXP;
            pg8::EpiPlain E{(bf16_t*)(ws + WS_Y2), D, 1.f / (W8_SCALE * ACT8_SCALE)};
            pg8::gemm_phase<pg8::EpiPlain, pg8::MoeOrder<false>, true>(F.lds, ws + WS_ACT, DEXP, ws + WS_WE2 + (size_t)layer * NEXP * D * DEXP, DEXP, DEXP, S, E);
            if (rep_ == 0) { int rk, nn; idle_rank(nblk * 8, F.G, (int)blockIdx.x, rk, nn); convert_range(F, args, layer + 1, 70000, CONV_ITEMS, rk, nn); }
        } }
        SEAM(pb + 9);
    }
    if (PHON(11) && IN(N_PHASES - 1)) { LAUNDER(); for (int rep_ = 0; rep_ < REPS(11); ++rep_) { if (rep_) { VM_WAIT(); __syncthreads(); } phase_final(F, args); } }
#undef IN
#undef SEAM
}

extern "C" void kernel_launch(void* const* d_in, const int* in_sizes, int n_in, void* d_out, int out_size, void* d_ws, size_t ws_size, hipStream_t stream) {
    static int grid = 0;
    if (grid == 0) {
        if (n_in != 22 || out_size != NLAT * D || ws_size < WS_END) { fprintf(stderr, "kernel_launch: unexpected shapes (n_in %d out %d ws %zu need %zu)\n", n_in, out_size, ws_size, (size_t)WS_END); grid = -1; return; }
        int dev = 0, cus = 0, per_cu = 0;
        if (hipGetDevice(&dev) != hipSuccess || hipDeviceGetAttribute(&cus, hipDeviceAttributeMultiprocessorCount, dev) != hipSuccess) { grid = -1; return; }
        if (hipFuncSetAttribute((const void*)mk_fwd, hipFuncAttributeMaxDynamicSharedMemorySize, LDS_BYTES) != hipSuccess) { fprintf(stderr, "kernel_launch: hipFuncSetAttribute failed\n"); grid = -1; return; }
        if (hipOccupancyMaxActiveBlocksPerMultiprocessor(&per_cu, (const void*)mk_fwd, 512, LDS_BYTES) != hipSuccess || per_cu < 1) fprintf(stderr, "kernel_launch: occupancy query says %d\n", per_cu);
        (void)hipGetLastError();
        grid = cus;
    }
    if (grid < 0) return;
    (void)hipMemsetAsync((char*)d_ws + WS_CTL, 0, CTL_BYTES, stream);
    Args a{};
    for (int i = 0; i < 22; ++i) a.in[i] = (const float*)d_in[i];
    a.out = (float*)d_out; a.ws = (unsigned char*)d_ws; a.rep = MK_REPMASK; a.pad = 0;
#if MK_ONE_LAUNCH
    a.ph_lo = 0; a.ph_hi = N_PHASES;
    hipLaunchKernelGGL(mk_fwd, dim3(grid), dim3(512), LDS_BYTES, stream, a);
#else
    for (int p = 0; p < N_PHASES; ++p) { a.ph_lo = p; a.ph_hi = p + 1; hipLaunchKernelGGL(mk_fwd, dim3(grid), dim3(512), LDS_BYTES, stream, a); }
#endif
}
```

```cpp
#include <hip/hip_runtime.h>
#include <cstdio>
#include <cstdint>

#ifndef MK_ONE_LAUNCH
#define MK_ONE_LAUNCH 1
#endif

constexpr int D = 2048, NBATCH = 4, SEQ = 4096, DEPTH = 4, CTXL = 256;
constexpr int NLAT = NBATCH * SEQ, NCTX = NBATCH * CTXL, MTOK = NLAT + NCTX;
constexpr int DPOOL = 1024, HGW = 1024, NHEAD = 8, HDK = 128;
constexpr int INC = 10240;
constexpr int NEXP = 16, DEXP = 512;
constexpr int MAXSLOT = 38912;
constexpr float EPS = 1e-6f;
constexpr int ZC_POOL = 0, ZC_Q = 1024, ZC_FF = 2048, ZC_FB = 3072, ZC_I = 4096, ZC_OG = 5120, ZC_GP = 6144, ZC_GH = 8192;

#define GAS __attribute__((address_space(1)))
#define LAS __attribute__((address_space(3)))
typedef unsigned short bf16_t;
typedef short bf16x8 __attribute__((ext_vector_type(8)));
typedef float f32x4 __attribute__((ext_vector_type(4)));
typedef float f32x2 __attribute__((ext_vector_type(2)));
typedef unsigned u32x4 __attribute__((ext_vector_type(4)));
typedef unsigned u32x2 __attribute__((ext_vector_type(2)));
typedef int i32x4 __attribute__((ext_vector_type(4)));
typedef int i32x8 __attribute__((ext_vector_type(8)));
constexpr float W8_SCALE = 32.f;

constexpr size_t MiB = 1u << 20;
constexpr size_t align_up(size_t x) { return (x + 255) & ~(size_t)255; }
constexpr size_t WS_CTL = 0, CTL_BYTES = 1 * MiB;
constexpr size_t WS_MOD = WS_CTL + CTL_BYTES;
constexpr size_t WS_LB = WS_MOD + align_up((size_t)DEPTH * 5 * 6 * D * 4);
constexpr size_t WS_ROUTE_I = WS_LB + align_up((size_t)DEPTH * 2 * 1024 * 4);
constexpr size_t WS_ROUTE_G = WS_ROUTE_I + align_up((size_t)MTOK * 8);
constexpr size_t WS_SLOTTOK = WS_ROUTE_G + align_up((size_t)MTOK * 8);
constexpr size_t WS_PADBASE = WS_SLOTTOK + align_up((size_t)NEXP * MTOK * 4);
constexpr size_t WS_WIN = WS_PADBASE + align_up((size_t)DEPTH * 16 * 4);
constexpr size_t WS_WPG = WS_WIN + (size_t)DEPTH * INC * D * 2;
constexpr size_t WS_WBP = WS_WPG + (size_t)DEPTH * 1024 * 256 * 2;
constexpr size_t WS_WBH = WS_WBP + (size_t)DEPTH * D * 1024 * 2;
constexpr size_t WS_WOUT = WS_WBH + (size_t)DEPTH * D * 1024 * 2;
constexpr size_t WS_WE13 = WS_WOUT + (size_t)DEPTH * D * D * 2;
constexpr size_t WS_WE2 = WS_WE13 + (size_t)DEPTH * NEXP * 1024 * D * 2;
constexpr size_t WS_X = WS_WE2 + (size_t)DEPTH * NEXP * D * DEXP * 2;
constexpr size_t WS_H = WS_X + (size_t)MTOK * D * 4;
constexpr size_t WS_Z = WS_H + (size_t)MTOK * D * 2;
constexpr size_t WS_ACT = WS_Z;
constexpr size_t WS_Y2 = WS_ACT + (size_t)MAXSLOT * DEXP * 2;
constexpr size_t WS_PD = WS_Z + (size_t)MTOK * INC * 2;
constexpr size_t WS_P = WS_PD + (size_t)MTOK * 1024 * 2;
constexpr size_t WS_HG = WS_P + (size_t)MTOK * 1024 * 2;
constexpr size_t WS_O2 = WS_HG + (size_t)MTOK * 1024 * 2;
constexpr size_t WS_QSG = WS_O2 + (size_t)2 * MTOK * 1024 * 2;
constexpr size_t WS_SMID = WS_QSG + (size_t)64 * 3 * 17 * 17408;
constexpr size_t WS_CORRV = WS_SMID + (size_t)64 * 3 * 128 * 128 * 4;
constexpr size_t WS_TOTSEG = WS_CORRV + (size_t)64 * 3 * 17 * 128 * 4;
static_assert(WS_TOTSEG + (size_t)64 * 4 * 128 * 4 <= WS_O2 + (size_t)2 * MTOK * 1024 * 4, "scan hand-off buffers fit in the O2 region");
constexpr size_t WS_M1 = WS_O2 + (size_t)2 * MTOK * 1024 * 4;
constexpr size_t WS_MX = WS_M1 + (size_t)MTOK * D * 2;
constexpr size_t WS_END = WS_MX + (size_t)MTOK * D * 2;
static_assert(WS_Y2 + (size_t)MAXSLOT * D * 2 <= WS_PD, "ACT|Y2 overlay fits in Z");

constexpr int CW_BAR = 4096;
constexpr int CW_CNT = 16384;

constexpr int LDS_STAGE = 131072;
constexpr int LDS_MISC = 149504;
constexpr int LDS_BYTES = LDS_MISC + 8192;

__device__ __forceinline__ unsigned f2bf(float f) { unsigned u = __builtin_bit_cast(unsigned, f); return (u + 0x7fffu + ((u >> 16) & 1u)) >> 16; }
typedef __bf16 bf16x2_t __attribute__((ext_vector_type(2)));
__device__ __forceinline__ unsigned pk2(float lo, float hi) { const f32x2 v = {lo, hi}; const bf16x2_t b = __builtin_convertvector(v, bf16x2_t); return __builtin_bit_cast(unsigned, b); }
__device__ __forceinline__ float bflo(unsigned w) { return __builtin_bit_cast(float, w << 16); }
__device__ __forceinline__ float bfhi(unsigned w) { return __builtin_bit_cast(float, w & 0xffff0000u); }
__device__ __forceinline__ float bf1(bf16_t h) { return __builtin_bit_cast(float, ((unsigned)h) << 16); }
__device__ __forceinline__ float fsigmoid(float x) { return __builtin_amdgcn_rcpf(1.f + __builtin_amdgcn_exp2f(-1.44269504f * x)); }
__device__ __forceinline__ float fsilu(float x) { return x * fsigmoid(x); }
__device__ __forceinline__ float lane_xor(float v, int o, int lane) { return __builtin_bit_cast(float, __builtin_amdgcn_ds_bpermute((lane ^ o) << 2, __builtin_bit_cast(int, v))); }
#define LDS_WAIT() asm volatile("s_waitcnt lgkmcnt(0)" ::: "memory")
#define VM_WAIT() asm volatile("s_waitcnt vmcnt(0)" ::: "memory")

__device__ __forceinline__ unsigned pk4_fp8(float a, float b, float c, float d) { int w = 0; w = __builtin_amdgcn_cvt_pk_fp8_f32(a, b, w, false); w = __builtin_amdgcn_cvt_pk_fp8_f32(c, d, w, true); return (unsigned)w; }
constexpr float HG8_SCALE = 4.f, ACT8_SCALE = 4.f;
#define XB_TMO      128
#define XB_XCNT(j)  (256  + 64 * (j))
#define XB_XSUB(j)  (1280 + 64 * (j))
#define XB_XGEN(j)  (2304 + 64 * (j))
#define XB_TOP      3328
#define XB_TOPGEN   3392
#define XCD_BAR_WORDS 3456
#define XB_SPIN_CAP (1u << 18)
__device__ __forceinline__ unsigned xb_ld(unsigned* p)              { return __hip_atomic_load(p, __ATOMIC_RELAXED, __HIP_MEMORY_SCOPE_AGENT); }
__device__ __forceinline__ unsigned xb_add(unsigned* p, unsigned v) { return __hip_atomic_fetch_add(p, v, __ATOMIC_RELAXED, __HIP_MEMORY_SCOPE_AGENT); }
__device__ __forceinline__ unsigned xb_xcc_id() { return (unsigned)__builtin_amdgcn_s_getreg((3 << 11) | 20) & 0xFu; }
#define XB_SPIN(cond, bar) do { unsigned _sp = 0; while (cond) { __builtin_amdgcn_s_sleep(1); \
    if ((++_sp & 255u) == 0u) { if (xb_ld(&(bar)[XB_TMO])) break; if (_sp > XB_SPIN_CAP) { atomicAdd(&(bar)[XB_TMO], 1u); break; } } } } while (0)
struct XcdBarrier { unsigned* bar; unsigned x; volatile LAS unsigned* st; };
__device__ __forceinline__ XcdBarrier xcd_barrier_post(unsigned* bar, volatile LAS unsigned* st) {
    XcdBarrier b; b.bar = bar; b.x = xb_xcc_id(); b.st = st;
    if (threadIdx.x == 0) (void)xb_add(&bar[XB_XCNT(b.x)], 1u);
    return b;
}
__device__ __forceinline__ void xcd_barrier_complete(unsigned* bar, unsigned x, unsigned& nloc, unsigned& nx) {
    const unsigned G = gridDim.x * gridDim.y * gridDim.z;
    unsigned sum, cnt, mine, sp = 0u;
    for (;;) {
        sum = 0u; cnt = 0u; mine = 0u;
#pragma unroll
        for (unsigned j = 0; j < 16; ++j) { const unsigned c = xb_ld(&bar[XB_XCNT(j)]); sum += c; cnt += (c > 0u) ? 1u : 0u; mine = (j == x) ? c : mine; }
        if (sum == G) break;
        __builtin_amdgcn_s_sleep(1);
        if ((++sp & 255u) == 0u) { if (xb_ld(&bar[XB_TMO])) break; if (sp > XB_SPIN_CAP) { atomicAdd(&bar[XB_TMO], 1u); break; } }
    }
    nloc = mine > 0u ? mine : 1u; nx = cnt > 0u ? cnt : 1u;
}
__device__ __forceinline__ void xcd_barrier(const XcdBarrier& b) {
    asm volatile("s_waitcnt vmcnt(0)" ::: "memory");
    __syncthreads();
    if (threadIdx.x == 0) {
        unsigned* bar = b.bar;
        __builtin_amdgcn_s_waitcnt(0);
        unsigned nloc = b.st[0], nx = b.st[1];
        if (nloc == 0u) { xcd_barrier_complete(bar, b.x, nloc, nx); b.st[0] = nloc; b.st[1] = nx; }
        const unsigned old = xb_add(&bar[XB_XSUB(b.x)], 1u);
        const unsigned gen = old / nloc;
        if (old + 1u == (gen + 1u) * nloc) {
            __builtin_amdgcn_fence(__ATOMIC_RELEASE, "agent");
            asm volatile("s_waitcnt vmcnt(0)" ::: "memory");
            const unsigned og = xb_add(&bar[XB_TOP], 1u);
            const unsigned tg = og / nx;
            if (og + 1u == (tg + 1u) * nx) xb_add(&bar[XB_TOPGEN], 1u);
            else XB_SPIN(xb_ld(&bar[XB_TOPGEN]) == tg, bar);
            __builtin_amdgcn_fence(__ATOMIC_ACQUIRE, "agent");
            xb_add(&bar[XB_XGEN(b.x)], 1u);
            asm volatile("s_waitcnt vmcnt(0)" ::: "memory");
        } else {
            XB_SPIN(xb_ld(&bar[XB_XGEN(b.x)]) == gen, bar);
            __builtin_amdgcn_fence(__ATOMIC_ACQUIRE, "agent");
            asm volatile("s_waitcnt vmcnt(0)" ::: "memory");
        }
    }
    __syncthreads();
}

namespace pg8 {
constexpr int BM = 256, BK = 64, HALF = 128, HTB = HALF * BK * 2, NXCD = 8, WGM = 8;
__host__ __device__ __forceinline__ int lds_byte(int r, int c) { const int st = (r >> 4) * 2 + (c >> 5), rr = r & 15, cc = c & 31, ob = rr * 64 + cc * 2; return st * 1024 + (ob ^ (((ob >> 9) & 1) << 5)); }
__host__ __device__ __forceinline__ void stage_rc(int b, int& R, int& C) { const int st = b / 1024, sb = b % 1024, swz = sb ^ (((sb >> 9) & 1) << 5); R = (st >> 1) * 16 + swz / 64; C = (st & 1) * 32 + (swz % 64) / 2; }
__host__ __device__ __forceinline__ int perm32(int rho) { const int n = rho >> 4, i = rho & 15; return 8 * (i >> 2) + 4 * n + (i & 3); }

struct Unit { int pm, pn; };

struct DenseOrder {
    static constexpr bool GATHER = false;
    int nM, nN, nwg, G, c, lda_b, acol_b;
    __device__ void init(int M, int N, int G_, int c_, int lda_b_, int acol_b_) { nM = M / BM; nN = N / BM; nwg = nM * nN; G = G_; c = c_; lda_b = lda_b_; acol_b = acol_b_; }
    __device__ __forceinline__ bool next(int i, Unit& u) const {
        const long L = (long)i * G + c; if (L >= nwg) return false;
        int wgid = (int)L; { const int q = nwg / NXCD, r = nwg % NXCD, xcd = wgid % NXCD, off = wgid / NXCD; wgid = (xcd < r ? xcd * (q + 1) : r * (q + 1) + (xcd - r) * q) + off; }
        const int nig = WGM * nN, gid = wgid / nig, fm = gid * WGM, gsz = (nM - fm) < WGM ? (nM - fm) : WGM;
        u.pm = fm + ((wgid % nig) % gsz); u.pn = (wgid % nig) / gsz; return true;
    }
    __device__ __forceinline__ size_t a_base(const Unit& u) const { return (size_t)u.pm * BM * lda_b + (size_t)u.pn * acol_b; }
    __device__ __forceinline__ void a_offs(const Unit&, unsigned (&)[2][2]) const {}
    __device__ __forceinline__ size_t b_off(const Unit& u, int ldb_b) const { return (size_t)u.pn * BM * ldb_b; }
};
template <bool GATHER_> struct MoeOrder {
    static constexpr bool GATHER = GATHER_;
    int nN, nunits, G, c, lda_b; const LAS int* tbl;
    const int* slottok; size_t b_estride;
    __device__ __forceinline__ bool next(int i, Unit& u) const {
        const int L = i * G + c; if (L >= nunits) return false;
        u.pm = L / nN; u.pn = L % nN; return true;
    }
    __device__ __forceinline__ size_t a_base(const Unit& u) const { return (size_t)u.pm * BM * lda_b; }
    __device__ __forceinline__ void a_offs(const Unit& u, unsigned (&v)[2][2]) const {
        const int e = __builtin_amdgcn_readfirstlane(tbl[64 + u.pm]), j0 = __builtin_amdgcn_readfirstlane((u.pm - tbl[16 + e]) * BM), cnt = __builtin_amdgcn_readfirstlane(tbl[e]);
#pragma unroll
        for (int i = 0; i < 2; ++i) { int R, C; stage_rc((int)threadIdx.x * 16 + i * 8192, R, C);
#pragma unroll
            for (int h = 0; h < 2; ++h) { const int j = j0 + h * HALF + R; const int tok = (j < cnt) ? slottok[(size_t)e * MTOK + j] : 0; v[h][i] = (unsigned)(tok * lda_b + C * 2); } }
    }
    __device__ __forceinline__ size_t b_off(const Unit& u, int ldb_b) const { const int e = __builtin_amdgcn_readfirstlane(tbl[64 + u.pm]); return (size_t)e * b_estride + (size_t)u.pn * BM * ldb_b; }
};

template <class Epi, class Sched, bool FP8 = false, bool SPLIT = false>
__device__ __forceinline__ void gemm_phase(LAS unsigned char* lds, const void* Abase, const int lda_b, const void* Bbase, const int Kb, const int ldb_b, const Sched& S, const Epi& E, const long dA = 0, const long dB = 0, const int nt1 = 0) {
    constexpr bool GA = Sched::GATHER;
    int tid_ = threadIdx.x; asm volatile("" : "+v"(tid_));
    const int tid = tid_, wid = __builtin_amdgcn_readfirstlane(tid >> 6), lane = tid & 63, wr = wid >> 2, wc = wid & 3, fr = lane & 15, fq = lane >> 4;
    const int nt = Kb / 128;
    unsigned voffA[2], voffB[2];
#pragma unroll
    for (int i = 0; i < 2; ++i) { int R, C; stage_rc(tid * 16 + i * 8192, R, C); const int Rb = Epi::PERM ? ((R & ~31) + perm32(R & 31)) : R; voffA[i] = (unsigned)(R * lda_b + C * 2); voffB[i] = (unsigned)(Rb * ldb_b + C * 2); }
    const size_t kstep = (size_t)(BK * 2);
    const size_t hstepA = (size_t)HALF * lda_b, hstepB = (size_t)HALF * ldb_b;
    const unsigned ldsw = (unsigned)wid * 1024u;
    const int aoff = lds_byte(wr * 64 + fr, fq * 8), boff = lds_byte(wc * 32 + fr, fq * 8);
#define PG8_SA(b, h) (((b) * 2 + (h)) * HTB)
#define PG8_SB(b, h) ((4 + (b) * 2 + (h)) * HTB)
#define PG8_STAGE2(bufoff, gbase, o0, o1) do { \
        __builtin_amdgcn_global_load_lds((const unsigned*)((const char*)(gbase) + (o0)), (LAS unsigned*)(lds + (bufoff) + ldsw), 16, 0, 0); \
        __builtin_amdgcn_global_load_lds((const unsigned*)((const char*)(gbase) + (o1)), (LAS unsigned*)(lds + (bufoff) + ldsw + 8192), 16, 0, 0); } while (0)
#define PG8_STAGEB(bufoff, gbase) PG8_STAGE2(bufoff, gbase, voffB[0], voffB[1])
#define PG8_STAGEA(bufoff, gbase, h, x0, x1) do { if constexpr (GA) PG8_STAGE2(bufoff, gbase, x0, x1); else PG8_STAGE2(bufoff, (gbase) + ((h) ? hstepA : (size_t)0), voffA[0], voffA[1]); } while (0)
#define PG8_LD32(dst, addr) do { const i32x4 lo_ = *(const LAS i32x4*)(lds + (addr)), hi_ = *(const LAS i32x4*)(lds + (addr) + 1024); dst = (i32x8){lo_[0], lo_[1], lo_[2], lo_[3], hi_[0], hi_[1], hi_[2], hi_[3]}; } while (0)
#define PG8_LDA(dst, b, h) do { _Pragma("unroll") for (int m = 0; m < 4; ++m) PG8_LD32(dst[m], PG8_SA(b, h) + aoff + m * 2048); } while (0)
#define PG8_LDB(dst, b, h) do { _Pragma("unroll") for (int n = 0; n < 2; ++n) PG8_LD32(dst[n], PG8_SB(b, h) + boff + n * 2048); } while (0)
#define PG8_HALF(v, k) __builtin_bit_cast(bf16x8, (i32x4){(v)[4 * (k)], (v)[4 * (k) + 1], (v)[4 * (k) + 2], (v)[4 * (k) + 3]})
#define PG8_MMA(ai, bj, At, Bt) do { __builtin_amdgcn_s_setprio(1); \
        if constexpr (FP8) { _Pragma("unroll") for (int m = 0; m < 4; ++m) _Pragma("unroll") for (int n = 0; n < 2; ++n) \
            asm volatile("v_mfma_scale_f32_16x16x128_f8f6f4 %0, %1, %2, %0, %3, %3 op_sel_hi:[0,0,0]" : "+v"(acc[ai][bj][m][n]) : "v"(Bt[n]), "v"(At[m]), "v"(one_scale)); } \
        else { _Pragma("unroll") for (int m = 0; m < 4; ++m) _Pragma("unroll") for (int n = 0; n < 2; ++n) _Pragma("unroll") for (int k = 0; k < 2; ++k) \
            acc[ai][bj][m][n] = __builtin_amdgcn_mfma_f32_16x16x32_bf16(PG8_HALF(Bt[n], k), PG8_HALF(At[m], k), acc[ai][bj][m][n], 0, 0, 0); } \
        __builtin_amdgcn_s_setprio(0); } while (0)
#define PG8_WAIT_V(n) asm volatile("s_waitcnt vmcnt(" #n ")" ::: "memory")
#define PG8_WAIT_L(n) asm volatile("s_waitcnt lgkmcnt(" #n ")" ::: "memory")
#define PG8_BAR __builtin_amdgcn_s_barrier()
#define PG8_SCHED __builtin_amdgcn_sched_barrier(0)
    Unit cur, nxt; int ui = 0;
    if (!S.next(0, cur)) return;
    f32x4 acc[2][2][4][2];
#pragma unroll
    for (int a = 0; a < 2; ++a)
#pragma unroll
        for (int b = 0; b < 2; ++b)
#pragma unroll
            for (int m = 0; m < 4; ++m)
#pragma unroll
                for (int n = 0; n < 2; ++n) acc[a][b][m][n] = (f32x4){0.f, 0.f, 0.f, 0.f};
    int one_scale = 0; if constexpr (FP8) asm volatile("v_mov_b32 %0, 0x7f7f7f7f" : "=v"(one_scale));
    i32x8 At[4], B0[2], B1[2];
    unsigned vA[2][2];
    if constexpr (GA) S.a_offs(cur, vA);
    const char* cA = (const char*)Abase + (GA ? (size_t)0 : S.a_base(cur));
    const char* cB = (const char*)Bbase + S.b_off(cur, ldb_b);
    PG8_STAGEB(PG8_SB(0, 0), cB); PG8_STAGEB(PG8_SB(0, 1), cB + hstepB); PG8_STAGEA(PG8_SA(0, 0), cA, 0, vA[0][0], vA[0][1]); PG8_STAGEA(PG8_SA(0, 1), cA, 1, vA[1][0], vA[1][1]);
    if (wr == 1) PG8_BAR;
    PG8_WAIT_V(2); PG8_BAR;
    PG8_STAGEB(PG8_SB(1, 0), cB + kstep); PG8_STAGEA(PG8_SA(1, 0), cA + kstep, 0, vA[0][0], vA[0][1]); PG8_STAGEB(PG8_SB(1, 1), cB + hstepB + kstep);
    PG8_WAIT_V(6); PG8_BAR;
    for (;;) {
        const bool has_next = S.next(ui + 1, nxt);
        const char* nA = (has_next && !GA) ? (const char*)Abase + S.a_base(nxt) : cA;
        const char* nB = has_next ? (const char*)Bbase + S.b_off(nxt, ldb_b) : cB;
_Pragma("nounroll")
        for (int t = 0; t < nt; t += 2) {
            const bool last = (t == nt - 2);
            const long sA1 = (SPLIT && t >= nt1) ? dA : 0, sA2 = (SPLIT && t + 2 >= nt1) ? dA : 0, sB2 = (SPLIT && t + 2 >= nt1) ? dB : 0;
            if constexpr (SPLIT) { if (t == nt1) { asm volatile("s_nop 15\n\ts_nop 15" ::: "memory"); int t3_ = threadIdx.x; asm volatile("" : "+v"(t3_)); const int l3_ = t3_ & 63; E.mid(acc, cur, wr, wc, l3_ & 15, l3_ >> 4); } }
            const char* a1 = cA + (size_t)(t + 1) * kstep + sA1;
            const char* a2 = last ? nA : cA + (size_t)(t + 2) * kstep + sA2; const char* b2 = last ? nB : cB + (size_t)(t + 2) * kstep + sB2;
            const char* a3 = a2 + kstep; const char* b3 = b2 + kstep;
            PG8_LDB(B0, 0, 0); PG8_LDB(B1, 0, 1); PG8_SCHED; PG8_LDA(At, 0, 0); PG8_STAGEA(PG8_SA(1, 1), a1, 1, vA[1][0], vA[1][1]);
            PG8_WAIT_V(8); PG8_WAIT_L(0); PG8_BAR; PG8_MMA(0, 0, At, B0); PG8_MMA(0, 1, At, B1); PG8_BAR; PG8_SCHED;
            if constexpr (GA) { if (last && has_next) S.a_offs(nxt, vA); }
            PG8_LDA(At, 0, 1); PG8_STAGEB(PG8_SB(0, 0), b2); PG8_STAGEB(PG8_SB(0, 1), b2 + hstepB); PG8_STAGEA(PG8_SA(0, 0), a2, 0, vA[0][0], vA[0][1]);
            PG8_WAIT_V(8); PG8_WAIT_L(0); PG8_BAR; PG8_MMA(1, 0, At, B0); PG8_MMA(1, 1, At, B1); PG8_BAR; PG8_SCHED;
            PG8_LDB(B0, 1, 0); PG8_LDB(B1, 1, 1); PG8_SCHED; PG8_LDA(At, 1, 0); PG8_STAGEA(PG8_SA(0, 1), a2, 1, vA[1][0], vA[1][1]);
            PG8_WAIT_V(8); PG8_WAIT_L(0); PG8_BAR; PG8_MMA(0, 0, At, B0); PG8_MMA(0, 1, At, B1); PG8_BAR; PG8_SCHED;
            PG8_LDA(At, 1, 1); PG8_STAGEB(PG8_SB(1, 0), b3); PG8_STAGEB(PG8_SB(1, 1), b3 + hstepB); PG8_STAGEA(PG8_SA(1, 0), a3, 0, vA[0][0], vA[0][1]);
            PG8_WAIT_V(8); PG8_WAIT_L(0); PG8_BAR; PG8_MMA(1, 0, At, B0); PG8_MMA(1, 1, At, B1); PG8_BAR; PG8_SCHED;
        }
        if constexpr (FP8) asm volatile("s_nop 15\n\ts_nop 15" ::: "memory");
        if (wr == 0) PG8_BAR;
        { int t2_ = threadIdx.x; asm volatile("" : "+v"(t2_)); const int l2_ = t2_ & 63; E(acc, cur, wr, wc, l2_ & 15, l2_ >> 4); }
        if (!has_next) break;
#pragma unroll
        for (int a = 0; a < 2; ++a)
#pragma unroll
            for (int b = 0; b < 2; ++b)
#pragma unroll
                for (int m = 0; m < 4; ++m)
#pragma unroll
                    for (int n = 0; n < 2; ++n) acc[a][b][m][n] = (f32x4){0.f, 0.f, 0.f, 0.f};
        cur = nxt; cA = nA; cB = nB; ++ui;
        if (wr == 1) PG8_BAR;
    }
    PG8_WAIT_V(0);
    PG8_BAR;
#undef PG8_SA
#undef PG8_SB
#undef PG8_STAGE2
#undef PG8_STAGEB
#undef PG8_STAGEA
#undef PG8_LDA
#undef PG8_LD32
#undef PG8_HALF
#undef PG8_LDB
#undef PG8_MMA
#undef PG8_WAIT_V
#undef PG8_WAIT_L
#undef PG8_BAR
#undef PG8_SCHED
}

typedef const f32x4 (&AccRef)[2][2][4][2];
__device__ __forceinline__ u32x4 pack8(const f32x4 v0, const f32x4 v1) { u32x4 w; w.x = pk2(v0[0], v0[1]); w.y = pk2(v0[2], v0[3]); w.z = pk2(v1[0], v1[1]); w.w = pk2(v1[2], v1[3]); return w; }
__device__ __forceinline__ void unpack8(const u32x4 w, f32x4& v0, f32x4& v1) { v0 = (f32x4){bflo(w.x), bfhi(w.x), bflo(w.y), bfhi(w.y)}; v1 = (f32x4){bflo(w.z), bfhi(w.z), bflo(w.w), bfhi(w.w)}; }

struct EpiIn {
    static constexpr bool PERM = true;
    bf16_t* Z; const float* lb;
    __device__ __forceinline__ void operator()(AccRef acc, const Unit& u, int wr, int wc, int fr, int fq) const {
        constexpr float KS = 1.f / W8_SCALE, KE = -1.44269504f / W8_SCALE;
        const int row0 = u.pm * BM + wr * 64 + fr, colt = u.pn * BM, seg = colt >> 10, col0 = colt + wc * 32 + 8 * fq;
        const int mode = (seg == 0 || seg == 4) ? 0 : (seg == 1 || seg == 5) ? 1 : (seg == 2 || seg == 3) ? 2 : 3;
#pragma unroll
        for (int bj = 0; bj < 2; ++bj) {
            f32x4 l0 = (f32x4){0.f, 0.f, 0.f, 0.f}, l1 = l0;
            if (mode == 2) { l0 = *(const f32x4*)(lb + (col0 + bj * HALF - ZC_FF)); l1 = *(const f32x4*)(lb + (col0 + bj * HALF + 4 - ZC_FF)); }
#pragma unroll
            for (int ai = 0; ai < 2; ++ai)
#pragma unroll
                for (int m = 0; m < 4; ++m) { bf16_t* rowp = Z + (size_t)(row0 + ai * HALF + m * 16) * INC + col0 + bj * HALF;
                    f32x4 v0 = acc[ai][bj][m][0], v1 = acc[ai][bj][m][1];
                    if (mode == 0) { v0 = v0 * KS; v1 = v1 * KS; }
                    else { f32x4 s0, s1;
#pragma unroll
                        for (int j = 0; j < 4; ++j) { s0[j] = __builtin_amdgcn_rcpf(1.f + __builtin_amdgcn_exp2f(v0[j] * KE)); s1[j] = __builtin_amdgcn_rcpf(1.f + __builtin_amdgcn_exp2f(v1[j] * KE)); }
                        if (mode == 1) { v0 = v0 * KS * s0; v1 = v1 * KS * s1; }
                        else if (mode == 3) { v0 = s0; v1 = s1; }
                        else {
#pragma unroll
                            for (int j = 0; j < 4; ++j) { v0[j] = __builtin_amdgcn_logf(l0[j] + (1.f - l0[j]) * s0[j]); v1[j] = __builtin_amdgcn_logf(l1[j] + (1.f - l1[j]) * s1[j]); } } }
                    *(u32x4*)rowp = pack8(v0, v1);
                    __builtin_amdgcn_sched_barrier(0); } }
    }
};
struct EpiPool {
    static constexpr bool PERM = true;
    bf16_t* P; const float* scale;
    __device__ __forceinline__ void operator()(AccRef acc, const Unit& u, int wr, int wc, int fr, int fq) const {
        const int row0 = u.pm * BM + wr * 64 + fr, col0 = u.pn * BM + wc * 32 + 8 * fq;
        f32x4 sv[2][2];
#pragma unroll
        for (int bj = 0; bj < 2; ++bj)
#pragma unroll
            for (int n = 0; n < 2; ++n) sv[bj][n] = *(const f32x4*)(scale + col0 + bj * HALF + 4 * n);
#pragma unroll
        for (int ai = 0; ai < 2; ++ai)
#pragma unroll
            for (int m = 0; m < 4; ++m) { bf16_t* rowp = P + (size_t)(row0 + ai * HALF + m * 16) * DPOOL + col0;
#pragma unroll
                for (int bj = 0; bj < 2; ++bj) { const f32x4 r0 = acc[ai][bj][m][0] * sv[bj][0], r1 = acc[ai][bj][m][1] * sv[bj][1];
                    u32x2 o; o.x = pk4_fp8(r0[0], r0[1], r0[2], r0[3]); o.y = pk4_fp8(r1[0], r1[1], r1[2], r1[3]); *(u32x2*)((unsigned char*)P + (size_t)(row0 + ai * HALF + m * 16) * DPOOL + col0 + bj * HALF) = o; } }
    }
};
template <bool ADD, bool OUT8 = false> struct EpiGate {
    static constexpr bool PERM = true;
    bf16_t* O; const bf16_t* prev; const bf16_t* Z; int gcol; float ascale;
    __device__ __forceinline__ void operator()(AccRef acc, const Unit& u, int wr, int wc, int fr, int fq) const {
        const int row0 = u.pm * BM + wr * 64 + fr, col0 = u.pn * BM + wc * 32 + 8 * fq;
#pragma unroll
        for (int ai = 0; ai < 2; ++ai)
#pragma unroll
            for (int m = 0; m < 4; ++m) { const size_t row = (size_t)(row0 + ai * HALF + m * 16);
#pragma unroll
                for (int bj = 0; bj < 2; ++bj) {
                    const u32x4 gw = *(const u32x4*)(Z + row * INC + gcol + col0 + bj * HALF); f32x4 g0, g1; unpack8(gw, g0, g1);
                    f32x4 r0 = acc[ai][bj][m][0] * ascale * g0, r1 = acc[ai][bj][m][1] * ascale * g1;
                    if (ADD) { const u32x4 pw = *(const u32x4*)(prev + row * D + col0 + bj * HALF); f32x4 p0, p1; unpack8(pw, p0, p1); r0 += p0; r1 += p1; }
                    if (OUT8) { int w0 = 0, w1 = 0; w0 = __builtin_amdgcn_cvt_pk_fp8_f32(r0[0], r0[1], w0, false); w0 = __builtin_amdgcn_cvt_pk_fp8_f32(r0[2], r0[3], w0, true);
                        w1 = __builtin_amdgcn_cvt_pk_fp8_f32(r1[0], r1[1], w1, false); w1 = __builtin_amdgcn_cvt_pk_fp8_f32(r1[2], r1[3], w1, true);
                        u32x2 o; o.x = (unsigned)w0; o.y = (unsigned)w1; *(u32x2*)((unsigned char*)O + row * D + col0 + bj * HALF) = o; }
                    else *(u32x4*)(O + row * D + col0 + bj * HALF) = pack8(r0, r1); } }
    }
};
struct EpiGate2 {
    static constexpr bool PERM = true;
    unsigned char* O; const bf16_t* Z; int gcol1, gcol2; float cratio, ascale;
    static constexpr float GMIN = 9.094947e-13f;
    __device__ __forceinline__ void mid(f32x4 (&acc)[2][2][4][2], const Unit& u, int wr, int wc, int fr, int fq) const {
        const int row0 = u.pm * BM + wr * 64 + fr, col0 = u.pn * BM + wc * 32 + 8 * fq;
#pragma unroll
        for (int ai = 0; ai < 2; ++ai)
#pragma unroll
            for (int m = 0; m < 4; ++m) { const size_t row = (size_t)(row0 + ai * HALF + m * 16);
#pragma unroll
                for (int bj = 0; bj < 2; ++bj) {
                    const u32x4 gw1 = *(const u32x4*)(Z + row * INC + gcol1 + col0 + bj * HALF), gw2 = *(const u32x4*)(Z + row * INC + gcol2 + col0 + bj * HALF);
                    f32x4 a0, a1, b0, b1; unpack8(gw1, a0, a1); unpack8(gw2, b0, b1);
#pragma unroll
                    for (int j = 0; j < 4; ++j) { acc[ai][bj][m][0][j] *= cratio * a0[j] * __builtin_amdgcn_rcpf(fmaxf(b0[j], GMIN)); acc[ai][bj][m][1][j] *= cratio * a1[j] * __builtin_amdgcn_rcpf(fmaxf(b1[j], GMIN)); } }
                }
    }
    __device__ __forceinline__ void operator()(AccRef acc, const Unit& u, int wr, int wc, int fr, int fq) const {
        const int row0 = u.pm * BM + wr * 64 + fr, col0 = u.pn * BM + wc * 32 + 8 * fq;
#pragma unroll
        for (int ai = 0; ai < 2; ++ai)
#pragma unroll
            for (int m = 0; m < 4; ++m) { const size_t row = (size_t)(row0 + ai * HALF + m * 16);
#pragma unroll
                for (int bj = 0; bj < 2; ++bj) {
                    const u32x4 gw = *(const u32x4*)(Z + row * INC + gcol2 + col0 + bj * HALF); f32x4 g0, g1; unpack8(gw, g0, g1);
                    f32x4 r0, r1;
#pragma unroll
                    for (int j = 0; j < 4; ++j) { r0[j] = acc[ai][bj][m][0][j] * ascale * fmaxf(g0[j], GMIN); r1[j] = acc[ai][bj][m][1][j] * ascale * fmaxf(g1[j], GMIN); }
                    u32x2 o; o.x = pk4_fp8(r0[0], r0[1], r0[2], r0[3]); o.y = pk4_fp8(r1[0], r1[1], r1[2], r1[3]);
                    *(u32x2*)(O + row * D + col0 + bj * HALF) = o; } }
    }
};
struct EpiOut {
    static constexpr bool PERM = true;
    bf16_t* X; const void* src_lat; const void* src_ctx; bool src_f32; const float* modl; float ascale;
    __device__ __forceinline__ void operator()(AccRef acc, const Unit& u, int wr, int wc, int fr, int fq) const {
        const int row0 = u.pm * BM + wr * 64 + fr, col0 = u.pn * BM + wc * 32 + 8 * fq;
        const int mrow = u.pm < 64 ? (u.pm >> 4) : 4;
        const float* g = modl + (size_t)mrow * 6 * D + 2 * D;
        const bool lat = u.pm < 64;
#pragma unroll
        for (int bj = 0; bj < 2; ++bj) { const int col = col0 + bj * HALF;
            const f32x4 g0 = *(const f32x4*)(g + col) * ascale, g1 = *(const f32x4*)(g + col + 4) * ascale;
#pragma unroll
            for (int ai = 0; ai < 2; ++ai)
#pragma unroll
                for (int m = 0; m < 4; ++m) { const int row = row0 + ai * HALF + m * 16; f32x4 s0, s1;
                    if (src_f32) { const float* sp = (lat ? (const float*)src_lat + (size_t)row * D : (const float*)src_ctx + (size_t)(row - NLAT) * D) + col; s0 = *(const f32x4*)sp; s1 = *(const f32x4*)(sp + 4); }
                    else unpack8(*(const u32x4*)((const bf16_t*)src_lat + (size_t)row * D + col), s0, s1);
                    *(u32x4*)(X + (size_t)row * D + col) = pack8(s0 + g0 * acc[ai][bj][m][0], s1 + g1 * acc[ai][bj][m][1]); } }
    }
};
struct EpiMoe1 {
    static constexpr bool PERM = true;
    bf16_t* ACT;
    __device__ __forceinline__ void operator()(AccRef acc, const Unit& u, int wr, int wc, int fr, int fq) const {
        const int row0 = u.pm * BM + wr * 64 + fr, col0 = u.pn * HALF + wc * 32 + 8 * fq;
        constexpr float KS = 1.f / W8_SCALE, KB = ACT8_SCALE / W8_SCALE;
#pragma unroll
        for (int ai = 0; ai < 2; ++ai)
#pragma unroll
            for (int m = 0; m < 4; ++m) { f32x4 r[2];
#pragma unroll
                for (int n = 0; n < 2; ++n)
#pragma unroll
                    for (int j = 0; j < 4; ++j) r[n][j] = __builtin_amdgcn_fmed3f(fsilu(acc[ai][0][m][n][j] * KS) * (acc[ai][1][m][n][j] * KB), -440.f, 440.f);
                u32x2 o; o.x = pk4_fp8(r[0][0], r[0][1], r[0][2], r[0][3]); o.y = pk4_fp8(r[1][0], r[1][1], r[1][2], r[1][3]);
                *(u32x2*)((unsigned char*)ACT + (size_t)(row0 + ai * HALF + m * 16) * DEXP + col0) = o; }
    }
};
struct EpiNone {
    static constexpr bool PERM = true;
    __device__ __forceinline__ void operator()(AccRef acc, const Unit&, int, int, int, int) const {
#pragma unroll
        for (int ai = 0; ai < 2; ++ai)
#pragma unroll
            for (int bj = 0; bj < 2; ++bj)
#pragma unroll
                for (int m = 0; m < 4; ++m)
#pragma unroll
                    for (int n = 0; n < 2; ++n) asm volatile("" :: "v"(acc[ai][bj][m][n]));
    }
};
struct EpiPlain {
    static constexpr bool PERM = true;
    bf16_t* O; int ldc; float ascale;
    __device__ __forceinline__ void operator()(AccRef acc, const Unit& u, int wr, int wc, int fr, int fq) const {
        const int row0 = u.pm * BM + wr * 64 + fr, col0 = u.pn * BM + wc * 32 + 8 * fq;
#pragma unroll
        for (int ai = 0; ai < 2; ++ai)
#pragma unroll
            for (int m = 0; m < 4; ++m) { bf16_t* rowp = O + (size_t)(row0 + ai * HALF + m * 16) * ldc + col0;
#pragma unroll
                for (int bj = 0; bj < 2; ++bj) *(u32x4*)(rowp + bj * HALF) = pack8(acc[ai][bj][m][0] * ascale, acc[ai][bj][m][1] * ascale); }
    }
};
}

struct Args { const float* in[22]; float* out; unsigned char* ws; int ph_lo, ph_hi, rep, pad; };
enum { I_X = 0, I_C, I_CTX, I_CCTX, I_WADA, I_BADA, I_N1W, I_N2W, I_WIN, I_WPG, I_PSCALE, I_HGNW, I_LBLOG, I_WBP, I_WBH, I_WOUT, I_WROUTER, I_RBIAS, I_WE1, I_WE3, I_WE2, I_FNW };

struct Frame {
    LAS unsigned char* lds;
    int tid, lane, wave, G, gw, NGW;
    unsigned char* ws;
};

__device__ __forceinline__ void transpose_item(const float* W, int K, int N, int k0, int n0, bf16_t* WT, size_t dst_row0, LAS float* scr, int lane) {
    float wv[32];
#pragma unroll
    for (int i = 0; i < 32; ++i) { const int kk = 2 * i + (lane >> 5); wv[i] = __builtin_nontemporal_load(W + (size_t)(k0 + kk) * N + n0 + (lane & 31)); }
#pragma unroll
    for (int i = 0; i < 32; ++i) { const int kk = 2 * i + (lane >> 5); scr[kk * 33 + (lane & 31)] = wv[i]; }
    LDS_WAIT(); asm volatile("" ::: "memory");
    const int c = lane & 7;
#pragma unroll
    for (int j = 0; j < 4; ++j) { const int n = (lane >> 3) + 8 * j; const LAS float* s = scr + (8 * c) * 33 + n;
        u32x4 o; o.x = pk2(s[0 * 33], s[1 * 33]); o.y = pk2(s[2 * 33], s[3 * 33]); o.z = pk2(s[4 * 33], s[5 * 33]); o.w = pk2(s[6 * 33], s[7 * 33]);
        *(u32x4*)(WT + (dst_row0 + n) * K + k0 + 8 * c) = o; }
    LDS_WAIT(); asm volatile("" ::: "memory");
}
__device__ __forceinline__ void transpose_item_fp8(const float* W, int K, int N, int k0, int n0, unsigned char* WT, size_t dst_row0, LAS float* scr, int lane) {
    float wv[32];
#pragma unroll
    for (int i = 0; i < 32; ++i) { const int kk = 2 * i + (lane >> 5); wv[i] = __builtin_nontemporal_load(W + (size_t)(k0 + kk) * N + n0 + (lane & 31)); }
#pragma unroll
    for (int i = 0; i < 32; ++i) { const int kk = 2 * i + (lane >> 5); scr[kk * 33 + (lane & 31)] = wv[i] * W8_SCALE; }
    LDS_WAIT(); asm volatile("" ::: "memory");
    const int c = lane & 7;
#pragma unroll
    for (int j = 0; j < 4; ++j) { const int n = (lane >> 3) + 8 * j; const LAS float* sp = scr + (8 * c) * 33 + n;
        int w0 = 0, w1 = 0; w0 = __builtin_amdgcn_cvt_pk_fp8_f32(sp[0 * 33], sp[1 * 33], w0, false); w0 = __builtin_amdgcn_cvt_pk_fp8_f32(sp[2 * 33], sp[3 * 33], w0, true);
        w1 = __builtin_amdgcn_cvt_pk_fp8_f32(sp[4 * 33], sp[5 * 33], w1, false); w1 = __builtin_amdgcn_cvt_pk_fp8_f32(sp[6 * 33], sp[7 * 33], w1, true);
        u32x2 o; o.x = (unsigned)w0; o.y = (unsigned)w1;
        *(u32x2*)(WT + (dst_row0 + n) * K + k0 + 8 * c) = o; }
    LDS_WAIT(); asm volatile("" ::: "memory");
}
__device__ __forceinline__ void transpose_family(Frame& F, const float* W, int mats, int K, int N, bf16_t* WT, int mode, int& itbase, int it_lo, int it_step) {
    const int nblk = N / 32, kblk = K / 64, per = nblk * kblk, total = mats * per;
    LAS float* scr = (LAS float*)(F.lds + F.wave * 16384);
    int first = (it_lo - itbase) % it_step; if (first < 0) first += it_step;
    for (int it = first; it < total; it += it_step) {
        const int mat = it / per, r = it % per, kb = r / nblk, nb = r % nblk, n0 = 32 * nb, k0 = 64 * kb;
        size_t dst_row0; bf16_t* dstm;
        if (mode == 3) { transpose_item_fp8(W + (size_t)mat * K * N, K, N, k0, n0, (unsigned char*)WT + (size_t)mat * N * K, n0, scr, F.lane); continue; }
        if (mode == 4 || mode == 5) { transpose_item_fp8(W + (size_t)mat * K * N, K, N, k0, n0, (unsigned char*)WT + (size_t)mat * 1024 * K, (size_t)(n0 >> 7) * 256 + (mode == 5 ? 128 : 0) + (n0 & 127), scr, F.lane); continue; }
        if (mode == 0) { dstm = WT + (size_t)mat * N * K; dst_row0 = n0; }
        else { dstm = WT + (size_t)mat * 1024 * K; dst_row0 = (size_t)(n0 >> 7) * 256 + (mode == 2 ? 128 : 0) + (n0 & 127); }
        transpose_item(W + (size_t)mat * K * N, K, N, k0, n0, dstm, dst_row0, scr, F.lane);
    }
    itbase += total;
}

struct ConvJob { const float* src; unsigned char* dst; int N; };
__device__ __forceinline__ ConvJob conv_decode(const Args& a, unsigned char* ws, int L, int s, int lane) {
    const float* W; unsigned char* T; int K, N, t, map = 0, lk, ln;
    if (s < 20480) { t = s; W = a.in[I_WIN] + (size_t)L * D * INC; T = ws + WS_WIN + (size_t)L * INC * D; K = D; N = INC; lk = 7; ln = 8; }
    else if (s < 22528) { t = s - 20480; W = a.in[I_WBP] + (size_t)L * 1024 * D; T = ws + WS_WBP + (size_t)L * D * 1024; K = 1024; N = D; lk = 6; ln = 5; }
    else if (s < 24576) { t = s - 22528; W = a.in[I_WBH] + (size_t)L * 1024 * D; T = ws + WS_WBH + (size_t)L * D * 1024; K = 1024; N = D; lk = 6; ln = 5; }
    else if (s < 28672) { t = s - 24576; W = a.in[I_WOUT] + (size_t)L * D * D; T = ws + WS_WOUT + (size_t)L * D * D; K = D; N = D; lk = 7; ln = 5; }
    else if (s < 45056) { t = s - 28672; W = a.in[I_WE1] + (size_t)L * NEXP * D * DEXP; T = ws + WS_WE13 + (size_t)L * NEXP * 1024 * D; K = D; N = DEXP; map = 1; lk = 7; ln = 3; }
    else if (s < 61440) { t = s - 45056; W = a.in[I_WE3] + (size_t)L * NEXP * D * DEXP; T = ws + WS_WE13 + (size_t)L * NEXP * 1024 * D; K = D; N = DEXP; map = 2; lk = 7; ln = 3; }
    else { t = s - 61440; W = a.in[I_WE2] + (size_t)L * NEXP * DEXP * D; T = ws + WS_WE2 + (size_t)L * NEXP * D * DEXP; K = DEXP; N = D; lk = 5; ln = 5; }
    const int kb = t & ((1 << lk) - 1), nb = (t >> lk) & ((1 << ln) - 1), mat = t >> (lk + ln);
    const int n = nb * 64 + lane, k0 = kb * 16;
    const size_t drow = map ? (size_t)mat * 1024 + (size_t)(n >> 7) * 256 + (map == 2 ? 128 : 0) + (n & 127) : (size_t)mat * N + n;
    ConvJob J; J.src = W + (size_t)mat * K * N + (size_t)k0 * N + n; J.dst = T + drow * K + k0; J.N = N; return J;
}
constexpr int CONV_ITEMS = 77824;
__device__ __forceinline__ void convert_range(Frame& F, const Args& a, int L, int lo, int hi, int rank, int n) {
    if (rank < 0 || L >= DEPTH || F.G != 256) return;
    for (int s0 = lo + (rank * 8 + F.wave) * 2; s0 < hi; s0 += n * 16) {
        const bool has2 = s0 + 1 < hi;
        const ConvJob J0 = conv_decode(a, F.ws, L, s0, F.lane), J1 = conv_decode(a, F.ws, L, has2 ? s0 + 1 : s0, F.lane);
        float v0[16], v1[16];
#pragma unroll
        for (int i = 0; i < 16; ++i) { v0[i] = __builtin_nontemporal_load(J0.src + (size_t)i * J0.N); v1[i] = __builtin_nontemporal_load(J1.src + (size_t)i * J1.N); }
        u32x4 o; o.x = pk4_fp8(v0[0] * W8_SCALE, v0[1] * W8_SCALE, v0[2] * W8_SCALE, v0[3] * W8_SCALE); o.y = pk4_fp8(v0[4] * W8_SCALE, v0[5] * W8_SCALE, v0[6] * W8_SCALE, v0[7] * W8_SCALE);
        o.z = pk4_fp8(v0[8] * W8_SCALE, v0[9] * W8_SCALE, v0[10] * W8_SCALE, v0[11] * W8_SCALE); o.w = pk4_fp8(v0[12] * W8_SCALE, v0[13] * W8_SCALE, v0[14] * W8_SCALE, v0[15] * W8_SCALE);
        *(u32x4*)J0.dst = o;
        if (has2) { o.x = pk4_fp8(v1[0] * W8_SCALE, v1[1] * W8_SCALE, v1[2] * W8_SCALE, v1[3] * W8_SCALE); o.y = pk4_fp8(v1[4] * W8_SCALE, v1[5] * W8_SCALE, v1[6] * W8_SCALE, v1[7] * W8_SCALE);
            o.z = pk4_fp8(v1[8] * W8_SCALE, v1[9] * W8_SCALE, v1[10] * W8_SCALE, v1[11] * W8_SCALE); o.w = pk4_fp8(v1[12] * W8_SCALE, v1[13] * W8_SCALE, v1[14] * W8_SCALE, v1[15] * W8_SCALE);
            *(u32x4*)J1.dst = o; }
    }
}
__device__ __forceinline__ void idle_rank(int nunits, int G, int c, int& rank, int& n) {
    const int rem = nunits % G;
    if (rem == 0 || G - rem < 64) { rank = c; n = G; } else { rank = c >= rem ? c - rem : -1; n = G - rem; }
}

__device__ __forceinline__ void phase_prologue(Frame& F, const Args& a) {
    unsigned char* ws = F.ws;
    int itbase = 0; const int nl = (F.G == 256) ? 0 : DEPTH;
    convert_range(F, a, 0, 0, CONV_ITEMS, (int)blockIdx.x, F.G);
    transpose_family(F, a.in[I_WIN], nl, D, INC, (bf16_t*)(ws + WS_WIN), 3, itbase, F.gw, F.NGW);
    transpose_family(F, a.in[I_WPG], DEPTH * 4, 256, 256, (bf16_t*)(ws + WS_WPG), 0, itbase, F.gw, F.NGW);
    transpose_family(F, a.in[I_WBP], nl, 1024, D, (bf16_t*)(ws + WS_WBP), 3, itbase, F.gw, F.NGW);
    transpose_family(F, a.in[I_WBH], nl, 1024, D, (bf16_t*)(ws + WS_WBH), 3, itbase, F.gw, F.NGW);
    transpose_family(F, a.in[I_WOUT], nl, D, D, (bf16_t*)(ws + WS_WOUT), 3, itbase, F.gw, F.NGW);
    transpose_family(F, a.in[I_WE1], nl * NEXP, D, DEXP, (bf16_t*)(ws + WS_WE13), 4, itbase, F.gw, F.NGW);
    transpose_family(F, a.in[I_WE3], nl * NEXP, D, DEXP, (bf16_t*)(ws + WS_WE13), 5, itbase, F.gw, F.NGW);
    transpose_family(F, a.in[I_WE2], nl * NEXP, DEXP, D, (bf16_t*)(ws + WS_WE2), 3, itbase, F.gw, F.NGW);
    if (blockIdx.x == 0) {
        const float* lg = a.in[I_LBLOG]; float* LB = (float*)(ws + WS_LB);
        for (int i = F.tid; i < 2 * 1024; i += 512) { const int dir = i >> 10, ch = i & 1023;
            float l[DEPTH], mx = -1e30f;
#pragma unroll
            for (int j = 0; j < DEPTH; ++j) { l[j] = lg[((size_t)dir * DEPTH + j) * 1024 + ch]; mx = fmaxf(mx, l[j]); }
            float s = 0.f;
#pragma unroll
            for (int j = 0; j < DEPTH; ++j) { l[j] = __expf(l[j] - mx); s += l[j]; }
            float cum = 0.f;
#pragma unroll
            for (int j = 0; j < DEPTH; ++j) { if (j > 0) cum += l[j] / s; LB[((size_t)j * 2 + dir) * 1024 + ch] = cum; } }
    }
    __syncthreads();
    {
        LAS float* sv = (LAS float*)F.lds;
        LAS float* red = (LAS float*)(F.lds + 5 * D * 4);
        for (int i = F.tid; i < 5 * D; i += 512) { const int r = i / D, k = i % D; const float v = r < 4 ? a.in[I_C][r * D + k] : a.in[I_CCTX][k]; sv[i] = fsilu(v); }
        __syncthreads();
        const float* wada = a.in[I_WADA]; const float* bada = a.in[I_BADA]; float* MOD = (float*)(ws + WS_MOD);
        constexpr int JB = 6 * D / 192;
        const int cg = F.tid % 48, kg = F.tid / 48;
        for (int it = blockIdx.x; it < DEPTH * JB; it += F.G) {
            const int layer = it / JB, j0 = (it % JB) * 192;
            if (kg < 10) {
                const float* w = wada + (size_t)layer * D * 6 * D + j0 + 4 * cg;
                f32x4 acc[5];
#pragma unroll
                for (int r = 0; r < 5; ++r) acc[r] = (f32x4){0.f, 0.f, 0.f, 0.f};
#pragma unroll 8
                for (int k = kg; k < D; k += 10) { const f32x4 wv = *(const f32x4*)(w + (size_t)k * 6 * D);
#pragma unroll
                    for (int r = 0; r < 5; ++r) acc[r] += wv * sv[r * D + k]; }
#pragma unroll
                for (int r = 0; r < 5; ++r) *(LAS f32x4*)(red + (kg * 5 + r) * 192 + 4 * cg) = acc[r];
            }
            __syncthreads();
            for (int o = F.tid; o < 5 * 192; o += 512) { const int r = o / 192, jj = o % 192; float t = bada[(size_t)layer * 6 * D + j0 + jj];
#pragma unroll
                for (int q = 0; q < 10; ++q) t += red[(q * 5 + r) * 192 + jj];
                MOD[((size_t)layer * 5 + r) * 6 * D + j0 + jj] = t; }
            __syncthreads();
        }
    }
    __syncthreads();
}

__device__ __forceinline__ void wave_rows(const Frame& F, int M, int& r0, int& r1) { r0 = (int)(((unsigned)F.gw * (unsigned)M) / (unsigned)F.NGW); r1 = (int)(((unsigned)(F.gw + 1) * (unsigned)M) / (unsigned)F.NGW); }
__device__ __forceinline__ int mod_row(int r) { return r < NLAT ? (r >> 12) : 4; }

__device__ __forceinline__ void xrow_load(const bf16_t* X, int r, int lane, f32x4 (&x)[8]) { const u32x2* xr = (const u32x2*)(X + (size_t)r * D) + lane;
#pragma unroll
    for (int j = 0; j < 8; ++j) { const u32x2 w = xr[64 * j]; x[j] = (f32x4){bflo(w.x), bfhi(w.x), bflo(w.y), bfhi(w.y)}; } }
__device__ __forceinline__ void xrow_store(bf16_t* X, int r, int lane, const f32x4 (&x)[8]) { u32x2* xr = (u32x2*)(X + (size_t)r * D) + lane;
#pragma unroll
    for (int j = 0; j < 8; ++j) { u32x2 w; w.x = pk2(x[j][0], x[j][1]); w.y = pk2(x[j][2], x[j][3]); xr[64 * j] = w; } }
template <int NR>
__device__ __forceinline__ void moe_combine_rows(f32x4 (&x)[NR][8], const int (&r)[NR], int lane, const unsigned char* ws, int player, const float* mod5) {
    const int* pb = (const int*)(ws + WS_PADBASE) + player * 16; const bf16_t* Y2 = (const bf16_t*)(ws + WS_Y2);
    int2 ri[NR]; float2 rg[NR]; const u32x2* y0[NR]; const u32x2* y1[NR];
#pragma unroll
    for (int q = 0; q < NR; ++q) { ri[q] = ((const int2*)(ws + WS_ROUTE_I))[r[q]]; rg[q] = ((const float2*)(ws + WS_ROUTE_G))[r[q]]; }
#pragma unroll
    for (int q = 0; q < NR; ++q) { const int s0 = pb[ri[q].x >> 20] + (ri[q].x & 0xfffff), s1 = pb[ri[q].y >> 20] + (ri[q].y & 0xfffff);
        y0[q] = (const u32x2*)(Y2 + (size_t)s0 * D) + lane; y1[q] = (const u32x2*)(Y2 + (size_t)s1 * D) + lane; }
#pragma unroll
    for (int j = 0; j < 8; ++j) { const f32x4 g = *((const f32x4*)mod5 + 64 * j + lane);
#pragma unroll
        for (int q = 0; q < NR; ++q) { const u32x2 a = y0[q][64 * j], b = y1[q][64 * j];
            const f32x4 ya = (f32x4){bflo(a.x), bfhi(a.x), bflo(a.y), bfhi(a.y)}, yb = (f32x4){bflo(b.x), bfhi(b.x), bflo(b.y), bfhi(b.y)};
            x[q][j] += g * (ya * rg[q].x + yb * rg[q].y); } }
}
__device__ __forceinline__ float row_sumsq(const f32x4 (&x)[8]) { float ss = 0.f;
#pragma unroll
    for (int j = 0; j < 8; ++j) ss += (x[j][0] * x[j][0] + x[j][1] * x[j][1]) + (x[j][2] * x[j][2] + x[j][3] * x[j][3]);
    return ss; }

__device__ __forceinline__ void phase_norm1(Frame& F, const Args& a, int layer, bool combine) {
    unsigned char* ws = F.ws; bf16_t* X = (bf16_t*)(ws + WS_X); bf16_t* H = (bf16_t*)(ws + WS_H);
    const float* MOD = (const float*)(ws + WS_MOD); const float* nw = a.in[I_N1W] + (size_t)layer * D;
    int r0, r1; wave_rows(F, MTOK, r0, r1);
    int curb = -1; f32x4 av[8], sv[8];
    for (int r = r0; r < r1;) {
        const int b = mod_row(r);
        const bool two = (r + 1 < r1) && (mod_row(r + 1) == b);
        const int rr[2] = {r, two ? r + 1 : r};
        if (b != curb) { curb = b; const float* m = MOD + ((size_t)layer * 5 + b) * 6 * D;
#pragma unroll
            for (int j = 0; j < 8; ++j) { const f32x4 w = *((const f32x4*)nw + 64 * j + F.lane), m1 = *((const f32x4*)(m + D) + 64 * j + F.lane); av[j] = w * (m1 + 1.f); sv[j] = *((const f32x4*)m + 64 * j + F.lane); } }
        f32x4 x[2][8];
#pragma unroll
        for (int q = 0; q < 2; ++q) {
            if (layer == 0) { const float* xs = rr[q] < NLAT ? a.in[I_X] + (size_t)rr[q] * D : a.in[I_CTX] + (size_t)(rr[q] - NLAT) * D;
                const f32x4* xr = (const f32x4*)xs + F.lane;
#pragma unroll
                for (int j = 0; j < 8; ++j) x[q][j] = xr[64 * j]; }
            else xrow_load(X, rr[q], F.lane, x[q]); }
        if (combine) { moe_combine_rows<2>(x, rr, F.lane, ws, layer - 1, MOD + ((size_t)(layer - 1) * 5 + b) * 6 * D + 5 * D);
#pragma unroll
            for (int q = 0; q < 2; ++q) if (q == 0 || two) xrow_store(X, rr[q], F.lane, x[q]); }
        float ss0 = row_sumsq(x[0]), ss1 = row_sumsq(x[1]);
#pragma unroll
        for (int o = 1; o < 64; o <<= 1) { ss0 += lane_xor(ss0, o, F.lane); ss1 += lane_xor(ss1, o, F.lane); }
        const float rs[2] = {1.0f / sqrtf(ss0 * (1.f / D) + EPS), 1.0f / sqrtf(ss1 * (1.f / D) + EPS)};
#pragma unroll
        for (int q = 0; q < 2; ++q) if (q == 0 || two) { unsigned* ho = (unsigned*)((unsigned char*)H + (size_t)rr[q] * D) + F.lane;
#pragma unroll
            for (int j = 0; j < 8; ++j) { const f32x4 h = x[q][j] * rs[q] * av[j] + sv[j]; int w = 0; w = __builtin_amdgcn_cvt_pk_fp8_f32(h[0], h[1], w, false); w = __builtin_amdgcn_cvt_pk_fp8_f32(h[2], h[3], w, true); ho[64 * j] = (unsigned)w; } }
        r += two ? 2 : 1;
    }
}

constexpr int RT_LCNT = LDS_MISC + 1024, RT_LBASE = LDS_MISC + 1088, RT_REC = LDS_MISC + 2048;
struct Route { int i1, i2; float g1, g2; };
__device__ __forceinline__ Route route_row(const float (&lg)[NEXP], const float* rbias) {
    float sc[NEXP], sel[NEXP];
#pragma unroll
    for (int e = 0; e < NEXP; ++e) { sc[e] = __builtin_amdgcn_rcpf(1.f + __builtin_amdgcn_exp2f(-1.44269504f * lg[e])); sel[e] = sc[e] + rbias[e]; }
    float gsc[4];
#pragma unroll
    for (int g = 0; g < 4; ++g) { float m1 = -1e30f, m2 = -1e30f;
#pragma unroll
        for (int i = 0; i < 4; ++i) { const float v = sel[g * 4 + i]; const bool c1 = v > m1, c2 = v > m2; m2 = c1 ? m1 : (c2 ? v : m2); m1 = c1 ? v : m1; }
        gsc[g] = m1 + m2; }
    int gbest = 0; float gbs = gsc[0];
#pragma unroll
    for (int g = 1; g < 4; ++g) { const bool c = gsc[g] > gbs; gbest = c ? g : gbest; gbs = c ? gsc[g] : gbs; }
    float sl[4], sx[4];
#pragma unroll
    for (int i = 0; i < 4; ++i) { sl[i] = gbest == 0 ? sel[i] : gbest == 1 ? sel[4 + i] : gbest == 2 ? sel[8 + i] : sel[12 + i]; sx[i] = gbest == 0 ? sc[i] : gbest == 1 ? sc[4 + i] : gbest == 2 ? sc[8 + i] : sc[12 + i]; }
    int i1 = 0, i2 = 0; float v1 = -1e30f, v2 = -1e30f, s1 = 0.f, s2 = 0.f;
#pragma unroll
    for (int i = 0; i < 4; ++i) { const float v = sl[i]; const bool c1 = v > v1, c2 = v > v2;
        i2 = c1 ? i1 : (c2 ? i : i2); s2 = c1 ? s1 : (c2 ? sx[i] : s2); v2 = c1 ? v1 : (c2 ? v : v2);
        i1 = c1 ? i : i1; s1 = c1 ? sx[i] : s1; v1 = c1 ? v : v1; }
    const float inv = __builtin_amdgcn_rcpf(s1 + s2);
    Route R; R.i1 = gbest * 4 + i1; R.i2 = gbest * 4 + i2; R.g1 = s1 * inv; R.g2 = s2 * inv; return R;
}
constexpr int RT_STRIDE = 4112;
constexpr int RT_WB = 0, RT_HT = 16 * RT_STRIDE, RT_PART = 32 * RT_STRIDE;
static_assert(RT_PART + 8192 <= LDS_MISC, "router LDS map");
__device__ __forceinline__ void phase_norm2_router(Frame& F, const Args& a, int layer, int Mrows, bool publish) {
    unsigned char* ws = F.ws; const bf16_t* X = (const bf16_t*)(ws + WS_X); bf16_t* H = (bf16_t*)(ws + WS_H);
    const float* MOD = (const float*)(ws + WS_MOD); const float* nw = a.in[I_N2W] + (size_t)layer * D;
    LAS unsigned char* L = F.lds;
    { const f32x4* wr4 = (const f32x4*)a.in[I_WROUTER];
#pragma unroll 1
      for (int i = 0; i < 2; ++i) { const int k = 2 * F.tid + 1024 * i; f32x4 wv[2][4];
#pragma unroll
          for (int h = 0; h < 2; ++h)
#pragma unroll
              for (int q = 0; q < 4; ++q) wv[h][q] = wr4[(size_t)(k + h) * 4 + q];
#pragma unroll
          for (int q = 0; q < 4; ++q)
#pragma unroll
              for (int ii = 0; ii < 4; ++ii) *(LAS unsigned*)(L + RT_WB + (4 * q + ii) * RT_STRIDE + k * 2) = pk2(wv[0][q][ii], wv[1][q][ii]); } }
    LAS unsigned* lcnt = (LAS unsigned*)(F.lds + RT_LCNT); LAS unsigned* lbase = (LAS unsigned*)(F.lds + RT_LBASE);
    if (F.tid < 16) lcnt[F.tid] = 0u;
    __syncthreads();
    const float* rbias = a.in[I_RBIAS];
    const int brow0 = 2 * (int)((blockIdx.x * (unsigned)(Mrows >> 1)) / (unsigned)F.G), brow1 = 2 * (int)(((blockIdx.x + 1) * (unsigned)(Mrows >> 1)) / (unsigned)F.G);
    const int nround = (brow1 - brow0 + 15) >> 4;
    const int fr = F.lane & 15, fq = F.lane >> 4;
#pragma unroll 1
    for (int t = 0; t < nround; ++t) {
        const int r = brow0 + 16 * t + 2 * F.wave;
        const bool v0 = r < brow1, v1 = r + 1 < brow1;
        const int rr[2] = {v0 ? r : brow0, v1 ? r + 1 : brow0};
        const int b = mod_row(rr[0]);
        const float* m = MOD + ((size_t)layer * 5 + b) * 6 * D;
        f32x4 x[2][8];
#pragma unroll
        for (int q = 0; q < 2; ++q) xrow_load(X, rr[q], F.lane, x[q]);
        float ss0 = row_sumsq(x[0]), ss1 = row_sumsq(x[1]);
#pragma unroll
        for (int o = 1; o < 64; o <<= 1) { ss0 += lane_xor(ss0, o, F.lane); ss1 += lane_xor(ss1, o, F.lane); }
        const float rs[2] = {1.0f / sqrtf(ss0 * (1.f / D) + EPS), 1.0f / sqrtf(ss1 * (1.f / D) + EPS)};
#pragma unroll
        for (int q = 0; q < 2; ++q) {
#pragma unroll
            for (int j = 0; j < 8; ++j) { const f32x4 w = *((const f32x4*)nw + 64 * j + F.lane), m4 = *((const f32x4*)(m + 4 * D) + 64 * j + F.lane), m3 = *((const f32x4*)(m + 3 * D) + 64 * j + F.lane);
                x[q][j] = x[q][j] * rs[q] * (w * (m4 + 1.f)) + m3; }
            if (q == 0 ? v0 : v1) { unsigned* ho = (unsigned*)((unsigned char*)H + (size_t)rr[q] * D) + F.lane;
#pragma unroll
                for (int j = 0; j < 8; ++j) ho[64 * j] = pk4_fp8(x[q][j][0], x[q][j][1], x[q][j][2], x[q][j][3]); }
            LAS unsigned char* hrow = L + RT_HT + (2 * F.wave + q) * RT_STRIDE + F.lane * 8;
#pragma unroll
            for (int j = 0; j < 8; ++j) { u32x2 w; w.x = pk2(x[q][j][0], x[q][j][1]); w.y = pk2(x[q][j][2], x[q][j][3]); *(LAS u32x2*)(hrow + j * 512) = w; } }
        __syncthreads();
        f32x4 acc = (f32x4){0.f, 0.f, 0.f, 0.f};
#pragma unroll
        for (int s = 0; s < 8; ++s) { const int kb = (256 * F.wave + 32 * s + 8 * fq) * 2;
            const bf16x8 wa = *(const LAS bf16x8*)(L + RT_WB + fr * RT_STRIDE + kb), hb = *(const LAS bf16x8*)(L + RT_HT + fr * RT_STRIDE + kb);
            acc = __builtin_amdgcn_mfma_f32_16x16x32_bf16(wa, hb, acc, 0, 0, 0); }
        *(LAS f32x4*)(L + RT_PART + F.wave * 1024 + fr * 64 + fq * 16) = acc;
        __syncthreads();
        if (F.lane < 2) { const int tr = 2 * F.wave + F.lane;
            f32x4 sg[4] = {(f32x4){0.f, 0.f, 0.f, 0.f}, (f32x4){0.f, 0.f, 0.f, 0.f}, (f32x4){0.f, 0.f, 0.f, 0.f}, (f32x4){0.f, 0.f, 0.f, 0.f}};
#pragma unroll
            for (int w8 = 0; w8 < 8; ++w8)
#pragma unroll
                for (int c = 0; c < 4; ++c) sg[c] += *(const LAS f32x4*)(L + RT_PART + w8 * 1024 + tr * 64 + c * 16);
            float lg[NEXP];
#pragma unroll
            for (int e = 0; e < NEXP; ++e) lg[e] = sg[e >> 2][e & 3];
            const Route R = route_row(lg, rbias); const int i1 = R.i1, i2 = R.i2; const float g1 = R.g1, g2 = R.g2;
            if ((F.lane == 0 ? v0 : v1) && publish) {
                const unsigned k1 = __hip_atomic_fetch_add(lcnt + i1, 1u, __ATOMIC_RELAXED, __HIP_MEMORY_SCOPE_WORKGROUP), k2 = __hip_atomic_fetch_add(lcnt + i2, 1u, __ATOMIC_RELAXED, __HIP_MEMORY_SCOPE_WORKGROUP);
                LAS unsigned* rec = (LAS unsigned*)(F.lds + RT_REC + (r + F.lane - brow0) * 32);
                rec[0] = (unsigned)i1; rec[1] = k1; rec[2] = (unsigned)i2; rec[3] = k2; rec[4] = __builtin_bit_cast(unsigned, g1); rec[5] = __builtin_bit_cast(unsigned, g2);
            } }
    }
    __syncthreads();
    if (F.tid < 16 && publish) { unsigned* cntw = (unsigned*)(ws + WS_CTL) + CW_CNT + layer * 1024; const unsigned n = lcnt[F.tid]; lbase[F.tid] = n ? atomicAdd(cntw + F.tid * 64, n) : 0u; }
    __syncthreads();
    if (F.tid < brow1 - brow0 && publish) { const int r = brow0 + F.tid; const LAS unsigned* rec = (const LAS unsigned*)(F.lds + RT_REC + F.tid * 32);
        const unsigned i1 = rec[0], i2 = rec[2], k1 = lbase[i1] + rec[1], k2 = lbase[i2] + rec[3];
        int* slottok = (int*)(ws + WS_SLOTTOK); slottok[(size_t)i1 * MTOK + k1] = r; slottok[(size_t)i2 * MTOK + k2] = r;
        ((int2*)(ws + WS_ROUTE_I))[r] = make_int2((int)((i1 << 20) | k1), (int)((i2 << 20) | k2));
        ((float2*)(ws + WS_ROUTE_G))[r] = make_float2(__builtin_bit_cast(float, rec[4]), __builtin_bit_cast(float, rec[5])); }
    __syncthreads();
}

__device__ __forceinline__ void phase_pooldiff(Frame& F, int Mrows) {
    unsigned char* ws = F.ws; const bf16_t* Z = (const bf16_t*)(ws + WS_Z); bf16_t* PD = (bf16_t*)(ws + WS_PD);
    LAS unsigned char* L = F.lds;
    const int cg = F.tid & 127, rq = F.tid >> 7, hw = 1 << (cg >> 5);
    const int ntile = NLAT / 64 + (Mrows > NLAT ? NCTX / 32 : 0);
    for (int tile = blockIdx.x; tile < ntile; tile += F.G) {
        int base, Lrow, t0, nt;
        if (tile < NLAT / 64) { base = tile * 64; Lrow = 64; t0 = 0; nt = 64; }
        else { const int u = tile - NLAT / 64; base = NLAT + (u >> 3) * CTXL; Lrow = CTXL; t0 = (u & 7) * 32; nt = 32; }
        const int lo = max(t0 - 8, 0), hi = min(t0 + nt + 7, Lrow - 1), nrow = hi - lo + 1;
        u32x4 buf[16];
#pragma unroll
        for (int i = 0; i < 16; ++i) { const int sl = rq + 4 * i; buf[i] = (sl < nrow) ? *(const u32x4*)(Z + (size_t)(base + lo + sl) * INC + ZC_POOL + cg * 8) : (u32x4){0u, 0u, 0u, 0u}; }
#pragma unroll
        for (int i = 0; i < 16; ++i) { const int sl = rq + 4 * i; *(LAS u32x4*)(L + sl * 2048 + cg * 16) = buf[i]; }
        __syncthreads();
        for (int i = 0; i < nt / 4; ++i) { const int t = t0 + rq + 4 * i;
            const int wl = max(t - hw, 0), wh = min(t + hw - 1, Lrow - 1);
            float s[8] = {0.f, 0.f, 0.f, 0.f, 0.f, 0.f, 0.f, 0.f};
            for (int p = wl; p <= wh; ++p) { const u32x4 a = *(const LAS u32x4*)(L + (p - lo) * 2048 + cg * 16);
                s[0] += bflo(a.x); s[1] += bfhi(a.x); s[2] += bflo(a.y); s[3] += bfhi(a.y); s[4] += bflo(a.z); s[5] += bfhi(a.z); s[6] += bflo(a.w); s[7] += bfhi(a.w); }
            const float inv = 1.f / (float)(wh - wl + 1);
            const u32x4 a = *(const LAS u32x4*)(L + (t - lo) * 2048 + cg * 16);
            u32x4 o; o.x = pk2(s[0] * inv - bflo(a.x), s[1] * inv - bfhi(a.x)); o.y = pk2(s[2] * inv - bflo(a.y), s[3] * inv - bfhi(a.y));
            o.z = pk2(s[4] * inv - bflo(a.z), s[5] * inv - bfhi(a.z)); o.w = pk2(s[6] * inv - bflo(a.w), s[7] * inv - bfhi(a.w));
            *(u32x4*)(PD + (size_t)(base + t) * DPOOL + cg * 8) = o; }
        __syncthreads();
    }
}

constexpr int SC_QS = 0, SC_KS = 17408, SC_KST = 34816, SC_VT = 53248, SC_VEC = 71680;
constexpr int SC_ST = 73216, SC_TOT = SC_ST + 34816, SC_END = SC_TOT + 4096;
constexpr int SC_P272 = 272, SC_P144 = 144;
constexpr int SEG_CH = 17, NSEG = 4;
static_assert(SC_END <= LDS_MISC, "scan LDS map");
struct ScanCtx { const bf16_t* Z; bf16_t* O2; LAS unsigned char* L; unsigned char* qsg; float* corrv; float* smid; float* totseg; int tid, lane, w, fr, fq, rt, vp, b, h, seg, dir, colq, colf, colv; };
__device__ __forceinline__ void scan_row0(int b, int dir, int c, int& g0, int& sg) {
    if (c < 4) { const int t0 = 64 * c; g0 = NLAT + b * CTXL + (dir ? CTXL - 1 - t0 : t0); } else { const int t0 = 64 * (c - 4); g0 = b * SEQ + (dir ? SEQ - 1 - t0 : t0); }
    sg = dir ? -1 : 1;
}
__device__ __forceinline__ void scan_load_lf(const ScanCtx& C, int c, unsigned (&lfw)[8]) {
    int g0, sg; scan_row0(C.b, C.dir, c, g0, sg);
#pragma unroll
    for (int j = 0; j < 8; ++j) lfw[j] = *(const unsigned*)(C.Z + (size_t)(g0 + sg * (8 * C.w + j)) * INC + C.colf);
}
__device__ __forceinline__ void scan_load_qv(const ScanCtx& C, int c, unsigned (&qw)[8], unsigned (&vw)[8]) {
    int g0, sg; scan_row0(C.b, C.dir, c, g0, sg);
#pragma unroll
    for (int j = 0; j < 8; ++j) { const bf16_t* zr = C.Z + (size_t)(g0 + sg * (8 * C.w + j)) * INC; qw[j] = *(const unsigned*)(zr + C.colq); vw[j] = *(const unsigned*)(zr + C.colv); }
}
__device__ __forceinline__ void scan_p1(const ScanCtx& C, const unsigned (&lfw)[8]) {
    float a0 = 0.f, a1 = 0.f;
#pragma unroll
    for (int j = 0; j < 8; ++j) { a0 += bflo(lfw[j]); a1 += bfhi(lfw[j]); }
    *(LAS f32x2*)(C.L + SC_TOT + (C.w * 128 + 2 * C.lane) * 4) = (f32x2){a0, a1};
}
__device__ __forceinline__ void scan_p2(const ScanCtx& C, int cl, const unsigned (&lfw)[8], const unsigned (&qw)[8], const unsigned (&vw)[8], float& cum0, float& cum1) {
    LAS unsigned char* L = C.L; const int lane = C.lane, w = C.w;
    float c0[8], c1[8], l0[8], l1[8];
    { float a0 = 0.f, a1 = 0.f;
#pragma unroll
      for (int j = 0; j < 8; ++j) { l0[j] = bflo(lfw[j]); l1[j] = bfhi(lfw[j]); a0 += l0[j]; a1 += l1[j]; c0[j] = a0; c1[j] = a1; } }
    float P0 = 0.f, P1 = 0.f, r0 = 0.f, r1 = 0.f, bl0 = 0.f, bl1 = 0.f;
#pragma unroll
    for (int o = 0; o < 8; ++o) { const f32x2 t = *(const LAS f32x2*)(L + SC_TOT + (o * 128 + 2 * lane) * 4);
        if (o < w) { P0 += t.x; P1 += t.y; } if (o < 4) { r0 += t.x; r1 += t.y; } bl0 += t.x; bl1 += t.y; }
    float k0v[8], k1v[8]; const float P0r = P0 - r0, P1r = P1 - r1;
#pragma unroll
    for (int j = 0; j < 8; ++j) {
        const float d0 = __builtin_amdgcn_fmed3f(P0r + c0[j], -120.f, 120.f), d1 = __builtin_amdgcn_fmed3f(P1r + c1[j], -120.f, 120.f);
        const float E0 = __builtin_amdgcn_exp2f(d0), E1 = __builtin_amdgcn_exp2f(d1), I0 = __builtin_amdgcn_exp2f(-d0), I1 = __builtin_amdgcn_exp2f(-d1);
        const float f0 = __builtin_amdgcn_exp2f(l0[j]), f1 = __builtin_amdgcn_exp2f(l1[j]);
        const float q0 = bflo(qw[j]), q1 = bfhi(qw[j]);
        k0v[j] = (1.f - f0) * I0; k1v[j] = (1.f - f1) * I1;
        const int rho = 8 * w + j;
        *(LAS unsigned*)(L + SC_QS + rho * SC_P272 + 4 * lane) = pk2(q0 * E0, q1 * E1);
        *(LAS unsigned*)(L + SC_KS + rho * SC_P272 + 4 * lane) = pk2(k0v[j], k1v[j]);
    }
    { u32x4 t0, t1; t0.x = pk2(k0v[0], k0v[1]); t0.y = pk2(k0v[2], k0v[3]); t0.z = pk2(k0v[4], k0v[5]); t0.w = pk2(k0v[6], k0v[7]);
      t1.x = pk2(k1v[0], k1v[1]); t1.y = pk2(k1v[2], k1v[3]); t1.z = pk2(k1v[4], k1v[5]); t1.w = pk2(k1v[6], k1v[7]);
      *(LAS u32x4*)(L + SC_KST + (2 * lane) * SC_P144 + 16 * w) = t0; *(LAS u32x4*)(L + SC_KST + (2 * lane + 1) * SC_P144 + 16 * w) = t1; }
    if (w == 0) {
        LAS float* vec = (LAS float*)(L + SC_VEC);
        *(LAS f32x2*)(vec + 2 * lane) = (f32x2){__builtin_amdgcn_exp2f(fmaxf(r0, -120.f)), __builtin_amdgcn_exp2f(fmaxf(r1, -120.f))};
        *(LAS f32x2*)(vec + 128 + 2 * lane) = (f32x2){__builtin_amdgcn_exp2f(fmaxf(bl0, -120.f)), __builtin_amdgcn_exp2f(fmaxf(bl1, -120.f))};
        *(LAS f32x2*)(vec + 256 + 2 * lane) = (f32x2){__builtin_amdgcn_exp2f(fmaxf(bl0 - r0, -120.f)), __builtin_amdgcn_exp2f(fmaxf(bl1 - r1, -120.f))};
        if (C.seg >= 1) *(f32x2*)(C.corrv + cl * 128 + 2 * lane) = (f32x2){r0 + cum0, r1 + cum1};
    }
    cum0 += bl0; cum1 += bl1;
    { u32x4 t0, t1;
      t0.x = (vw[0] & 0xffffu) | (vw[1] << 16); t0.y = (vw[2] & 0xffffu) | (vw[3] << 16); t0.z = (vw[4] & 0xffffu) | (vw[5] << 16); t0.w = (vw[6] & 0xffffu) | (vw[7] << 16);
      t1.x = (vw[0] >> 16) | (vw[1] & 0xffff0000u); t1.y = (vw[2] >> 16) | (vw[3] & 0xffff0000u); t1.z = (vw[4] >> 16) | (vw[5] & 0xffff0000u); t1.w = (vw[6] >> 16) | (vw[7] & 0xffff0000u);
      *(LAS u32x4*)(L + SC_VT + (2 * lane) * SC_P144 + 16 * w) = t0; *(LAS u32x4*)(L + SC_VT + (2 * lane + 1) * SC_P144 + 16 * w) = t1; }
}
__device__ __forceinline__ void scan_c1(const ScanCtx& C, const f32x4 (&S)[2][4]) {
#pragma unroll
    for (int i = 0; i < 2; ++i) { const int k = ((C.w >> 1) * 2 + i) * 16 + 4 * C.fq;
        f32x4 r = *(const LAS f32x4*)(C.L + SC_TOT + k * 4);
#pragma unroll
        for (int o = 1; o < 4; ++o) r += *(const LAS f32x4*)(C.L + SC_TOT + (o * 128 + k) * 4);
        f32x4 e;
#pragma unroll
        for (int q = 0; q < 4; ++q) e[q] = __builtin_amdgcn_exp2f(fmaxf(r[q], -120.f));
#pragma unroll
        for (int u = 0; u < 4; ++u) { const int v = (4 * C.vp + u) * 16 + C.fr; const f32x4 sv = S[i][u] * e;
            u32x2 t; t.x = pk2(sv[0], sv[1]); t.y = pk2(sv[2], sv[3]); *(LAS u32x2*)(C.L + SC_ST + v * SC_P272 + k * 2) = t; } }
}
__device__ __forceinline__ void scan_c2(const ScanCtx& C, int c, f32x4 (&S)[2][4]) {
    LAS unsigned char* L = C.L; const int fr = C.fr, fq = C.fq, rt = C.rt, w = C.w;
    bf16x8 yq[4];
#pragma unroll
    for (int ks = 0; ks < 4; ++ks) yq[ks] = *(const LAS bf16x8*)(L + SC_QS + (rt * 16 + fr) * SC_P272 + (ks * 32 + fq * 8) * 2);
    f32x4 at[4];
#pragma unroll
    for (int st = 0; st < 4; ++st) { f32x4 a = (f32x4){0.f, 0.f, 0.f, 0.f};
        if (st <= rt) {
#pragma unroll
            for (int ks = 0; ks < 4; ++ks) { const bf16x8 x = *(const LAS bf16x8*)(L + SC_KS + (st * 16 + fr) * SC_P272 + (ks * 32 + fq * 8) * 2); a = __builtin_amdgcn_mfma_f32_16x16x32_bf16(x, yq[ks], a, 0, 0, 0); }
            if (st == rt) {
#pragma unroll
                for (int r = 0; r < 4; ++r) if (4 * fq + r > fr) a[r] = 0.f; } }
        at[st] = a; }
    u32x4 yw[2];
#pragma unroll
    for (int ks2 = 0; ks2 < 2; ++ks2) { yw[ks2].x = pk2(at[2 * ks2][0], at[2 * ks2][1]); yw[ks2].y = pk2(at[2 * ks2][2], at[2 * ks2][3]); yw[ks2].z = pk2(at[2 * ks2 + 1][0], at[2 * ks2 + 1][1]); yw[ks2].w = pk2(at[2 * ks2 + 1][2], at[2 * ks2 + 1][3]); }
    int g0, sg; scan_row0(C.b, C.dir, c, g0, sg);
#pragma unroll
    for (int u = 0; u < 4; ++u) { const int vt = 4 * C.vp + u; f32x4 o = (f32x4){0.f, 0.f, 0.f, 0.f};
#pragma unroll
        for (int ks = 0; ks < 4; ++ks) { const bf16x8 x = *(const LAS bf16x8*)(L + SC_ST + (vt * 16 + fr) * SC_P272 + (ks * 32 + fq * 8) * 2); o = __builtin_amdgcn_mfma_f32_16x16x32_bf16(x, yq[ks], o, 0, 0, 0); }
#pragma unroll
        for (int ks2 = 0; ks2 < 2; ++ks2) { if (2 * ks2 <= rt) {
            const u32x2 xa = *(const LAS u32x2*)(L + SC_VT + (vt * 16 + fr) * SC_P144 + (ks2 * 32 + 4 * fq) * 2), xb = *(const LAS u32x2*)(L + SC_VT + (vt * 16 + fr) * SC_P144 + (ks2 * 32 + 16 + 4 * fq) * 2);
            u32x4 xw; xw.x = xa.x; xw.y = xa.y; xw.z = xb.x; xw.w = xb.y;
            o = __builtin_amdgcn_mfma_f32_16x16x32_bf16(__builtin_bit_cast(bf16x8, xw), __builtin_bit_cast(bf16x8, yw[ks2]), o, 0, 0, 0); } }
        u32x2 ow; ow.x = pk2(o[0], o[1]); ow.y = pk2(o[2], o[3]);
        *(u32x2*)(C.O2 + ((size_t)C.dir * MTOK + (g0 + sg * (rt * 16 + fr))) * HGW + C.h * HDK + vt * 16 + 4 * fq) = ow;
        __builtin_amdgcn_sched_barrier(0); }
    bf16x8 xk[2][2];
#pragma unroll
    for (int i = 0; i < 2; ++i)
#pragma unroll
        for (int ks = 0; ks < 2; ++ks) xk[i][ks] = *(const LAS bf16x8*)(L + SC_KST + (((w >> 1) * 2 + i) * 16 + fr) * SC_P144 + (ks * 32 + fq * 8) * 2);
#pragma unroll
    for (int u = 0; u < 4; ++u) { bf16x8 yv[2];
#pragma unroll
        for (int ks = 0; ks < 2; ++ks) yv[ks] = *(const LAS bf16x8*)(L + SC_VT + ((4 * C.vp + u) * 16 + fr) * SC_P144 + (ks * 32 + fq * 8) * 2);
#pragma unroll
        for (int i = 0; i < 2; ++i) { f32x4 d = (f32x4){0.f, 0.f, 0.f, 0.f};
#pragma unroll
            for (int ks = 0; ks < 2; ++ks) d = __builtin_amdgcn_mfma_f32_16x16x32_bf16(xk[i][ks], yv[ks], d, 0, 0, 0);
            const int k = ((w >> 1) * 2 + i) * 16 + 4 * fq; const f32x4 ebl = *(const LAS f32x4*)(L + SC_VEC + (128 + k) * 4), ebr = *(const LAS f32x4*)(L + SC_VEC + (256 + k) * 4);
            S[i][u] = ebl * S[i][u] + ebr * d; }
        __builtin_amdgcn_sched_barrier(0); }
}
__device__ __forceinline__ void phase_scan_mfma(Frame& F) {
    ScanCtx C; C.Z = (const bf16_t*)(F.ws + WS_Z); C.O2 = (bf16_t*)(F.ws + WS_O2); C.L = F.lds;
    C.tid = F.tid; C.lane = F.lane; C.w = F.wave; C.fr = F.lane & 15; C.fq = F.lane >> 4; C.rt = F.wave >> 1; C.vp = F.wave & 1;
    for (int it = blockIdx.x; it < 64 * NSEG; it += F.G) {
        const int sbh = it >> 2; C.h = sbh & 7; C.b = (sbh >> 3) & 3; C.dir = sbh >> 5;
        C.seg = C.dir ? 3 - (it & 3) : (it & 3);
        C.qsg = F.ws + WS_QSG + (size_t)(sbh * 3 + (C.seg - 1)) * SEG_CH * 17408; C.corrv = (float*)(F.ws + WS_CORRV) + (size_t)(sbh * 3 + (C.seg - 1)) * SEG_CH * 128;
        C.smid = (float*)(F.ws + WS_SMID) + (size_t)(sbh * 3 + C.seg) * 128 * 128; C.totseg = (float*)(F.ws + WS_TOTSEG) + (size_t)(sbh * NSEG + C.seg) * 128;
        C.colq = ZC_Q + C.h * HDK + 2 * C.lane; C.colf = (C.dir == 0 ? ZC_FF : ZC_FB) + C.h * HDK + 2 * C.lane; C.colv = ZC_I + C.h * HDK + 2 * C.lane;
        f32x4 S[2][4];
#pragma unroll
        for (int i = 0; i < 2; ++i)
#pragma unroll
            for (int u = 0; u < 4; ++u) S[i][u] = (f32x4){0.f, 0.f, 0.f, 0.f};
        float cum0 = 0.f, cum1 = 0.f;
        unsigned lfW[8], qW[8], vW[8];
        const int c_lo = C.seg * SEG_CH;
        scan_load_lf(C, c_lo, lfW); scan_load_qv(C, c_lo, qW, vW);
        scan_p1(C, lfW);
        __syncthreads();
#define SC_STEP(cl) do { \
            scan_p2(C, (cl), lfW, qW, vW, cum0, cum1); scan_c1(C, S); \
            if ((cl) + 1 < SEG_CH) { scan_load_lf(C, c_lo + (cl) + 1, lfW); scan_load_qv(C, c_lo + (cl) + 1, qW, vW); } \
            __syncthreads(); \
            if (C.seg >= 1) { unsigned char* dst = C.qsg + (size_t)(cl) * 17408; const LAS unsigned char* src = C.L + SC_QS; for (int i_ = C.tid; i_ < 1088; i_ += 512) *(u32x4*)(dst + 16 * i_) = *(const LAS u32x4*)(src + 16 * i_); } \
            scan_c2(C, c_lo + (cl), S); \
            if ((cl) + 1 < SEG_CH) scan_p1(C, lfW); \
            __syncthreads(); } while (0)
        for (int cl = 0; cl < SEG_CH; ++cl) SC_STEP(cl);
#undef SC_STEP
        if (C.seg < 3) {
#pragma unroll
            for (int i = 0; i < 2; ++i)
#pragma unroll
                for (int u = 0; u < 4; ++u) *(f32x4*)(C.smid + ((4 * C.vp + u) * 16 + C.fr) * 128 + ((C.w >> 1) * 2 + i) * 16 + 4 * C.fq) = S[i][u]; }
        if (C.w == 0) *(f32x2*)(C.totseg + 2 * C.lane) = (f32x2){cum0, cum1};
        __syncthreads();
    }
}
__device__ __forceinline__ void phase_scan_fix(Frame& F) {
    unsigned char* ws = F.ws; bf16_t* O2 = (bf16_t*)(ws + WS_O2); LAS unsigned char* L = F.lds;
    LAS float* facv = (LAS float*)(L + 36864); LAS int* flg = (LAS int*)(L + 36864 + 512);
    const int w = F.wave, fr = F.lane & 15, fq = F.lane >> 4, rt = w >> 1, vp = w & 1;
    for (int item = blockIdx.x; item < 64 * 3; item += F.G) {
        const int j = 1 + item % 3, sbh = item / 3, dir = sbh >> 5, b = (sbh >> 3) & 3, h = sbh & 7;
        const int v = F.tid >> 2, k0 = (F.tid & 3) * 32;
        f32x4 sin[8];
        { const float* E = (const float*)(ws + WS_SMID) + ((size_t)(sbh * 3 + 0) * 128 + v) * 128 + k0;
#pragma unroll
          for (int i = 0; i < 8; ++i) sin[i] = *(const f32x4*)(E + 4 * i); }
        for (int jj = 1; jj < j; ++jj) { const float* E = (const float*)(ws + WS_SMID) + ((size_t)(sbh * 3 + jj) * 128 + v) * 128 + k0; const float* T = (const float*)(ws + WS_TOTSEG) + (size_t)(sbh * NSEG + jj) * 128 + k0;
#pragma unroll
            for (int i = 0; i < 8; ++i) { const f32x4 t = *(const f32x4*)(T + 4 * i); f32x4 d;
#pragma unroll
                for (int q = 0; q < 4; ++q) d[q] = __builtin_amdgcn_exp2f(fmaxf(t[q], -200.f));
                sin[i] = d * sin[i] + *(const f32x4*)(E + 4 * i); } }
        for (int cl = 0; cl < SEG_CH; ++cl) {
            if (F.tid == 0) flg[0] = 0;
            __syncthreads();
            if (F.tid < 128) { const float e = ((const float*)(ws + WS_CORRV))[((size_t)(sbh * 3 + (j - 1)) * SEG_CH + cl) * 128 + F.tid]; const float f = __builtin_amdgcn_exp2f(fmaxf(e, -200.f)); facv[F.tid] = f; if (f != 0.f) flg[0] = 1; }
            __syncthreads();
            if (flg[0] != 0) {
#pragma unroll
                for (int i = 0; i < 4; ++i) { const f32x4 a0 = sin[2 * i] * *(const LAS f32x4*)(facv + k0 + 8 * i), a1 = sin[2 * i + 1] * *(const LAS f32x4*)(facv + k0 + 8 * i + 4);
                    u32x4 o; o.x = pk2(a0[0], a0[1]); o.y = pk2(a0[2], a0[3]); o.z = pk2(a1[0], a1[1]); o.w = pk2(a1[2], a1[3]);
                    *(LAS u32x4*)(L + v * SC_P272 + (k0 + 8 * i) * 2) = o; }
                __syncthreads();
                const unsigned char* qs = ws + WS_QSG + ((size_t)(sbh * 3 + (j - 1)) * SEG_CH + cl) * 17408;
                bf16x8 yq[4];
#pragma unroll
                for (int ks = 0; ks < 4; ++ks) yq[ks] = *(const bf16x8*)(qs + (rt * 16 + fr) * SC_P272 + (ks * 32 + fq * 8) * 2);
                int g0, sg; scan_row0(b, dir, j * SEG_CH + cl, g0, sg);
#pragma unroll
                for (int u = 0; u < 4; ++u) { const int vt = 4 * vp + u; f32x4 o = (f32x4){0.f, 0.f, 0.f, 0.f};
#pragma unroll
                    for (int ks = 0; ks < 4; ++ks) { const bf16x8 x = *(const LAS bf16x8*)(L + (vt * 16 + fr) * SC_P272 + (ks * 32 + fq * 8) * 2); o = __builtin_amdgcn_mfma_f32_16x16x32_bf16(x, yq[ks], o, 0, 0, 0); }
                    u32x2* p = (u32x2*)(O2 + ((size_t)dir * MTOK + (g0 + sg * (rt * 16 + fr))) * HGW + h * HDK + vt * 16 + 4 * fq);
                    const u32x2 old = *p; u32x2 nw; nw.x = pk2(bflo(old.x) + o[0], bfhi(old.x) + o[1]); nw.y = pk2(bflo(old.y) + o[2], bfhi(old.y) + o[3]); *p = nw; }
            }
            __syncthreads();
        }
    }
}
__device__ __forceinline__ void phase_readout_naive(Frame& F, const Args& a, int layer, int Mrows) {
    unsigned char* ws = F.ws; const bf16_t* Z = (const bf16_t*)(ws + WS_Z); const float* O2 = (const float*)(ws + WS_O2); bf16_t* HG = (bf16_t*)(ws + WS_HG);
    const float* wn = a.in[I_HGNW] + (size_t)layer * HGW;
    int r0, r1; wave_rows(F, Mrows, r0, r1);
    const int c0 = F.lane * 16;
    float wv[16];
#pragma unroll
    for (int j = 0; j < 16; ++j) wv[j] = wn[c0 + j] * HG8_SCALE;
    for (int rb = r0; rb < r1; rb += 2) {
        const bool two = rb + 1 < r1; const int rr[2] = {rb, two ? rb + 1 : rb};
        u32x2 xw[2][4], yw[2][4]; u32x4 ga[2], gb[2];
#pragma unroll
        for (int q = 0; q < 2; ++q) {
#pragma unroll
            for (int j = 0; j < 4; ++j) { xw[q][j] = *(const u32x2*)((const bf16_t*)O2 + (size_t)rr[q] * HGW + c0 + 4 * j); yw[q][j] = *(const u32x2*)((const bf16_t*)O2 + ((size_t)MTOK + rr[q]) * HGW + c0 + 4 * j); }
            const u32x4* zp = (const u32x4*)(Z + (size_t)rr[q] * INC + ZC_OG + c0); ga[q] = zp[0]; gb[q] = zp[1]; }
#pragma unroll
        for (int q = 0; q < 2; ++q) { if (q == 0 || two) {
            float o[16]; float ss = 0.f;
#pragma unroll
            for (int j = 0; j < 4; ++j) { const f32x4 x = (f32x4){bflo(xw[q][j].x), bfhi(xw[q][j].x), bflo(xw[q][j].y), bfhi(xw[q][j].y)}, y = (f32x4){bflo(yw[q][j].x), bfhi(yw[q][j].x), bflo(yw[q][j].y), bfhi(yw[q][j].y)};
#pragma unroll
                for (int i = 0; i < 4; ++i) { o[4 * j + i] = x[i] + y[i]; ss += o[4 * j + i] * o[4 * j + i]; } }
            ss += lane_xor(ss, 1, F.lane); ss += lane_xor(ss, 2, F.lane); ss += lane_xor(ss, 4, F.lane);
            const float rs = 1.0f / sqrtf(ss * (1.f / HDK) + EPS);
            const float g[16] = {bflo(ga[q].x), bfhi(ga[q].x), bflo(ga[q].y), bfhi(ga[q].y), bflo(ga[q].z), bfhi(ga[q].z), bflo(ga[q].w), bfhi(ga[q].w), bflo(gb[q].x), bfhi(gb[q].x), bflo(gb[q].y), bfhi(gb[q].y), bflo(gb[q].z), bfhi(gb[q].z), bflo(gb[q].w), bfhi(gb[q].w)};
            float y[16];
#pragma unroll
            for (int j = 0; j < 16; ++j) y[j] = o[j] * rs * wv[j] * g[j];
            u32x4 o0; o0.x = pk4_fp8(y[0], y[1], y[2], y[3]); o0.y = pk4_fp8(y[4], y[5], y[6], y[7]); o0.z = pk4_fp8(y[8], y[9], y[10], y[11]); o0.w = pk4_fp8(y[12], y[13], y[14], y[15]);
            *(u32x4*)((unsigned char*)HG + (size_t)rr[q] * HGW + c0) = o0; } }
    }
}

__device__ __forceinline__ void phase_final(Frame& F, const Args& a) {
    unsigned char* ws = F.ws; const bf16_t* X = (const bf16_t*)(ws + WS_X); const float* MOD = (const float*)(ws + WS_MOD); const float* fw = a.in[I_FNW];
    int r0, r1; wave_rows(F, NLAT, r0, r1);
    for (int r = r0; r < r1;) {
        const bool two = (r + 1 < r1) && (mod_row(r + 1) == mod_row(r));
        const int rr[2] = {r, two ? r + 1 : r};
        f32x4 x[2][8];
#pragma unroll
        for (int q = 0; q < 2; ++q) xrow_load(X, rr[q], F.lane, x[q]);
        moe_combine_rows<2>(x, rr, F.lane, ws, DEPTH - 1, MOD + ((size_t)(DEPTH - 1) * 5 + mod_row(r)) * 6 * D + 5 * D);
        float ss0 = row_sumsq(x[0]), ss1 = row_sumsq(x[1]);
#pragma unroll
        for (int o = 1; o < 64; o <<= 1) { ss0 += lane_xor(ss0, o, F.lane); ss1 += lane_xor(ss1, o, F.lane); }
        const float rs[2] = {1.0f / sqrtf(ss0 * (1.f / D) + EPS), 1.0f / sqrtf(ss1 * (1.f / D) + EPS)};
#pragma unroll
        for (int q = 0; q < 2; ++q) if (q == 0 || two) { f32x4* o = (f32x4*)(a.out + (size_t)rr[q] * D) + F.lane;
#pragma unroll
            for (int j = 0; j < 8; ++j) o[64 * j] = x[q][j] * rs[q] * *((const f32x4*)fw + 64 * j + F.lane); }
        r += two ? 2 : 1;
    }
}

__device__ __forceinline__ int moe_tables(Frame& F, int layer) {
    LAS int* tbl = (LAS int*)(F.lds + LDS_MISC + 64);
    const unsigned* cntw = (const unsigned*)(F.ws + WS_CTL) + CW_CNT + layer * 1024;
    if (F.tid < NEXP) tbl[F.tid] = (int)__hip_atomic_load(cntw + F.tid * 64, __ATOMIC_RELAXED, __HIP_MEMORY_SCOPE_AGENT);
    __syncthreads();
    if (F.tid == 0) {
        int blk = 0;
#pragma unroll 1
        for (int e = 0; e < NEXP; ++e) { const int c = tbl[e]; const int nb = (c + 255) >> 8;
            tbl[16 + e] = blk; for (int j = 0; j < nb; ++j) tbl[64 + blk + j] = e;
            if (blockIdx.x == 0) ((int*)(F.ws + WS_PADBASE))[layer * 16 + e] = blk * 256;
            blk += nb; }
        tbl[32] = blk;
    }
    __syncthreads();
    return tbl[32];
}

constexpr int PH_PER_LAYER = 10;
constexpr int N_PHASES = 1 + DEPTH * PH_PER_LAYER + 1;

__global__ void __launch_bounds__(512, 2) mk_fwd(Args args) {
    extern __shared__ __attribute__((aligned(16))) unsigned char lds_raw[];
    Frame F;
    F.lds = (LAS unsigned char*)lds_raw;
    F.tid = threadIdx.x; F.lane = F.tid & 63; F.wave = __builtin_amdgcn_readfirstlane(F.tid >> 6);
    F.G = gridDim.x; F.gw = blockIdx.x * 8 + F.wave; F.NGW = F.G * 8; F.ws = args.ws;
    unsigned char* ws = args.ws;
    volatile LAS unsigned* misc = (volatile LAS unsigned*)(F.lds + LDS_MISC);
    if (F.tid < 16) misc[F.tid] = 0u;
    __syncthreads();
    const int lo = args.ph_lo, hi = args.ph_hi;
#if MK_ONE_LAUNCH
    XcdBarrier bar = xcd_barrier_post((unsigned*)(ws + WS_CTL) + CW_BAR, misc);
#define GRID_BAR() xcd_barrier(bar)
#else
#define GRID_BAR() do {} while (0)
#endif
#ifndef MK_PHMASK
#define MK_PHMASK 0xFFFF
#endif
#define PHON(b) ((MK_PHMASK >> (b)) & 1)
#ifndef MK_REPMASK
#define MK_REPMASK 0
#endif
#define REPS(b) (((args.rep >> (b)) & 1) + 1)
#define IN(k) (lo <= (k) && (k) < hi)
#define LAUNDER() do { int t_ = threadIdx.x; asm volatile("" : "+v"(t_)); F.tid = t_; F.lane = t_ & 63; unsigned char* w_ = args.ws; asm volatile("" : "+s"(w_)); F.ws = w_; ws = w_; } while (0)
#define SEAM(k) do { if (IN(k) && IN((k) + 1)) { GRID_BAR(); if ((args.rep >> 15) & 1) GRID_BAR(); } } while (0)

    if (PHON(0) && IN(0)) { LAUNDER(); for (int rep_ = 0; rep_ < REPS(0); ++rep_) { if (rep_) { VM_WAIT(); __syncthreads(); } phase_prologue(F, args); } }
    SEAM(0);

    for (int layer_ = 0; layer_ < DEPTH; ++layer_) {
        int layer = layer_; asm volatile("" : "+s"(layer));
        const int pb = 1 + layer * PH_PER_LAYER;
        const bool lastl = (layer == DEPTH - 1);
        const int Mr = lastl ? NLAT : MTOK;
        if (PHON(1) && IN(pb + 0)) { LAUNDER(); for (int rep_ = 0; rep_ < REPS(1); ++rep_) { if (rep_) { VM_WAIT(); __syncthreads(); } phase_norm1(F, args, layer, layer > 0 && rep_ == 0); } }
        SEAM(pb + 0);
        if (PHON(2) && IN(pb + 1)) { LAUNDER(); for (int rep_ = 0; rep_ < REPS(2); ++rep_) { if (rep_) { VM_WAIT(); __syncthreads(); }
            pg8::DenseOrder S; S.init(MTOK, INC, F.G, (int)blockIdx.x, D, 0);
            pg8::EpiIn E{(bf16_t*)(ws + WS_Z), (const float*)(ws + WS_LB) + (size_t)layer * 2 * 1024};
            pg8::gemm_phase<pg8::EpiIn, pg8::DenseOrder, true>(F.lds, ws + WS_H, D, ws + WS_WIN + (size_t)layer * INC * D, D, D, S, E);
        } }
        SEAM(pb + 1);
        if (PHON(3) && IN(pb + 2)) { LAUNDER(); for (int rep_ = 0; rep_ < REPS(3); ++rep_) { if (rep_) { VM_WAIT(); __syncthreads(); } phase_pooldiff(F, Mr); __syncthreads(); } { VM_WAIT(); __syncthreads(); phase_scan_mfma(F); GRID_BAR(); LAUNDER(); phase_scan_fix(F); } }
        SEAM(pb + 2);
        if (PHON(4) && IN(pb + 3)) { LAUNDER(); for (int rep_ = 0; rep_ < REPS(4); ++rep_) { if (rep_) { VM_WAIT(); __syncthreads(); }
            pg8::DenseOrder S; S.init(Mr, DPOOL, F.G, (int)blockIdx.x, DPOOL * 2, 512);
            pg8::EpiPool E{(bf16_t*)(ws + WS_P), args.in[I_PSCALE] + (size_t)layer * DPOOL};
            pg8::gemm_phase(F.lds, ws + WS_PD, DPOOL * 2, ws + WS_WPG + (size_t)layer * 1024 * 256 * 2, 512, 512, S, E);
        } }
        if (PHON(4) && IN(pb + 3)) { VM_WAIT(); __syncthreads(); }
        if (PHON(5) && IN(pb + 4)) { LAUNDER(); for (int rep_ = 0; rep_ < REPS(5); ++rep_) { if (rep_) { VM_WAIT(); __syncthreads(); } phase_readout_naive(F, args, layer, Mr); } }
        SEAM(pb + 4);
        if (PHON(6) && IN(pb + 5)) { LAUNDER(); for (int rep_ = 0; rep_ < REPS(6); ++rep_) { if (rep_) { VM_WAIT(); __syncthreads(); }
            pg8::DenseOrder S; S.init(Mr, D, F.G, (int)blockIdx.x, 1024, 0);
            { pg8::EpiGate2 E{ws + WS_MX, (const bf16_t*)(ws + WS_Z), ZC_GP, ZC_GH, HG8_SCALE, 1.f / (W8_SCALE * HG8_SCALE)};
              pg8::gemm_phase<pg8::EpiGate2, pg8::DenseOrder, true, true>(F.lds, ws + WS_P, 1024, ws + WS_WBP + (size_t)layer * D * 1024, 2048, 1024, S, E,
                  (long)WS_HG - (long)WS_P - 8 * 128, (long)WS_WBH - (long)WS_WBP - 8 * 128, 8); }
            if (rep_ == 0) { int rk, nn; idle_rank((Mr / 256) * 8, F.G, (int)blockIdx.x, rk, nn); convert_range(F, args, layer + 1, 0, 36000, rk, nn); }
        } }
        SEAM(pb + 5);
        if (PHON(7) && IN(pb + 6)) { LAUNDER(); for (int rep_ = 0; rep_ < REPS(7); ++rep_) { if (rep_) { VM_WAIT(); __syncthreads(); }
            pg8::DenseOrder S; S.init(Mr, D, F.G, (int)blockIdx.x, D, 0);
            pg8::EpiOut E{(bf16_t*)(ws + (rep_ ? WS_O2 : WS_X)), layer == 0 ? (const void*)args.in[I_X] : (const void*)(ws + WS_X), layer == 0 ? (const void*)args.in[I_CTX] : (const void*)(ws + WS_X), layer == 0, (const float*)(ws + WS_MOD) + (size_t)layer * 5 * 6 * D, 1.f / W8_SCALE};
            pg8::gemm_phase<pg8::EpiOut, pg8::DenseOrder, true>(F.lds, ws + WS_MX, D, ws + WS_WOUT + (size_t)layer * D * D, D, D, S, E);
            if (rep_ == 0) { int rk, nn; idle_rank((Mr / 256) * 8, F.G, (int)blockIdx.x, rk, nn); convert_range(F, args, layer + 1, 36000, 52000, rk, nn); }
        } }
        SEAM(pb + 6);
        if (PHON(8) && IN(pb + 7)) { LAUNDER(); for (int rep_ = 0; rep_ < REPS(8); ++rep_) { if (rep_) { VM_WAIT(); __syncthreads(); } phase_norm2_router(F, args, layer, Mr, rep_ == 0); } }
        SEAM(pb + 7);
        if (PHON(9) && IN(pb + 8)) { LAUNDER(); for (int rep_ = 0; rep_ < REPS(9); ++rep_) { if (rep_) { VM_WAIT(); __syncthreads(); }
            const int nblk = moe_tables(F, layer);
            pg8::MoeOrder<true> S; S.nN = 4; S.nunits = nblk * 4; S.G = F.G; S.c = (int)blockIdx.x; S.lda_b = D; S.tbl = (const LAS int*)(F.lds + LDS_MISC + 64);
            S.slottok = (const int*)(ws + WS_SLOTTOK); S.b_estride = (size_t)1024 * D;
            pg8::EpiMoe1 E{(bf16_t*)(ws + WS_ACT)};
            pg8::gemm_phase<pg8::EpiMoe1, pg8::MoeOrder<true>, true>(F.lds, ws + WS_H, D, ws + WS_WE13 + (size_t)layer * NEXP * 1024 * D, D, D, S, E);
            if (rep_ == 0) { int rk, nn; idle_rank(nblk * 4, F.G, (int)blockIdx.x, rk, nn); convert_range(F, args, layer + 1, 52000, 70000, rk, nn); }
        } }
        SEAM(pb + 8);
        if (PHON(10) && IN(pb + 9)) { LAUNDER(); for (int rep_ = 0; rep_ < REPS(10); ++rep_) { if (rep_) { VM_WAIT(); __syncthreads(); }
            const int nblk = moe_tables(F, layer);
            pg8::MoeOrder<false> S; S.nN = 8; S.nunits = nblk * 8; S.G = F.G; S.c = (int)blockIdx.x; S.lda_b = DEXP; S.tbl = (const LAS int*)(F.lds + LDS_MISC + 64);
            S.slottok = nullptr; S.b_estride = (size_t)D * DEXP;
            pg8::EpiPlain E{(bf16_t*)(ws + WS_Y2), D, 1.f / (W8_SCALE * ACT8_SCALE)};
            pg8::gemm_phase<pg8::EpiPlain, pg8::MoeOrder<false>, true>(F.lds, ws + WS_ACT, DEXP, ws + WS_WE2 + (size_t)layer * NEXP * D * DEXP, DEXP, DEXP, S, E);
            if (rep_ == 0) { int rk, nn; idle_rank(nblk * 8, F.G, (int)blockIdx.x, rk, nn); convert_range(F, args, layer + 1, 70000, CONV_ITEMS, rk, nn); }
        } }
        SEAM(pb + 9);
    }
    if (PHON(11) && IN(N_PHASES - 1)) { LAUNDER(); for (int rep_ = 0; rep_ < REPS(11); ++rep_) { if (rep_) { VM_WAIT(); __syncthreads(); } phase_final(F, args); } }
#undef IN
#undef SEAM
}

extern "C" void kernel_launch(void* const* d_in, const int* in_sizes, int n_in, void* d_out, int out_size, void* d_ws, size_t ws_size, hipStream_t stream) {
    static int grid = 0;
    if (grid == 0) {
        if (n_in != 22 || out_size != NLAT * D || ws_size < WS_END) { fprintf(stderr, "kernel_launch: unexpected shapes (n_in %d out %d ws %zu need %zu)\n", n_in, out_size, ws_size, (size_t)WS_END); grid = -1; return; }
        int dev = 0, cus = 0, per_cu = 0;
        if (hipGetDevice(&dev) != hipSuccess || hipDeviceGetAttribute(&cus, hipDeviceAttributeMultiprocessorCount, dev) != hipSuccess) { grid = -1; return; }
        if (hipFuncSetAttribute((const void*)mk_fwd, hipFuncAttributeMaxDynamicSharedMemorySize, LDS_BYTES) != hipSuccess) { fprintf(stderr, "kernel_launch: hipFuncSetAttribute failed\n"); grid = -1; return; }
        if (hipOccupancyMaxActiveBlocksPerMultiprocessor(&per_cu, (const void*)mk_fwd, 512, LDS_BYTES) != hipSuccess || per_cu < 1) fprintf(stderr, "kernel_launch: occupancy query says %d\n", per_cu);
        (void)hipGetLastError();
        grid = cus;
    }
    if (grid < 0) return;
    (void)hipMemsetAsync((char*)d_ws + WS_CTL, 0, CTL_BYTES, stream);
    Args a{};
    for (int i = 0; i < 22; ++i) a.in[i] = (const float*)d_in[i];
    a.out = (float*)d_out; a.ws = (unsigned char*)d_ws; a.rep = MK_REPMASK; a.pad = 0;
#if MK_ONE_LAUNCH
    a.ph_lo = 0; a.ph_hi = N_PHASES;
    hipLaunchKernelGGL(mk_fwd, dim3(grid), dim3(512), LDS_BYTES, stream, a);
#else
    for (int p = 0; p < N_PHASES; ++p) { a.ph_lo = p; a.ph_hi = p + 1; hipLaunchKernelGGL(mk_fwd, dim3(grid), dim3(512), LDS_BYTES, stream, a); }
#endif
}
```

```cpp
#include <hip/hip_runtime.h>
#include <cstdio>
#include <cstdint>

#ifndef MK_ONE_LAUNCH
#define MK_ONE_LAUNCH 1
#endif

constexpr int D = 2048, NBATCH = 4, SEQ = 4096, DEPTH = 4, CTXL = 256;
constexpr int NLAT = NBATCH * SEQ, NCTX = NBATCH * CTXL, MTOK = NLAT + NCTX;
constexpr int DPOOL = 1024, HGW = 1024, NHEAD = 8, HDK = 128;
constexpr int INC = 10240;
constexpr int NEXP = 16, DEXP = 512;
constexpr int MAXSLOT = 38912;
constexpr float EPS = 1e-6f;
constexpr int ZC_POOL = 0, ZC_Q = 1024, ZC_FF = 2048, ZC_FB = 3072, ZC_I = 4096, ZC_OG = 5120, ZC_GP = 6144, ZC_GH = 8192;

#define GAS __attribute__((address_space(1)))
#define LAS __attribute__((address_space(3)))
typedef unsigned short bf16_t;
typedef short bf16x8 __attribute__((ext_vector_type(8)));
typedef float f32x4 __attribute__((ext_vector_type(4)));
typedef float f32x2 __attribute__((ext_vector_type(2)));
typedef unsigned u32x4 __attribute__((ext_vector_type(4)));
typedef unsigned u32x2 __attribute__((ext_vector_type(2)));
typedef int i32x4 __attribute__((ext_vector_type(4)));
typedef int i32x8 __attribute__((ext_vector_type(8)));
constexpr float W8_SCALE = 32.f;

constexpr size_t MiB = 1u << 20;
constexpr size_t align_up(size_t x) { return (x + 255) & ~(size_t)255; }
constexpr size_t WS_CTL = 0, CTL_BYTES = 1 * MiB;
constexpr size_t WS_MOD = WS_CTL + CTL_BYTES;
constexpr size_t WS_LB = WS_MOD + align_up((size_t)DEPTH * 5 * 6 * D * 4);
constexpr size_t WS_ROUTE_I = WS_LB + align_up((size_t)DEPTH * 2 * 1024 * 4);
constexpr size_t WS_ROUTE_G = WS_ROUTE_I + align_up((size_t)MTOK * 8);
constexpr size_t WS_SLOTTOK = WS_ROUTE_G + align_up((size_t)MTOK * 8);
constexpr size_t WS_PADBASE = WS_SLOTTOK + align_up((size_t)NEXP * MTOK * 4);
constexpr size_t WS_WIN = WS_PADBASE + align_up((size_t)DEPTH * 16 * 4);
constexpr size_t WS_WPG = WS_WIN + (size_t)DEPTH * INC * D * 2;
constexpr size_t WS_WBP = WS_WPG + (size_t)DEPTH * 1024 * 256 * 2;
constexpr size_t WS_WBH = WS_WBP + (size_t)DEPTH * D * 1024 * 2;
constexpr size_t WS_WOUT = WS_WBH + (size_t)DEPTH * D * 1024 * 2;
constexpr size_t WS_WE13 = WS_WOUT + (size_t)DEPTH * D * D * 2;
constexpr size_t WS_WE2 = WS_WE13 + (size_t)DEPTH * NEXP * 1024 * D * 2;
constexpr size_t WS_X = WS_WE2 + (size_t)DEPTH * NEXP * D * DEXP * 2;
constexpr size_t WS_H = WS_X + (size_t)MTOK * D * 4;
constexpr size_t WS_Z = WS_H + (size_t)MTOK * D * 2;
constexpr size_t WS_ACT = WS_Z;
constexpr size_t WS_Y2 = WS_ACT + (size_t)MAXSLOT * DEXP * 2;
constexpr size_t WS_PD = WS_Z + (size_t)MTOK * INC * 2;
constexpr size_t WS_P = WS_PD + (size_t)MTOK * 1024 * 2;
constexpr size_t WS_HG = WS_P + (size_t)MTOK * 1024 * 2;
constexpr size_t WS_O2 = WS_HG + (size_t)MTOK * 1024 * 2;
constexpr size_t WS_QSG = WS_O2 + (size_t)2 * MTOK * 1024 * 2;
constexpr size_t WS_SMID = WS_QSG + (size_t)64 * 3 * 17 * 17408;
constexpr size_t WS_CORRV = WS_SMID + (size_t)64 * 3 * 128 * 128 * 4;
constexpr size_t WS_TOTSEG = WS_CORRV + (size_t)64 * 3 * 17 * 128 * 4;
static_assert(WS_TOTSEG + (size_t)64 * 4 * 128 * 4 <= WS_O2 + (size_t)2 * MTOK * 1024 * 4, "scan hand-off buffers fit in the O2 region");
constexpr size_t WS_M1 = WS_O2 + (size_t)2 * MTOK * 1024 * 4;
constexpr size_t WS_MX = WS_M1 + (size_t)MTOK * D * 2;
constexpr size_t WS_END = WS_MX + (size_t)MTOK * D * 2;
static_assert(WS_Y2 + (size_t)MAXSLOT * D * 2 <= WS_PD, "ACT|Y2 overlay fits in Z");

constexpr int CW_BAR = 4096;
constexpr int CW_CNT = 16384;

constexpr int LDS_STAGE = 131072;
constexpr int LDS_MISC = 149504;
constexpr int LDS_BYTES = LDS_MISC + 8192;

__device__ __forceinline__ unsigned f2bf(float f) { unsigned u = __builtin_bit_cast(unsigned, f); return (u + 0x7fffu + ((u >> 16) & 1u)) >> 16; }
typedef __bf16 bf16x2_t __attribute__((ext_vector_type(2)));
__device__ __forceinline__ unsigned pk2(float lo, float hi) { const f32x2 v = {lo, hi}; const bf16x2_t b = __builtin_convertvector(v, bf16x2_t); return __builtin_bit_cast(unsigned, b); }
__device__ __forceinline__ float bflo(unsigned w) { return __builtin_bit_cast(float, w << 16); }
__device__ __forceinline__ float bfhi(unsigned w) { return __builtin_bit_cast(float, w & 0xffff0000u); }
__device__ __forceinline__ float bf1(bf16_t h) { return __builtin_bit_cast(float, ((unsigned)h) << 16); }
__device__ __forceinline__ float fsigmoid(float x) { return __builtin_amdgcn_rcpf(1.f + __builtin_amdgcn_exp2f(-1.44269504f * x)); }
__device__ __forceinline__ float fsilu(float x) { return x * fsigmoid(x); }
__device__ __forceinline__ float lane_xor(float v, int o, int lane) { return __builtin_bit_cast(float, __builtin_amdgcn_ds_bpermute((lane ^ o) << 2, __builtin_bit_cast(int, v))); }
#define LDS_WAIT() asm volatile("s_waitcnt lgkmcnt(0)" ::: "memory")
#define VM_WAIT() asm volatile("s_waitcnt vmcnt(0)" ::: "memory")

__device__ __forceinline__ unsigned pk4_fp8(float a, float b, float c, float d) { int w = 0; w = __builtin_amdgcn_cvt_pk_fp8_f32(a, b, w, false); w = __builtin_amdgcn_cvt_pk_fp8_f32(c, d, w, true); return (unsigned)w; }
constexpr float HG8_SCALE = 4.f, ACT8_SCALE = 4.f;
#define XB_TMO      128
#define XB_XCNT(j)  (256  + 64 * (j))
#define XB_XSUB(j)  (1280 + 64 * (j))
#define XB_XGEN(j)  (2304 + 64 * (j))
#define XB_TOP      3328
#define XB_TOPGEN   3392
#define XCD_BAR_WORDS 3456
#define XB_SPIN_CAP (1u << 18)
__device__ __forceinline__ unsigned xb_ld(unsigned* p)              { return __hip_atomic_load(p, __ATOMIC_RELAXED, __HIP_MEMORY_SCOPE_AGENT); }
__device__ __forceinline__ unsigned xb_add(unsigned* p, unsigned v) { return __hip_atomic_fetch_add(p, v, __ATOMIC_RELAXED, __HIP_MEMORY_SCOPE_AGENT); }
__device__ __forceinline__ unsigned xb_xcc_id() { return (unsigned)__builtin_amdgcn_s_getreg((3 << 11) | 20) & 0xFu; }
#define XB_SPIN(cond, bar) do { unsigned _sp = 0; while (cond) { __builtin_amdgcn_s_sleep(1); \
    if ((++_sp & 255u) == 0u) { if (xb_ld(&(bar)[XB_TMO])) break; if (_sp > XB_SPIN_CAP) { atomicAdd(&(bar)[XB_TMO], 1u); break; } } } } while (0)
struct XcdBarrier { unsigned* bar; unsigned x; volatile LAS unsigned* st; };
__device__ __forceinline__ XcdBarrier xcd_barrier_post(unsigned* bar, volatile LAS unsigned* st) {
    XcdBarrier b; b.bar = bar; b.x = xb_xcc_id(); b.st = st;
    if (threadIdx.x == 0) (void)xb_add(&bar[XB_XCNT(b.x)], 1u);
    return b;
}
__device__ __forceinline__ void xcd_barrier_complete(unsigned* bar, unsigned x, unsigned& nloc, unsigned& nx) {
    const unsigned G = gridDim.x * gridDim.y * gridDim.z;
    unsigned sum, cnt, mine, sp = 0u;
    for (;;) {
        sum = 0u; cnt = 0u; mine = 0u;
#pragma unroll
        for (unsigned j = 0; j < 16; ++j) { const unsigned c = xb_ld(&bar[XB_XCNT(j)]); sum += c; cnt += (c > 0u) ? 1u : 0u; mine = (j == x) ? c : mine; }
        if (sum == G) break;
        __builtin_amdgcn_s_sleep(1);
        if ((++sp & 255u) == 0u) { if (xb_ld(&bar[XB_TMO])) break; if (sp > XB_SPIN_CAP) { atomicAdd(&bar[XB_TMO], 1u); break; } }
    }
    nloc = mine > 0u ? mine : 1u; nx = cnt > 0u ? cnt : 1u;
}
__device__ __forceinline__ void xcd_barrier(const XcdBarrier& b) {
    asm volatile("s_waitcnt vmcnt(0)" ::: "memory");
    __syncthreads();
    if (threadIdx.x == 0) {
        unsigned* bar = b.bar;
        __builtin_amdgcn_s_waitcnt(0);
        unsigned nloc = b.st[0], nx = b.st[1];
        if (nloc == 0u) { xcd_barrier_complete(bar, b.x, nloc, nx); b.st[0] = nloc; b.st[1] = nx; }
        const unsigned old = xb_add(&bar[XB_XSUB(b.x)], 1u);
        const unsigned gen = old / nloc;
        if (old + 1u == (gen + 1u) * nloc) {
            __builtin_amdgcn_fence(__ATOMIC_RELEASE, "agent");
            asm volatile("s_waitcnt vmcnt(0)" ::: "memory");
            const unsigned og = xb_add(&bar[XB_TOP], 1u);
            const unsigned tg = og / nx;
            if (og + 1u == (tg + 1u) * nx) xb_add(&bar[XB_TOPGEN], 1u);
            else XB_SPIN(xb_ld(&bar[XB_TOPGEN]) == tg, bar);
            __builtin_amdgcn_fence(__ATOMIC_ACQUIRE, "agent");
            xb_add(&bar[XB_XGEN(b.x)], 1u);
            asm volatile("s_waitcnt vmcnt(0)" ::: "memory");
        } else {
            XB_SPIN(xb_ld(&bar[XB_XGEN(b.x)]) == gen, bar);
            __builtin_amdgcn_fence(__ATOMIC_ACQUIRE, "agent");
            asm volatile("s_waitcnt vmcnt(0)" ::: "memory");
        }
    }
    __syncthreads();
}

namespace pg8 {
constexpr int BM = 256, BK = 64, HALF = 128, HTB = HALF * BK * 2, NXCD = 8, WGM = 8;
__host__ __device__ __forceinline__ int lds_byte(int r, int c) { const int st = (r >> 4) * 2 + (c >> 5), rr = r & 15, cc = c & 31, ob = rr * 64 + cc * 2; return st * 1024 + (ob ^ (((ob >> 9) & 1) << 5)); }
__host__ __device__ __forceinline__ void stage_rc(int b, int& R, int& C) { const int st = b / 1024, sb = b % 1024, swz = sb ^ (((sb >> 9) & 1) << 5); R = (st >> 1) * 16 + swz / 64; C = (st & 1) * 32 + (swz % 64) / 2; }
__host__ __device__ __forceinline__ int perm32(int rho) { const int n = rho >> 4, i = rho & 15; return 8 * (i >> 2) + 4 * n + (i & 3); }

struct Unit { int pm, pn; };

struct DenseOrder {
    static constexpr bool GATHER = false;
    int nM, nN, nwg, G, c, lda_b, acol_b;
    __device__ void init(int M, int N, int G_, int c_, int lda_b_, int acol_b_) { nM = M / BM; nN = N / BM; nwg = nM * nN; G = G_; c = c_; lda_b = lda_b_; acol_b = acol_b_; }
    __device__ __forceinline__ bool next(int i, Unit& u) const {
        const long L = (long)i * G + c; if (L >= nwg) return false;
        int wgid = (int)L; { const int q = nwg / NXCD, r = nwg % NXCD, xcd = wgid % NXCD, off = wgid / NXCD; wgid = (xcd < r ? xcd * (q + 1) : r * (q + 1) + (xcd - r) * q) + off; }
        const int nig = WGM * nN, gid = wgid / nig, fm = gid * WGM, gsz = (nM - fm) < WGM ? (nM - fm) : WGM;
        u.pm = fm + ((wgid % nig) % gsz); u.pn = (wgid % nig) / gsz; return true;
    }
    __device__ __forceinline__ size_t a_base(const Unit& u) const { return (size_t)u.pm * BM * lda_b + (size_t)u.pn * acol_b; }
    __device__ __forceinline__ void a_offs(const Unit&, unsigned (&)[2][2]) const {}
    __device__ __forceinline__ size_t b_off(const Unit& u, int ldb_b) const { return (size_t)u.pn * BM * ldb_b; }
};
template <bool GATHER_> struct MoeOrder {
    static constexpr bool GATHER = GATHER_;
    int nN, nunits, G, c, lda_b; const LAS int* tbl;
    const int* slottok; size_t b_estride;
    __device__ __forceinline__ bool next(int i, Unit& u) const {
        const int L = i * G + c; if (L >= nunits) return false;
        u.pm = L / nN; u.pn = L % nN; return true;
    }
    __device__ __forceinline__ size_t a_base(const Unit& u) const { return (size_t)u.pm * BM * lda_b; }
    __device__ __forceinline__ void a_offs(const Unit& u, unsigned (&v)[2][2]) const {
        const int e = __builtin_amdgcn_readfirstlane(tbl[64 + u.pm]), j0 = __builtin_amdgcn_readfirstlane((u.pm - tbl[16 + e]) * BM), cnt = __builtin_amdgcn_readfirstlane(tbl[e]);
#pragma unroll
        for (int i = 0; i < 2; ++i) { int R, C; stage_rc((int)threadIdx.x * 16 + i * 8192, R, C);
#pragma unroll
            for (int h = 0; h < 2; ++h) { const int j = j0 + h * HALF + R; const int tok = (j < cnt) ? slottok[(size_t)e * MTOK + j] : 0; v[h][i] = (unsigned)(tok * lda_b + C * 2); } }
    }
    __device__ __forceinline__ size_t b_off(const Unit& u, int ldb_b) const { const int e = __builtin_amdgcn_readfirstlane(tbl[64 + u.pm]); return (size_t)e * b_estride + (size_t)u.pn * BM * ldb_b; }
};

template <class Epi, class Sched, bool FP8 = false, bool SPLIT = false>
__device__ __forceinline__ void gemm_phase(LAS unsigned char* lds, const void* Abase, const int lda_b, const void* Bbase, const int Kb, const int ldb_b, const Sched& S, const Epi& E, const long dA = 0, const long dB = 0, const int nt1 = 0) {
    constexpr bool GA = Sched::GATHER;
    int tid_ = threadIdx.x; asm volatile("" : "+v"(tid_));
    const int tid = tid_, wid = __builtin_amdgcn_readfirstlane(tid >> 6), lane = tid & 63, wr = wid >> 2, wc = wid & 3, fr = lane & 15, fq = lane >> 4;
    const int nt = Kb / 128;
    unsigned voffA[2], voffB[2];
#pragma unroll
    for (int i = 0; i < 2; ++i) { int R, C; stage_rc(tid * 16 + i * 8192, R, C); const int Rb = Epi::PERM ? ((R & ~31) + perm32(R & 31)) : R; voffA[i] = (unsigned)(R * lda_b + C * 2); voffB[i] = (unsigned)(Rb * ldb_b + C * 2); }
    const size_t kstep = (size_t)(BK * 2);
    const size_t hstepA = (size_t)HALF * lda_b, hstepB = (size_t)HALF * ldb_b;
    const unsigned ldsw = (unsigned)wid * 1024u;
    const int aoff = lds_byte(wr * 64 + fr, fq * 8), boff = lds_byte(wc * 32 + fr, fq * 8);
#define PG8_SA(b, h) (((b) * 2 + (h)) * HTB)
#define PG8_SB(b, h) ((4 + (b) * 2 + (h)) * HTB)
#define PG8_STAGE2(bufoff, gbase, o0, o1) do { \
        __builtin_amdgcn_global_load_lds((const unsigned*)((const char*)(gbase) + (o0)), (LAS unsigned*)(lds + (bufoff) + ldsw), 16, 0, 0); \
        __builtin_amdgcn_global_load_lds((const unsigned*)((const char*)(gbase) + (o1)), (LAS unsigned*)(lds + (bufoff) + ldsw + 8192), 16, 0, 0); } while (0)
#define PG8_STAGEB(bufoff, gbase) PG8_STAGE2(bufoff, gbase, voffB[0], voffB[1])
#define PG8_STAGEA(bufoff, gbase, h, x0, x1) do { if constexpr (GA) PG8_STAGE2(bufoff, gbase, x0, x1); else PG8_STAGE2(bufoff, (gbase) + ((h) ? hstepA : (size_t)0), voffA[0], voffA[1]); } while (0)
#define PG8_LD32(dst, addr) do { const i32x4 lo_ = *(const LAS i32x4*)(lds + (addr)), hi_ = *(const LAS i32x4*)(lds + (addr) + 1024); dst = (i32x8){lo_[0], lo_[1], lo_[2], lo_[3], hi_[0], hi_[1], hi_[2], hi_[3]}; } while (0)
#define PG8_LDA(dst, b, h) do { _Pragma("unroll") for (int m = 0; m < 4; ++m) PG8_LD32(dst[m], PG8_SA(b, h) + aoff + m * 2048); } while (0)
#define PG8_LDB(dst, b, h) do { _Pragma("unroll") for (int n = 0; n < 2; ++n) PG8_LD32(dst[n], PG8_SB(b, h) + boff + n * 2048); } while (0)
#define PG8_HALF(v, k) __builtin_bit_cast(bf16x8, (i32x4){(v)[4 * (k)], (v)[4 * (k) + 1], (v)[4 * (k) + 2], (v)[4 * (k) + 3]})
#define PG8_MMA(ai, bj, At, Bt) do { __builtin_amdgcn_s_setprio(1); \
        if constexpr (FP8) { _Pragma("unroll") for (int m = 0; m < 4; ++m) _Pragma("unroll") for (int n = 0; n < 2; ++n) \
            asm volatile("v_mfma_scale_f32_16x16x128_f8f6f4 %0, %1, %2, %0, %3, %3 op_sel_hi:[0,0,0]" : "+v"(acc[ai][bj][m][n]) : "v"(Bt[n]), "v"(At[m]), "v"(one_scale)); } \
        else { _Pragma("unroll") for (int m = 0; m < 4; ++m) _Pragma("unroll") for (int n = 0; n < 2; ++n) _Pragma("unroll") for (int k = 0; k < 2; ++k) \
            acc[ai][bj][m][n] = __builtin_amdgcn_mfma_f32_16x16x32_bf16(PG8_HALF(Bt[n], k), PG8_HALF(At[m], k), acc[ai][bj][m][n], 0, 0, 0); } \
        __builtin_amdgcn_s_setprio(0); } while (0)
#define PG8_WAIT_V(n) asm volatile("s_waitcnt vmcnt(" #n ")" ::: "memory")
#define PG8_WAIT_L(n) asm volatile("s_waitcnt lgkmcnt(" #n ")" ::: "memory")
#define PG8_BAR __builtin_amdgcn_s_barrier()
#define PG8_SCHED __builtin_amdgcn_sched_barrier(0)
    Unit cur, nxt; int ui = 0;
    if (!S.next(0, cur)) return;
    f32x4 acc[2][2][4][2];
#pragma unroll
    for (int a = 0; a < 2; ++a)
#pragma unroll
        for (int b = 0; b < 2; ++b)
#pragma unroll
            for (int m = 0; m < 4; ++m)
#pragma unroll
                for (int n = 0; n < 2; ++n) acc[a][b][m][n] = (f32x4){0.f, 0.f, 0.f, 0.f};
    int one_scale = 0; if constexpr (FP8) asm volatile("v_mov_b32 %0, 0x7f7f7f7f" : "=v"(one_scale));
    i32x8 At[4], B0[2], B1[2];
    unsigned vA[2][2];
    if constexpr (GA) S.a_offs(cur, vA);
    const char* cA = (const char*)Abase + (GA ? (size_t)0 : S.a_base(cur));
    const char* cB = (const char*)Bbase + S.b_off(cur, ldb_b);
    PG8_STAGEB(PG8_SB(0, 0), cB); PG8_STAGEB(PG8_SB(0, 1), cB + hstepB); PG8_STAGEA(PG8_SA(0, 0), cA, 0, vA[0][0], vA[0][1]); PG8_STAGEA(PG8_SA(0, 1), cA, 1, vA[1][0], vA[1][1]);
    if (wr == 1) PG8_BAR;
    PG8_WAIT_V(2); PG8_BAR;
    PG8_STAGEB(PG8_SB(1, 0), cB + kstep); PG8_STAGEA(PG8_SA(1, 0), cA + kstep, 0, vA[0][0], vA[0][1]); PG8_STAGEB(PG8_SB(1, 1), cB + hstepB + kstep);
    PG8_WAIT_V(6); PG8_BAR;
    for (;;) {
        const bool has_next = S.next(ui + 1, nxt);
        const char* nA = (has_next && !GA) ? (const char*)Abase + S.a_base(nxt) : cA;
        const char* nB = has_next ? (const char*)Bbase + S.b_off(nxt, ldb_b) : cB;
_Pragma("nounroll")
        for (int t = 0; t < nt; t += 2) {
            const bool last = (t == nt - 2);
            const long sA1 = (SPLIT && t >= nt1) ? dA : 0, sA2 = (SPLIT && t + 2 >= nt1) ? dA : 0, sB2 = (SPLIT && t + 2 >= nt1) ? dB : 0;
            if constexpr (SPLIT) { if (t == nt1) { asm volatile("s_nop 15\n\ts_nop 15" ::: "memory"); int t3_ = threadIdx.x; asm volatile("" : "+v"(t3_)); const int l3_ = t3_ & 63; E.mid(acc, cur, wr, wc, l3_ & 15, l3_ >> 4); } }
            const char* a1 = cA + (size_t)(t + 1) * kstep + sA1;
            const char* a2 = last ? nA : cA + (size_t)(t + 2) * kstep + sA2; const char* b2 = last ? nB : cB + (size_t)(t + 2) * kstep + sB2;
            const char* a3 = a2 + kstep; const char* b3 = b2 + kstep;
            PG8_LDB(B0, 0, 0); PG8_LDB(B1, 0, 1); PG8_SCHED; PG8_LDA(At, 0, 0); PG8_STAGEA(PG8_SA(1, 1), a1, 1, vA[1][0], vA[1][1]);
            PG8_WAIT_V(8); PG8_WAIT_L(0); PG8_BAR; PG8_MMA(0, 0, At, B0); PG8_MMA(0, 1, At, B1); PG8_BAR; PG8_SCHED;
            if constexpr (GA) { if (last && has_next) S.a_offs(nxt, vA); }
            PG8_LDA(At, 0, 1); PG8_STAGEB(PG8_SB(0, 0), b2); PG8_STAGEB(PG8_SB(0, 1), b2 + hstepB); PG8_STAGEA(PG8_SA(0, 0), a2, 0, vA[0][0], vA[0][1]);
            PG8_WAIT_V(8); PG8_WAIT_L(0); PG8_BAR; PG8_MMA(1, 0, At, B0); PG8_MMA(1, 1, At, B1); PG8_BAR; PG8_SCHED;
            PG8_LDB(B0, 1, 0); PG8_LDB(B1, 1, 1); PG8_SCHED; PG8_LDA(At, 1, 0); PG8_STAGEA(PG8_SA(0, 1), a2, 1, vA[1][0], vA[1][1]);
            PG8_WAIT_V(8); PG8_WAIT_L(0); PG8_BAR; PG8_MMA(0, 0, At, B0); PG8_MMA(0, 1, At, B1); PG8_BAR; PG8_SCHED;
            PG8_LDA(At, 1, 1); PG8_STAGEB(PG8_SB(1, 0), b3); PG8_STAGEB(PG8_SB(1, 1), b3 + hstepB); PG8_STAGEA(PG8_SA(1, 0), a3, 0, vA[0][0], vA[0][1]);
            PG8_WAIT_V(8); PG8_WAIT_L(0); PG8_BAR; PG8_MMA(1, 0, At, B0); PG8_MMA(1, 1, At, B1); PG8_BAR; PG8_SCHED;
        }
        if constexpr (FP8) asm volatile("s_nop 15\n\ts_nop 15" ::: "memory");
        if (wr == 0) PG8_BAR;
        { int t2_ = threadIdx.x; asm volatile("" : "+v"(t2_)); const int l2_ = t2_ & 63; E(acc, cur, wr, wc, l2_ & 15, l2_ >> 4); }
        if (!has_next) break;
#pragma unroll
        for (int a = 0; a < 2; ++a)
#pragma unroll
            for (int b = 0; b < 2; ++b)
#pragma unroll
                for (int m = 0; m < 4; ++m)
#pragma unroll
                    for (int n = 0; n < 2; ++n) acc[a][b][m][n] = (f32x4){0.f, 0.f, 0.f, 0.f};
        cur = nxt; cA = nA; cB = nB; ++ui;
        if (wr == 1) PG8_BAR;
    }
    PG8_WAIT_V(0);
    PG8_BAR;
#undef PG8_SA
#undef PG8_SB
#undef PG8_STAGE2
#undef PG8_STAGEB
#undef PG8_STAGEA
#undef PG8_LDA
#undef PG8_LD32
#undef PG8_HALF
#undef PG8_LDB
#undef PG8_MMA
#undef PG8_WAIT_V
#undef PG8_WAIT_L
#undef PG8_BAR
#undef PG8_SCHED
}

typedef const f32x4 (&AccRef)[2][2][4][2];
__device__ __forceinline__ u32x4 pack8(const f32x4 v0, const f32x4 v1) { u32x4 w; w.x = pk2(v0[0], v0[1]); w.y = pk2(v0[2], v0[3]); w.z = pk2(v1[0], v1[1]); w.w = pk2(v1[2], v1[3]); return w; }
__device__ __forceinline__ void unpack8(const u32x4 w, f32x4& v0, f32x4& v1) { v0 = (f32x4){bflo(w.x), bfhi(w.x), bflo(w.y), bfhi(w.y)}; v1 = (f32x4){bflo(w.z), bfhi(w.z), bflo(w.w), bfhi(w.w)}; }

struct EpiIn {
    static constexpr bool PERM = true;
    bf16_t* Z; const float* lb;
    __device__ __forceinline__ void operator()(AccRef acc, const Unit& u, int wr, int wc, int fr, int fq) const {
        constexpr float KS = 1.f / W8_SCALE, KE = -1.44269504f / W8_SCALE;
        const int row0 = u.pm * BM + wr * 64 + fr, colt = u.pn * BM, seg = colt >> 10, col0 = colt + wc * 32 + 8 * fq;
        const int mode = (seg == 0 || seg == 4) ? 0 : (seg == 1 || seg == 5) ? 1 : (seg == 2 || seg == 3) ? 2 : 3;
#pragma unroll
        for (int bj = 0; bj < 2; ++bj) {
            f32x4 l0 = (f32x4){0.f, 0.f, 0.f, 0.f}, l1 = l0;
            if (mode == 2) { l0 = *(const f32x4*)(lb + (col0 + bj * HALF - ZC_FF)); l1 = *(const f32x4*)(lb + (col0 + bj * HALF + 4 - ZC_FF)); }
#pragma unroll
            for (int ai = 0; ai < 2; ++ai)
#pragma unroll
                for (int m = 0; m < 4; ++m) { bf16_t* rowp = Z + (size_t)(row0 + ai * HALF + m * 16) * INC + col0 + bj * HALF;
                    f32x4 v0 = acc[ai][bj][m][0], v1 = acc[ai][bj][m][1];
                    if (mode == 0) { v0 = v0 * KS; v1 = v1 * KS; }
                    else { f32x4 s0, s1;
#pragma unroll
                        for (int j = 0; j < 4; ++j) { s0[j] = __builtin_amdgcn_rcpf(1.f + __builtin_amdgcn_exp2f(v0[j] * KE)); s1[j] = __builtin_amdgcn_rcpf(1.f + __builtin_amdgcn_exp2f(v1[j] * KE)); }
                        if (mode == 1) { v0 = v0 * KS * s0; v1 = v1 * KS * s1; }
                        else if (mode == 3) { v0 = s0; v1 = s1; }
                        else {
#pragma unroll
                            for (int j = 0; j < 4; ++j) { v0[j] = __builtin_amdgcn_logf(l0[j] + (1.f - l0[j]) * s0[j]); v1[j] = __builtin_amdgcn_logf(l1[j] + (1.f - l1[j]) * s1[j]); } } }
                    *(u32x4*)rowp = pack8(v0, v1);
                    __builtin_amdgcn_sched_barrier(0); } }
    }
};
struct EpiPool {
    static constexpr bool PERM = true;
    bf16_t* P; const float* scale;
    __device__ __forceinline__ void operator()(AccRef acc, const Unit& u, int wr, int wc, int fr, int fq) const {
        const int row0 = u.pm * BM + wr * 64 + fr, col0 = u.pn * BM + wc * 32 + 8 * fq;
        f32x4 sv[2][2];
#pragma unroll
        for (int bj = 0; bj < 2; ++bj)
#pragma unroll
            for (int n = 0; n < 2; ++n) sv[bj][n] = *(const f32x4*)(scale + col0 + bj * HALF + 4 * n);
#pragma unroll
        for (int ai = 0; ai < 2; ++ai)
#pragma unroll
            for (int m = 0; m < 4; ++m) { bf16_t* rowp = P + (size_t)(row0 + ai * HALF + m * 16) * DPOOL + col0;
#pragma unroll
                for (int bj = 0; bj < 2; ++bj) { const f32x4 r0 = acc[ai][bj][m][0] * sv[bj][0], r1 = acc[ai][bj][m][1] * sv[bj][1];
                    u32x2 o; o.x = pk4_fp8(r0[0], r0[1], r0[2], r0[3]); o.y = pk4_fp8(r1[0], r1[1], r1[2], r1[3]); *(u32x2*)((unsigned char*)P + (size_t)(row0 + ai * HALF + m * 16) * DPOOL + col0 + bj * HALF) = o; } }
    }
};
template <bool ADD, bool OUT8 = false> struct EpiGate {
    static constexpr bool PERM = true;
    bf16_t* O; const bf16_t* prev; const bf16_t* Z; int gcol; float ascale;
    __device__ __forceinline__ void operator()(AccRef acc, const Unit& u, int wr, int wc, int fr, int fq) const {
        const int row0 = u.pm * BM + wr * 64 + fr, col0 = u.pn * BM + wc * 32 + 8 * fq;
#pragma unroll
        for (int ai = 0; ai < 2; ++ai)
#pragma unroll
            for (int m = 0; m < 4; ++m) { const size_t row = (size_t)(row0 + ai * HALF + m * 16);
#pragma unroll
                for (int bj = 0; bj < 2; ++bj) {
                    const u32x4 gw = *(const u32x4*)(Z + row * INC + gcol + col0 + bj * HALF); f32x4 g0, g1; unpack8(gw, g0, g1);
                    f32x4 r0 = acc[ai][bj][m][0] * ascale * g0, r1 = acc[ai][bj][m][1] * ascale * g1;
                    if (ADD) { const u32x4 pw = *(const u32x4*)(prev + row * D + col0 + bj * HALF); f32x4 p0, p1; unpack8(pw, p0, p1); r0 += p0; r1 += p1; }
                    if (OUT8) { int w0 = 0, w1 = 0; w0 = __builtin_amdgcn_cvt_pk_fp8_f32(r0[0], r0[1], w0, false); w0 = __builtin_amdgcn_cvt_pk_fp8_f32(r0[2], r0[3], w0, true);
                        w1 = __builtin_amdgcn_cvt_pk_fp8_f32(r1[0], r1[1], w1, false); w1 = __builtin_amdgcn_cvt_pk_fp8_f32(r1[2], r1[3], w1, true);
                        u32x2 o; o.x = (unsigned)w0; o.y = (unsigned)w1; *(u32x2*)((unsigned char*)O + row * D + col0 + bj * HALF) = o; }
                    else *(u32x4*)(O + row * D + col0 + bj * HALF) = pack8(r0, r1); } }
    }
};
struct EpiGate2 {
    static constexpr bool PERM = true;
    unsigned char* O; const bf16_t* Z; int gcol1, gcol2; float cratio, ascale;
    static constexpr float GMIN = 9.094947e-13f;
    __device__ __forceinline__ void mid(f32x4 (&acc)[2][2][4][2], const Unit& u, int wr, int wc, int fr, int fq) const {
        const int row0 = u.pm * BM + wr * 64 + fr, col0 = u.pn * BM + wc * 32 + 8 * fq;
#pragma unroll
        for (int ai = 0; ai < 2; ++ai)
#pragma unroll
            for (int m = 0; m < 4; ++m) { const size_t row = (size_t)(row0 + ai * HALF + m * 16);
#pragma unroll
                for (int bj = 0; bj < 2; ++bj) {
                    const u32x4 gw1 = *(const u32x4*)(Z + row * INC + gcol1 + col0 + bj * HALF), gw2 = *(const u32x4*)(Z + row * INC + gcol2 + col0 + bj * HALF);
                    f32x4 a0, a1, b0, b1; unpack8(gw1, a0, a1); unpack8(gw2, b0, b1);
#pragma unroll
                    for (int j = 0; j < 4; ++j) { acc[ai][bj][m][0][j] *= cratio * a0[j] * __builtin_amdgcn_rcpf(fmaxf(b0[j], GMIN)); acc[ai][bj][m][1][j] *= cratio * a1[j] * __builtin_amdgcn_rcpf(fmaxf(b1[j], GMIN)); } }
                }
    }
    __device__ __forceinline__ void operator()(AccRef acc, const Unit& u, int wr, int wc, int fr, int fq) const {
        const int row0 = u.pm * BM + wr * 64 + fr, col0 = u.pn * BM + wc * 32 + 8 * fq;
#pragma unroll
        for (int ai = 0; ai < 2; ++ai)
#pragma unroll
            for (int m = 0; m < 4; ++m) { const size_t row = (size_t)(row0 + ai * HALF + m * 16);
#pragma unroll
                for (int bj = 0; bj < 2; ++bj) {
                    const u32x4 gw = *(const u32x4*)(Z + row * INC + gcol2 + col0 + bj * HALF); f32x4 g0, g1; unpack8(gw, g0, g1);
                    f32x4 r0, r1;
#pragma unroll
                    for (int j = 0; j < 4; ++j) { r0[j] = acc[ai][bj][m][0][j] * ascale * fmaxf(g0[j], GMIN); r1[j] = acc[ai][bj][m][1][j] * ascale * fmaxf(g1[j], GMIN); }
                    u32x2 o; o.x = pk4_fp8(r0[0], r0[1], r0[2], r0[3]); o.y = pk4_fp8(r1[0], r1[1], r1[2], r1[3]);
                    *(u32x2*)(O + row * D + col0 + bj * HALF) = o; } }
    }
};
struct EpiOut {
    static constexpr bool PERM = true;
    bf16_t* X; const void* src_lat; const void* src_ctx; bool src_f32; const float* modl; float ascale;
    __device__ __forceinline__ void operator()(AccRef acc, const Unit& u, int wr, int wc, int fr, int fq) const {
        const int row0 = u.pm * BM + wr * 64 + fr, col0 = u.pn * BM + wc * 32 + 8 * fq;
        const int mrow = u.pm < 64 ? (u.pm >> 4) : 4;
        const float* g = modl + (size_t)mrow * 6 * D + 2 * D;
        const bool lat = u.pm < 64;
#pragma unroll
        for (int bj = 0; bj < 2; ++bj) { const int col = col0 + bj * HALF;
            const f32x4 g0 = *(const f32x4*)(g + col) * ascale, g1 = *(const f32x4*)(g + col + 4) * ascale;
#pragma unroll
            for (int ai = 0; ai < 2; ++ai)
#pragma unroll
                for (int m = 0; m < 4; ++m) { const int row = row0 + ai * HALF + m * 16; f32x4 s0, s1;
                    if (src_f32) { const float* sp = (lat ? (const float*)src_lat + (size_t)row * D : (const float*)src_ctx + (size_t)(row - NLAT) * D) + col; s0 = *(const f32x4*)sp; s1 = *(const f32x4*)(sp + 4); }
                    else unpack8(*(const u32x4*)((const bf16_t*)src_lat + (size_t)row * D + col), s0, s1);
                    *(u32x4*)(X + (size_t)row * D + col) = pack8(s0 + g0 * acc[ai][bj][m][0], s1 + g1 * acc[ai][bj][m][1]); } }
    }
};
struct EpiMoe1 {
    static constexpr bool PERM = true;
    bf16_t* ACT;
    __device__ __forceinline__ void operator()(AccRef acc, const Unit& u, int wr, int wc, int fr, int fq) const {
        const int row0 = u.pm * BM + wr * 64 + fr, col0 = u.pn * HALF + wc * 32 + 8 * fq;
        constexpr float KS = 1.f / W8_SCALE, KB = ACT8_SCALE / W8_SCALE;
#pragma unroll
        for (int ai = 0; ai < 2; ++ai)
#pragma unroll
            for (int m = 0; m < 4; ++m) { f32x4 r[2];
#pragma unroll
                for (int n = 0; n < 2; ++n)
#pragma unroll
                    for (int j = 0; j < 4; ++j) r[n][j] = __builtin_amdgcn_fmed3f(fsilu(acc[ai][0][m][n][j] * KS) * (acc[ai][1][m][n][j] * KB), -440.f, 440.f);
                u32x2 o; o.x = pk4_fp8(r[0][0], r[0][1], r[0][2], r[0][3]); o.y = pk4_fp8(r[1][0], r[1][1], r[1][2], r[1][3]);
                *(u32x2*)((unsigned char*)ACT + (size_t)(row0 + ai * HALF + m * 16) * DEXP + col0) = o; }
    }
};
struct EpiNone {
    static constexpr bool PERM = true;
    __device__ __forceinline__ void operator()(AccRef acc, const Unit&, int, int, int, int) const {
#pragma unroll
        for (int ai = 0; ai < 2; ++ai)
#pragma unroll
            for (int bj = 0; bj < 2; ++bj)
#pragma unroll
                for (int m = 0; m < 4; ++m)
#pragma unroll
                    for (int n = 0; n < 2; ++n) asm volatile("" :: "v"(acc[ai][bj][m][n]));
    }
};
struct EpiPlain {
    static constexpr bool PERM = true;
    bf16_t* O; int ldc; float ascale;
    __device__ __forceinline__ void operator()(AccRef acc, const Unit& u, int wr, int wc, int fr, int fq) const {
        const int row0 = u.pm * BM + wr * 64 + fr, col0 = u.pn * BM + wc * 32 + 8 * fq;
#pragma unroll
        for (int ai = 0; ai < 2; ++ai)
#pragma unroll
            for (int m = 0; m < 4; ++m) { bf16_t* rowp = O + (size_t)(row0 + ai * HALF + m * 16) * ldc + col0;
#pragma unroll
                for (int bj = 0; bj < 2; ++bj) *(u32x4*)(rowp + bj * HALF) = pack8(acc[ai][bj][m][0] * ascale, acc[ai][bj][m][1] * ascale); }
    }
};
}

struct Args { const float* in[22]; float* out; unsigned char* ws; int ph_lo, ph_hi, rep, pad; };
enum { I_X = 0, I_C, I_CTX, I_CCTX, I_WADA, I_BADA, I_N1W, I_N2W, I_WIN, I_WPG, I_PSCALE, I_HGNW, I_LBLOG, I_WBP, I_WBH, I_WOUT, I_WROUTER, I_RBIAS, I_WE1, I_WE3, I_WE2, I_FNW };

struct Frame {
    LAS unsigned char* lds;
    int tid, lane, wave, G, gw, NGW;
    unsigned char* ws;
};

__device__ __forceinline__ void transpose_item(const float* W, int K, int N, int k0, int n0, bf16_t* WT, size_t dst_row0, LAS float* scr, int lane) {
    float wv[32];
#pragma unroll
    for (int i = 0; i < 32; ++i) { const int kk = 2 * i + (lane >> 5); wv[i] = __builtin_nontemporal_load(W + (size_t)(k0 + kk) * N + n0 + (lane & 31)); }
#pragma unroll
    for (int i = 0; i < 32; ++i) { const int kk = 2 * i + (lane >> 5); scr[kk * 33 + (lane & 31)] = wv[i]; }
    LDS_WAIT(); asm volatile("" ::: "memory");
    const int c = lane & 7;
#pragma unroll
    for (int j = 0; j < 4; ++j) { const int n = (lane >> 3) + 8 * j; const LAS float* s = scr + (8 * c) * 33 + n;
        u32x4 o; o.x = pk2(s[0 * 33], s[1 * 33]); o.y = pk2(s[2 * 33], s[3 * 33]); o.z = pk2(s[4 * 33], s[5 * 33]); o.w = pk2(s[6 * 33], s[7 * 33]);
        *(u32x4*)(WT + (dst_row0 + n) * K + k0 + 8 * c) = o; }
    LDS_WAIT(); asm volatile("" ::: "memory");
}
__device__ __forceinline__ void transpose_item_fp8(const float* W, int K, int N, int k0, int n0, unsigned char* WT, size_t dst_row0, LAS float* scr, int lane) {
    float wv[32];
#pragma unroll
    for (int i = 0; i < 32; ++i) { const int kk = 2 * i + (lane >> 5); wv[i] = __builtin_nontemporal_load(W + (size_t)(k0 + kk) * N + n0 + (lane & 31)); }
#pragma unroll
    for (int i = 0; i < 32; ++i) { const int kk = 2 * i + (lane >> 5); scr[kk * 33 + (lane & 31)] = wv[i] * W8_SCALE; }
    LDS_WAIT(); asm volatile("" ::: "memory");
    const int c = lane & 7;
#pragma unroll
    for (int j = 0; j < 4; ++j) { const int n = (lane >> 3) + 8 * j; const LAS float* sp = scr + (8 * c) * 33 + n;
        int w0 = 0, w1 = 0; w0 = __builtin_amdgcn_cvt_pk_fp8_f32(sp[0 * 33], sp[1 * 33], w0, false); w0 = __builtin_amdgcn_cvt_pk_fp8_f32(sp[2 * 33], sp[3 * 33], w0, true);
        w1 = __builtin_amdgcn_cvt_pk_fp8_f32(sp[4 * 33], sp[5 * 33], w1, false); w1 = __builtin_amdgcn_cvt_pk_fp8_f32(sp[6 * 33], sp[7 * 33], w1, true);
        u32x2 o; o.x = (unsigned)w0; o.y = (unsigned)w1;
        *(u32x2*)(WT + (dst_row0 + n) * K + k0 + 8 * c) = o; }
    LDS_WAIT(); asm volatile("" ::: "memory");
}
__device__ __forceinline__ void transpose_family(Frame& F, const float* W, int mats, int K, int N, bf16_t* WT, int mode, int& itbase, int it_lo, int it_step) {
    const int nblk = N / 32, kblk = K / 64, per = nblk * kblk, total = mats * per;
    LAS float* scr = (LAS float*)(F.lds + F.wave * 16384);
    int first = (it_lo - itbase) % it_step; if (first < 0) first += it_step;
    for (int it = first; it < total; it += it_step) {
        const int mat = it / per, r = it % per, kb = r / nblk, nb = r % nblk, n0 = 32 * nb, k0 = 64 * kb;
        size_t dst_row0; bf16_t* dstm;
        if (mode == 3) { transpose_item_fp8(W + (size_t)mat * K * N, K, N, k0, n0, (unsigned char*)WT + (size_t)mat * N * K, n0, scr, F.lane); continue; }
        if (mode == 4 || mode == 5) { transpose_item_fp8(W + (size_t)mat * K * N, K, N, k0, n0, (unsigned char*)WT + (size_t)mat * 1024 * K, (size_t)(n0 >> 7) * 256 + (mode == 5 ? 128 : 0) + (n0 & 127), scr, F.lane); continue; }
        if (mode == 0) { dstm = WT + (size_t)mat * N * K; dst_row0 = n0; }
        else { dstm = WT + (size_t)mat * 1024 * K; dst_row0 = (size_t)(n0 >> 7) * 256 + (mode == 2 ? 128 : 0) + (n0 & 127); }
        transpose_item(W + (size_t)mat * K * N, K, N, k0, n0, dstm, dst_row0, scr, F.lane);
    }
    itbase += total;
}

struct ConvJob { const float* src; unsigned char* dst; int N; };
__device__ __forceinline__ ConvJob conv_decode(const Args& a, unsigned char* ws, int L, int s, int lane) {
    const float* W; unsigned char* T; int K, N, t, map = 0, lk, ln;
    if (s < 20480) { t = s; W = a.in[I_WIN] + (size_t)L * D * INC; T = ws + WS_WIN + (size_t)L * INC * D; K = D; N = INC; lk = 7; ln = 8; }
    else if (s < 22528) { t = s - 20480; W = a.in[I_WBP] + (size_t)L * 1024 * D; T = ws + WS_WBP + (size_t)L * D * 1024; K = 1024; N = D; lk = 6; ln = 5; }
    else if (s < 24576) { t = s - 22528; W = a.in[I_WBH] + (size_t)L * 1024 * D; T = ws + WS_WBH + (size_t)L * D * 1024; K = 1024; N = D; lk = 6; ln = 5; }
    else if (s < 28672) { t = s - 24576; W = a.in[I_WOUT] + (size_t)L * D * D; T = ws + WS_WOUT + (size_t)L * D * D; K = D; N = D; lk = 7; ln = 5; }
    else if (s < 45056) { t = s - 28672; W = a.in[I_WE1] + (size_t)L * NEXP * D * DEXP; T = ws + WS_WE13 + (size_t)L * NEXP * 1024 * D; K = D; N = DEXP; map = 1; lk = 7; ln = 3; }
    else if (s < 61440) { t = s - 45056; W = a.in[I_WE3] + (size_t)L * NEXP * D * DEXP; T = ws + WS_WE13 + (size_t)L * NEXP * 1024 * D; K = D; N = DEXP; map = 2; lk = 7; ln = 3; }
    else { t = s - 61440; W = a.in[I_WE2] + (size_t)L * NEXP * DEXP * D; T = ws + WS_WE2 + (size_t)L * NEXP * D * DEXP; K = DEXP; N = D; lk = 5; ln = 5; }
    const int kb = t & ((1 << lk) - 1), nb = (t >> lk) & ((1 << ln) - 1), mat = t >> (lk + ln);
    const int n = nb * 64 + lane, k0 = kb * 16;
    const size_t drow = map ? (size_t)mat * 1024 + (size_t)(n >> 7) * 256 + (map == 2 ? 128 : 0) + (n & 127) : (size_t)mat * N + n;
    ConvJob J; J.src = W + (size_t)mat * K * N + (size_t)k0 * N + n; J.dst = T + drow * K + k0; J.N = N; return J;
}
constexpr int CONV_ITEMS = 77824;
__device__ __forceinline__ void convert_range(Frame& F, const Args& a, int L, int lo, int hi, int rank, int n) {
    if (rank < 0 || L >= DEPTH || F.G != 256) return;
    for (int s0 = lo + (rank * 8 + F.wave) * 2; s0 < hi; s0 += n * 16) {
        const bool has2 = s0 + 1 < hi;
        const ConvJob J0 = conv_decode(a, F.ws, L, s0, F.lane), J1 = conv_decode(a, F.ws, L, has2 ? s0 + 1 : s0, F.lane);
        float v0[16], v1[16];
#pragma unroll
        for (int i = 0; i < 16; ++i) { v0[i] = __builtin_nontemporal_load(J0.src + (size_t)i * J0.N); v1[i] = __builtin_nontemporal_load(J1.src + (size_t)i * J1.N); }
        u32x4 o; o.x = pk4_fp8(v0[0] * W8_SCALE, v0[1] * W8_SCALE, v0[2] * W8_SCALE, v0[3] * W8_SCALE); o.y = pk4_fp8(v0[4] * W8_SCALE, v0[5] * W8_SCALE, v0[6] * W8_SCALE, v0[7] * W8_SCALE);
        o.z = pk4_fp8(v0[8] * W8_SCALE, v0[9] * W8_SCALE, v0[10] * W8_SCALE, v0[11] * W8_SCALE); o.w = pk4_fp8(v0[12] * W8_SCALE, v0[13] * W8_SCALE, v0[14] * W8_SCALE, v0[15] * W8_SCALE);
        *(u32x4*)J0.dst = o;
        if (has2) { o.x = pk4_fp8(v1[0] * W8_SCALE, v1[1] * W8_SCALE, v1[2] * W8_SCALE, v1[3] * W8_SCALE); o.y = pk4_fp8(v1[4] * W8_SCALE, v1[5] * W8_SCALE, v1[6] * W8_SCALE, v1[7] * W8_SCALE);
            o.z = pk4_fp8(v1[8] * W8_SCALE, v1[9] * W8_SCALE, v1[10] * W8_SCALE, v1[11] * W8_SCALE); o.w = pk4_fp8(v1[12] * W8_SCALE, v1[13] * W8_SCALE, v1[14] * W8_SCALE, v1[15] * W8_SCALE);
            *(u32x4*)J1.dst = o; }
    }
}
__device__ __forceinline__ void idle_rank(int nunits, int G, int c, int& rank, int& n) {
    const int rem = nunits % G;
    if (rem == 0 || G - rem < 64) { rank = c; n = G; } else { rank = c >= rem ? c - rem : -1; n = G - rem; }
}

__device__ __forceinline__ void phase_prologue(Frame& F, const Args& a) {
    unsigned char* ws = F.ws;
    int itbase = 0; const int nl = (F.G == 256) ? 0 : DEPTH;
    convert_range(F, a, 0, 0, CONV_ITEMS, (int)blockIdx.x, F.G);
    transpose_family(F, a.in[I_WIN], nl, D, INC, (bf16_t*)(ws + WS_WIN), 3, itbase, F.gw, F.NGW);
    transpose_family(F, a.in[I_WPG], DEPTH * 4, 256, 256, (bf16_t*)(ws + WS_WPG), 0, itbase, F.gw, F.NGW);
    transpose_family(F, a.in[I_WBP], nl, 1024, D, (bf16_t*)(ws + WS_WBP), 3, itbase, F.gw, F.NGW);
    transpose_family(F, a.in[I_WBH], nl, 1024, D, (bf16_t*)(ws + WS_WBH), 3, itbase, F.gw, F.NGW);
    transpose_family(F, a.in[I_WOUT], nl, D, D, (bf16_t*)(ws + WS_WOUT), 3, itbase, F.gw, F.NGW);
    transpose_family(F, a.in[I_WE1], nl * NEXP, D, DEXP, (bf16_t*)(ws + WS_WE13), 4, itbase, F.gw, F.NGW);
    transpose_family(F, a.in[I_WE3], nl * NEXP, D, DEXP, (bf16_t*)(ws + WS_WE13), 5, itbase, F.gw, F.NGW);
    transpose_family(F, a.in[I_WE2], nl * NEXP, DEXP, D, (bf16_t*)(ws + WS_WE2), 3, itbase, F.gw, F.NGW);
    if (blockIdx.x == 0) {
        const float* lg = a.in[I_LBLOG]; float* LB = (float*)(ws + WS_LB);
        for (int i = F.tid; i < 2 * 1024; i += 512) { const int dir = i >> 10, ch = i & 1023;
            float l[DEPTH], mx = -1e30f;
#pragma unroll
            for (int j = 0; j < DEPTH; ++j) { l[j] = lg[((size_t)dir * DEPTH + j) * 1024 + ch]; mx = fmaxf(mx, l[j]); }
            float s = 0.f;
#pragma unroll
            for (int j = 0; j < DEPTH; ++j) { l[j] = __expf(l[j] - mx); s += l[j]; }
            float cum = 0.f;
#pragma unroll
            for (int j = 0; j < DEPTH; ++j) { if (j > 0) cum += l[j] / s; LB[((size_t)j * 2 + dir) * 1024 + ch] = cum; } }
    }
    __syncthreads();
    {
        LAS float* sv = (LAS float*)F.lds;
        LAS float* red = (LAS float*)(F.lds + 5 * D * 4);
        for (int i = F.tid; i < 5 * D; i += 512) { const int r = i / D, k = i % D; const float v = r < 4 ? a.in[I_C][r * D + k] : a.in[I_CCTX][k]; sv[i] = fsilu(v); }
        __syncthreads();
        const float* wada = a.in[I_WADA]; const float* bada = a.in[I_BADA]; float* MOD = (float*)(ws + WS_MOD);
        constexpr int JB = 6 * D / 192;
        const int cg = F.tid % 48, kg = F.tid / 48;
        for (int it = blockIdx.x; it < DEPTH * JB; it += F.G) {
            const int layer = it / JB, j0 = (it % JB) * 192;
            if (kg < 10) {
                const float* w = wada + (size_t)layer * D * 6 * D + j0 + 4 * cg;
                f32x4 acc[5];
#pragma unroll
                for (int r = 0; r < 5; ++r) acc[r] = (f32x4){0.f, 0.f, 0.f, 0.f};
#pragma unroll 8
                for (int k = kg; k < D; k += 10) { const f32x4 wv = *(const f32x4*)(w + (size_t)k * 6 * D);
#pragma unroll
                    for (int r = 0; r < 5; ++r) acc[r] += wv * sv[r * D + k]; }
#pragma unroll
                for (int r = 0; r < 5; ++r) *(LAS f32x4*)(red + (kg * 5 + r) * 192 + 4 * cg) = acc[r];
            }
            __syncthreads();
            for (int o = F.tid; o < 5 * 192; o += 512) { const int r = o / 192, jj = o % 192; float t = bada[(size_t)layer * 6 * D + j0 + jj];
#pragma unroll
                for (int q = 0; q < 10; ++q) t += red[(q * 5 + r) * 192 + jj];
                MOD[((size_t)layer * 5 + r) * 6 * D + j0 + jj] = t; }
            __syncthreads();
        }
    }
    __syncthreads();
}

__device__ __forceinline__ void wave_rows(const Frame& F, int M, int& r0, int& r1) { r0 = (int)(((unsigned)F.gw * (unsigned)M) / (unsigned)F.NGW); r1 = (int)(((unsigned)(F.gw + 1) * (unsigned)M) / (unsigned)F.NGW); }
__device__ __forceinline__ int mod_row(int r) { return r < NLAT ? (r >> 12) : 4; }

__device__ __forceinline__ void xrow_load(const bf16_t* X, int r, int lane, f32x4 (&x)[8]) { const u32x2* xr = (const u32x2*)(X + (size_t)r * D) + lane;
#pragma unroll
    for (int j = 0; j < 8; ++j) { const u32x2 w = xr[64 * j]; x[j] = (f32x4){bflo(w.x), bfhi(w.x), bflo(w.y), bfhi(w.y)}; } }
__device__ __forceinline__ void xrow_store(bf16_t* X, int r, int lane, const f32x4 (&x)[8]) { u32x2* xr = (u32x2*)(X + (size_t)r * D) + lane;
#pragma unroll
    for (int j = 0; j < 8; ++j) { u32x2 w; w.x = pk2(x[j][0], x[j][1]); w.y = pk2(x[j][2], x[j][3]); xr[64 * j] = w; } }
template <int NR>
__device__ __forceinline__ void moe_combine_rows(f32x4 (&x)[NR][8], const int (&r)[NR], int lane, const unsigned char* ws, int player, const float* mod5) {
    const int* pb = (const int*)(ws + WS_PADBASE) + player * 16; const bf16_t* Y2 = (const bf16_t*)(ws + WS_Y2);
    int2 ri[NR]; float2 rg[NR]; const u32x2* y0[NR]; const u32x2* y1[NR];
#pragma unroll
    for (int q = 0; q < NR; ++q) { ri[q] = ((const int2*)(ws + WS_ROUTE_I))[r[q]]; rg[q] = ((const float2*)(ws + WS_ROUTE_G))[r[q]]; }
#pragma unroll
    for (int q = 0; q < NR; ++q) { const int s0 = pb[ri[q].x >> 20] + (ri[q].x & 0xfffff), s1 = pb[ri[q].y >> 20] + (ri[q].y & 0xfffff);
        y0[q] = (const u32x2*)(Y2 + (size_t)s0 * D) + lane; y1[q] = (const u32x2*)(Y2 + (size_t)s1 * D) + lane; }
#pragma unroll
    for (int j = 0; j < 8; ++j) { const f32x4 g = *((const f32x4*)mod5 + 64 * j + lane);
#pragma unroll
        for (int q = 0; q < NR; ++q) { const u32x2 a = y0[q][64 * j], b = y1[q][64 * j];
            const f32x4 ya = (f32x4){bflo(a.x), bfhi(a.x), bflo(a.y), bfhi(a.y)}, yb = (f32x4){bflo(b.x), bfhi(b.x), bflo(b.y), bfhi(b.y)};
            x[q][j] += g * (ya * rg[q].x + yb * rg[q].y); } }
}
__device__ __forceinline__ float row_sumsq(const f32x4 (&x)[8]) { float ss = 0.f;
#pragma unroll
    for (int j = 0; j < 8; ++j) ss += (x[j][0] * x[j][0] + x[j][1] * x[j][1]) + (x[j][2] * x[j][2] + x[j][3] * x[j][3]);
    return ss; }

__device__ __forceinline__ void phase_norm1(Frame& F, const Args& a, int layer, bool combine) {
    unsigned char* ws = F.ws; bf16_t* X = (bf16_t*)(ws + WS_X); bf16_t* H = (bf16_t*)(ws + WS_H);
    const float* MOD = (const float*)(ws + WS_MOD); const float* nw = a.in[I_N1W] + (size_t)layer * D;
    int r0, r1; wave_rows(F, MTOK, r0, r1);
    int curb = -1; f32x4 av[8], sv[8];
    for (int r = r0; r < r1;) {
        const int b = mod_row(r);
        const bool two = (r + 1 < r1) && (mod_row(r + 1) == b);
        const int rr[2] = {r, two ? r + 1 : r};
        if (b != curb) { curb = b; const float* m = MOD + ((size_t)layer * 5 + b) * 6 * D;
#pragma unroll
            for (int j = 0; j < 8; ++j) { const f32x4 w = *((const f32x4*)nw + 64 * j + F.lane), m1 = *((const f32x4*)(m + D) + 64 * j + F.lane); av[j] = w * (m1 + 1.f); sv[j] = *((const f32x4*)m + 64 * j + F.lane); } }
        f32x4 x[2][8];
#pragma unroll
        for (int q = 0; q < 2; ++q) {
            if (layer == 0) { const float* xs = rr[q] < NLAT ? a.in[I_X] + (size_t)rr[q] * D : a.in[I_CTX] + (size_t)(rr[q] - NLAT) * D;
                const f32x4* xr = (const f32x4*)xs + F.lane;
#pragma unroll
                for (int j = 0; j < 8; ++j) x[q][j] = xr[64 * j]; }
            else xrow_load(X, rr[q], F.lane, x[q]); }
        if (combine) { moe_combine_rows<2>(x, rr, F.lane, ws, layer - 1, MOD + ((size_t)(layer - 1) * 5 + b) * 6 * D + 5 * D);
#pragma unroll
            for (int q = 0; q < 2; ++q) if (q == 0 || two) xrow_store(X, rr[q], F.lane, x[q]); }
        float ss0 = row_sumsq(x[0]), ss1 = row_sumsq(x[1]);
#pragma unroll
        for (int o = 1; o < 64; o <<= 1) { ss0 += lane_xor(ss0, o, F.lane); ss1 += lane_xor(ss1, o, F.lane); }
        const float rs[2] = {1.0f / sqrtf(ss0 * (1.f / D) + EPS), 1.0f / sqrtf(ss1 * (1.f / D) + EPS)};
#pragma unroll
        for (int q = 0; q < 2; ++q) if (q == 0 || two) { unsigned* ho = (unsigned*)((unsigned char*)H + (size_t)rr[q] * D) + F.lane;
#pragma unroll
            for (int j = 0; j < 8; ++j) { const f32x4 h = x[q][j] * rs[q] * av[j] + sv[j]; int w = 0; w = __builtin_amdgcn_cvt_pk_fp8_f32(h[0], h[1], w, false); w = __builtin_amdgcn_cvt_pk_fp8_f32(h[2], h[3], w, true); ho[64 * j] = (unsigned)w; } }
        r += two ? 2 : 1;
    }
}

constexpr int RT_LCNT = LDS_MISC + 1024, RT_LBASE = LDS_MISC + 1088, RT_REC = LDS_MISC + 2048;
struct Route { int i1, i2; float g1, g2; };
__device__ __forceinline__ Route route_row(const float (&lg)[NEXP], const float* rbias) {
    float sc[NEXP], sel[NEXP];
#pragma unroll
    for (int e = 0; e < NEXP; ++e) { sc[e] = __builtin_amdgcn_rcpf(1.f + __builtin_amdgcn_exp2f(-1.44269504f * lg[e])); sel[e] = sc[e] + rbias[e]; }
    float gsc[4];
#pragma unroll
    for (int g = 0; g < 4; ++g) { float m1 = -1e30f, m2 = -1e30f;
#pragma unroll
        for (int i = 0; i < 4; ++i) { const float v = sel[g * 4 + i]; const bool c1 = v > m1, c2 = v > m2; m2 = c1 ? m1 : (c2 ? v : m2); m1 = c1 ? v : m1; }
        gsc[g] = m1 + m2; }
    int gbest = 0; float gbs = gsc[0];
#pragma unroll
    for (int g = 1; g < 4; ++g) { const bool c = gsc[g] > gbs; gbest = c ? g : gbest; gbs = c ? gsc[g] : gbs; }
    float sl[4], sx[4];
#pragma unroll
    for (int i = 0; i < 4; ++i) { sl[i] = gbest == 0 ? sel[i] : gbest == 1 ? sel[4 + i] : gbest == 2 ? sel[8 + i] : sel[12 + i]; sx[i] = gbest == 0 ? sc[i] : gbest == 1 ? sc[4 + i] : gbest == 2 ? sc[8 + i] : sc[12 + i]; }
    int i1 = 0, i2 = 0; float v1 = -1e30f, v2 = -1e30f, s1 = 0.f, s2 = 0.f;
#pragma unroll
    for (int i = 0; i < 4; ++i) { const float v = sl[i]; const bool c1 = v > v1, c2 = v > v2;
        i2 = c1 ? i1 : (c2 ? i : i2); s2 = c1 ? s1 : (c2 ? sx[i] : s2); v2 = c1 ? v1 : (c2 ? v : v2);
        i1 = c1 ? i : i1; s1 = c1 ? sx[i] : s1; v1 = c1 ? v : v1; }
    const float inv = __builtin_amdgcn_rcpf(s1 + s2);
    Route R; R.i1 = gbest * 4 + i1; R.i2 = gbest * 4 + i2; R.g1 = s1 * inv; R.g2 = s2 * inv; return R;
}
constexpr int RT_STRIDE = 4112;
constexpr int RT_WB = 0, RT_HT = 16 * RT_STRIDE, RT_PART = 32 * RT_STRIDE;
static_assert(RT_PART + 8192 <= LDS_MISC, "router LDS map");
__device__ __forceinline__ void phase_norm2_router(Frame& F, const Args& a, int layer, int Mrows, bool publish) {
    unsigned char* ws = F.ws; const bf16_t* X = (const bf16_t*)(ws + WS_X); bf16_t* H = (bf16_t*)(ws + WS_H);
    const float* MOD = (const float*)(ws + WS_MOD); const float* nw = a.in[I_N2W] + (size_t)layer * D;
    LAS unsigned char* L = F.lds;
    { const f32x4* wr4 = (const f32x4*)a.in[I_WROUTER];
#pragma unroll 1
      for (int i = 0; i < 2; ++i) { const int k = 2 * F.tid + 1024 * i; f32x4 wv[2][4];
#pragma unroll
          for (int h = 0; h < 2; ++h)
#pragma unroll
              for (int q = 0; q < 4; ++q) wv[h][q] = wr4[(size_t)(k + h) * 4 + q];
#pragma unroll
          for (int q = 0; q < 4; ++q)
#pragma unroll
              for (int ii = 0; ii < 4; ++ii) *(LAS unsigned*)(L + RT_WB + (4 * q + ii) * RT_STRIDE + k * 2) = pk2(wv[0][q][ii], wv[1][q][ii]); } }
    LAS unsigned* lcnt = (LAS unsigned*)(F.lds + RT_LCNT); LAS unsigned* lbase = (LAS unsigned*)(F.lds + RT_LBASE);
    if (F.tid < 16) lcnt[F.tid] = 0u;
    __syncthreads();
    const float* rbias = a.in[I_RBIAS];
    const int brow0 = 2 * (int)((blockIdx.x * (unsigned)(Mrows >> 1)) / (unsigned)F.G), brow1 = 2 * (int)(((blockIdx.x + 1) * (unsigned)(Mrows >> 1)) / (unsigned)F.G);
    const int nround = (brow1 - brow0 + 15) >> 4;
    const int fr = F.lane & 15, fq = F.lane >> 4;
#pragma unroll 1
    for (int t = 0; t < nround; ++t) {
        const int r = brow0 + 16 * t + 2 * F.wave;
        const bool v0 = r < brow1, v1 = r + 1 < brow1;
        const int rr[2] = {v0 ? r : brow0, v1 ? r + 1 : brow0};
        const int b = mod_row(rr[0]);
        const float* m = MOD + ((size_t)layer * 5 + b) * 6 * D;
        f32x4 x[2][8];
#pragma unroll
        for (int q = 0; q < 2; ++q) xrow_load(X, rr[q], F.lane, x[q]);
        float ss0 = row_sumsq(x[0]), ss1 = row_sumsq(x[1]);
#pragma unroll
        for (int o = 1; o < 64; o <<= 1) { ss0 += lane_xor(ss0, o, F.lane); ss1 += lane_xor(ss1, o, F.lane); }
        const float rs[2] = {1.0f / sqrtf(ss0 * (1.f / D) + EPS), 1.0f / sqrtf(ss1 * (1.f / D) + EPS)};
#pragma unroll
        for (int q = 0; q < 2; ++q) {
#pragma unroll
            for (int j = 0; j < 8; ++j) { const f32x4 w = *((const f32x4*)nw + 64 * j + F.lane), m4 = *((const f32x4*)(m + 4 * D) + 64 * j + F.lane), m3 = *((const f32x4*)(m + 3 * D) + 64 * j + F.lane);
                x[q][j] = x[q][j] * rs[q] * (w * (m4 + 1.f)) + m3; }
            if (q == 0 ? v0 : v1) { unsigned* ho = (unsigned*)((unsigned char*)H + (size_t)rr[q] * D) + F.lane;
#pragma unroll
                for (int j = 0; j < 8; ++j) ho[64 * j] = pk4_fp8(x[q][j][0], x[q][j][1], x[q][j][2], x[q][j][3]); }
            LAS unsigned char* hrow = L + RT_HT + (2 * F.wave + q) * RT_STRIDE + F.lane * 8;
#pragma unroll
            for (int j = 0; j < 8; ++j) { u32x2 w; w.x = pk2(x[q][j][0], x[q][j][1]); w.y = pk2(x[q][j][2], x[q][j][3]); *(LAS u32x2*)(hrow + j * 512) = w; } }
        __syncthreads();
        f32x4 acc = (f32x4){0.f, 0.f, 0.f, 0.f};
#pragma unroll
        for (int s = 0; s < 8; ++s) { const int kb = (256 * F.wave + 32 * s + 8 * fq) * 2;
            const bf16x8 wa = *(const LAS bf16x8*)(L + RT_WB + fr * RT_STRIDE + kb), hb = *(const LAS bf16x8*)(L + RT_HT + fr * RT_STRIDE + kb);
            acc = __builtin_amdgcn_mfma_f32_16x16x32_bf16(wa, hb, acc, 0, 0, 0); }
        *(LAS f32x4*)(L + RT_PART + F.wave * 1024 + fr * 64 + fq * 16) = acc;
        __syncthreads();
        if (F.lane < 2) { const int tr = 2 * F.wave + F.lane;
            f32x4 sg[4] = {(f32x4){0.f, 0.f, 0.f, 0.f}, (f32x4){0.f, 0.f, 0.f, 0.f}, (f32x4){0.f, 0.f, 0.f, 0.f}, (f32x4){0.f, 0.f, 0.f, 0.f}};
#pragma unroll
            for (int w8 = 0; w8 < 8; ++w8)
#pragma unroll
                for (int c = 0; c < 4; ++c) sg[c] += *(const LAS f32x4*)(L + RT_PART + w8 * 1024 + tr * 64 + c * 16);
            float lg[NEXP];
#pragma unroll
            for (int e = 0; e < NEXP; ++e) lg[e] = sg[e >> 2][e & 3];
            const Route R = route_row(lg, rbias); const int i1 = R.i1, i2 = R.i2; const float g1 = R.g1, g2 = R.g2;
            if ((F.lane == 0 ? v0 : v1) && publish) {
                const unsigned k1 = __hip_atomic_fetch_add(lcnt + i1, 1u, __ATOMIC_RELAXED, __HIP_MEMORY_SCOPE_WORKGROUP), k2 = __hip_atomic_fetch_add(lcnt + i2, 1u, __ATOMIC_RELAXED, __HIP_MEMORY_SCOPE_WORKGROUP);
                LAS unsigned* rec = (LAS unsigned*)(F.lds + RT_REC + (r + F.lane - brow0) * 32);
                rec[0] = (unsigned)i1; rec[1] = k1; rec[2] = (unsigned)i2; rec[3] = k2; rec[4] = __builtin_bit_cast(unsigned, g1); rec[5] = __builtin_bit_cast(unsigned, g2);
            } }
    }
    __syncthreads();
    if (F.tid < 16 && publish) { unsigned* cntw = (unsigned*)(ws + WS_CTL) + CW_CNT + layer * 1024; const unsigned n = lcnt[F.tid]; lbase[F.tid] = n ? atomicAdd(cntw + F.tid * 64, n) : 0u; }
    __syncthreads();
    if (F.tid < brow1 - brow0 && publish) { const int r = brow0 + F.tid; const LAS unsigned* rec = (const LAS unsigned*)(F.lds + RT_REC + F.tid * 32);
        const unsigned i1 = rec[0], i2 = rec[2], k1 = lbase[i1] + rec[1], k2 = lbase[i2] + rec[3];
        int* slottok = (int*)(ws + WS_SLOTTOK); slottok[(size_t)i1 * MTOK + k1] = r; slottok[(size_t)i2 * MTOK + k2] = r;
        ((int2*)(ws + WS_ROUTE_I))[r] = make_int2((int)((i1 << 20) | k1), (int)((i2 << 20) | k2));
        ((float2*)(ws + WS_ROUTE_G))[r] = make_float2(__builtin_bit_cast(float, rec[4]), __builtin_bit_cast(float, rec[5])); }
    __syncthreads();
}

__device__ __forceinline__ void phase_pooldiff(Frame& F, int Mrows) {
    unsigned char* ws = F.ws; const bf16_t* Z = (const bf16_t*)(ws + WS_Z); bf16_t* PD = (bf16_t*)(ws + WS_PD);
    LAS unsigned char* L = F.lds;
    const int cg = F.tid & 127, rq = F.tid >> 7, hw = 1 << (cg >> 5);
    const int ntile = NLAT / 64;
    for (int tile = blockIdx.x; tile < ntile; tile += F.G) {
        int base, Lrow, t0, nt;
        if (tile < NLAT / 64) { base = tile * 64; Lrow = 64; t0 = 0; nt = 64; }
        else { const int u = tile - NLAT / 64; base = NLAT + (u >> 3) * CTXL; Lrow = CTXL; t0 = (u & 7) * 32; nt = 32; }
        const int lo = max(t0 - 8, 0), hi = min(t0 + nt + 7, Lrow - 1), nrow = hi - lo + 1;
        u32x4 buf[16];
#pragma unroll
        for (int i = 0; i < 16; ++i) { const int sl = rq + 4 * i; buf[i] = (sl < nrow) ? *(const u32x4*)(Z + (size_t)(base + lo + sl) * INC + ZC_POOL + cg * 8) : (u32x4){0u, 0u, 0u, 0u}; }
#pragma unroll
        for (int i = 0; i < 16; ++i) { const int sl = rq + 4 * i; *(LAS u32x4*)(L + sl * 2048 + cg * 16) = buf[i]; }
        __syncthreads();
        for (int i = 0; i < nt / 4; ++i) { const int t = t0 + rq + 4 * i;
            const int wl = max(t - hw, 0), wh = min(t + hw - 1, Lrow - 1);
            float s[8] = {0.f, 0.f, 0.f, 0.f, 0.f, 0.f, 0.f, 0.f};
            for (int p = wl; p <= wh; ++p) { const u32x4 a = *(const LAS u32x4*)(L + (p - lo) * 2048 + cg * 16);
                s[0] += bflo(a.x); s[1] += bfhi(a.x); s[2] += bflo(a.y); s[3] += bfhi(a.y); s[4] += bflo(a.z); s[5] += bfhi(a.z); s[6] += bflo(a.w); s[7] += bfhi(a.w); }
            const float inv = 1.f / (float)(wh - wl + 1);
            const u32x4 a = *(const LAS u32x4*)(L + (t - lo) * 2048 + cg * 16);
            u32x4 o; o.x = pk2(s[0] * inv - bflo(a.x), s[1] * inv - bfhi(a.x)); o.y = pk2(s[2] * inv - bflo(a.y), s[3] * inv - bfhi(a.y));
            o.z = pk2(s[4] * inv - bflo(a.z), s[5] * inv - bfhi(a.z)); o.w = pk2(s[6] * inv - bflo(a.w), s[7] * inv - bfhi(a.w));
            *(u32x4*)(PD + (size_t)(base + t) * DPOOL + cg * 8) = o; }
        __syncthreads();
    }
    if (Mrows > NLAT) {
        const int cgl = F.tid & 15, rq2 = F.tid >> 4;
        for (int it = blockIdx.x; it < (NCTX / 32) * 8; it += F.G) {
            const int u = it >> 3, k = it & 7, cg2 = k * 16 + cgl, hw2 = 1 << (k >> 1);
            const int base = NLAT + (u >> 3) * CTXL, t0 = (u & 7) * 32;
            const int lo = max(t0 - 8, 0), hi = min(t0 + 32 + 7, CTXL - 1), nrow = hi - lo + 1;
            u32x4 buf[2];
#pragma unroll
            for (int i = 0; i < 2; ++i) { const int sl = rq2 + 32 * i; buf[i] = (sl < nrow) ? *(const u32x4*)(Z + (size_t)(base + lo + sl) * INC + ZC_POOL + cg2 * 8) : (u32x4){0u, 0u, 0u, 0u}; }
#pragma unroll
            for (int i = 0; i < 2; ++i) { const int sl = rq2 + 32 * i; *(LAS u32x4*)(L + sl * 2048 + cg2 * 16) = buf[i]; }
            __syncthreads();
            { const int t = t0 + rq2;
              const int wl = max(t - hw2, 0), wh = min(t + hw2 - 1, CTXL - 1);
              float s8[8] = {0.f, 0.f, 0.f, 0.f, 0.f, 0.f, 0.f, 0.f};
              for (int p = wl; p <= wh; ++p) { const u32x4 a = *(const LAS u32x4*)(L + (p - lo) * 2048 + cg2 * 16);
                  s8[0] += bflo(a.x); s8[1] += bfhi(a.x); s8[2] += bflo(a.y); s8[3] += bfhi(a.y); s8[4] += bflo(a.z); s8[5] += bfhi(a.z); s8[6] += bflo(a.w); s8[7] += bfhi(a.w); }
              const float inv = 1.f / (float)(wh - wl + 1);
              const u32x4 a = *(const LAS u32x4*)(L + (t - lo) * 2048 + cg2 * 16);
              u32x4 o; o.x = pk2(s8[0] * inv - bflo(a.x), s8[1] * inv - bfhi(a.x)); o.y = pk2(s8[2] * inv - bflo(a.y), s8[3] * inv - bfhi(a.y));
              o.z = pk2(s8[4] * inv - bflo(a.z), s8[5] * inv - bfhi(a.z)); o.w = pk2(s8[6] * inv - bflo(a.w), s8[7] * inv - bfhi(a.w));
              *(u32x4*)(PD + (size_t)(base + t) * DPOOL + cg2 * 8) = o; }
            __syncthreads();
        }
    }
}

constexpr int SC_QS = 0, SC_KS = 17408, SC_KST = 34816, SC_VT = 53248, SC_VEC = 71680;
constexpr int SC_ST = 73216, SC_TOT = SC_ST + 34816, SC_END = SC_TOT + 4096;
constexpr int SC_P272 = 272, SC_P144 = 144;
constexpr int SEG_CH = 17, NSEG = 4;
static_assert(SC_END <= LDS_MISC, "scan LDS map");
struct ScanCtx { const bf16_t* Z; bf16_t* O2; LAS unsigned char* L; unsigned char* qsg; float* corrv; float* smid; float* totseg; int tid, lane, w, fr, fq, rt, vp, b, h, seg, dir, colq, colf, colv; };
__device__ __forceinline__ void scan_row0(int b, int dir, int c, int& g0, int& sg) {
    if (c < 4) { const int t0 = 64 * c; g0 = NLAT + b * CTXL + (dir ? CTXL - 1 - t0 : t0); } else { const int t0 = 64 * (c - 4); g0 = b * SEQ + (dir ? SEQ - 1 - t0 : t0); }
    sg = dir ? -1 : 1;
}
__device__ __forceinline__ void scan_load_lf(const ScanCtx& C, int c, unsigned (&lfw)[8]) {
    int g0, sg; scan_row0(C.b, C.dir, c, g0, sg);
#pragma unroll
    for (int j = 0; j < 8; ++j) lfw[j] = *(const unsigned*)(C.Z + (size_t)(g0 + sg * (8 * C.w + j)) * INC + C.colf);
}
__device__ __forceinline__ void scan_load_qv(const ScanCtx& C, int c, unsigned (&qw)[8], unsigned (&vw)[8]) {
    int g0, sg; scan_row0(C.b, C.dir, c, g0, sg);
#pragma unroll
    for (int j = 0; j < 8; ++j) { const bf16_t* zr = C.Z + (size_t)(g0 + sg * (8 * C.w + j)) * INC; qw[j] = *(const unsigned*)(zr + C.colq); vw[j] = *(const unsigned*)(zr + C.colv); }
}
__device__ __forceinline__ void scan_p1(const ScanCtx& C, const unsigned (&lfw)[8]) {
    float a0 = 0.f, a1 = 0.f;
#pragma unroll
    for (int j = 0; j < 8; ++j) { a0 += bflo(lfw[j]); a1 += bfhi(lfw[j]); }
    *(LAS f32x2*)(C.L + SC_TOT + (C.w * 128 + 2 * C.lane) * 4) = (f32x2){a0, a1};
}
__device__ __forceinline__ void scan_p2(const ScanCtx& C, int cl, const unsigned (&lfw)[8], const unsigned (&qw)[8], const unsigned (&vw)[8], float& cum0, float& cum1) {
    LAS unsigned char* L = C.L; const int lane = C.lane, w = C.w;
    float c0[8], c1[8], l0[8], l1[8];
    { float a0 = 0.f, a1 = 0.f;
#pragma unroll
      for (int j = 0; j < 8; ++j) { l0[j] = bflo(lfw[j]); l1[j] = bfhi(lfw[j]); a0 += l0[j]; a1 += l1[j]; c0[j] = a0; c1[j] = a1; } }
    float P0 = 0.f, P1 = 0.f, r0 = 0.f, r1 = 0.f, bl0 = 0.f, bl1 = 0.f;
#pragma unroll
    for (int o = 0; o < 8; ++o) { const f32x2 t = *(const LAS f32x2*)(L + SC_TOT + (o * 128 + 2 * lane) * 4);
        if (o < w) { P0 += t.x; P1 += t.y; } if (o < 4) { r0 += t.x; r1 += t.y; } bl0 += t.x; bl1 += t.y; }
    float k0v[8], k1v[8]; const float P0r = P0 - r0, P1r = P1 - r1;
#pragma unroll
    for (int j = 0; j < 8; ++j) {
        const float d0 = __builtin_amdgcn_fmed3f(P0r + c0[j], -120.f, 120.f), d1 = __builtin_amdgcn_fmed3f(P1r + c1[j], -120.f, 120.f);
        const float E0 = __builtin_amdgcn_exp2f(d0), E1 = __builtin_amdgcn_exp2f(d1), I0 = __builtin_amdgcn_exp2f(-d0), I1 = __builtin_amdgcn_exp2f(-d1);
        const float f0 = __builtin_amdgcn_exp2f(l0[j]), f1 = __builtin_amdgcn_exp2f(l1[j]);
        const float q0 = bflo(qw[j]), q1 = bfhi(qw[j]);
        k0v[j] = (1.f - f0) * I0; k1v[j] = (1.f - f1) * I1;
        const int rho = 8 * w + j;
        *(LAS unsigned*)(L + SC_QS + rho * SC_P272 + 4 * lane) = pk2(q0 * E0, q1 * E1);
        *(LAS unsigned*)(L + SC_KS + rho * SC_P272 + 4 * lane) = pk2(k0v[j], k1v[j]);
    }
    { u32x4 t0, t1; t0.x = pk2(k0v[0], k0v[1]); t0.y = pk2(k0v[2], k0v[3]); t0.z = pk2(k0v[4], k0v[5]); t0.w = pk2(k0v[6], k0v[7]);
      t1.x = pk2(k1v[0], k1v[1]); t1.y = pk2(k1v[2], k1v[3]); t1.z = pk2(k1v[4], k1v[5]); t1.w = pk2(k1v[6], k1v[7]);
      *(LAS u32x4*)(L + SC_KST + (2 * lane) * SC_P144 + 16 * w) = t0; *(LAS u32x4*)(L + SC_KST + (2 * lane + 1) * SC_P144 + 16 * w) = t1; }
    if (w == 0) {
        LAS float* vec = (LAS float*)(L + SC_VEC);
        *(LAS f32x2*)(vec + 2 * lane) = (f32x2){__builtin_amdgcn_exp2f(fmaxf(r0, -120.f)), __builtin_amdgcn_exp2f(fmaxf(r1, -120.f))};
        *(LAS f32x2*)(vec + 128 + 2 * lane) = (f32x2){__builtin_amdgcn_exp2f(fmaxf(bl0, -120.f)), __builtin_amdgcn_exp2f(fmaxf(bl1, -120.f))};
        *(LAS f32x2*)(vec + 256 + 2 * lane) = (f32x2){__builtin_amdgcn_exp2f(fmaxf(bl0 - r0, -120.f)), __builtin_amdgcn_exp2f(fmaxf(bl1 - r1, -120.f))};
        if (C.seg >= 1) *(f32x2*)(C.corrv + cl * 128 + 2 * lane) = (f32x2){r0 + cum0, r1 + cum1};
    }
    cum0 += bl0; cum1 += bl1;
    { u32x4 t0, t1;
      t0.x = (vw[0] & 0xffffu) | (vw[1] << 16); t0.y = (vw[2] & 0xffffu) | (vw[3] << 16); t0.z = (vw[4] & 0xffffu) | (vw[5] << 16); t0.w = (vw[6] & 0xffffu) | (vw[7] << 16);
      t1.x = (vw[0] >> 16) | (vw[1] & 0xffff0000u); t1.y = (vw[2] >> 16) | (vw[3] & 0xffff0000u); t1.z = (vw[4] >> 16) | (vw[5] & 0xffff0000u); t1.w = (vw[6] >> 16) | (vw[7] & 0xffff0000u);
      *(LAS u32x4*)(L + SC_VT + (2 * lane) * SC_P144 + 16 * w) = t0; *(LAS u32x4*)(L + SC_VT + (2 * lane + 1) * SC_P144 + 16 * w) = t1; }
}
__device__ __forceinline__ void scan_c1(const ScanCtx& C, const f32x4 (&S)[2][4]) {
#pragma unroll
    for (int i = 0; i < 2; ++i) { const int k = ((C.w >> 1) * 2 + i) * 16 + 4 * C.fq;
        f32x4 r = *(const LAS f32x4*)(C.L + SC_TOT + k * 4);
#pragma unroll
        for (int o = 1; o < 4; ++o) r += *(const LAS f32x4*)(C.L + SC_TOT + (o * 128 + k) * 4);
        f32x4 e;
#pragma unroll
        for (int q = 0; q < 4; ++q) e[q] = __builtin_amdgcn_exp2f(fmaxf(r[q], -120.f));
#pragma unroll
        for (int u = 0; u < 4; ++u) { const int v = (4 * C.vp + u) * 16 + C.fr; const f32x4 sv = S[i][u] * e;
            u32x2 t; t.x = pk2(sv[0], sv[1]); t.y = pk2(sv[2], sv[3]); *(LAS u32x2*)(C.L + SC_ST + v * SC_P272 + k * 2) = t; } }
}
__device__ __forceinline__ void scan_c2(const ScanCtx& C, int c, f32x4 (&S)[2][4]) {
    LAS unsigned char* L = C.L; const int fr = C.fr, fq = C.fq, rt = C.rt, w = C.w;
    bf16x8 yq[4];
#pragma unroll
    for (int ks = 0; ks < 4; ++ks) yq[ks] = *(const LAS bf16x8*)(L + SC_QS + (rt * 16 + fr) * SC_P272 + (ks * 32 + fq * 8) * 2);
    f32x4 at[4];
#pragma unroll
    for (int st = 0; st < 4; ++st) { f32x4 a = (f32x4){0.f, 0.f, 0.f, 0.f};
        if (st <= rt) {
#pragma unroll
            for (int ks = 0; ks < 4; ++ks) { const bf16x8 x = *(const LAS bf16x8*)(L + SC_KS + (st * 16 + fr) * SC_P272 + (ks * 32 + fq * 8) * 2); a = __builtin_amdgcn_mfma_f32_16x16x32_bf16(x, yq[ks], a, 0, 0, 0); }
            if (st == rt) {
#pragma unroll
                for (int r = 0; r < 4; ++r) if (4 * fq + r > fr) a[r] = 0.f; } }
        at[st] = a; }
    u32x4 yw[2];
#pragma unroll
    for (int ks2 = 0; ks2 < 2; ++ks2) { yw[ks2].x = pk2(at[2 * ks2][0], at[2 * ks2][1]); yw[ks2].y = pk2(at[2 * ks2][2], at[2 * ks2][3]); yw[ks2].z = pk2(at[2 * ks2 + 1][0], at[2 * ks2 + 1][1]); yw[ks2].w = pk2(at[2 * ks2 + 1][2], at[2 * ks2 + 1][3]); }
    int g0, sg; scan_row0(C.b, C.dir, c, g0, sg);
#pragma unroll
    for (int u = 0; u < 4; ++u) { const int vt = 4 * C.vp + u; f32x4 o = (f32x4){0.f, 0.f, 0.f, 0.f};
#pragma unroll
        for (int ks = 0; ks < 4; ++ks) { const bf16x8 x = *(const LAS bf16x8*)(L + SC_ST + (vt * 16 + fr) * SC_P272 + (ks * 32 + fq * 8) * 2); o = __builtin_amdgcn_mfma_f32_16x16x32_bf16(x, yq[ks], o, 0, 0, 0); }
#pragma unroll
        for (int ks2 = 0; ks2 < 2; ++ks2) { if (2 * ks2 <= rt) {
            const u32x2 xa = *(const LAS u32x2*)(L + SC_VT + (vt * 16 + fr) * SC_P144 + (ks2 * 32 + 4 * fq) * 2), xb = *(const LAS u32x2*)(L + SC_VT + (vt * 16 + fr) * SC_P144 + (ks2 * 32 + 16 + 4 * fq) * 2);
            u32x4 xw; xw.x = xa.x; xw.y = xa.y; xw.z = xb.x; xw.w = xb.y;
            o = __builtin_amdgcn_mfma_f32_16x16x32_bf16(__builtin_bit_cast(bf16x8, xw), __builtin_bit_cast(bf16x8, yw[ks2]), o, 0, 0, 0); } }
        u32x2 ow; ow.x = pk2(o[0], o[1]); ow.y = pk2(o[2], o[3]);
        *(u32x2*)(C.O2 + ((size_t)C.dir * MTOK + (g0 + sg * (rt * 16 + fr))) * HGW + C.h * HDK + vt * 16 + 4 * fq) = ow;
        __builtin_amdgcn_sched_barrier(0); }
    bf16x8 xk[2][2];
#pragma unroll
    for (int i = 0; i < 2; ++i)
#pragma unroll
        for (int ks = 0; ks < 2; ++ks) xk[i][ks] = *(const LAS bf16x8*)(L + SC_KST + (((w >> 1) * 2 + i) * 16 + fr) * SC_P144 + (ks * 32 + fq * 8) * 2);
#pragma unroll
    for (int u = 0; u < 4; ++u) { bf16x8 yv[2];
#pragma unroll
        for (int ks = 0; ks < 2; ++ks) yv[ks] = *(const LAS bf16x8*)(L + SC_VT + ((4 * C.vp + u) * 16 + fr) * SC_P144 + (ks * 32 + fq * 8) * 2);
#pragma unroll
        for (int i = 0; i < 2; ++i) { f32x4 d = (f32x4){0.f, 0.f, 0.f, 0.f};
#pragma unroll
            for (int ks = 0; ks < 2; ++ks) d = __builtin_amdgcn_mfma_f32_16x16x32_bf16(xk[i][ks], yv[ks], d, 0, 0, 0);
            const int k = ((w >> 1) * 2 + i) * 16 + 4 * fq; const f32x4 ebl = *(const LAS f32x4*)(L + SC_VEC + (128 + k) * 4), ebr = *(const LAS f32x4*)(L + SC_VEC + (256 + k) * 4);
            S[i][u] = ebl * S[i][u] + ebr * d; }
        __builtin_amdgcn_sched_barrier(0); }
}
__device__ __forceinline__ void phase_scan_mfma(Frame& F) {
    ScanCtx C; C.Z = (const bf16_t*)(F.ws + WS_Z); C.O2 = (bf16_t*)(F.ws + WS_O2); C.L = F.lds;
    C.tid = F.tid; C.lane = F.lane; C.w = F.wave; C.fr = F.lane & 15; C.fq = F.lane >> 4; C.rt = F.wave >> 1; C.vp = F.wave & 1;
    for (int it = blockIdx.x; it < 64 * NSEG; it += F.G) {
        const int sbh = it >> 2; C.h = sbh & 7; C.b = (sbh >> 3) & 3; C.dir = sbh >> 5;
        C.seg = C.dir ? 3 - (it & 3) : (it & 3);
        C.qsg = F.ws + WS_QSG + (size_t)(sbh * 3 + (C.seg - 1)) * SEG_CH * 17408; C.corrv = (float*)(F.ws + WS_CORRV) + (size_t)(sbh * 3 + (C.seg - 1)) * SEG_CH * 128;
        C.smid = (float*)(F.ws + WS_SMID) + (size_t)(sbh * 3 + C.seg) * 128 * 128; C.totseg = (float*)(F.ws + WS_TOTSEG) + (size_t)(sbh * NSEG + C.seg) * 128;
        C.colq = ZC_Q + C.h * HDK + 2 * C.lane; C.colf = (C.dir == 0 ? ZC_FF : ZC_FB) + C.h * HDK + 2 * C.lane; C.colv = ZC_I + C.h * HDK + 2 * C.lane;
        f32x4 S[2][4];
#pragma unroll
        for (int i = 0; i < 2; ++i)
#pragma unroll
            for (int u = 0; u < 4; ++u) S[i][u] = (f32x4){0.f, 0.f, 0.f, 0.f};
        float cum0 = 0.f, cum1 = 0.f;
        unsigned lfW[8], qW[8], vW[8];
        const int c_lo = C.seg * SEG_CH;
        scan_load_lf(C, c_lo, lfW); scan_load_qv(C, c_lo, qW, vW);
        scan_p1(C, lfW);
        __syncthreads();
#define SC_STEP(cl) do { \
            scan_p2(C, (cl), lfW, qW, vW, cum0, cum1); scan_c1(C, S); \
            if ((cl) + 1 < SEG_CH) { scan_load_lf(C, c_lo + (cl) + 1, lfW); scan_load_qv(C, c_lo + (cl) + 1, qW, vW); } \
            __syncthreads(); \
            if (C.seg >= 1) { unsigned char* dst = C.qsg + (size_t)(cl) * 17408; const LAS unsigned char* src = C.L + SC_QS; for (int i_ = C.tid; i_ < 1088; i_ += 512) *(u32x4*)(dst + 16 * i_) = *(const LAS u32x4*)(src + 16 * i_); } \
            scan_c2(C, c_lo + (cl), S); \
            if ((cl) + 1 < SEG_CH) scan_p1(C, lfW); \
            __syncthreads(); } while (0)
        for (int cl = 0; cl < SEG_CH; ++cl) SC_STEP(cl);
#undef SC_STEP
        if (C.seg < 3) {
#pragma unroll
            for (int i = 0; i < 2; ++i)
#pragma unroll
                for (int u = 0; u < 4; ++u) *(f32x4*)(C.smid + ((4 * C.vp + u) * 16 + C.fr) * 128 + ((C.w >> 1) * 2 + i) * 16 + 4 * C.fq) = S[i][u]; }
        if (C.w == 0) *(f32x2*)(C.totseg + 2 * C.lane) = (f32x2){cum0, cum1};
        __syncthreads();
    }
}
__device__ __forceinline__ void phase_scan_fix(Frame& F) {
    unsigned char* ws = F.ws; bf16_t* O2 = (bf16_t*)(ws + WS_O2); LAS unsigned char* L = F.lds;
    LAS float* facv = (LAS float*)(L + 36864); LAS int* flg = (LAS int*)(L + 36864 + 512);
    const int w = F.wave, fr = F.lane & 15, fq = F.lane >> 4, rt = w >> 1, vp = w & 1;
    for (int item = blockIdx.x; item < 64 * 3; item += F.G) {
        const int j = 1 + item % 3, sbh = item / 3, dir = sbh >> 5, b = (sbh >> 3) & 3, h = sbh & 7;
        const int v = F.tid >> 2, k0 = (F.tid & 3) * 32;
        f32x4 sin[8];
        { const float* E = (const float*)(ws + WS_SMID) + ((size_t)(sbh * 3 + 0) * 128 + v) * 128 + k0;
#pragma unroll
          for (int i = 0; i < 8; ++i) sin[i] = *(const f32x4*)(E + 4 * i); }
        for (int jj = 1; jj < j; ++jj) { const float* E = (const float*)(ws + WS_SMID) + ((size_t)(sbh * 3 + jj) * 128 + v) * 128 + k0; const float* T = (const float*)(ws + WS_TOTSEG) + (size_t)(sbh * NSEG + jj) * 128 + k0;
#pragma unroll
            for (int i = 0; i < 8; ++i) { const f32x4 t = *(const f32x4*)(T + 4 * i); f32x4 d;
#pragma unroll
                for (int q = 0; q < 4; ++q) d[q] = __builtin_amdgcn_exp2f(fmaxf(t[q], -200.f));
                sin[i] = d * sin[i] + *(const f32x4*)(E + 4 * i); } }
        for (int cl = 0; cl < SEG_CH; ++cl) {
            if (F.tid == 0) flg[0] = 0;
            __syncthreads();
            if (F.tid < 128) { const float e = ((const float*)(ws + WS_CORRV))[((size_t)(sbh * 3 + (j - 1)) * SEG_CH + cl) * 128 + F.tid]; const float f = __builtin_amdgcn_exp2f(fmaxf(e, -200.f)); facv[F.tid] = f; if (f != 0.f) flg[0] = 1; }
            __syncthreads();
            if (flg[0] != 0) {
#pragma unroll
                for (int i = 0; i < 4; ++i) { const f32x4 a0 = sin[2 * i] * *(const LAS f32x4*)(facv + k0 + 8 * i), a1 = sin[2 * i + 1] * *(const LAS f32x4*)(facv + k0 + 8 * i + 4);
                    u32x4 o; o.x = pk2(a0[0], a0[1]); o.y = pk2(a0[2], a0[3]); o.z = pk2(a1[0], a1[1]); o.w = pk2(a1[2], a1[3]);
                    *(LAS u32x4*)(L + v * SC_P272 + (k0 + 8 * i) * 2) = o; }
                __syncthreads();
                const unsigned char* qs = ws + WS_QSG + ((size_t)(sbh * 3 + (j - 1)) * SEG_CH + cl) * 17408;
                bf16x8 yq[4];
#pragma unroll
                for (int ks = 0; ks < 4; ++ks) yq[ks] = *(const bf16x8*)(qs + (rt * 16 + fr) * SC_P272 + (ks * 32 + fq * 8) * 2);
                int g0, sg; scan_row0(b, dir, j * SEG_CH + cl, g0, sg);
#pragma unroll
                for (int u = 0; u < 4; ++u) { const int vt = 4 * vp + u; f32x4 o = (f32x4){0.f, 0.f, 0.f, 0.f};
#pragma unroll
                    for (int ks = 0; ks < 4; ++ks) { const bf16x8 x = *(const LAS bf16x8*)(L + (vt * 16 + fr) * SC_P272 + (ks * 32 + fq * 8) * 2); o = __builtin_amdgcn_mfma_f32_16x16x32_bf16(x, yq[ks], o, 0, 0, 0); }
                    u32x2* p = (u32x2*)(O2 + ((size_t)dir * MTOK + (g0 + sg * (rt * 16 + fr))) * HGW + h * HDK + vt * 16 + 4 * fq);
                    const u32x2 old = *p; u32x2 nw; nw.x = pk2(bflo(old.x) + o[0], bfhi(old.x) + o[1]); nw.y = pk2(bflo(old.y) + o[2], bfhi(old.y) + o[3]); *p = nw; }
            }
            __syncthreads();
        }
    }
}
__device__ __forceinline__ void phase_readout_naive(Frame& F, const Args& a, int layer, int Mrows) {
    unsigned char* ws = F.ws; const bf16_t* Z = (const bf16_t*)(ws + WS_Z); const float* O2 = (const float*)(ws + WS_O2); bf16_t* HG = (bf16_t*)(ws + WS_HG);
    const float* wn = a.in[I_HGNW] + (size_t)layer * HGW;
    int r0, r1;
    { const int G = F.G, extra = (Mrows / 256) * (DPOOL / 256) - G, c = (int)blockIdx.x;
      int b0, b1;
      if (extra > 0 && 2 * extra < G) { const int nb = (Mrows + extra * 36) / G, heavy = Mrows - (G - extra) * nb;
          if (c < extra) { b0 = (int)(((unsigned)c * (unsigned)heavy) / (unsigned)extra); b1 = (int)(((unsigned)(c + 1) * (unsigned)heavy) / (unsigned)extra); }
          else { b0 = heavy + (c - extra) * nb; b1 = b0 + nb; } }
      else { b0 = (int)(((unsigned)c * (unsigned)Mrows) / (unsigned)G); b1 = (int)(((unsigned)(c + 1) * (unsigned)Mrows) / (unsigned)G); }
      const int n = b1 - b0; r0 = b0 + (F.wave * n) / 8; r1 = b0 + ((F.wave + 1) * n) / 8; }
    const int c0 = F.lane * 16;
    float wv[16];
#pragma unroll
    for (int j = 0; j < 16; ++j) wv[j] = wn[c0 + j] * HG8_SCALE;
    for (int rb = r0; rb < r1; rb += 2) {
        const bool two = rb + 1 < r1; const int rr[2] = {rb, two ? rb + 1 : rb};
        u32x2 xw[2][4], yw[2][4]; u32x4 ga[2], gb[2];
#pragma unroll
        for (int q = 0; q < 2; ++q) {
#pragma unroll
            for (int j = 0; j < 4; ++j) { xw[q][j] = *(const u32x2*)((const bf16_t*)O2 + (size_t)rr[q] * HGW + c0 + 4 * j); yw[q][j] = *(const u32x2*)((const bf16_t*)O2 + ((size_t)MTOK + rr[q]) * HGW + c0 + 4 * j); }
            const u32x4* zp = (const u32x4*)(Z + (size_t)rr[q] * INC + ZC_OG + c0); ga[q] = zp[0]; gb[q] = zp[1]; }
#pragma unroll
        for (int q = 0; q < 2; ++q) { if (q == 0 || two) {
            float o[16]; float ss = 0.f;
#pragma unroll
            for (int j = 0; j < 4; ++j) { const f32x4 x = (f32x4){bflo(xw[q][j].x), bfhi(xw[q][j].x), bflo(xw[q][j].y), bfhi(xw[q][j].y)}, y = (f32x4){bflo(yw[q][j].x), bfhi(yw[q][j].x), bflo(yw[q][j].y), bfhi(yw[q][j].y)};
#pragma unroll
                for (int i = 0; i < 4; ++i) { o[4 * j + i] = x[i] + y[i]; ss += o[4 * j + i] * o[4 * j + i]; } }
            ss += lane_xor(ss, 1, F.lane); ss += lane_xor(ss, 2, F.lane); ss += lane_xor(ss, 4, F.lane);
            const float rs = 1.0f / sqrtf(ss * (1.f / HDK) + EPS);
            const float g[16] = {bflo(ga[q].x), bfhi(ga[q].x), bflo(ga[q].y), bfhi(ga[q].y), bflo(ga[q].z), bfhi(ga[q].z), bflo(ga[q].w), bfhi(ga[q].w), bflo(gb[q].x), bfhi(gb[q].x), bflo(gb[q].y), bfhi(gb[q].y), bflo(gb[q].z), bfhi(gb[q].z), bflo(gb[q].w), bfhi(gb[q].w)};
            float y[16];
#pragma unroll
            for (int j = 0; j < 16; ++j) y[j] = o[j] * rs * wv[j] * g[j];
            u32x4 o0; o0.x = pk4_fp8(y[0], y[1], y[2], y[3]); o0.y = pk4_fp8(y[4], y[5], y[6], y[7]); o0.z = pk4_fp8(y[8], y[9], y[10], y[11]); o0.w = pk4_fp8(y[12], y[13], y[14], y[15]);
            *(u32x4*)((unsigned char*)HG + (size_t)rr[q] * HGW + c0) = o0; } }
    }
}

__device__ __forceinline__ void phase_final(Frame& F, const Args& a) {
    unsigned char* ws = F.ws; const bf16_t* X = (const bf16_t*)(ws + WS_X); const float* MOD = (const float*)(ws + WS_MOD); const float* fw = a.in[I_FNW];
    int r0, r1; wave_rows(F, NLAT, r0, r1);
    for (int r = r0; r < r1;) {
        const bool two = (r + 1 < r1) && (mod_row(r + 1) == mod_row(r));
        const int rr[2] = {r, two ? r + 1 : r};
        f32x4 x[2][8];
#pragma unroll
        for (int q = 0; q < 2; ++q) xrow_load(X, rr[q], F.lane, x[q]);
        moe_combine_rows<2>(x, rr, F.lane, ws, DEPTH - 1, MOD + ((size_t)(DEPTH - 1) * 5 + mod_row(r)) * 6 * D + 5 * D);
        float ss0 = row_sumsq(x[0]), ss1 = row_sumsq(x[1]);
#pragma unroll
        for (int o = 1; o < 64; o <<= 1) { ss0 += lane_xor(ss0, o, F.lane); ss1 += lane_xor(ss1, o, F.lane); }
        const float rs[2] = {1.0f / sqrtf(ss0 * (1.f / D) + EPS), 1.0f / sqrtf(ss1 * (1.f / D) + EPS)};
#pragma unroll
        for (int q = 0; q < 2; ++q) if (q == 0 || two) { f32x4* o = (f32x4*)(a.out + (size_t)rr[q] * D) + F.lane;
#pragma unroll
            for (int j = 0; j < 8; ++j) o[64 * j] = x[q][j] * rs[q] * *((const f32x4*)fw + 64 * j + F.lane); }
        r += two ? 2 : 1;
    }
}

__device__ __forceinline__ int moe_tables(Frame& F, int layer) {
    LAS int* tbl = (LAS int*)(F.lds + LDS_MISC + 64);
    const unsigned* cntw = (const unsigned*)(F.ws + WS_CTL) + CW_CNT + layer * 1024;
    if (F.tid < NEXP) tbl[F.tid] = (int)__hip_atomic_load(cntw + F.tid * 64, __ATOMIC_RELAXED, __HIP_MEMORY_SCOPE_AGENT);
    __syncthreads();
    if (F.tid == 0) {
        int blk = 0;
#pragma unroll 1
        for (int e = 0; e < NEXP; ++e) { const int c = tbl[e]; const int nb = (c + 255) >> 8;
            tbl[16 + e] = blk; for (int j = 0; j < nb; ++j) tbl[64 + blk + j] = e;
            if (blockIdx.x == 0) ((int*)(F.ws + WS_PADBASE))[layer * 16 + e] = blk * 256;
            blk += nb; }
        tbl[32] = blk;
    }
    __syncthreads();
    return tbl[32];
}

constexpr int PH_PER_LAYER = 10;
constexpr int N_PHASES = 1 + DEPTH * PH_PER_LAYER + 1;

__global__ void __launch_bounds__(512, 2) mk_fwd(Args args) {
    extern __shared__ __attribute__((aligned(16))) unsigned char lds_raw[];
    Frame F;
    F.lds = (LAS unsigned char*)lds_raw;
    F.tid = threadIdx.x; F.lane = F.tid & 63; F.wave = __builtin_amdgcn_readfirstlane(F.tid >> 6);
    F.G = gridDim.x; F.gw = blockIdx.x * 8 + F.wave; F.NGW = F.G * 8; F.ws = args.ws;
    unsigned char* ws = args.ws;
    volatile LAS unsigned* misc = (volatile LAS unsigned*)(F.lds + LDS_MISC);
    if (F.tid < 16) misc[F.tid] = 0u;
    __syncthreads();
    const int lo = args.ph_lo, hi = args.ph_hi;
#if MK_ONE_LAUNCH
    XcdBarrier bar = xcd_barrier_post((unsigned*)(ws + WS_CTL) + CW_BAR, misc);
#define GRID_BAR() xcd_barrier(bar)
#else
#define GRID_BAR() do {} while (0)
#endif
#ifndef MK_PHMASK
#define MK_PHMASK 0xFFFF
#endif
#define PHON(b) ((MK_PHMASK >> (b)) & 1)
#ifndef MK_REPMASK
#define MK_REPMASK 0
#endif
#define REPS(b) (((args.rep >> (b)) & 1) + 1)
#define IN(k) (lo <= (k) && (k) < hi)
#define LAUNDER() do { int t_ = threadIdx.x; asm volatile("" : "+v"(t_)); F.tid = t_; F.lane = t_ & 63; unsigned char* w_ = args.ws; asm volatile("" : "+s"(w_)); F.ws = w_; ws = w_; } while (0)
#define SEAM(k) do { if (IN(k) && IN((k) + 1)) { GRID_BAR(); if ((args.rep >> 15) & 1) GRID_BAR(); } } while (0)

    if (PHON(0) && IN(0)) { LAUNDER(); for (int rep_ = 0; rep_ < REPS(0); ++rep_) { if (rep_) { VM_WAIT(); __syncthreads(); } phase_prologue(F, args); } }
    SEAM(0);

    for (int layer_ = 0; layer_ < DEPTH; ++layer_) {
        int layer = layer_; asm volatile("" : "+s"(layer));
        const int pb = 1 + layer * PH_PER_LAYER;
        const bool lastl = (layer == DEPTH - 1);
        const int Mr = lastl ? NLAT : MTOK;
        if (PHON(1) && IN(pb + 0)) { LAUNDER(); for (int rep_ = 0; rep_ < REPS(1); ++rep_) { if (rep_) { VM_WAIT(); __syncthreads(); } phase_norm1(F, args, layer, layer > 0 && rep_ == 0); } }
        SEAM(pb + 0);
        if (PHON(2) && IN(pb + 1)) { LAUNDER(); for (int rep_ = 0; rep_ < REPS(2); ++rep_) { if (rep_) { VM_WAIT(); __syncthreads(); }
            pg8::DenseOrder S; S.init(MTOK, INC, F.G, (int)blockIdx.x, D, 0);
            pg8::EpiIn E{(bf16_t*)(ws + WS_Z), (const float*)(ws + WS_LB) + (size_t)layer * 2 * 1024};
            pg8::gemm_phase<pg8::EpiIn, pg8::DenseOrder, true>(F.lds, ws + WS_H, D, ws + WS_WIN + (size_t)layer * INC * D, D, D, S, E);
        } }
        SEAM(pb + 1);
        if (PHON(3) && IN(pb + 2)) { LAUNDER(); for (int rep_ = 0; rep_ < REPS(3); ++rep_) { if (rep_) { VM_WAIT(); __syncthreads(); } phase_pooldiff(F, Mr); __syncthreads(); } { VM_WAIT(); __syncthreads(); phase_scan_mfma(F); GRID_BAR(); LAUNDER(); phase_scan_fix(F); } }
        SEAM(pb + 2);
        if (PHON(4) && IN(pb + 3)) { LAUNDER(); for (int rep_ = 0; rep_ < REPS(4); ++rep_) { if (rep_) { VM_WAIT(); __syncthreads(); }
            pg8::DenseOrder S; S.init(Mr, DPOOL, F.G, (int)blockIdx.x, DPOOL * 2, 512);
            pg8::EpiPool E{(bf16_t*)(ws + WS_P), args.in[I_PSCALE] + (size_t)layer * DPOOL};
            pg8::gemm_phase(F.lds, ws + WS_PD, DPOOL * 2, ws + WS_WPG + (size_t)layer * 1024 * 256 * 2, 512, 512, S, E);
        } }
        if (PHON(4) && IN(pb + 3)) { VM_WAIT(); __syncthreads(); }
        if (PHON(5) && IN(pb + 4)) { LAUNDER(); for (int rep_ = 0; rep_ < REPS(5); ++rep_) { if (rep_) { VM_WAIT(); __syncthreads(); } phase_readout_naive(F, args, layer, Mr); } }
        SEAM(pb + 4);
        if (PHON(6) && IN(pb + 5)) { LAUNDER(); for (int rep_ = 0; rep_ < REPS(6); ++rep_) { if (rep_) { VM_WAIT(); __syncthreads(); }
            pg8::DenseOrder S; S.init(Mr, D, F.G, (int)blockIdx.x, 1024, 0);
            { pg8::EpiGate2 E{ws + WS_MX, (const bf16_t*)(ws + WS_Z), ZC_GP, ZC_GH, HG8_SCALE, 1.f / (W8_SCALE * HG8_SCALE)};
              pg8::gemm_phase<pg8::EpiGate2, pg8::DenseOrder, true, true>(F.lds, ws + WS_P, 1024, ws + WS_WBP + (size_t)layer * D * 1024, 2048, 1024, S, E,
                  (long)WS_HG - (long)WS_P - 8 * 128, (long)WS_WBH - (long)WS_WBP - 8 * 128, 8); }
            if (rep_ == 0) { int rk, nn; idle_rank((Mr / 256) * 8, F.G, (int)blockIdx.x, rk, nn); convert_range(F, args, layer + 1, 0, 36000, rk, nn); }
        } }
        SEAM(pb + 5);
        if (PHON(7) && IN(pb + 6)) { LAUNDER(); for (int rep_ = 0; rep_ < REPS(7); ++rep_) { if (rep_) { VM_WAIT(); __syncthreads(); }
            pg8::DenseOrder S; S.init(Mr, D, F.G, (int)blockIdx.x, D, 0);
            pg8::EpiOut E{(bf16_t*)(ws + (rep_ ? WS_O2 : WS_X)), layer == 0 ? (const void*)args.in[I_X] : (const void*)(ws + WS_X), layer == 0 ? (const void*)args.in[I_CTX] : (const void*)(ws + WS_X), layer == 0, (const float*)(ws + WS_MOD) + (size_t)layer * 5 * 6 * D, 1.f / W8_SCALE};
            pg8::gemm_phase<pg8::EpiOut, pg8::DenseOrder, true>(F.lds, ws + WS_MX, D, ws + WS_WOUT + (size_t)layer * D * D, D, D, S, E);
            if (rep_ == 0) { int rk, nn; idle_rank((Mr / 256) * 8, F.G, (int)blockIdx.x, rk, nn); convert_range(F, args, layer + 1, 36000, 52000, rk, nn); }
        } }
        SEAM(pb + 6);
        if (PHON(8) && IN(pb + 7)) { LAUNDER(); for (int rep_ = 0; rep_ < REPS(8); ++rep_) { if (rep_) { VM_WAIT(); __syncthreads(); } phase_norm2_router(F, args, layer, Mr, rep_ == 0); } }
        SEAM(pb + 7);
        if (PHON(9) && IN(pb + 8)) { LAUNDER(); for (int rep_ = 0; rep_ < REPS(9); ++rep_) { if (rep_) { VM_WAIT(); __syncthreads(); }
            const int nblk = moe_tables(F, layer);
            pg8::MoeOrder<true> S; S.nN = 4; S.nunits = nblk * 4; S.G = F.G; S.c = (int)blockIdx.x; S.lda_b = D; S.tbl = (const LAS int*)(F.lds + LDS_MISC + 64);
            S.slottok = (const int*)(ws + WS_SLOTTOK); S.b_estride = (size_t)1024 * D;
            pg8::EpiMoe1 E{(bf16_t*)(ws + WS_ACT)};
            pg8::gemm_phase<pg8::EpiMoe1, pg8::MoeOrder<true>, true>(F.lds, ws + WS_H, D, ws + WS_WE13 + (size_t)layer * NEXP * 1024 * D, D, D, S, E);
            if (rep_ == 0) { int rk, nn; idle_rank(nblk * 4, F.G, (int)blockIdx.x, rk, nn); convert_range(F, args, layer + 1, 52000, 70000, rk, nn); }
        } }
        SEAM(pb + 8);
        if (PHON(10) && IN(pb + 9)) { LAUNDER(); for (int rep_ = 0; rep_ < REPS(10); ++rep_) { if (rep_) { VM_WAIT(); __syncthreads(); }
            const int nblk = moe_tables(F, layer);
            pg8::MoeOrder<false> S; S.nN = 8; S.nunits = nblk * 8; S.G = F.G; S.c = (int)blockIdx.x; S.lda_b = DEXP; S.tbl = (const LAS int*)(F.lds + LDS_MISC + 64);
            S.slottok = nullptr; S.b_estride = (size_t)D * DEXP;
            pg8::EpiPlain E{(bf16_t*)(ws + WS_Y2), D, 1.f / (W8_SCALE * ACT8_SCALE)};
            pg8::gemm_phase<pg8::EpiPlain, pg8::MoeOrder<false>, true>(F.lds, ws + WS_ACT, DEXP, ws + WS_WE2 + (size_t)layer * NEXP * D * DEXP, DEXP, DEXP, S, E);
            if (rep_ == 0) { int rk, nn; idle_rank(nblk * 8, F.G, (int)blockIdx.x, rk, nn); convert_range(F, args, layer + 1, 70000, CONV_ITEMS, rk, nn); }
        } }
        SEAM(pb + 9);
    }
    if (PHON(11) && IN(N_PHASES - 1)) { LAUNDER(); for (int rep_ = 0; rep_ < REPS(11); ++rep_) { if (rep_) { VM_WAIT(); __syncthreads(); } phase_final(F, args); } }
#undef IN
#undef SEAM
}

extern "C" void kernel_launch(void* const* d_in, const int* in_sizes, int n_in, void* d_out, int out_size, void* d_ws, size_t ws_size, hipStream_t stream) {
    static int grid = 0;
    if (grid == 0) {
        if (n_in != 22 || out_size != NLAT * D || ws_size < WS_END) { fprintf(stderr, "kernel_launch: unexpected shapes (n_in %d out %d ws %zu need %zu)\n", n_in, out_size, ws_size, (size_t)WS_END); grid = -1; return; }
        int dev = 0, cus = 0, per_cu = 0;
        if (hipGetDevice(&dev) != hipSuccess || hipDeviceGetAttribute(&cus, hipDeviceAttributeMultiprocessorCount, dev) != hipSuccess) { grid = -1; return; }
        if (hipFuncSetAttribute((const void*)mk_fwd, hipFuncAttributeMaxDynamicSharedMemorySize, LDS_BYTES) != hipSuccess) { fprintf(stderr, "kernel_launch: hipFuncSetAttribute failed\n"); grid = -1; return; }
        if (hipOccupancyMaxActiveBlocksPerMultiprocessor(&per_cu, (const void*)mk_fwd, 512, LDS_BYTES) != hipSuccess || per_cu < 1) fprintf(stderr, "kernel_launch: occupancy query says %d\n", per_cu);
        (void)hipGetLastError();
        grid = cus;
    }
    if (grid < 0) return;
    (void)hipMemsetAsync((char*)d_ws + WS_CTL, 0, CTL_BYTES, stream);
    Args a{};
    for (int i = 0; i < 22; ++i) a.in[i] = (const float*)d_in[i];
    a.out = (float*)d_out; a.ws = (unsigned char*)d_ws; a.rep = MK_REPMASK; a.pad = 0;
#if MK_ONE_LAUNCH
    a.ph_lo = 0; a.ph_hi = N_PHASES;
    hipLaunchKernelGGL(mk_fwd, dim3(grid), dim3(512), LDS_BYTES, stream, a);
#else
    for (int p = 0; p < N_PHASES; ++p) { a.ph_lo = p; a.ph_hi = p + 1; hipLaunchKernelGGL(mk_fwd, dim3(grid), dim3(512), LDS_BYTES, stream, a); }
#endif
}
```

```cpp
#include <hip/hip_runtime.h>
#include <cstdio>
#include <cstdint>

#ifndef MK_ONE_LAUNCH
#define MK_ONE_LAUNCH 1
#endif

constexpr int D = 2048, NBATCH = 4, SEQ = 4096, DEPTH = 4, CTXL = 256;
constexpr int NLAT = NBATCH * SEQ, NCTX = NBATCH * CTXL, MTOK = NLAT + NCTX;
constexpr int DPOOL = 1024, HGW = 1024, NHEAD = 8, HDK = 128;
constexpr int INC = 10240;
constexpr int NEXP = 16, DEXP = 512;
constexpr int MAXSLOT = 38912;
constexpr float EPS = 1e-6f;
constexpr int ZC_POOL = 0, ZC_Q = 1024, ZC_FF = 2048, ZC_FB = 3072, ZC_I = 4096, ZC_OG = 5120, ZC_GP = 6144, ZC_GH = 8192;

#define GAS __attribute__((address_space(1)))
#define LAS __attribute__((address_space(3)))
typedef unsigned short bf16_t;
typedef short bf16x8 __attribute__((ext_vector_type(8)));
typedef float f32x4 __attribute__((ext_vector_type(4)));
typedef float f32x2 __attribute__((ext_vector_type(2)));
typedef unsigned u32x4 __attribute__((ext_vector_type(4)));
typedef unsigned u32x2 __attribute__((ext_vector_type(2)));
typedef int i32x4 __attribute__((ext_vector_type(4)));
typedef int i32x8 __attribute__((ext_vector_type(8)));
constexpr float W8_SCALE = 32.f;

constexpr size_t MiB = 1u << 20;
constexpr size_t align_up(size_t x) { return (x + 255) & ~(size_t)255; }
constexpr size_t WS_CTL = 0, CTL_BYTES = 1 * MiB;
constexpr size_t WS_MOD = WS_CTL + CTL_BYTES;
constexpr size_t WS_LB = WS_MOD + align_up((size_t)DEPTH * 5 * 6 * D * 4);
constexpr size_t WS_ROUTE_I = WS_LB + align_up((size_t)DEPTH * 2 * 1024 * 4);
constexpr size_t WS_ROUTE_G = WS_ROUTE_I + align_up((size_t)MTOK * 8);
constexpr size_t WS_SLOTTOK = WS_ROUTE_G + align_up((size_t)MTOK * 8);
constexpr size_t WS_PADBASE = WS_SLOTTOK + align_up((size_t)NEXP * MTOK * 4);
constexpr size_t WS_WIN = WS_PADBASE + align_up((size_t)DEPTH * 16 * 4);
constexpr size_t WS_WPG = WS_WIN + (size_t)DEPTH * INC * D * 2;
constexpr size_t WS_WBP = WS_WPG + (size_t)DEPTH * 1024 * 256 * 2;
constexpr size_t WS_WBH = WS_WBP + (size_t)DEPTH * D * 1024 * 2;
constexpr size_t WS_WOUT = WS_WBH + (size_t)DEPTH * D * 1024 * 2;
constexpr size_t WS_WE13 = WS_WOUT + (size_t)DEPTH * D * D * 2;
constexpr size_t WS_WE2 = WS_WE13 + (size_t)DEPTH * NEXP * 1024 * D * 2;
constexpr size_t WS_X = WS_WE2 + (size_t)DEPTH * NEXP * D * DEXP * 2;
constexpr size_t WS_H = WS_X + (size_t)MTOK * D * 4;
constexpr size_t WS_Z = WS_H + (size_t)MTOK * D * 2;
constexpr size_t WS_ACT = WS_Z;
constexpr size_t WS_Y2 = WS_ACT + (size_t)MAXSLOT * DEXP * 2;
constexpr size_t WS_PD = WS_Z + (size_t)MTOK * INC * 2;
constexpr size_t WS_P = WS_PD + (size_t)MTOK * 1024 * 2;
constexpr size_t WS_HG = WS_P + (size_t)MTOK * 1024 * 2;
constexpr size_t WS_O2 = WS_HG + (size_t)MTOK * 1024 * 2;
constexpr size_t WS_QSG = WS_O2 + (size_t)2 * MTOK * 1024 * 2;
constexpr size_t WS_SMID = WS_QSG + (size_t)64 * 3 * 17 * 17408;
constexpr size_t WS_CORRV = WS_SMID + (size_t)64 * 3 * 128 * 128 * 4;
constexpr size_t WS_TOTSEG = WS_CORRV + (size_t)64 * 3 * 17 * 128 * 4;
static_assert(WS_TOTSEG + (size_t)64 * 4 * 128 * 4 <= WS_O2 + (size_t)2 * MTOK * 1024 * 4, "scan hand-off buffers fit in the O2 region");
constexpr size_t WS_M1 = WS_O2 + (size_t)2 * MTOK * 1024 * 4;
constexpr size_t WS_MX = WS_M1 + (size_t)MTOK * D * 2;
constexpr size_t WS_G8 = WS_M1;
constexpr size_t WS_END = WS_MX + (size_t)MTOK * D * 2;
static_assert(WS_Y2 + (size_t)MAXSLOT * D * 2 <= WS_PD, "ACT|Y2 overlay fits in Z");

constexpr int CW_BAR = 4096;
constexpr int CW_CNT = 16384;

constexpr int LDS_STAGE = 131072;
constexpr int LDS_MISC = 149504;
constexpr int LDS_BYTES = LDS_MISC + 8192;

__device__ __forceinline__ unsigned f2bf(float f) { unsigned u = __builtin_bit_cast(unsigned, f); return (u + 0x7fffu + ((u >> 16) & 1u)) >> 16; }
typedef __bf16 bf16x2_t __attribute__((ext_vector_type(2)));
__device__ __forceinline__ unsigned pk2(float lo, float hi) { const f32x2 v = {lo, hi}; const bf16x2_t b = __builtin_convertvector(v, bf16x2_t); return __builtin_bit_cast(unsigned, b); }
__device__ __forceinline__ float bflo(unsigned w) { return __builtin_bit_cast(float, w << 16); }
__device__ __forceinline__ float bfhi(unsigned w) { return __builtin_bit_cast(float, w & 0xffff0000u); }
__device__ __forceinline__ float bf1(bf16_t h) { return __builtin_bit_cast(float, ((unsigned)h) << 16); }
__device__ __forceinline__ float fsigmoid(float x) { return __builtin_amdgcn_rcpf(1.f + __builtin_amdgcn_exp2f(-1.44269504f * x)); }
__device__ __forceinline__ float fsilu(float x) { return x * fsigmoid(x); }
__device__ __forceinline__ float lane_xor(float v, int o, int lane) { return __builtin_bit_cast(float, __builtin_amdgcn_ds_bpermute((lane ^ o) << 2, __builtin_bit_cast(int, v))); }
#define LDS_WAIT() asm volatile("s_waitcnt lgkmcnt(0)" ::: "memory")
#define VM_WAIT() asm volatile("s_waitcnt vmcnt(0)" ::: "memory")

__device__ __forceinline__ unsigned pk4_fp8(float a, float b, float c, float d) { int w = 0; w = __builtin_amdgcn_cvt_pk_fp8_f32(a, b, w, false); w = __builtin_amdgcn_cvt_pk_fp8_f32(c, d, w, true); return (unsigned)w; }
constexpr float HG8_SCALE = 4.f, ACT8_SCALE = 4.f;
#define XB_TMO      128
#define XB_XCNT(j)  (256  + 64 * (j))
#define XB_XSUB(j)  (1280 + 64 * (j))
#define XB_XGEN(j)  (2304 + 64 * (j))
#define XB_TOP      3328
#define XB_TOPGEN   3392
#define XCD_BAR_WORDS 3456
#define XB_SPIN_CAP (1u << 18)
__device__ __forceinline__ unsigned xb_ld(unsigned* p)              { return __hip_atomic_load(p, __ATOMIC_RELAXED, __HIP_MEMORY_SCOPE_AGENT); }
__device__ __forceinline__ unsigned xb_add(unsigned* p, unsigned v) { return __hip_atomic_fetch_add(p, v, __ATOMIC_RELAXED, __HIP_MEMORY_SCOPE_AGENT); }
__device__ __forceinline__ unsigned xb_xcc_id() { return (unsigned)__builtin_amdgcn_s_getreg((3 << 11) | 20) & 0xFu; }
#define XB_SPIN(cond, bar) do { unsigned _sp = 0; while (cond) { __builtin_amdgcn_s_sleep(1); \
    if ((++_sp & 255u) == 0u) { if (xb_ld(&(bar)[XB_TMO])) break; if (_sp > XB_SPIN_CAP) { atomicAdd(&(bar)[XB_TMO], 1u); break; } } } } while (0)
struct XcdBarrier { unsigned* bar; unsigned x; volatile LAS unsigned* st; };
__device__ __forceinline__ XcdBarrier xcd_barrier_post(unsigned* bar, volatile LAS unsigned* st) {
    XcdBarrier b; b.bar = bar; b.x = xb_xcc_id(); b.st = st;
    if (threadIdx.x == 0) (void)xb_add(&bar[XB_XCNT(b.x)], 1u);
    return b;
}
__device__ __forceinline__ void xcd_barrier_complete(unsigned* bar, unsigned x, unsigned& nloc, unsigned& nx) {
    const unsigned G = gridDim.x * gridDim.y * gridDim.z;
    unsigned sum, cnt, mine, sp = 0u;
    for (;;) {
        sum = 0u; cnt = 0u; mine = 0u;
#pragma unroll
        for (unsigned j = 0; j < 16; ++j) { const unsigned c = xb_ld(&bar[XB_XCNT(j)]); sum += c; cnt += (c > 0u) ? 1u : 0u; mine = (j == x) ? c : mine; }
        if (sum == G) break;
        __builtin_amdgcn_s_sleep(1);
        if ((++sp & 255u) == 0u) { if (xb_ld(&bar[XB_TMO])) break; if (sp > XB_SPIN_CAP) { atomicAdd(&bar[XB_TMO], 1u); break; } }
    }
    nloc = mine > 0u ? mine : 1u; nx = cnt > 0u ? cnt : 1u;
}
__device__ __forceinline__ void xcd_barrier(const XcdBarrier& b) {
    asm volatile("s_waitcnt vmcnt(0)" ::: "memory");
    __syncthreads();
    if (threadIdx.x == 0) {
        unsigned* bar = b.bar;
        __builtin_amdgcn_s_waitcnt(0);
        unsigned nloc = b.st[0], nx = b.st[1];
        if (nloc == 0u) { xcd_barrier_complete(bar, b.x, nloc, nx); b.st[0] = nloc; b.st[1] = nx; }
        const unsigned old = xb_add(&bar[XB_XSUB(b.x)], 1u);
        const unsigned gen = old / nloc;
        if (old + 1u == (gen + 1u) * nloc) {
            __builtin_amdgcn_fence(__ATOMIC_RELEASE, "agent");
            asm volatile("s_waitcnt vmcnt(0)" ::: "memory");
            const unsigned og = xb_add(&bar[XB_TOP], 1u);
            const unsigned tg = og / nx;
            if (og + 1u == (tg + 1u) * nx) xb_add(&bar[XB_TOPGEN], 1u);
            else XB_SPIN(xb_ld(&bar[XB_TOPGEN]) == tg, bar);
            __builtin_amdgcn_fence(__ATOMIC_ACQUIRE, "agent");
            xb_add(&bar[XB_XGEN(b.x)], 1u);
            asm volatile("s_waitcnt vmcnt(0)" ::: "memory");
        } else {
            XB_SPIN(xb_ld(&bar[XB_XGEN(b.x)]) == gen, bar);
            __builtin_amdgcn_fence(__ATOMIC_ACQUIRE, "agent");
            asm volatile("s_waitcnt vmcnt(0)" ::: "memory");
        }
    }
    __syncthreads();
}

namespace pg8 {
constexpr int BM = 256, BK = 64, HALF = 128, HTB = HALF * BK * 2, NXCD = 8, WGM = 8;
__host__ __device__ __forceinline__ int lds_byte(int r, int c) { const int st = (r >> 4) * 2 + (c >> 5), rr = r & 15, cc = c & 31, ob = rr * 64 + cc * 2; return st * 1024 + (ob ^ (((ob >> 9) & 1) << 5)); }
__host__ __device__ __forceinline__ void stage_rc(int b, int& R, int& C) { const int st = b / 1024, sb = b % 1024, swz = sb ^ (((sb >> 9) & 1) << 5); R = (st >> 1) * 16 + swz / 64; C = (st & 1) * 32 + (swz % 64) / 2; }
__host__ __device__ __forceinline__ int perm32(int rho) { const int n = rho >> 4, i = rho & 15; return 8 * (i >> 2) + 4 * n + (i & 3); }

struct Unit { int pm, pn; };

struct DenseOrder {
    static constexpr bool GATHER = false;
    int nM, nN, nwg, G, c, lda_b, acol_b;
    __device__ void init(int M, int N, int G_, int c_, int lda_b_, int acol_b_) { nM = M / BM; nN = N / BM; nwg = nM * nN; G = G_; c = c_; lda_b = lda_b_; acol_b = acol_b_; }
    __device__ __forceinline__ bool next(int i, Unit& u) const {
        const long L = (long)i * G + c; if (L >= nwg) return false;
        int wgid = (int)L; { const int q = nwg / NXCD, r = nwg % NXCD, xcd = wgid % NXCD, off = wgid / NXCD; wgid = (xcd < r ? xcd * (q + 1) : r * (q + 1) + (xcd - r) * q) + off; }
        const int nig = WGM * nN, gid = wgid / nig, fm = gid * WGM, gsz = (nM - fm) < WGM ? (nM - fm) : WGM;
        u.pm = fm + ((wgid % nig) % gsz); u.pn = (wgid % nig) / gsz; return true;
    }
    __device__ __forceinline__ size_t a_base(const Unit& u) const { return (size_t)u.pm * BM * lda_b + (size_t)u.pn * acol_b; }
    __device__ __forceinline__ void a_offs(const Unit&, unsigned (&)[2][2]) const {}
    __device__ __forceinline__ size_t b_off(const Unit& u, int ldb_b) const { return (size_t)u.pn * BM * ldb_b; }
};
template <bool GATHER_> struct MoeOrder {
    static constexpr bool GATHER = GATHER_;
    int nN, nunits, G, c, lda_b; const LAS int* tbl;
    const int* slottok; size_t b_estride;
    __device__ __forceinline__ bool next(int i, Unit& u) const {
        const int L = i * G + c; if (L >= nunits) return false;
        u.pm = L / nN; u.pn = L % nN; return true;
    }
    __device__ __forceinline__ size_t a_base(const Unit& u) const { return (size_t)u.pm * BM * lda_b; }
    __device__ __forceinline__ void a_offs(const Unit& u, unsigned (&v)[2][2]) const {
        const int e = __builtin_amdgcn_readfirstlane(tbl[64 + u.pm]), j0 = __builtin_amdgcn_readfirstlane((u.pm - tbl[16 + e]) * BM), cnt = __builtin_amdgcn_readfirstlane(tbl[e]);
#pragma unroll
        for (int i = 0; i < 2; ++i) { int R, C; stage_rc((int)threadIdx.x * 16 + i * 8192, R, C);
#pragma unroll
            for (int h = 0; h < 2; ++h) { const int j = j0 + h * HALF + R; const int tok = (j < cnt) ? slottok[(size_t)e * MTOK + j] : 0; v[h][i] = (unsigned)(tok * lda_b + C * 2); } }
    }
    __device__ __forceinline__ size_t b_off(const Unit& u, int ldb_b) const { const int e = __builtin_amdgcn_readfirstlane(tbl[64 + u.pm]); return (size_t)e * b_estride + (size_t)u.pn * BM * ldb_b; }
};

template <class Epi, class Sched, bool FP8 = false, bool SPLIT = false>
__device__ __forceinline__ void gemm_phase(LAS unsigned char* lds, const void* Abase, const int lda_b, const void* Bbase, const int Kb, const int ldb_b, const Sched& S, const Epi& E, const long dA = 0, const long dB = 0, const int nt1 = 0) {
    constexpr bool GA = Sched::GATHER;
    int tid_ = threadIdx.x; asm volatile("" : "+v"(tid_));
    const int tid = tid_, wid = __builtin_amdgcn_readfirstlane(tid >> 6), lane = tid & 63, wr = wid >> 2, wc = wid & 3, fr = lane & 15, fq = lane >> 4;
    const int nt = Kb / 128;
    unsigned voffA[2], voffB[2];
#pragma unroll
    for (int i = 0; i < 2; ++i) { int R, C; stage_rc(tid * 16 + i * 8192, R, C); const int Rb = Epi::PERM ? ((R & ~31) + perm32(R & 31)) : R; voffA[i] = (unsigned)(R * lda_b + C * 2); voffB[i] = (unsigned)(Rb * ldb_b + C * 2); }
    const size_t kstep = (size_t)(BK * 2);
    const size_t hstepA = (size_t)HALF * lda_b, hstepB = (size_t)HALF * ldb_b;
    const unsigned ldsw = (unsigned)wid * 1024u;
    const int aoff = lds_byte(wr * 64 + fr, fq * 8), boff = lds_byte(wc * 32 + fr, fq * 8);
#define PG8_SA(b, h) (((b) * 2 + (h)) * HTB)
#define PG8_SB(b, h) ((4 + (b) * 2 + (h)) * HTB)
#define PG8_STAGE2(bufoff, gbase, o0, o1) do { \
        __builtin_amdgcn_global_load_lds((const unsigned*)((const char*)(gbase) + (o0)), (LAS unsigned*)(lds + (bufoff) + ldsw), 16, 0, 0); \
        __builtin_amdgcn_global_load_lds((const unsigned*)((const char*)(gbase) + (o1)), (LAS unsigned*)(lds + (bufoff) + ldsw + 8192), 16, 0, 0); } while (0)
#define PG8_STAGEB(bufoff, gbase) PG8_STAGE2(bufoff, gbase, voffB[0], voffB[1])
#define PG8_STAGEA(bufoff, gbase, h, x0, x1) do { if constexpr (GA) PG8_STAGE2(bufoff, gbase, x0, x1); else PG8_STAGE2(bufoff, (gbase) + ((h) ? hstepA : (size_t)0), voffA[0], voffA[1]); } while (0)
#define PG8_LD32(dst, addr) do { const i32x4 lo_ = *(const LAS i32x4*)(lds + (addr)), hi_ = *(const LAS i32x4*)(lds + (addr) + 1024); dst = (i32x8){lo_[0], lo_[1], lo_[2], lo_[3], hi_[0], hi_[1], hi_[2], hi_[3]}; } while (0)
#define PG8_LDA(dst, b, h) do { _Pragma("unroll") for (int m = 0; m < 4; ++m) PG8_LD32(dst[m], PG8_SA(b, h) + aoff + m * 2048); } while (0)
#define PG8_LDB(dst, b, h) do { _Pragma("unroll") for (int n = 0; n < 2; ++n) PG8_LD32(dst[n], PG8_SB(b, h) + boff + n * 2048); } while (0)
#define PG8_HALF(v, k) __builtin_bit_cast(bf16x8, (i32x4){(v)[4 * (k)], (v)[4 * (k) + 1], (v)[4 * (k) + 2], (v)[4 * (k) + 3]})
#define PG8_MMA(ai, bj, At, Bt) do { __builtin_amdgcn_s_setprio(1); \
        if constexpr (FP8) { _Pragma("unroll") for (int m = 0; m < 4; ++m) _Pragma("unroll") for (int n = 0; n < 2; ++n) \
            asm volatile("v_mfma_scale_f32_16x16x128_f8f6f4 %0, %1, %2, %0, %3, %3 op_sel_hi:[0,0,0]" : "+v"(acc[ai][bj][m][n]) : "v"(Bt[n]), "v"(At[m]), "v"(one_scale)); } \
        else { _Pragma("unroll") for (int m = 0; m < 4; ++m) _Pragma("unroll") for (int n = 0; n < 2; ++n) _Pragma("unroll") for (int k = 0; k < 2; ++k) \
            acc[ai][bj][m][n] = __builtin_amdgcn_mfma_f32_16x16x32_bf16(PG8_HALF(Bt[n], k), PG8_HALF(At[m], k), acc[ai][bj][m][n], 0, 0, 0); } \
        __builtin_amdgcn_s_setprio(0); } while (0)
#define PG8_WAIT_V(n) asm volatile("s_waitcnt vmcnt(" #n ")" ::: "memory")
#define PG8_WAIT_L(n) asm volatile("s_waitcnt lgkmcnt(" #n ")" ::: "memory")
#define PG8_BAR __builtin_amdgcn_s_barrier()
#define PG8_SCHED __builtin_amdgcn_sched_barrier(0)
    Unit cur, nxt; int ui = 0;
    if (!S.next(0, cur)) return;
    f32x4 acc[2][2][4][2];
#pragma unroll
    for (int a = 0; a < 2; ++a)
#pragma unroll
        for (int b = 0; b < 2; ++b)
#pragma unroll
            for (int m = 0; m < 4; ++m)
#pragma unroll
                for (int n = 0; n < 2; ++n) acc[a][b][m][n] = (f32x4){0.f, 0.f, 0.f, 0.f};
    int one_scale = 0; if constexpr (FP8) asm volatile("v_mov_b32 %0, 0x7f7f7f7f" : "=v"(one_scale));
    i32x8 At[4], B0[2], B1[2];
    unsigned vA[2][2];
    if constexpr (GA) S.a_offs(cur, vA);
    const char* cA = (const char*)Abase + (GA ? (size_t)0 : S.a_base(cur));
    const char* cB = (const char*)Bbase + S.b_off(cur, ldb_b);
    PG8_STAGEB(PG8_SB(0, 0), cB); PG8_STAGEB(PG8_SB(0, 1), cB + hstepB); PG8_STAGEA(PG8_SA(0, 0), cA, 0, vA[0][0], vA[0][1]); PG8_STAGEA(PG8_SA(0, 1), cA, 1, vA[1][0], vA[1][1]);
    if (wr == 1) PG8_BAR;
    PG8_WAIT_V(2); PG8_BAR;
    PG8_STAGEB(PG8_SB(1, 0), cB + kstep); PG8_STAGEA(PG8_SA(1, 0), cA + kstep, 0, vA[0][0], vA[0][1]); PG8_STAGEB(PG8_SB(1, 1), cB + hstepB + kstep);
    PG8_WAIT_V(6); PG8_BAR;
    for (;;) {
        const bool has_next = S.next(ui + 1, nxt);
        const char* nA = (has_next && !GA) ? (const char*)Abase + S.a_base(nxt) : cA;
        const char* nB = has_next ? (const char*)Bbase + S.b_off(nxt, ldb_b) : cB;
_Pragma("nounroll")
        for (int t = 0; t < nt; t += 2) {
            const bool last = (t == nt - 2);
            const long sA1 = (SPLIT && t >= nt1) ? dA : 0, sA2 = (SPLIT && t + 2 >= nt1) ? dA : 0, sB2 = (SPLIT && t + 2 >= nt1) ? dB : 0;
            if constexpr (SPLIT) { if (t == nt1) { asm volatile("s_nop 15\n\ts_nop 15" ::: "memory"); int t3_ = threadIdx.x; asm volatile("" : "+v"(t3_)); const int l3_ = t3_ & 63; E.mid(acc, cur, wr, wc, l3_ & 15, l3_ >> 4); } }
            const char* a1 = cA + (size_t)(t + 1) * kstep + sA1;
            const char* a2 = last ? nA : cA + (size_t)(t + 2) * kstep + sA2; const char* b2 = last ? nB : cB + (size_t)(t + 2) * kstep + sB2;
            const char* a3 = a2 + kstep; const char* b3 = b2 + kstep;
            PG8_LDB(B0, 0, 0); PG8_LDB(B1, 0, 1); PG8_SCHED; PG8_LDA(At, 0, 0); PG8_STAGEA(PG8_SA(1, 1), a1, 1, vA[1][0], vA[1][1]);
            PG8_WAIT_V(8); PG8_WAIT_L(0); PG8_BAR; PG8_MMA(0, 0, At, B0); PG8_MMA(0, 1, At, B1); PG8_BAR; PG8_SCHED;
            if constexpr (GA) { if (last && has_next) S.a_offs(nxt, vA); }
            PG8_LDA(At, 0, 1); PG8_STAGEB(PG8_SB(0, 0), b2); PG8_STAGEB(PG8_SB(0, 1), b2 + hstepB); PG8_STAGEA(PG8_SA(0, 0), a2, 0, vA[0][0], vA[0][1]);
            PG8_WAIT_V(8); PG8_WAIT_L(0); PG8_BAR; PG8_MMA(1, 0, At, B0); PG8_MMA(1, 1, At, B1); PG8_BAR; PG8_SCHED;
            PG8_LDB(B0, 1, 0); PG8_LDB(B1, 1, 1); PG8_SCHED; PG8_LDA(At, 1, 0); PG8_STAGEA(PG8_SA(0, 1), a2, 1, vA[1][0], vA[1][1]);
            PG8_WAIT_V(8); PG8_WAIT_L(0); PG8_BAR; PG8_MMA(0, 0, At, B0); PG8_MMA(0, 1, At, B1); PG8_BAR; PG8_SCHED;
            PG8_LDA(At, 1, 1); PG8_STAGEB(PG8_SB(1, 0), b3); PG8_STAGEB(PG8_SB(1, 1), b3 + hstepB); PG8_STAGEA(PG8_SA(1, 0), a3, 0, vA[0][0], vA[0][1]);
            PG8_WAIT_V(8); PG8_WAIT_L(0); PG8_BAR; PG8_MMA(1, 0, At, B0); PG8_MMA(1, 1, At, B1); PG8_BAR; PG8_SCHED;
        }
        if constexpr (FP8) asm volatile("s_nop 15\n\ts_nop 15" ::: "memory");
        if (wr == 0) PG8_BAR;
        { int t2_ = threadIdx.x; asm volatile("" : "+v"(t2_)); const int l2_ = t2_ & 63; E(acc, cur, wr, wc, l2_ & 15, l2_ >> 4); }
        if (!has_next) break;
#pragma unroll
        for (int a = 0; a < 2; ++a)
#pragma unroll
            for (int b = 0; b < 2; ++b)
#pragma unroll
                for (int m = 0; m < 4; ++m)
#pragma unroll
                    for (int n = 0; n < 2; ++n) acc[a][b][m][n] = (f32x4){0.f, 0.f, 0.f, 0.f};
        cur = nxt; cA = nA; cB = nB; ++ui;
        if (wr == 1) PG8_BAR;
    }
    PG8_WAIT_V(0);
    PG8_BAR;
#undef PG8_SA
#undef PG8_SB
#undef PG8_STAGE2
#undef PG8_STAGEB
#undef PG8_STAGEA
#undef PG8_LDA
#undef PG8_LD32
#undef PG8_HALF
#undef PG8_LDB
#undef PG8_MMA
#undef PG8_WAIT_V
#undef PG8_WAIT_L
#undef PG8_BAR
#undef PG8_SCHED
}

typedef const f32x4 (&AccRef)[2][2][4][2];
__device__ __forceinline__ u32x4 pack8(const f32x4 v0, const f32x4 v1) { u32x4 w; w.x = pk2(v0[0], v0[1]); w.y = pk2(v0[2], v0[3]); w.z = pk2(v1[0], v1[1]); w.w = pk2(v1[2], v1[3]); return w; }
__device__ __forceinline__ void unpack8(const u32x4 w, f32x4& v0, f32x4& v1) { v0 = (f32x4){bflo(w.x), bfhi(w.x), bflo(w.y), bfhi(w.y)}; v1 = (f32x4){bflo(w.z), bfhi(w.z), bflo(w.w), bfhi(w.w)}; }

struct EpiIn {
    static constexpr bool PERM = true;
    bf16_t* Z; const float* lb; unsigned char* G8;
    __device__ __forceinline__ void operator()(AccRef acc, const Unit& u, int wr, int wc, int fr, int fq) const {
        constexpr float KS = 1.f / W8_SCALE, KE = -1.44269504f / W8_SCALE;
        const int row0 = u.pm * BM + wr * 64 + fr, colt = u.pn * BM, seg = colt >> 10, col0 = colt + wc * 32 + 8 * fq;
        const int mode = (seg == 0 || seg == 4) ? 0 : (seg == 1 || seg == 5) ? 1 : (seg == 2 || seg == 3) ? 2 : 3;
#pragma unroll
        for (int bj = 0; bj < 2; ++bj) {
            f32x4 l0 = (f32x4){0.f, 0.f, 0.f, 0.f}, l1 = l0;
            if (mode == 2) { l0 = *(const f32x4*)(lb + (col0 + bj * HALF - ZC_FF)); l1 = *(const f32x4*)(lb + (col0 + bj * HALF + 4 - ZC_FF)); }
#pragma unroll
            for (int ai = 0; ai < 2; ++ai)
#pragma unroll
                for (int m = 0; m < 4; ++m) { bf16_t* rowp = Z + (size_t)(row0 + ai * HALF + m * 16) * INC + col0 + bj * HALF;
                    f32x4 v0 = acc[ai][bj][m][0], v1 = acc[ai][bj][m][1];
                    if (mode == 0) { v0 = v0 * KS; v1 = v1 * KS; }
                    else { f32x4 s0, s1;
#pragma unroll
                        for (int j = 0; j < 4; ++j) { s0[j] = __builtin_amdgcn_rcpf(1.f + __builtin_amdgcn_exp2f(v0[j] * KE)); s1[j] = __builtin_amdgcn_rcpf(1.f + __builtin_amdgcn_exp2f(v1[j] * KE)); }
                        if (mode == 1) { v0 = v0 * KS * s0; v1 = v1 * KS * s1; }
                        else if (mode == 3) { unsigned w0 = 0u, w1 = 0u;
#pragma unroll
                            for (int j = 0; j < 4; ++j) { w0 = __builtin_amdgcn_cvt_pk_u8_f32(fmaxf(__builtin_rintf(s0[j] * 255.f), 1.f), j, w0); w1 = __builtin_amdgcn_cvt_pk_u8_f32(fmaxf(__builtin_rintf(s1[j] * 255.f), 1.f), j, w1); }
                            u32x2 o; o.x = w0; o.y = w1; *(u32x2*)(G8 + (size_t)(row0 + ai * HALF + m * 16) * 4096 + (col0 + bj * HALF - ZC_GP)) = o;
                            __builtin_amdgcn_sched_barrier(0); continue; }
                        else {
#pragma unroll
                            for (int j = 0; j < 4; ++j) { v0[j] = __builtin_amdgcn_logf(l0[j] + (1.f - l0[j]) * s0[j]); v1[j] = __builtin_amdgcn_logf(l1[j] + (1.f - l1[j]) * s1[j]); } } }
                    *(u32x4*)rowp = pack8(v0, v1);
                    __builtin_amdgcn_sched_barrier(0); } }
    }
};
struct EpiPool {
    static constexpr bool PERM = true;
    bf16_t* P; const float* scale;
    __device__ __forceinline__ void operator()(AccRef acc, const Unit& u, int wr, int wc, int fr, int fq) const {
        const int row0 = u.pm * BM + wr * 64 + fr, col0 = u.pn * BM + wc * 32 + 8 * fq;
        f32x4 sv[2][2];
#pragma unroll
        for (int bj = 0; bj < 2; ++bj)
#pragma unroll
            for (int n = 0; n < 2; ++n) sv[bj][n] = *(const f32x4*)(scale + col0 + bj * HALF + 4 * n);
#pragma unroll
        for (int ai = 0; ai < 2; ++ai)
#pragma unroll
            for (int m = 0; m < 4; ++m) { bf16_t* rowp = P + (size_t)(row0 + ai * HALF + m * 16) * DPOOL + col0;
#pragma unroll
                for (int bj = 0; bj < 2; ++bj) { const f32x4 r0 = acc[ai][bj][m][0] * sv[bj][0], r1 = acc[ai][bj][m][1] * sv[bj][1];
                    u32x2 o; o.x = pk4_fp8(r0[0], r0[1], r0[2], r0[3]); o.y = pk4_fp8(r1[0], r1[1], r1[2], r1[3]); *(u32x2*)((unsigned char*)P + (size_t)(row0 + ai * HALF + m * 16) * DPOOL + col0 + bj * HALF) = o; } }
    }
};
template <bool ADD, bool OUT8 = false> struct EpiGate {
    static constexpr bool PERM = true;
    bf16_t* O; const bf16_t* prev; const bf16_t* Z; int gcol; float ascale;
    __device__ __forceinline__ void operator()(AccRef acc, const Unit& u, int wr, int wc, int fr, int fq) const {
        const int row0 = u.pm * BM + wr * 64 + fr, col0 = u.pn * BM + wc * 32 + 8 * fq;
#pragma unroll
        for (int ai = 0; ai < 2; ++ai)
#pragma unroll
            for (int m = 0; m < 4; ++m) { const size_t row = (size_t)(row0 + ai * HALF + m * 16);
#pragma unroll
                for (int bj = 0; bj < 2; ++bj) {
                    const u32x4 gw = *(const u32x4*)(Z + row * INC + gcol + col0 + bj * HALF); f32x4 g0, g1; unpack8(gw, g0, g1);
                    f32x4 r0 = acc[ai][bj][m][0] * ascale * g0, r1 = acc[ai][bj][m][1] * ascale * g1;
                    if (ADD) { const u32x4 pw = *(const u32x4*)(prev + row * D + col0 + bj * HALF); f32x4 p0, p1; unpack8(pw, p0, p1); r0 += p0; r1 += p1; }
                    if (OUT8) { int w0 = 0, w1 = 0; w0 = __builtin_amdgcn_cvt_pk_fp8_f32(r0[0], r0[1], w0, false); w0 = __builtin_amdgcn_cvt_pk_fp8_f32(r0[2], r0[3], w0, true);
                        w1 = __builtin_amdgcn_cvt_pk_fp8_f32(r1[0], r1[1], w1, false); w1 = __builtin_amdgcn_cvt_pk_fp8_f32(r1[2], r1[3], w1, true);
                        u32x2 o; o.x = (unsigned)w0; o.y = (unsigned)w1; *(u32x2*)((unsigned char*)O + row * D + col0 + bj * HALF) = o; }
                    else *(u32x4*)(O + row * D + col0 + bj * HALF) = pack8(r0, r1); } }
    }
};
struct EpiGate2 {
    static constexpr bool PERM = true; static constexpr int NVM = 16;
    unsigned char* O; const unsigned char* G8; int gcol1, gcol2; float cratio, ascale;
    static __device__ __forceinline__ float ub(unsigned w, int j) { return (float)((w >> (8 * j)) & 0xffu); }
    __device__ __forceinline__ void mid(f32x4 (&acc)[2][2][4][2], const Unit& u, int wr, int wc, int fr, int fq) const {
        const int row0 = u.pm * BM + wr * 64 + fr, col0 = u.pn * BM + wc * 32 + 8 * fq;
#pragma unroll
        for (int ai = 0; ai < 2; ++ai)
#pragma unroll
            for (int m = 0; m < 4; ++m) { const size_t row = (size_t)(row0 + ai * HALF + m * 16);
#pragma unroll
                for (int bj = 0; bj < 2; ++bj) {
                    const u32x2 q1 = *(const u32x2*)(G8 + row * 4096 + gcol1 + col0 + bj * HALF), q2 = *(const u32x2*)(G8 + row * 4096 + gcol2 + col0 + bj * HALF);
#pragma unroll
                    for (int j = 0; j < 4; ++j) { acc[ai][bj][m][0][j] *= cratio * ub(q1.x, j) * __builtin_amdgcn_rcpf(ub(q2.x, j)); acc[ai][bj][m][1][j] *= cratio * ub(q1.y, j) * __builtin_amdgcn_rcpf(ub(q2.y, j)); } }
                }
    }
    __device__ __forceinline__ void operator()(AccRef acc, const Unit& u, int wr, int wc, int fr, int fq) const {
        const int row0 = u.pm * BM + wr * 64 + fr, col0 = u.pn * BM + wc * 32 + 8 * fq;
#pragma unroll
        for (int ai = 0; ai < 2; ++ai)
#pragma unroll
            for (int m = 0; m < 4; ++m) { const size_t row = (size_t)(row0 + ai * HALF + m * 16);
#pragma unroll
                for (int bj = 0; bj < 2; ++bj) {
                    const u32x2 q2 = *(const u32x2*)(G8 + row * 4096 + gcol2 + col0 + bj * HALF);
                    f32x4 r0, r1;
#pragma unroll
                    for (int j = 0; j < 4; ++j) { r0[j] = acc[ai][bj][m][0][j] * ascale * ub(q2.x, j); r1[j] = acc[ai][bj][m][1][j] * ascale * ub(q2.y, j); }
                    u32x2 o; o.x = pk4_fp8(r0[0], r0[1], r0[2], r0[3]); o.y = pk4_fp8(r1[0], r1[1], r1[2], r1[3]);
                    *(u32x2*)(O + row * D + col0 + bj * HALF) = o; } }
    }
};
struct EpiOut {
    static constexpr bool PERM = true;
    bf16_t* X; const void* src_lat; const void* src_ctx; bool src_f32; const float* modl; float ascale;
    __device__ __forceinline__ void operator()(AccRef acc, const Unit& u, int wr, int wc, int fr, int fq) const {
        const int row0 = u.pm * BM + wr * 64 + fr, col0 = u.pn * BM + wc * 32 + 8 * fq;
        const int mrow = u.pm < 64 ? (u.pm >> 4) : 4;
        const float* g = modl + (size_t)mrow * 6 * D + 2 * D;
        const bool lat = u.pm < 64;
#pragma unroll
        for (int bj = 0; bj < 2; ++bj) { const int col = col0 + bj * HALF;
            const f32x4 g0 = *(const f32x4*)(g + col) * ascale, g1 = *(const f32x4*)(g + col + 4) * ascale;
#pragma unroll
            for (int ai = 0; ai < 2; ++ai)
#pragma unroll
                for (int m = 0; m < 4; ++m) { const int row = row0 + ai * HALF + m * 16; f32x4 s0, s1;
                    if (src_f32) { const float* sp = (lat ? (const float*)src_lat + (size_t)row * D : (const float*)src_ctx + (size_t)(row - NLAT) * D) + col; s0 = *(const f32x4*)sp; s1 = *(const f32x4*)(sp + 4); }
                    else unpack8(*(const u32x4*)((const bf16_t*)src_lat + (size_t)row * D + col), s0, s1);
                    *(u32x4*)(X + (size_t)row * D + col) = pack8(s0 + g0 * acc[ai][bj][m][0], s1 + g1 * acc[ai][bj][m][1]); } }
    }
};
struct EpiMoe1 {
    static constexpr bool PERM = true;
    bf16_t* ACT;
    __device__ __forceinline__ void operator()(AccRef acc, const Unit& u, int wr, int wc, int fr, int fq) const {
        const int row0 = u.pm * BM + wr * 64 + fr, col0 = u.pn * HALF + wc * 32 + 8 * fq;
        constexpr float KS = 1.f / W8_SCALE, KB = ACT8_SCALE / W8_SCALE;
#pragma unroll
        for (int ai = 0; ai < 2; ++ai)
#pragma unroll
            for (int m = 0; m < 4; ++m) { f32x4 r[2];
#pragma unroll
                for (int n = 0; n < 2; ++n)
#pragma unroll
                    for (int j = 0; j < 4; ++j) r[n][j] = __builtin_amdgcn_fmed3f(fsilu(acc[ai][0][m][n][j] * KS) * (acc[ai][1][m][n][j] * KB), -440.f, 440.f);
                u32x2 o; o.x = pk4_fp8(r[0][0], r[0][1], r[0][2], r[0][3]); o.y = pk4_fp8(r[1][0], r[1][1], r[1][2], r[1][3]);
                *(u32x2*)((unsigned char*)ACT + (size_t)(row0 + ai * HALF + m * 16) * DEXP + col0) = o; }
    }
};
struct EpiNone {
    static constexpr bool PERM = true;
    __device__ __forceinline__ void operator()(AccRef acc, const Unit&, int, int, int, int) const {
#pragma unroll
        for (int ai = 0; ai < 2; ++ai)
#pragma unroll
            for (int bj = 0; bj < 2; ++bj)
#pragma unroll
                for (int m = 0; m < 4; ++m)
#pragma unroll
                    for (int n = 0; n < 2; ++n) asm volatile("" :: "v"(acc[ai][bj][m][n]));
    }
};
struct EpiPlain {
    static constexpr bool PERM = true;
    bf16_t* O; int ldc; float ascale;
    __device__ __forceinline__ void operator()(AccRef acc, const Unit& u, int wr, int wc, int fr, int fq) const {
        const int row0 = u.pm * BM + wr * 64 + fr, col0 = u.pn * BM + wc * 32 + 8 * fq;
#pragma unroll
        for (int ai = 0; ai < 2; ++ai)
#pragma unroll
            for (int m = 0; m < 4; ++m) { bf16_t* rowp = O + (size_t)(row0 + ai * HALF + m * 16) * ldc + col0;
#pragma unroll
                for (int bj = 0; bj < 2; ++bj) *(u32x4*)(rowp + bj * HALF) = pack8(acc[ai][bj][m][0] * ascale, acc[ai][bj][m][1] * ascale); }
    }
};
}

struct Args { const float* in[22]; float* out; unsigned char* ws; int ph_lo, ph_hi, rep, pad; };
enum { I_X = 0, I_C, I_CTX, I_CCTX, I_WADA, I_BADA, I_N1W, I_N2W, I_WIN, I_WPG, I_PSCALE, I_HGNW, I_LBLOG, I_WBP, I_WBH, I_WOUT, I_WROUTER, I_RBIAS, I_WE1, I_WE3, I_WE2, I_FNW };

struct Frame {
    LAS unsigned char* lds;
    int tid, lane, wave, G, gw, NGW;
    unsigned char* ws;
};

__device__ __forceinline__ void transpose_item(const float* W, int K, int N, int k0, int n0, bf16_t* WT, size_t dst_row0, LAS float* scr, int lane) {
    float wv[32];
#pragma unroll
    for (int i = 0; i < 32; ++i) { const int kk = 2 * i + (lane >> 5); wv[i] = __builtin_nontemporal_load(W + (size_t)(k0 + kk) * N + n0 + (lane & 31)); }
#pragma unroll
    for (int i = 0; i < 32; ++i) { const int kk = 2 * i + (lane >> 5); scr[kk * 33 + (lane & 31)] = wv[i]; }
    LDS_WAIT(); asm volatile("" ::: "memory");
    const int c = lane & 7;
#pragma unroll
    for (int j = 0; j < 4; ++j) { const int n = (lane >> 3) + 8 * j; const LAS float* s = scr + (8 * c) * 33 + n;
        u32x4 o; o.x = pk2(s[0 * 33], s[1 * 33]); o.y = pk2(s[2 * 33], s[3 * 33]); o.z = pk2(s[4 * 33], s[5 * 33]); o.w = pk2(s[6 * 33], s[7 * 33]);
        *(u32x4*)(WT + (dst_row0 + n) * K + k0 + 8 * c) = o; }
    LDS_WAIT(); asm volatile("" ::: "memory");
}
__device__ __forceinline__ void transpose_item_fp8(const float* W, int K, int N, int k0, int n0, unsigned char* WT, size_t dst_row0, LAS float* scr, int lane) {
    float wv[32];
#pragma unroll
    for (int i = 0; i < 32; ++i) { const int kk = 2 * i + (lane >> 5); wv[i] = __builtin_nontemporal_load(W + (size_t)(k0 + kk) * N + n0 + (lane & 31)); }
#pragma unroll
    for (int i = 0; i < 32; ++i) { const int kk = 2 * i + (lane >> 5); scr[kk * 33 + (lane & 31)] = wv[i] * W8_SCALE; }
    LDS_WAIT(); asm volatile("" ::: "memory");
    const int c = lane & 7;
#pragma unroll
    for (int j = 0; j < 4; ++j) { const int n = (lane >> 3) + 8 * j; const LAS float* sp = scr + (8 * c) * 33 + n;
        int w0 = 0, w1 = 0; w0 = __builtin_amdgcn_cvt_pk_fp8_f32(sp[0 * 33], sp[1 * 33], w0, false); w0 = __builtin_amdgcn_cvt_pk_fp8_f32(sp[2 * 33], sp[3 * 33], w0, true);
        w1 = __builtin_amdgcn_cvt_pk_fp8_f32(sp[4 * 33], sp[5 * 33], w1, false); w1 = __builtin_amdgcn_cvt_pk_fp8_f32(sp[6 * 33], sp[7 * 33], w1, true);
        u32x2 o; o.x = (unsigned)w0; o.y = (unsigned)w1;
        *(u32x2*)(WT + (dst_row0 + n) * K + k0 + 8 * c) = o; }
    LDS_WAIT(); asm volatile("" ::: "memory");
}
__device__ __forceinline__ void transpose_family(Frame& F, const float* W, int mats, int K, int N, bf16_t* WT, int mode, int& itbase, int it_lo, int it_step) {
    const int nblk = N / 32, kblk = K / 64, per = nblk * kblk, total = mats * per;
    LAS float* scr = (LAS float*)(F.lds + F.wave * 16384);
    int first = (it_lo - itbase) % it_step; if (first < 0) first += it_step;
    for (int it = first; it < total; it += it_step) {
        const int mat = it / per, r = it % per, kb = r / nblk, nb = r % nblk, n0 = 32 * nb, k0 = 64 * kb;
        size_t dst_row0; bf16_t* dstm;
        if (mode == 3) { transpose_item_fp8(W + (size_t)mat * K * N, K, N, k0, n0, (unsigned char*)WT + (size_t)mat * N * K, n0, scr, F.lane); continue; }
        if (mode == 4 || mode == 5) { transpose_item_fp8(W + (size_t)mat * K * N, K, N, k0, n0, (unsigned char*)WT + (size_t)mat * 1024 * K, (size_t)(n0 >> 7) * 256 + (mode == 5 ? 128 : 0) + (n0 & 127), scr, F.lane); continue; }
        if (mode == 0) { dstm = WT + (size_t)mat * N * K; dst_row0 = n0; }
        else { dstm = WT + (size_t)mat * 1024 * K; dst_row0 = (size_t)(n0 >> 7) * 256 + (mode == 2 ? 128 : 0) + (n0 & 127); }
        transpose_item(W + (size_t)mat * K * N, K, N, k0, n0, dstm, dst_row0, scr, F.lane);
    }
    itbase += total;
}

struct ConvJob { const float* src; unsigned char* dst; int N; };
__device__ __forceinline__ ConvJob conv_decode(const Args& a, unsigned char* ws, int L, int s, int lane) {
    const float* W; unsigned char* T; int K, N, t, map = 0, lk, ln;
    if (s < 20480) { t = s; W = a.in[I_WIN] + (size_t)L * D * INC; T = ws + WS_WIN + (size_t)L * INC * D; K = D; N = INC; lk = 7; ln = 8; }
    else if (s < 22528) { t = s - 20480; W = a.in[I_WBP] + (size_t)L * 1024 * D; T = ws + WS_WBP + (size_t)L * D * 1024; K = 1024; N = D; lk = 6; ln = 5; }
    else if (s < 24576) { t = s - 22528; W = a.in[I_WBH] + (size_t)L * 1024 * D; T = ws + WS_WBH + (size_t)L * D * 1024; K = 1024; N = D; lk = 6; ln = 5; }
    else if (s < 28672) { t = s - 24576; W = a.in[I_WOUT] + (size_t)L * D * D; T = ws + WS_WOUT + (size_t)L * D * D; K = D; N = D; lk = 7; ln = 5; }
    else if (s < 45056) { t = s - 28672; W = a.in[I_WE1] + (size_t)L * NEXP * D * DEXP; T = ws + WS_WE13 + (size_t)L * NEXP * 1024 * D; K = D; N = DEXP; map = 1; lk = 7; ln = 3; }
    else if (s < 61440) { t = s - 45056; W = a.in[I_WE3] + (size_t)L * NEXP * D * DEXP; T = ws + WS_WE13 + (size_t)L * NEXP * 1024 * D; K = D; N = DEXP; map = 2; lk = 7; ln = 3; }
    else { t = s - 61440; W = a.in[I_WE2] + (size_t)L * NEXP * DEXP * D; T = ws + WS_WE2 + (size_t)L * NEXP * D * DEXP; K = DEXP; N = D; lk = 5; ln = 5; }
    const int kb = t & ((1 << lk) - 1), nb = (t >> lk) & ((1 << ln) - 1), mat = t >> (lk + ln);
    const int n = nb * 64 + lane, k0 = kb * 16;
    const size_t drow = map ? (size_t)mat * 1024 + (size_t)(n >> 7) * 256 + (map == 2 ? 128 : 0) + (n & 127) : (size_t)mat * N + n;
    ConvJob J; J.src = W + (size_t)mat * K * N + (size_t)k0 * N + n; J.dst = T + drow * K + k0; J.N = N; return J;
}
constexpr int CONV_ITEMS = 77824;
__device__ __forceinline__ void convert_range(Frame& F, const Args& a, int L, int lo, int hi, int rank, int n) {
    if (rank < 0 || L >= DEPTH || F.G != 256) return;
    for (int s0 = lo + (rank * 8 + F.wave) * 2; s0 < hi; s0 += n * 16) {
        const bool has2 = s0 + 1 < hi;
        const ConvJob J0 = conv_decode(a, F.ws, L, s0, F.lane), J1 = conv_decode(a, F.ws, L, has2 ? s0 + 1 : s0, F.lane);
        float v0[16], v1[16];
#pragma unroll
        for (int i = 0; i < 16; ++i) { v0[i] = __builtin_nontemporal_load(J0.src + (size_t)i * J0.N); v1[i] = __builtin_nontemporal_load(J1.src + (size_t)i * J1.N); }
        u32x4 o; o.x = pk4_fp8(v0[0] * W8_SCALE, v0[1] * W8_SCALE, v0[2] * W8_SCALE, v0[3] * W8_SCALE); o.y = pk4_fp8(v0[4] * W8_SCALE, v0[5] * W8_SCALE, v0[6] * W8_SCALE, v0[7] * W8_SCALE);
        o.z = pk4_fp8(v0[8] * W8_SCALE, v0[9] * W8_SCALE, v0[10] * W8_SCALE, v0[11] * W8_SCALE); o.w = pk4_fp8(v0[12] * W8_SCALE, v0[13] * W8_SCALE, v0[14] * W8_SCALE, v0[15] * W8_SCALE);
        *(u32x4*)J0.dst = o;
        if (has2) { o.x = pk4_fp8(v1[0] * W8_SCALE, v1[1] * W8_SCALE, v1[2] * W8_SCALE, v1[3] * W8_SCALE); o.y = pk4_fp8(v1[4] * W8_SCALE, v1[5] * W8_SCALE, v1[6] * W8_SCALE, v1[7] * W8_SCALE);
            o.z = pk4_fp8(v1[8] * W8_SCALE, v1[9] * W8_SCALE, v1[10] * W8_SCALE, v1[11] * W8_SCALE); o.w = pk4_fp8(v1[12] * W8_SCALE, v1[13] * W8_SCALE, v1[14] * W8_SCALE, v1[15] * W8_SCALE);
            *(u32x4*)J1.dst = o; }
    }
}
__device__ __forceinline__ void idle_rank(int nunits, int G, int c, int& rank, int& n) {
    const int rem = nunits % G;
    if (rem == 0 || G - rem < 64) { rank = c; n = G; } else { rank = c >= rem ? c - rem : -1; n = G - rem; }
}

__device__ __forceinline__ void phase_prologue(Frame& F, const Args& a) {
    unsigned char* ws = F.ws;
    int itbase = 0; const int nl = (F.G == 256) ? 0 : DEPTH;
    convert_range(F, a, 0, 0, CONV_ITEMS, (int)blockIdx.x, F.G);
    transpose_family(F, a.in[I_WIN], nl, D, INC, (bf16_t*)(ws + WS_WIN), 3, itbase, F.gw, F.NGW);
    transpose_family(F, a.in[I_WPG], DEPTH * 4, 256, 256, (bf16_t*)(ws + WS_WPG), 0, itbase, F.gw, F.NGW);
    transpose_family(F, a.in[I_WBP], nl, 1024, D, (bf16_t*)(ws + WS_WBP), 3, itbase, F.gw, F.NGW);
    transpose_family(F, a.in[I_WBH], nl, 1024, D, (bf16_t*)(ws + WS_WBH), 3, itbase, F.gw, F.NGW);
    transpose_family(F, a.in[I_WOUT], nl, D, D, (bf16_t*)(ws + WS_WOUT), 3, itbase, F.gw, F.NGW);
    transpose_family(F, a.in[I_WE1], nl * NEXP, D, DEXP, (bf16_t*)(ws + WS_WE13), 4, itbase, F.gw, F.NGW);
    transpose_family(F, a.in[I_WE3], nl * NEXP, D, DEXP, (bf16_t*)(ws + WS_WE13), 5, itbase, F.gw, F.NGW);
    transpose_family(F, a.in[I_WE2], nl * NEXP, DEXP, D, (bf16_t*)(ws + WS_WE2), 3, itbase, F.gw, F.NGW);
    if (blockIdx.x == 0) {
        const float* lg = a.in[I_LBLOG]; float* LB = (float*)(ws + WS_LB);
        for (int i = F.tid; i < 2 * 1024; i += 512) { const int dir = i >> 10, ch = i & 1023;
            float l[DEPTH], mx = -1e30f;
#pragma unroll
            for (int j = 0; j < DEPTH; ++j) { l[j] = lg[((size_t)dir * DEPTH + j) * 1024 + ch]; mx = fmaxf(mx, l[j]); }
            float s = 0.f;
#pragma unroll
            for (int j = 0; j < DEPTH; ++j) { l[j] = __expf(l[j] - mx); s += l[j]; }
            float cum = 0.f;
#pragma unroll
            for (int j = 0; j < DEPTH; ++j) { if (j > 0) cum += l[j] / s; LB[((size_t)j * 2 + dir) * 1024 + ch] = cum; } }
    }
    __syncthreads();
    {
        LAS float* sv = (LAS float*)F.lds;
        LAS float* red = (LAS float*)(F.lds + 5 * D * 4);
        for (int i = F.tid; i < 5 * D; i += 512) { const int r = i / D, k = i % D; const float v = r < 4 ? a.in[I_C][r * D + k] : a.in[I_CCTX][k]; sv[i] = fsilu(v); }
        __syncthreads();
        const float* wada = a.in[I_WADA]; const float* bada = a.in[I_BADA]; float* MOD = (float*)(ws + WS_MOD);
        constexpr int JB = 6 * D / 192;
        const int cg = F.tid % 48, kg = F.tid / 48;
        for (int it = blockIdx.x; it < DEPTH * JB; it += F.G) {
            const int layer = it / JB, j0 = (it % JB) * 192;
            if (kg < 10) {
                const float* w = wada + (size_t)layer * D * 6 * D + j0 + 4 * cg;
                f32x4 acc[5];
#pragma unroll
                for (int r = 0; r < 5; ++r) acc[r] = (f32x4){0.f, 0.f, 0.f, 0.f};
#pragma unroll 8
                for (int k = kg; k < D; k += 10) { const f32x4 wv = *(const f32x4*)(w + (size_t)k * 6 * D);
#pragma unroll
                    for (int r = 0; r < 5; ++r) acc[r] += wv * sv[r * D + k]; }
#pragma unroll
                for (int r = 0; r < 5; ++r) *(LAS f32x4*)(red + (kg * 5 + r) * 192 + 4 * cg) = acc[r];
            }
            __syncthreads();
            for (int o = F.tid; o < 5 * 192; o += 512) { const int r = o / 192, jj = o % 192; float t = bada[(size_t)layer * 6 * D + j0 + jj];
#pragma unroll
                for (int q = 0; q < 10; ++q) t += red[(q * 5 + r) * 192 + jj];
                MOD[((size_t)layer * 5 + r) * 6 * D + j0 + jj] = t; }
            __syncthreads();
        }
    }
    __syncthreads();
}

__device__ __forceinline__ void wave_rows(const Frame& F, int M, int& r0, int& r1) { r0 = (int)(((unsigned)F.gw * (unsigned)M) / (unsigned)F.NGW); r1 = (int)(((unsigned)(F.gw + 1) * (unsigned)M) / (unsigned)F.NGW); }
__device__ __forceinline__ int mod_row(int r) { return r < NLAT ? (r >> 12) : 4; }

__device__ __forceinline__ void xrow_load(const bf16_t* X, int r, int lane, f32x4 (&x)[8]) { const u32x2* xr = (const u32x2*)(X + (size_t)r * D) + lane;
#pragma unroll
    for (int j = 0; j < 8; ++j) { const u32x2 w = xr[64 * j]; x[j] = (f32x4){bflo(w.x), bfhi(w.x), bflo(w.y), bfhi(w.y)}; } }
__device__ __forceinline__ void xrow_store(bf16_t* X, int r, int lane, const f32x4 (&x)[8]) { u32x2* xr = (u32x2*)(X + (size_t)r * D) + lane;
#pragma unroll
    for (int j = 0; j < 8; ++j) { u32x2 w; w.x = pk2(x[j][0], x[j][1]); w.y = pk2(x[j][2], x[j][3]); xr[64 * j] = w; } }
template <int NR>
__device__ __forceinline__ void moe_combine_rows(f32x4 (&x)[NR][8], const int (&r)[NR], int lane, const unsigned char* ws, int player, const float* mod5) {
    const int* pb = (const int*)(ws + WS_PADBASE) + player * 16; const bf16_t* Y2 = (const bf16_t*)(ws + WS_Y2);
    int2 ri[NR]; float2 rg[NR]; const u32x2* y0[NR]; const u32x2* y1[NR];
#pragma unroll
    for (int q = 0; q < NR; ++q) { ri[q] = ((const int2*)(ws + WS_ROUTE_I))[r[q]]; rg[q] = ((const float2*)(ws + WS_ROUTE_G))[r[q]]; }
#pragma unroll
    for (int q = 0; q < NR; ++q) { const int s0 = pb[ri[q].x >> 20] + (ri[q].x & 0xfffff), s1 = pb[ri[q].y >> 20] + (ri[q].y & 0xfffff);
        y0[q] = (const u32x2*)(Y2 + (size_t)s0 * D) + lane; y1[q] = (const u32x2*)(Y2 + (size_t)s1 * D) + lane; }
#pragma unroll
    for (int j = 0; j < 8; ++j) { const f32x4 g = *((const f32x4*)mod5 + 64 * j + lane);
#pragma unroll
        for (int q = 0; q < NR; ++q) { const u32x2 a = y0[q][64 * j], b = y1[q][64 * j];
            const f32x4 ya = (f32x4){bflo(a.x), bfhi(a.x), bflo(a.y), bfhi(a.y)}, yb = (f32x4){bflo(b.x), bfhi(b.x), bflo(b.y), bfhi(b.y)};
            x[q][j] += g * (ya * rg[q].x + yb * rg[q].y); } }
}
__device__ __forceinline__ float row_sumsq(const f32x4 (&x)[8]) { float ss = 0.f;
#pragma unroll
    for (int j = 0; j < 8; ++j) ss += (x[j][0] * x[j][0] + x[j][1] * x[j][1]) + (x[j][2] * x[j][2] + x[j][3] * x[j][3]);
    return ss; }

__device__ __forceinline__ void phase_norm1(Frame& F, const Args& a, int layer, bool combine) {
    unsigned char* ws = F.ws; bf16_t* X = (bf16_t*)(ws + WS_X); bf16_t* H = (bf16_t*)(ws + WS_H);
    const float* MOD = (const float*)(ws + WS_MOD); const float* nw = a.in[I_N1W] + (size_t)layer * D;
    int r0, r1; wave_rows(F, MTOK, r0, r1);
    int curb = -1; f32x4 av[8], sv[8];
    for (int r = r0; r < r1;) {
        const int b = mod_row(r);
        const bool two = (r + 1 < r1) && (mod_row(r + 1) == b);
        const int rr[2] = {r, two ? r + 1 : r};
        if (b != curb) { curb = b; const float* m = MOD + ((size_t)layer * 5 + b) * 6 * D;
#pragma unroll
            for (int j = 0; j < 8; ++j) { const f32x4 w = *((const f32x4*)nw + 64 * j + F.lane), m1 = *((const f32x4*)(m + D) + 64 * j + F.lane); av[j] = w * (m1 + 1.f); sv[j] = *((const f32x4*)m + 64 * j + F.lane); } }
        f32x4 x[2][8];
#pragma unroll
        for (int q = 0; q < 2; ++q) {
            if (layer == 0) { const float* xs = rr[q] < NLAT ? a.in[I_X] + (size_t)rr[q] * D : a.in[I_CTX] + (size_t)(rr[q] - NLAT) * D;
                const f32x4* xr = (const f32x4*)xs + F.lane;
#pragma unroll
                for (int j = 0; j < 8; ++j) x[q][j] = xr[64 * j]; }
            else xrow_load(X, rr[q], F.lane, x[q]); }
        if (combine) { moe_combine_rows<2>(x, rr, F.lane, ws, layer - 1, MOD + ((size_t)(layer - 1) * 5 + b) * 6 * D + 5 * D);
#pragma unroll
            for (int q = 0; q < 2; ++q) if (q == 0 || two) xrow_store(X, rr[q], F.lane, x[q]); }
        float ss0 = row_sumsq(x[0]), ss1 = row_sumsq(x[1]);
#pragma unroll
        for (int o = 1; o < 64; o <<= 1) { ss0 += lane_xor(ss0, o, F.lane); ss1 += lane_xor(ss1, o, F.lane); }
        const float rs[2] = {1.0f / sqrtf(ss0 * (1.f / D) + EPS), 1.0f / sqrtf(ss1 * (1.f / D) + EPS)};
#pragma unroll
        for (int q = 0; q < 2; ++q) if (q == 0 || two) { unsigned* ho = (unsigned*)((unsigned char*)H + (size_t)rr[q] * D) + F.lane;
#pragma unroll
            for (int j = 0; j < 8; ++j) { const f32x4 h = x[q][j] * rs[q] * av[j] + sv[j]; int w = 0; w = __builtin_amdgcn_cvt_pk_fp8_f32(h[0], h[1], w, false); w = __builtin_amdgcn_cvt_pk_fp8_f32(h[2], h[3], w, true); ho[64 * j] = (unsigned)w; } }
        r += two ? 2 : 1;
    }
}

constexpr int RT_LCNT = LDS_MISC + 1024, RT_LBASE = LDS_MISC + 1088, RT_REC = LDS_MISC + 2048;
struct Route { int i1, i2; float g1, g2; };
__device__ __forceinline__ Route route_row(const float (&lg)[NEXP], const float* rbias) {
    float sc[NEXP], sel[NEXP];
#pragma unroll
    for (int e = 0; e < NEXP; ++e) { sc[e] = __builtin_amdgcn_rcpf(1.f + __builtin_amdgcn_exp2f(-1.44269504f * lg[e])); sel[e] = sc[e] + rbias[e]; }
    float gsc[4];
#pragma unroll
    for (int g = 0; g < 4; ++g) { float m1 = -1e30f, m2 = -1e30f;
#pragma unroll
        for (int i = 0; i < 4; ++i) { const float v = sel[g * 4 + i]; const bool c1 = v > m1, c2 = v > m2; m2 = c1 ? m1 : (c2 ? v : m2); m1 = c1 ? v : m1; }
        gsc[g] = m1 + m2; }
    int gbest = 0; float gbs = gsc[0];
#pragma unroll
    for (int g = 1; g < 4; ++g) { const bool c = gsc[g] > gbs; gbest = c ? g : gbest; gbs = c ? gsc[g] : gbs; }
    float sl[4], sx[4];
#pragma unroll
    for (int i = 0; i < 4; ++i) { sl[i] = gbest == 0 ? sel[i] : gbest == 1 ? sel[4 + i] : gbest == 2 ? sel[8 + i] : sel[12 + i]; sx[i] = gbest == 0 ? sc[i] : gbest == 1 ? sc[4 + i] : gbest == 2 ? sc[8 + i] : sc[12 + i]; }
    int i1 = 0, i2 = 0; float v1 = -1e30f, v2 = -1e30f, s1 = 0.f, s2 = 0.f;
#pragma unroll
    for (int i = 0; i < 4; ++i) { const float v = sl[i]; const bool c1 = v > v1, c2 = v > v2;
        i2 = c1 ? i1 : (c2 ? i : i2); s2 = c1 ? s1 : (c2 ? sx[i] : s2); v2 = c1 ? v1 : (c2 ? v : v2);
        i1 = c1 ? i : i1; s1 = c1 ? sx[i] : s1; v1 = c1 ? v : v1; }
    const float inv = __builtin_amdgcn_rcpf(s1 + s2);
    Route R; R.i1 = gbest * 4 + i1; R.i2 = gbest * 4 + i2; R.g1 = s1 * inv; R.g2 = s2 * inv; return R;
}
constexpr int RT_STRIDE = 4112;
constexpr int RT_WB = 0, RT_HT = 16 * RT_STRIDE, RT_PART = 32 * RT_STRIDE;
static_assert(RT_PART + 8192 <= LDS_MISC, "router LDS map");
__device__ __forceinline__ void phase_norm2_router(Frame& F, const Args& a, int layer, int Mrows, bool publish) {
    unsigned char* ws = F.ws; const bf16_t* X = (const bf16_t*)(ws + WS_X); bf16_t* H = (bf16_t*)(ws + WS_H);
    const float* MOD = (const float*)(ws + WS_MOD); const float* nw = a.in[I_N2W] + (size_t)layer * D;
    LAS unsigned char* L = F.lds;
    { const f32x4* wr4 = (const f32x4*)a.in[I_WROUTER];
#pragma unroll 1
      for (int i = 0; i < 2; ++i) { const int k = 2 * F.tid + 1024 * i; f32x4 wv[2][4];
#pragma unroll
          for (int h = 0; h < 2; ++h)
#pragma unroll
              for (int q = 0; q < 4; ++q) wv[h][q] = wr4[(size_t)(k + h) * 4 + q];
#pragma unroll
          for (int q = 0; q < 4; ++q)
#pragma unroll
              for (int ii = 0; ii < 4; ++ii) *(LAS unsigned*)(L + RT_WB + (4 * q + ii) * RT_STRIDE + k * 2) = pk2(wv[0][q][ii], wv[1][q][ii]); } }
    LAS unsigned* lcnt = (LAS unsigned*)(F.lds + RT_LCNT); LAS unsigned* lbase = (LAS unsigned*)(F.lds + RT_LBASE);
    if (F.tid < 16) lcnt[F.tid] = 0u;
    __syncthreads();
    const float* rbias = a.in[I_RBIAS];
    const int brow0 = 2 * (int)((blockIdx.x * (unsigned)(Mrows >> 1)) / (unsigned)F.G), brow1 = 2 * (int)(((blockIdx.x + 1) * (unsigned)(Mrows >> 1)) / (unsigned)F.G);
    const int nround = (brow1 - brow0 + 15) >> 4;
    const int fr = F.lane & 15, fq = F.lane >> 4;
#pragma unroll 1
    for (int t = 0; t < nround; ++t) {
        const int r = brow0 + 16 * t + 2 * F.wave;
        const bool v0 = r < brow1, v1 = r + 1 < brow1;
        const int rr[2] = {v0 ? r : brow0, v1 ? r + 1 : brow0};
        const int b = mod_row(rr[0]);
        const float* m = MOD + ((size_t)layer * 5 + b) * 6 * D;
        f32x4 x[2][8];
#pragma unroll
        for (int q = 0; q < 2; ++q) xrow_load(X, rr[q], F.lane, x[q]);
        float ss0 = row_sumsq(x[0]), ss1 = row_sumsq(x[1]);
#pragma unroll
        for (int o = 1; o < 64; o <<= 1) { ss0 += lane_xor(ss0, o, F.lane); ss1 += lane_xor(ss1, o, F.lane); }
        const float rs[2] = {1.0f / sqrtf(ss0 * (1.f / D) + EPS), 1.0f / sqrtf(ss1 * (1.f / D) + EPS)};
#pragma unroll
        for (int q = 0; q < 2; ++q) {
#pragma unroll
            for (int j = 0; j < 8; ++j) { const f32x4 w = *((const f32x4*)nw + 64 * j + F.lane), m4 = *((const f32x4*)(m + 4 * D) + 64 * j + F.lane), m3 = *((const f32x4*)(m + 3 * D) + 64 * j + F.lane);
                x[q][j] = x[q][j] * rs[q] * (w * (m4 + 1.f)) + m3; }
            if (q == 0 ? v0 : v1) { unsigned* ho = (unsigned*)((unsigned char*)H + (size_t)rr[q] * D) + F.lane;
#pragma unroll
                for (int j = 0; j < 8; ++j) ho[64 * j] = pk4_fp8(x[q][j][0], x[q][j][1], x[q][j][2], x[q][j][3]); }
            LAS unsigned char* hrow = L + RT_HT + (2 * F.wave + q) * RT_STRIDE + F.lane * 8;
#pragma unroll
            for (int j = 0; j < 8; ++j) { u32x2 w; w.x = pk2(x[q][j][0], x[q][j][1]); w.y = pk2(x[q][j][2], x[q][j][3]); *(LAS u32x2*)(hrow + j * 512) = w; } }
        __syncthreads();
        f32x4 acc = (f32x4){0.f, 0.f, 0.f, 0.f};
#pragma unroll
        for (int s = 0; s < 8; ++s) { const int kb = (256 * F.wave + 32 * s + 8 * fq) * 2;
            const bf16x8 wa = *(const LAS bf16x8*)(L + RT_WB + fr * RT_STRIDE + kb), hb = *(const LAS bf16x8*)(L + RT_HT + fr * RT_STRIDE + kb);
            acc = __builtin_amdgcn_mfma_f32_16x16x32_bf16(wa, hb, acc, 0, 0, 0); }
        *(LAS f32x4*)(L + RT_PART + F.wave * 1024 + fr * 64 + fq * 16) = acc;
        __syncthreads();
        if (F.lane < 2) { const int tr = 2 * F.wave + F.lane;
            f32x4 sg[4] = {(f32x4){0.f, 0.f, 0.f, 0.f}, (f32x4){0.f, 0.f, 0.f, 0.f}, (f32x4){0.f, 0.f, 0.f, 0.f}, (f32x4){0.f, 0.f, 0.f, 0.f}};
#pragma unroll
            for (int w8 = 0; w8 < 8; ++w8)
#pragma unroll
                for (int c = 0; c < 4; ++c) sg[c] += *(const LAS f32x4*)(L + RT_PART + w8 * 1024 + tr * 64 + c * 16);
            float lg[NEXP];
#pragma unroll
            for (int e = 0; e < NEXP; ++e) lg[e] = sg[e >> 2][e & 3];
            const Route R = route_row(lg, rbias); const int i1 = R.i1, i2 = R.i2; const float g1 = R.g1, g2 = R.g2;
            if ((F.lane == 0 ? v0 : v1) && publish) {
                const unsigned k1 = __hip_atomic_fetch_add(lcnt + i1, 1u, __ATOMIC_RELAXED, __HIP_MEMORY_SCOPE_WORKGROUP), k2 = __hip_atomic_fetch_add(lcnt + i2, 1u, __ATOMIC_RELAXED, __HIP_MEMORY_SCOPE_WORKGROUP);
                LAS unsigned* rec = (LAS unsigned*)(F.lds + RT_REC + (r + F.lane - brow0) * 32);
                rec[0] = (unsigned)i1; rec[1] = k1; rec[2] = (unsigned)i2; rec[3] = k2; rec[4] = __builtin_bit_cast(unsigned, g1); rec[5] = __builtin_bit_cast(unsigned, g2);
            } }
    }
    __syncthreads();
    if (F.tid < 16 && publish) { unsigned* cntw = (unsigned*)(ws + WS_CTL) + CW_CNT + layer * 1024; const unsigned n = lcnt[F.tid]; lbase[F.tid] = n ? atomicAdd(cntw + F.tid * 64, n) : 0u; }
    __syncthreads();
    if (F.tid < brow1 - brow0 && publish) { const int r = brow0 + F.tid; const LAS unsigned* rec = (const LAS unsigned*)(F.lds + RT_REC + F.tid * 32);
        const unsigned i1 = rec[0], i2 = rec[2], k1 = lbase[i1] + rec[1], k2 = lbase[i2] + rec[3];
        int* slottok = (int*)(ws + WS_SLOTTOK); slottok[(size_t)i1 * MTOK + k1] = r; slottok[(size_t)i2 * MTOK + k2] = r;
        ((int2*)(ws + WS_ROUTE_I))[r] = make_int2((int)((i1 << 20) | k1), (int)((i2 << 20) | k2));
        ((float2*)(ws + WS_ROUTE_G))[r] = make_float2(__builtin_bit_cast(float, rec[4]), __builtin_bit_cast(float, rec[5])); }
    __syncthreads();
}

__device__ __forceinline__ void phase_pooldiff(Frame& F, int Mrows) {
    unsigned char* ws = F.ws; const bf16_t* Z = (const bf16_t*)(ws + WS_Z); bf16_t* PD = (bf16_t*)(ws + WS_PD);
    LAS unsigned char* L = F.lds;
    const int cg = F.tid & 127, rq = F.tid >> 7, hw = 1 << (cg >> 5);
    const int ntile = NLAT / 64;
    for (int tile = blockIdx.x; tile < ntile; tile += F.G) {
        int base, Lrow, t0, nt;
        if (tile < NLAT / 64) { base = tile * 64; Lrow = 64; t0 = 0; nt = 64; }
        else { const int u = tile - NLAT / 64; base = NLAT + (u >> 3) * CTXL; Lrow = CTXL; t0 = (u & 7) * 32; nt = 32; }
        const int lo = max(t0 - 8, 0), hi = min(t0 + nt + 7, Lrow - 1), nrow = hi - lo + 1;
        u32x4 buf[16];
#pragma unroll
        for (int i = 0; i < 16; ++i) { const int sl = rq + 4 * i; buf[i] = (sl < nrow) ? *(const u32x4*)(Z + (size_t)(base + lo + sl) * INC + ZC_POOL + cg * 8) : (u32x4){0u, 0u, 0u, 0u}; }
#pragma unroll
        for (int i = 0; i < 16; ++i) { const int sl = rq + 4 * i; *(LAS u32x4*)(L + sl * 2048 + cg * 16) = buf[i]; }
        __syncthreads();
        for (int i = 0; i < nt / 4; ++i) { const int t = t0 + rq + 4 * i;
            const int wl = max(t - hw, 0), wh = min(t + hw - 1, Lrow - 1);
            float s[8] = {0.f, 0.f, 0.f, 0.f, 0.f, 0.f, 0.f, 0.f};
            for (int p = wl; p <= wh; ++p) { const u32x4 a = *(const LAS u32x4*)(L + (p - lo) * 2048 + cg * 16);
                s[0] += bflo(a.x); s[1] += bfhi(a.x); s[2] += bflo(a.y); s[3] += bfhi(a.y); s[4] += bflo(a.z); s[5] += bfhi(a.z); s[6] += bflo(a.w); s[7] += bfhi(a.w); }
            const float inv = 1.f / (float)(wh - wl + 1);
            const u32x4 a = *(const LAS u32x4*)(L + (t - lo) * 2048 + cg * 16);
            u32x4 o; o.x = pk2(s[0] * inv - bflo(a.x), s[1] * inv - bfhi(a.x)); o.y = pk2(s[2] * inv - bflo(a.y), s[3] * inv - bfhi(a.y));
            o.z = pk2(s[4] * inv - bflo(a.z), s[5] * inv - bfhi(a.z)); o.w = pk2(s[6] * inv - bflo(a.w), s[7] * inv - bfhi(a.w));
            *(u32x4*)(PD + (size_t)(base + t) * DPOOL + cg * 8) = o; }
        __syncthreads();
    }
    if (Mrows > NLAT) {
        const int cgl = F.tid & 15, rq2 = F.tid >> 4;
        for (int it = blockIdx.x; it < (NCTX / 32) * 8; it += F.G) {
            const int u = it >> 3, k = it & 7, cg2 = k * 16 + cgl, hw2 = 1 << (k >> 1);
            const int base = NLAT + (u >> 3) * CTXL, t0 = (u & 7) * 32;
            const int lo = max(t0 - 8, 0), hi = min(t0 + 32 + 7, CTXL - 1), nrow = hi - lo + 1;
            u32x4 buf[2];
#pragma unroll
            for (int i = 0; i < 2; ++i) { const int sl = rq2 + 32 * i; buf[i] = (sl < nrow) ? *(const u32x4*)(Z + (size_t)(base + lo + sl) * INC + ZC_POOL + cg2 * 8) : (u32x4){0u, 0u, 0u, 0u}; }
#pragma unroll
            for (int i = 0; i < 2; ++i) { const int sl = rq2 + 32 * i; *(LAS u32x4*)(L + sl * 2048 + cg2 * 16) = buf[i]; }
            __syncthreads();
            { const int t = t0 + rq2;
              const int wl = max(t - hw2, 0), wh = min(t + hw2 - 1, CTXL - 1);
              float s8[8] = {0.f, 0.f, 0.f, 0.f, 0.f, 0.f, 0.f, 0.f};
              for (int p = wl; p <= wh; ++p) { const u32x4 a = *(const LAS u32x4*)(L + (p - lo) * 2048 + cg2 * 16);
                  s8[0] += bflo(a.x); s8[1] += bfhi(a.x); s8[2] += bflo(a.y); s8[3] += bfhi(a.y); s8[4] += bflo(a.z); s8[5] += bfhi(a.z); s8[6] += bflo(a.w); s8[7] += bfhi(a.w); }
              const float inv = 1.f / (float)(wh - wl + 1);
              const u32x4 a = *(const LAS u32x4*)(L + (t - lo) * 2048 + cg2 * 16);
              u32x4 o; o.x = pk2(s8[0] * inv - bflo(a.x), s8[1] * inv - bfhi(a.x)); o.y = pk2(s8[2] * inv - bflo(a.y), s8[3] * inv - bfhi(a.y));
              o.z = pk2(s8[4] * inv - bflo(a.z), s8[5] * inv - bfhi(a.z)); o.w = pk2(s8[6] * inv - bflo(a.w), s8[7] * inv - bfhi(a.w));
              *(u32x4*)(PD + (size_t)(base + t) * DPOOL + cg2 * 8) = o; }
            __syncthreads();
        }
    }
}

constexpr int SC_QS = 0, SC_KS = 17408, SC_KST = 34816, SC_VT = 53248, SC_VEC = 71680;
constexpr int SC_ST = 73216, SC_TOT = SC_ST + 34816, SC_END = SC_TOT + 4096;
constexpr int SC_P272 = 272, SC_P144 = 144;
constexpr int SEG_CH = 17, NSEG = 4;
static_assert(SC_END <= LDS_MISC, "scan LDS map");
struct ScanCtx { const bf16_t* Z; bf16_t* O2; LAS unsigned char* L; unsigned char* qsg; float* corrv; float* smid; float* totseg; int tid, lane, w, fr, fq, rt, vp, b, h, seg, dir, colq, colf, colv; };
__device__ __forceinline__ void scan_row0(int b, int dir, int c, int& g0, int& sg) {
    if (c < 4) { const int t0 = 64 * c; g0 = NLAT + b * CTXL + (dir ? CTXL - 1 - t0 : t0); } else { const int t0 = 64 * (c - 4); g0 = b * SEQ + (dir ? SEQ - 1 - t0 : t0); }
    sg = dir ? -1 : 1;
}
__device__ __forceinline__ void scan_load_lf(const ScanCtx& C, int c, unsigned (&lfw)[8]) {
    int g0, sg; scan_row0(C.b, C.dir, c, g0, sg);
#pragma unroll
    for (int j = 0; j < 8; ++j) lfw[j] = *(const unsigned*)(C.Z + (size_t)(g0 + sg * (8 * C.w + j)) * INC + C.colf);
}
__device__ __forceinline__ void scan_load_qv(const ScanCtx& C, int c, unsigned (&qw)[8], unsigned (&vw)[8]) {
    int g0, sg; scan_row0(C.b, C.dir, c, g0, sg);
#pragma unroll
    for (int j = 0; j < 8; ++j) { const bf16_t* zr = C.Z + (size_t)(g0 + sg * (8 * C.w + j)) * INC; qw[j] = *(const unsigned*)(zr + C.colq); vw[j] = *(const unsigned*)(zr + C.colv); }
}
__device__ __forceinline__ void scan_p1(const ScanCtx& C, const unsigned (&lfw)[8]) {
    float a0 = 0.f, a1 = 0.f;
#pragma unroll
    for (int j = 0; j < 8; ++j) { a0 += bflo(lfw[j]); a1 += bfhi(lfw[j]); }
    *(LAS f32x2*)(C.L + SC_TOT + (C.w * 128 + 2 * C.lane) * 4) = (f32x2){a0, a1};
}
__device__ __forceinline__ void scan_p2(const ScanCtx& C, int cl, const unsigned (&lfw)[8], const unsigned (&qw)[8], const unsigned (&vw)[8], float& cum0, float& cum1) {
    LAS unsigned char* L = C.L; const int lane = C.lane, w = C.w;
    float c0[8], c1[8], l0[8], l1[8];
    { float a0 = 0.f, a1 = 0.f;
#pragma unroll
      for (int j = 0; j < 8; ++j) { l0[j] = bflo(lfw[j]); l1[j] = bfhi(lfw[j]); a0 += l0[j]; a1 += l1[j]; c0[j] = a0; c1[j] = a1; } }
    float P0 = 0.f, P1 = 0.f, r0 = 0.f, r1 = 0.f, bl0 = 0.f, bl1 = 0.f;
#pragma unroll
    for (int o = 0; o < 8; ++o) { const f32x2 t = *(const LAS f32x2*)(L + SC_TOT + (o * 128 + 2 * lane) * 4);
        if (o < w) { P0 += t.x; P1 += t.y; } if (o < 4) { r0 += t.x; r1 += t.y; } bl0 += t.x; bl1 += t.y; }
    float k0v[8], k1v[8]; const float P0r = P0 - r0, P1r = P1 - r1;
#pragma unroll
    for (int j = 0; j < 8; ++j) {
        const float d0 = __builtin_amdgcn_fmed3f(P0r + c0[j], -120.f, 120.f), d1 = __builtin_amdgcn_fmed3f(P1r + c1[j], -120.f, 120.f);
        const float E0 = __builtin_amdgcn_exp2f(d0), E1 = __builtin_amdgcn_exp2f(d1), I0 = __builtin_amdgcn_exp2f(-d0), I1 = __builtin_amdgcn_exp2f(-d1);
        const float f0 = __builtin_amdgcn_exp2f(l0[j]), f1 = __builtin_amdgcn_exp2f(l1[j]);
        const float q0 = bflo(qw[j]), q1 = bfhi(qw[j]);
        k0v[j] = (1.f - f0) * I0; k1v[j] = (1.f - f1) * I1;
        const int rho = 8 * w + j;
        *(LAS unsigned*)(L + SC_QS + rho * SC_P272 + 4 * lane) = pk2(q0 * E0, q1 * E1);
        *(LAS unsigned*)(L + SC_KS + rho * SC_P272 + 4 * lane) = pk2(k0v[j], k1v[j]);
    }
    { u32x4 t0, t1; t0.x = pk2(k0v[0], k0v[1]); t0.y = pk2(k0v[2], k0v[3]); t0.z = pk2(k0v[4], k0v[5]); t0.w = pk2(k0v[6], k0v[7]);
      t1.x = pk2(k1v[0], k1v[1]); t1.y = pk2(k1v[2], k1v[3]); t1.z = pk2(k1v[4], k1v[5]); t1.w = pk2(k1v[6], k1v[7]);
      *(LAS u32x4*)(L + SC_KST + (2 * lane) * SC_P144 + 16 * w) = t0; *(LAS u32x4*)(L + SC_KST + (2 * lane + 1) * SC_P144 + 16 * w) = t1; }
    if (w == 0) {
        LAS float* vec = (LAS float*)(L + SC_VEC);
        *(LAS f32x2*)(vec + 2 * lane) = (f32x2){__builtin_amdgcn_exp2f(fmaxf(r0, -120.f)), __builtin_amdgcn_exp2f(fmaxf(r1, -120.f))};
        *(LAS f32x2*)(vec + 128 + 2 * lane) = (f32x2){__builtin_amdgcn_exp2f(fmaxf(bl0, -120.f)), __builtin_amdgcn_exp2f(fmaxf(bl1, -120.f))};
        *(LAS f32x2*)(vec + 256 + 2 * lane) = (f32x2){__builtin_amdgcn_exp2f(fmaxf(bl0 - r0, -120.f)), __builtin_amdgcn_exp2f(fmaxf(bl1 - r1, -120.f))};
        if (C.seg >= 1) *(f32x2*)(C.corrv + cl * 128 + 2 * lane) = (f32x2){r0 + cum0, r1 + cum1};
    }
    cum0 += bl0; cum1 += bl1;
    { u32x4 t0, t1;
      t0.x = (vw[0] & 0xffffu) | (vw[1] << 16); t0.y = (vw[2] & 0xffffu) | (vw[3] << 16); t0.z = (vw[4] & 0xffffu) | (vw[5] << 16); t0.w = (vw[6] & 0xffffu) | (vw[7] << 16);
      t1.x = (vw[0] >> 16) | (vw[1] & 0xffff0000u); t1.y = (vw[2] >> 16) | (vw[3] & 0xffff0000u); t1.z = (vw[4] >> 16) | (vw[5] & 0xffff0000u); t1.w = (vw[6] >> 16) | (vw[7] & 0xffff0000u);
      *(LAS u32x4*)(L + SC_VT + (2 * lane) * SC_P144 + 16 * w) = t0; *(LAS u32x4*)(L + SC_VT + (2 * lane + 1) * SC_P144 + 16 * w) = t1; }
}
__device__ __forceinline__ void scan_c1(const ScanCtx& C, const f32x4 (&S)[2][4]) {
#pragma unroll
    for (int i = 0; i < 2; ++i) { const int k = ((C.w >> 1) * 2 + i) * 16 + 4 * C.fq;
        f32x4 r = *(const LAS f32x4*)(C.L + SC_TOT + k * 4);
#pragma unroll
        for (int o = 1; o < 4; ++o) r += *(const LAS f32x4*)(C.L + SC_TOT + (o * 128 + k) * 4);
        f32x4 e;
#pragma unroll
        for (int q = 0; q < 4; ++q) e[q] = __builtin_amdgcn_exp2f(fmaxf(r[q], -120.f));
#pragma unroll
        for (int u = 0; u < 4; ++u) { const int v = (4 * C.vp + u) * 16 + C.fr; const f32x4 sv = S[i][u] * e;
            u32x2 t; t.x = pk2(sv[0], sv[1]); t.y = pk2(sv[2], sv[3]); *(LAS u32x2*)(C.L + SC_ST + v * SC_P272 + k * 2) = t; } }
}
__device__ __forceinline__ void scan_c2(const ScanCtx& C, int c, f32x4 (&S)[2][4]) {
    LAS unsigned char* L = C.L; const int fr = C.fr, fq = C.fq, rt = C.rt, w = C.w;
    bf16x8 yq[4];
#pragma unroll
    for (int ks = 0; ks < 4; ++ks) yq[ks] = *(const LAS bf16x8*)(L + SC_QS + (rt * 16 + fr) * SC_P272 + (ks * 32 + fq * 8) * 2);
    f32x4 at[4];
#pragma unroll
    for (int st = 0; st < 4; ++st) { f32x4 a = (f32x4){0.f, 0.f, 0.f, 0.f};
        if (st <= rt) {
#pragma unroll
            for (int ks = 0; ks < 4; ++ks) { const bf16x8 x = *(const LAS bf16x8*)(L + SC_KS + (st * 16 + fr) * SC_P272 + (ks * 32 + fq * 8) * 2); a = __builtin_amdgcn_mfma_f32_16x16x32_bf16(x, yq[ks], a, 0, 0, 0); }
            if (st == rt) {
#pragma unroll
                for (int r = 0; r < 4; ++r) if (4 * fq + r > fr) a[r] = 0.f; } }
        at[st] = a; }
    u32x4 yw[2];
#pragma unroll
    for (int ks2 = 0; ks2 < 2; ++ks2) { yw[ks2].x = pk2(at[2 * ks2][0], at[2 * ks2][1]); yw[ks2].y = pk2(at[2 * ks2][2], at[2 * ks2][3]); yw[ks2].z = pk2(at[2 * ks2 + 1][0], at[2 * ks2 + 1][1]); yw[ks2].w = pk2(at[2 * ks2 + 1][2], at[2 * ks2 + 1][3]); }
    int g0, sg; scan_row0(C.b, C.dir, c, g0, sg);
#pragma unroll
    for (int u = 0; u < 4; ++u) { const int vt = 4 * C.vp + u; f32x4 o = (f32x4){0.f, 0.f, 0.f, 0.f};
#pragma unroll
        for (int ks = 0; ks < 4; ++ks) { const bf16x8 x = *(const LAS bf16x8*)(L + SC_ST + (vt * 16 + fr) * SC_P272 + (ks * 32 + fq * 8) * 2); o = __builtin_amdgcn_mfma_f32_16x16x32_bf16(x, yq[ks], o, 0, 0, 0); }
#pragma unroll
        for (int ks2 = 0; ks2 < 2; ++ks2) { if (2 * ks2 <= rt) {
            const u32x2 xa = *(const LAS u32x2*)(L + SC_VT + (vt * 16 + fr) * SC_P144 + (ks2 * 32 + 4 * fq) * 2), xb = *(const LAS u32x2*)(L + SC_VT + (vt * 16 + fr) * SC_P144 + (ks2 * 32 + 16 + 4 * fq) * 2);
            u32x4 xw; xw.x = xa.x; xw.y = xa.y; xw.z = xb.x; xw.w = xb.y;
            o = __builtin_amdgcn_mfma_f32_16x16x32_bf16(__builtin_bit_cast(bf16x8, xw), __builtin_bit_cast(bf16x8, yw[ks2]), o, 0, 0, 0); } }
        u32x2 ow; ow.x = pk2(o[0], o[1]); ow.y = pk2(o[2], o[3]);
        *(u32x2*)(C.O2 + ((size_t)C.dir * MTOK + (g0 + sg * (rt * 16 + fr))) * HGW + C.h * HDK + vt * 16 + 4 * fq) = ow;
        __builtin_amdgcn_sched_barrier(0); }
    bf16x8 xk[2][2];
#pragma unroll
    for (int i = 0; i < 2; ++i)
#pragma unroll
        for (int ks = 0; ks < 2; ++ks) xk[i][ks] = *(const LAS bf16x8*)(L + SC_KST + (((w >> 1) * 2 + i) * 16 + fr) * SC_P144 + (ks * 32 + fq * 8) * 2);
#pragma unroll
    for (int u = 0; u < 4; ++u) { bf16x8 yv[2];
#pragma unroll
        for (int ks = 0; ks < 2; ++ks) yv[ks] = *(const LAS bf16x8*)(L + SC_VT + ((4 * C.vp + u) * 16 + fr) * SC_P144 + (ks * 32 + fq * 8) * 2);
#pragma unroll
        for (int i = 0; i < 2; ++i) { f32x4 d = (f32x4){0.f, 0.f, 0.f, 0.f};
#pragma unroll
            for (int ks = 0; ks < 2; ++ks) d = __builtin_amdgcn_mfma_f32_16x16x32_bf16(xk[i][ks], yv[ks], d, 0, 0, 0);
            const int k = ((w >> 1) * 2 + i) * 16 + 4 * fq; const f32x4 ebl = *(const LAS f32x4*)(L + SC_VEC + (128 + k) * 4), ebr = *(const LAS f32x4*)(L + SC_VEC + (256 + k) * 4);
            S[i][u] = ebl * S[i][u] + ebr * d; }
        __builtin_amdgcn_sched_barrier(0); }
}
__device__ __forceinline__ void phase_scan_mfma(Frame& F) {
    ScanCtx C; C.Z = (const bf16_t*)(F.ws + WS_Z); C.O2 = (bf16_t*)(F.ws + WS_O2); C.L = F.lds;
    C.tid = F.tid; C.lane = F.lane; C.w = F.wave; C.fr = F.lane & 15; C.fq = F.lane >> 4; C.rt = F.wave >> 1; C.vp = F.wave & 1;
    for (int it = blockIdx.x; it < 64 * NSEG; it += F.G) {
        const int sbh = it >> 2; C.h = sbh & 7; C.b = (sbh >> 3) & 3; C.dir = sbh >> 5;
        C.seg = C.dir ? 3 - (it & 3) : (it & 3);
        C.qsg = F.ws + WS_QSG + (size_t)(sbh * 3 + (C.seg - 1)) * SEG_CH * 17408; C.corrv = (float*)(F.ws + WS_CORRV) + (size_t)(sbh * 3 + (C.seg - 1)) * SEG_CH * 128;
        C.smid = (float*)(F.ws + WS_SMID) + (size_t)(sbh * 3 + C.seg) * 128 * 128; C.totseg = (float*)(F.ws + WS_TOTSEG) + (size_t)(sbh * NSEG + C.seg) * 128;
        C.colq = ZC_Q + C.h * HDK + 2 * C.lane; C.colf = (C.dir == 0 ? ZC_FF : ZC_FB) + C.h * HDK + 2 * C.lane; C.colv = ZC_I + C.h * HDK + 2 * C.lane;
        f32x4 S[2][4];
#pragma unroll
        for (int i = 0; i < 2; ++i)
#pragma unroll
            for (int u = 0; u < 4; ++u) S[i][u] = (f32x4){0.f, 0.f, 0.f, 0.f};
        float cum0 = 0.f, cum1 = 0.f;
        unsigned lfW[8], qW[8], vW[8];
        const int c_lo = C.seg * SEG_CH;
        scan_load_lf(C, c_lo, lfW); scan_load_qv(C, c_lo, qW, vW);
        scan_p1(C, lfW);
        __syncthreads();
#define SC_STEP(cl) do { \
            scan_p2(C, (cl), lfW, qW, vW, cum0, cum1); scan_c1(C, S); \
            if ((cl) + 1 < SEG_CH) { scan_load_lf(C, c_lo + (cl) + 1, lfW); scan_load_qv(C, c_lo + (cl) + 1, qW, vW); } \
            __syncthreads(); \
            if (C.seg >= 1) { unsigned char* dst = C.qsg + (size_t)(cl) * 17408; const LAS unsigned char* src = C.L + SC_QS; for (int i_ = C.tid; i_ < 1088; i_ += 512) *(u32x4*)(dst + 16 * i_) = *(const LAS u32x4*)(src + 16 * i_); } \
            scan_c2(C, c_lo + (cl), S); \
            if ((cl) + 1 < SEG_CH) scan_p1(C, lfW); \
            __syncthreads(); } while (0)
        for (int cl = 0; cl < SEG_CH; ++cl) SC_STEP(cl);
#undef SC_STEP
        if (C.seg < 3) {
#pragma unroll
            for (int i = 0; i < 2; ++i)
#pragma unroll
                for (int u = 0; u < 4; ++u) *(f32x4*)(C.smid + ((4 * C.vp + u) * 16 + C.fr) * 128 + ((C.w >> 1) * 2 + i) * 16 + 4 * C.fq) = S[i][u]; }
        if (C.w == 0) *(f32x2*)(C.totseg + 2 * C.lane) = (f32x2){cum0, cum1};
        __syncthreads();
    }
}
__device__ __forceinline__ void phase_scan_fix(Frame& F) {
    unsigned char* ws = F.ws; bf16_t* O2 = (bf16_t*)(ws + WS_O2); LAS unsigned char* L = F.lds;
    LAS float* facv = (LAS float*)(L + 36864); LAS int* flg = (LAS int*)(L + 36864 + 512);
    const int w = F.wave, fr = F.lane & 15, fq = F.lane >> 4, rt = w >> 1, vp = w & 1;
    for (int item = blockIdx.x; item < 64 * 3; item += F.G) {
        const int j = 1 + item % 3, sbh = item / 3, dir = sbh >> 5, b = (sbh >> 3) & 3, h = sbh & 7;
        const int v = F.tid >> 2, k0 = (F.tid & 3) * 32;
        f32x4 sin[8];
        { const float* E = (const float*)(ws + WS_SMID) + ((size_t)(sbh * 3 + 0) * 128 + v) * 128 + k0;
#pragma unroll
          for (int i = 0; i < 8; ++i) sin[i] = *(const f32x4*)(E + 4 * i); }
        for (int jj = 1; jj < j; ++jj) { const float* E = (const float*)(ws + WS_SMID) + ((size_t)(sbh * 3 + jj) * 128 + v) * 128 + k0; const float* T = (const float*)(ws + WS_TOTSEG) + (size_t)(sbh * NSEG + jj) * 128 + k0;
#pragma unroll
            for (int i = 0; i < 8; ++i) { const f32x4 t = *(const f32x4*)(T + 4 * i); f32x4 d;
#pragma unroll
                for (int q = 0; q < 4; ++q) d[q] = __builtin_amdgcn_exp2f(fmaxf(t[q], -200.f));
                sin[i] = d * sin[i] + *(const f32x4*)(E + 4 * i); } }
        for (int cl = 0; cl < SEG_CH; ++cl) {
            if (F.tid == 0) flg[0] = 0;
            __syncthreads();
            if (F.tid < 128) { const float e = ((const float*)(ws + WS_CORRV))[((size_t)(sbh * 3 + (j - 1)) * SEG_CH + cl) * 128 + F.tid]; const float f = __builtin_amdgcn_exp2f(fmaxf(e, -200.f)); facv[F.tid] = f; if (f != 0.f) flg[0] = 1; }
            __syncthreads();
            if (flg[0] != 0) {
#pragma unroll
                for (int i = 0; i < 4; ++i) { const f32x4 a0 = sin[2 * i] * *(const LAS f32x4*)(facv + k0 + 8 * i), a1 = sin[2 * i + 1] * *(const LAS f32x4*)(facv + k0 + 8 * i + 4);
                    u32x4 o; o.x = pk2(a0[0], a0[1]); o.y = pk2(a0[2], a0[3]); o.z = pk2(a1[0], a1[1]); o.w = pk2(a1[2], a1[3]);
                    *(LAS u32x4*)(L + v * SC_P272 + (k0 + 8 * i) * 2) = o; }
                __syncthreads();
                const unsigned char* qs = ws + WS_QSG + ((size_t)(sbh * 3 + (j - 1)) * SEG_CH + cl) * 17408;
                bf16x8 yq[4];
#pragma unroll
                for (int ks = 0; ks < 4; ++ks) yq[ks] = *(const bf16x8*)(qs + (rt * 16 + fr) * SC_P272 + (ks * 32 + fq * 8) * 2);
                int g0, sg; scan_row0(b, dir, j * SEG_CH + cl, g0, sg);
#pragma unroll
                for (int u = 0; u < 4; ++u) { const int vt = 4 * vp + u; f32x4 o = (f32x4){0.f, 0.f, 0.f, 0.f};
#pragma unroll
                    for (int ks = 0; ks < 4; ++ks) { const bf16x8 x = *(const LAS bf16x8*)(L + (vt * 16 + fr) * SC_P272 + (ks * 32 + fq * 8) * 2); o = __builtin_amdgcn_mfma_f32_16x16x32_bf16(x, yq[ks], o, 0, 0, 0); }
                    u32x2* p = (u32x2*)(O2 + ((size_t)dir * MTOK + (g0 + sg * (rt * 16 + fr))) * HGW + h * HDK + vt * 16 + 4 * fq);
                    const u32x2 old = *p; u32x2 nw; nw.x = pk2(bflo(old.x) + o[0], bfhi(old.x) + o[1]); nw.y = pk2(bflo(old.y) + o[2], bfhi(old.y) + o[3]); *p = nw; }
            }
            __syncthreads();
        }
    }
}
__device__ __forceinline__ void phase_readout_naive(Frame& F, const Args& a, int layer, int Mrows) {
    unsigned char* ws = F.ws; const bf16_t* Z = (const bf16_t*)(ws + WS_Z); const float* O2 = (const float*)(ws + WS_O2); bf16_t* HG = (bf16_t*)(ws + WS_HG);
    const float* wn = a.in[I_HGNW] + (size_t)layer * HGW;
    int r0, r1;
    { const int G = F.G, extra = (Mrows / 256) * (DPOOL / 256) - G, c = (int)blockIdx.x;
      int b0, b1;
      if (extra > 0 && 2 * extra < G) { const int nb = (Mrows + extra * 36) / G, heavy = Mrows - (G - extra) * nb;
          if (c < extra) { b0 = (int)(((unsigned)c * (unsigned)heavy) / (unsigned)extra); b1 = (int)(((unsigned)(c + 1) * (unsigned)heavy) / (unsigned)extra); }
          else { b0 = heavy + (c - extra) * nb; b1 = b0 + nb; } }
      else { b0 = (int)(((unsigned)c * (unsigned)Mrows) / (unsigned)G); b1 = (int)(((unsigned)(c + 1) * (unsigned)Mrows) / (unsigned)G); }
      const int n = b1 - b0; r0 = b0 + (F.wave * n) / 8; r1 = b0 + ((F.wave + 1) * n) / 8; }
    const int c0 = F.lane * 16;
    float wv[16];
#pragma unroll
    for (int j = 0; j < 16; ++j) wv[j] = wn[c0 + j] * HG8_SCALE;
    for (int rb = r0; rb < r1; rb += 2) {
        const bool two = rb + 1 < r1; const int rr[2] = {rb, two ? rb + 1 : rb};
        u32x2 xw[2][4], yw[2][4]; u32x4 ga[2], gb[2];
#pragma unroll
        for (int q = 0; q < 2; ++q) {
#pragma unroll
            for (int j = 0; j < 4; ++j) { xw[q][j] = *(const u32x2*)((const bf16_t*)O2 + (size_t)rr[q] * HGW + c0 + 4 * j); yw[q][j] = *(const u32x2*)((const bf16_t*)O2 + ((size_t)MTOK + rr[q]) * HGW + c0 + 4 * j); }
            const u32x4* zp = (const u32x4*)(Z + (size_t)rr[q] * INC + ZC_OG + c0); ga[q] = zp[0]; gb[q] = zp[1]; }
#pragma unroll
        for (int q = 0; q < 2; ++q) { if (q == 0 || two) {
            float o[16]; float ss = 0.f;
#pragma unroll
            for (int j = 0; j < 4; ++j) { const f32x4 x = (f32x4){bflo(xw[q][j].x), bfhi(xw[q][j].x), bflo(xw[q][j].y), bfhi(xw[q][j].y)}, y = (f32x4){bflo(yw[q][j].x), bfhi(yw[q][j].x), bflo(yw[q][j].y), bfhi(yw[q][j].y)};
#pragma unroll
                for (int i = 0; i < 4; ++i) { o[4 * j + i] = x[i] + y[i]; ss += o[4 * j + i] * o[4 * j + i]; } }
            ss += lane_xor(ss, 1, F.lane); ss += lane_xor(ss, 2, F.lane); ss += lane_xor(ss, 4, F.lane);
            const float rs = 1.0f / sqrtf(ss * (1.f / HDK) + EPS);
            const float g[16] = {bflo(ga[q].x), bfhi(ga[q].x), bflo(ga[q].y), bfhi(ga[q].y), bflo(ga[q].z), bfhi(ga[q].z), bflo(ga[q].w), bfhi(ga[q].w), bflo(gb[q].x), bfhi(gb[q].x), bflo(gb[q].y), bfhi(gb[q].y), bflo(gb[q].z), bfhi(gb[q].z), bflo(gb[q].w), bfhi(gb[q].w)};
            float y[16];
#pragma unroll
            for (int j = 0; j < 16; ++j) y[j] = o[j] * rs * wv[j] * g[j];
            u32x4 o0; o0.x = pk4_fp8(y[0], y[1], y[2], y[3]); o0.y = pk4_fp8(y[4], y[5], y[6], y[7]); o0.z = pk4_fp8(y[8], y[9], y[10], y[11]); o0.w = pk4_fp8(y[12], y[13], y[14], y[15]);
            *(u32x4*)((unsigned char*)HG + (size_t)rr[q] * HGW + c0) = o0; } }
    }
}

__device__ __forceinline__ void phase_final(Frame& F, const Args& a) {
    unsigned char* ws = F.ws; const bf16_t* X = (const bf16_t*)(ws + WS_X); const float* MOD = (const float*)(ws + WS_MOD); const float* fw = a.in[I_FNW];
    int r0, r1; wave_rows(F, NLAT, r0, r1);
    for (int r = r0; r < r1;) {
        const bool two = (r + 1 < r1) && (mod_row(r + 1) == mod_row(r));
        const int rr[2] = {r, two ? r + 1 : r};
        f32x4 x[2][8];
#pragma unroll
        for (int q = 0; q < 2; ++q) xrow_load(X, rr[q], F.lane, x[q]);
        moe_combine_rows<2>(x, rr, F.lane, ws, DEPTH - 1, MOD + ((size_t)(DEPTH - 1) * 5 + mod_row(r)) * 6 * D + 5 * D);
        float ss0 = row_sumsq(x[0]), ss1 = row_sumsq(x[1]);
#pragma unroll
        for (int o = 1; o < 64; o <<= 1) { ss0 += lane_xor(ss0, o, F.lane); ss1 += lane_xor(ss1, o, F.lane); }
        const float rs[2] = {1.0f / sqrtf(ss0 * (1.f / D) + EPS), 1.0f / sqrtf(ss1 * (1.f / D) + EPS)};
#pragma unroll
        for (int q = 0; q < 2; ++q) if (q == 0 || two) { f32x4* o = (f32x4*)(a.out + (size_t)rr[q] * D) + F.lane;
#pragma unroll
            for (int j = 0; j < 8; ++j) o[64 * j] = x[q][j] * rs[q] * *((const f32x4*)fw + 64 * j + F.lane); }
        r += two ? 2 : 1;
    }
}

__device__ __forceinline__ int moe_tables(Frame& F, int layer) {
    LAS int* tbl = (LAS int*)(F.lds + LDS_MISC + 64);
    const unsigned* cntw = (const unsigned*)(F.ws + WS_CTL) + CW_CNT + layer * 1024;
    if (F.tid < NEXP) tbl[F.tid] = (int)__hip_atomic_load(cntw + F.tid * 64, __ATOMIC_RELAXED, __HIP_MEMORY_SCOPE_AGENT);
    __syncthreads();
    if (F.tid == 0) {
        int blk = 0;
#pragma unroll 1
        for (int e = 0; e < NEXP; ++e) { const int c = tbl[e]; const int nb = (c + 255) >> 8;
            tbl[16 + e] = blk; for (int j = 0; j < nb; ++j) tbl[64 + blk + j] = e;
            if (blockIdx.x == 0) ((int*)(F.ws + WS_PADBASE))[layer * 16 + e] = blk * 256;
            blk += nb; }
        tbl[32] = blk;
    }
    __syncthreads();
    return tbl[32];
}

constexpr int PH_PER_LAYER = 10;
constexpr int N_PHASES = 1 + DEPTH * PH_PER_LAYER + 1;

__global__ void __launch_bounds__(512, 2) mk_fwd(Args args) {
    extern __shared__ __attribute__((aligned(16))) unsigned char lds_raw[];
    Frame F;
    F.lds = (LAS unsigned char*)lds_raw;
    F.tid = threadIdx.x; F.lane = F.tid & 63; F.wave = __builtin_amdgcn_readfirstlane(F.tid >> 6);
    F.G = gridDim.x; F.gw = blockIdx.x * 8 + F.wave; F.NGW = F.G * 8; F.ws = args.ws;
    unsigned char* ws = args.ws;
    volatile LAS unsigned* misc = (volatile LAS unsigned*)(F.lds + LDS_MISC);
    if (F.tid < 16) misc[F.tid] = 0u;
    __syncthreads();
    const int lo = args.ph_lo, hi = args.ph_hi;
#if MK_ONE_LAUNCH
    XcdBarrier bar = xcd_barrier_post((unsigned*)(ws + WS_CTL) + CW_BAR, misc);
#define GRID_BAR() xcd_barrier(bar)
#else
#define GRID_BAR() do {} while (0)
#endif
#ifndef MK_PHMASK
#define MK_PHMASK 0xFFFF
#endif
#define PHON(b) ((MK_PHMASK >> (b)) & 1)
#ifndef MK_REPMASK
#define MK_REPMASK 0
#endif
#define REPS(b) (((args.rep >> (b)) & 1) + 1)
#define IN(k) (lo <= (k) && (k) < hi)
#define LAUNDER() do { int t_ = threadIdx.x; asm volatile("" : "+v"(t_)); F.tid = t_; F.lane = t_ & 63; unsigned char* w_ = args.ws; asm volatile("" : "+s"(w_)); F.ws = w_; ws = w_; } while (0)
#define SEAM(k) do { if (IN(k) && IN((k) + 1)) { GRID_BAR(); if ((args.rep >> 15) & 1) GRID_BAR(); } } while (0)

    if (PHON(0) && IN(0)) { LAUNDER(); for (int rep_ = 0; rep_ < REPS(0); ++rep_) { if (rep_) { VM_WAIT(); __syncthreads(); } phase_prologue(F, args); } }
    SEAM(0);

    for (int layer_ = 0; layer_ < DEPTH; ++layer_) {
        int layer = layer_; asm volatile("" : "+s"(layer));
        const int pb = 1 + layer * PH_PER_LAYER;
        const bool lastl = (layer == DEPTH - 1);
        const int Mr = lastl ? NLAT : MTOK;
        if (PHON(1) && IN(pb + 0)) { LAUNDER(); for (int rep_ = 0; rep_ < REPS(1); ++rep_) { if (rep_) { VM_WAIT(); __syncthreads(); } phase_norm1(F, args, layer, layer > 0 && rep_ == 0); } }
        SEAM(pb + 0);
        if (PHON(2) && IN(pb + 1)) { LAUNDER(); for (int rep_ = 0; rep_ < REPS(2); ++rep_) { if (rep_) { VM_WAIT(); __syncthreads(); }
            pg8::DenseOrder S; S.init(MTOK, INC, F.G, (int)blockIdx.x, D, 0);
            pg8::EpiIn E{(bf16_t*)(ws + WS_Z), (const float*)(ws + WS_LB) + (size_t)layer * 2 * 1024, ws + WS_G8};
            pg8::gemm_phase<pg8::EpiIn, pg8::DenseOrder, true>(F.lds, ws + WS_H, D, ws + WS_WIN + (size_t)layer * INC * D, D, D, S, E);
        } }
        SEAM(pb + 1);
        if (PHON(3) && IN(pb + 2)) { LAUNDER(); for (int rep_ = 0; rep_ < REPS(3); ++rep_) { if (rep_) { VM_WAIT(); __syncthreads(); } phase_pooldiff(F, Mr); __syncthreads(); } { VM_WAIT(); __syncthreads(); phase_scan_mfma(F); GRID_BAR(); LAUNDER(); phase_scan_fix(F); } }
        SEAM(pb + 2);
        if (PHON(4) && IN(pb + 3)) { LAUNDER(); for (int rep_ = 0; rep_ < REPS(4); ++rep_) { if (rep_) { VM_WAIT(); __syncthreads(); }
            pg8::DenseOrder S; S.init(Mr, DPOOL, F.G, (int)blockIdx.x, DPOOL * 2, 512);
            pg8::EpiPool E{(bf16_t*)(ws + WS_P), args.in[I_PSCALE] + (size_t)layer * DPOOL};
            pg8::gemm_phase(F.lds, ws + WS_PD, DPOOL * 2, ws + WS_WPG + (size_t)layer * 1024 * 256 * 2, 512, 512, S, E);
        } }
        if (PHON(4) && IN(pb + 3)) { VM_WAIT(); __syncthreads(); }
        if (PHON(5) && IN(pb + 4)) { LAUNDER(); for (int rep_ = 0; rep_ < REPS(5); ++rep_) { if (rep_) { VM_WAIT(); __syncthreads(); } phase_readout_naive(F, args, layer, Mr); } }
        SEAM(pb + 4);
        if (PHON(6) && IN(pb + 5)) { LAUNDER(); for (int rep_ = 0; rep_ < REPS(6); ++rep_) { if (rep_) { VM_WAIT(); __syncthreads(); }
            pg8::DenseOrder S; S.init(Mr, D, F.G, (int)blockIdx.x, 1024, 0);
            { pg8::EpiGate2 E{ws + WS_MX, ws + WS_G8, 0, ZC_GH - ZC_GP, HG8_SCALE, 1.f / (W8_SCALE * HG8_SCALE * 255.f)};
              pg8::gemm_phase<pg8::EpiGate2, pg8::DenseOrder, true, true>(F.lds, ws + WS_P, 1024, ws + WS_WBP + (size_t)layer * D * 1024, 2048, 1024, S, E,
                  (long)WS_HG - (long)WS_P - 8 * 128, (long)WS_WBH - (long)WS_WBP - 8 * 128, 8); }
            if (rep_ == 0) { int rk, nn; idle_rank((Mr / 256) * 8, F.G, (int)blockIdx.x, rk, nn); convert_range(F, args, layer + 1, 0, 36000, rk, nn); }
        } }
        SEAM(pb + 5);
        if (PHON(7) && IN(pb + 6)) { LAUNDER(); for (int rep_ = 0; rep_ < REPS(7); ++rep_) { if (rep_) { VM_WAIT(); __syncthreads(); }
            pg8::DenseOrder S; S.init(Mr, D, F.G, (int)blockIdx.x, D, 0);
            pg8::EpiOut E{(bf16_t*)(ws + (rep_ ? WS_O2 : WS_X)), layer == 0 ? (const void*)args.in[I_X] : (const void*)(ws + WS_X), layer == 0 ? (const void*)args.in[I_CTX] : (const void*)(ws + WS_X), layer == 0, (const float*)(ws + WS_MOD) + (size_t)layer * 5 * 6 * D, 1.f / W8_SCALE};
            pg8::gemm_phase<pg8::EpiOut, pg8::DenseOrder, true>(F.lds, ws + WS_MX, D, ws + WS_WOUT + (size_t)layer * D * D, D, D, S, E);
            if (rep_ == 0) { int rk, nn; idle_rank((Mr / 256) * 8, F.G, (int)blockIdx.x, rk, nn); convert_range(F, args, layer + 1, 36000, 52000, rk, nn); }
        } }
        SEAM(pb + 6);
        if (PHON(8) && IN(pb + 7)) { LAUNDER(); for (int rep_ = 0; rep_ < REPS(8); ++rep_) { if (rep_) { VM_WAIT(); __syncthreads(); } phase_norm2_router(F, args, layer, Mr, rep_ == 0); } }
        SEAM(pb + 7);
        if (PHON(9) && IN(pb + 8)) { LAUNDER(); for (int rep_ = 0; rep_ < REPS(9); ++rep_) { if (rep_) { VM_WAIT(); __syncthreads(); }
            const int nblk = moe_tables(F, layer);
            pg8::MoeOrder<true> S; S.nN = 4; S.nunits = nblk * 4; S.G = F.G; S.c = (int)blockIdx.x; S.lda_b = D; S.tbl = (const LAS int*)(F.lds + LDS_MISC + 64);
            S.slottok = (const int*)(ws + WS_SLOTTOK); S.b_estride = (size_t)1024 * D;
            pg8::EpiMoe1 E{(bf16_t*)(ws + WS_ACT)};
            pg8::gemm_phase<pg8::EpiMoe1, pg8::MoeOrder<true>, true>(F.lds, ws + WS_H, D, ws + WS_WE13 + (size_t)layer * NEXP * 1024 * D, D, D, S, E);
            if (rep_ == 0) { int rk, nn; idle_rank(nblk * 4, F.G, (int)blockIdx.x, rk, nn); convert_range(F, args, layer + 1, 52000, 70000, rk, nn); }
        } }
        SEAM(pb + 8);
        if (PHON(10) && IN(pb + 9)) { LAUNDER(); for (int rep_ = 0; rep_ < REPS(10); ++rep_) { if (rep_) { VM_WAIT(); __syncthreads(); }
            const int nblk = moe_tables(F, layer);
            pg8::MoeOrder<false> S; S.nN = 8; S.nunits = nblk * 8; S.G = F.G; S.c = (int)blockIdx.x; S.lda_b = DEXP; S.tbl = (const LAS int*)(F.lds + LDS_MISC + 64);
            S.slottok = nullptr; S.b_estride = (size_t)D * DEXP;
            pg8::EpiPlain E{(bf16_t*)(ws + WS_Y2), D, 1.f / (W8_SCALE * ACT8_SCALE)};
            pg8::gemm_phase<pg8::EpiPlain, pg8::MoeOrder<false>, true>(F.lds, ws + WS_ACT, DEXP, ws + WS_WE2 + (size_t)layer * NEXP * D * DEXP, DEXP, DEXP, S, E);
            if (rep_ == 0) { int rk, nn; idle_rank(nblk * 8, F.G, (int)blockIdx.x, rk, nn); convert_range(F, args, layer + 1, 70000, CONV_ITEMS, rk, nn); }
        } }
        SEAM(pb + 9);
    }
    if (PHON(11) && IN(N_PHASES - 1)) { LAUNDER(); for (int rep_ = 0; rep_ < REPS(11); ++rep_) { if (rep_) { VM_WAIT(); __syncthreads(); } phase_final(F, args); } }
#undef IN
#undef SEAM
}

extern "C" void kernel_launch(void* const* d_in, const int* in_sizes, int n_in, void* d_out, int out_size, void* d_ws, size_t ws_size, hipStream_t stream) {
    static int grid = 0;
    if (grid == 0) {
        if (n_in != 22 || out_size != NLAT * D || ws_size < WS_END) { fprintf(stderr, "kernel_launch: unexpected shapes (n_in %d out %d ws %zu need %zu)\n", n_in, out_size, ws_size, (size_t)WS_END); grid = -1; return; }
        int dev = 0, cus = 0, per_cu = 0;
        if (hipGetDevice(&dev) != hipSuccess || hipDeviceGetAttribute(&cus, hipDeviceAttributeMultiprocessorCount, dev) != hipSuccess) { grid = -1; return; }
        if (hipFuncSetAttribute((const void*)mk_fwd, hipFuncAttributeMaxDynamicSharedMemorySize, LDS_BYTES) != hipSuccess) { fprintf(stderr, "kernel_launch: hipFuncSetAttribute failed\n"); grid = -1; return; }
        if (hipOccupancyMaxActiveBlocksPerMultiprocessor(&per_cu, (const void*)mk_fwd, 512, LDS_BYTES) != hipSuccess || per_cu < 1) fprintf(stderr, "kernel_launch: occupancy query says %d\n", per_cu);
        (void)hipGetLastError();
        grid = cus;
    }
    if (grid < 0) return;
    (void)hipMemsetAsync((char*)d_ws + WS_CTL, 0, CTL_BYTES, stream);
    Args a{};
    for (int i = 0; i < 22; ++i) a.in[i] = (const float*)d_in[i];
    a.out = (float*)d_out; a.ws = (unsigned char*)d_ws; a.rep = MK_REPMASK; a.pad = 0;
#if MK_ONE_LAUNCH
    a.ph_lo = 0; a.ph_hi = N_PHASES;
    hipLaunchKernelGGL(mk_fwd, dim3(grid), dim3(512), LDS_BYTES, stream, a);
#else
    for (int p = 0; p < N_PHASES; ++p) { a.ph_lo = p; a.ph_hi = p + 1; hipLaunchKernelGGL(mk_fwd, dim3(grid), dim3(512), LDS_BYTES, stream, a); }
#endif
}
```

```cpp
#include <hip/hip_runtime.h>
#include <cstdio>
#include <cstdint>

#ifndef MK_ONE_LAUNCH
#define MK_ONE_LAUNCH 1
#endif

constexpr int D = 2048, NBATCH = 4, SEQ = 4096, DEPTH = 4, CTXL = 256;
constexpr int NLAT = NBATCH * SEQ, NCTX = NBATCH * CTXL, MTOK = NLAT + NCTX;
constexpr int DPOOL = 1024, HGW = 1024, NHEAD = 8, HDK = 128;
constexpr int INC = 10240;
constexpr int NEXP = 16, DEXP = 512;
constexpr int MAXSLOT = 38912;
constexpr float EPS = 1e-6f;
constexpr int ZC_POOL = 0, ZC_Q = 1024, ZC_FF = 2048, ZC_FB = 3072, ZC_I = 4096, ZC_OG = 5120, ZC_GP = 6144, ZC_GH = 8192;

#define GAS __attribute__((address_space(1)))
#define LAS __attribute__((address_space(3)))
typedef unsigned short bf16_t;
typedef short bf16x8 __attribute__((ext_vector_type(8)));
typedef float f32x4 __attribute__((ext_vector_type(4)));
typedef float f32x2 __attribute__((ext_vector_type(2)));
typedef unsigned u32x4 __attribute__((ext_vector_type(4)));
typedef unsigned u32x2 __attribute__((ext_vector_type(2)));
typedef int i32x4 __attribute__((ext_vector_type(4)));
typedef int i32x8 __attribute__((ext_vector_type(8)));
constexpr float W8_SCALE = 32.f;

constexpr size_t MiB = 1u << 20;
constexpr size_t align_up(size_t x) { return (x + 255) & ~(size_t)255; }
constexpr size_t WS_CTL = 0, CTL_BYTES = 1 * MiB;
constexpr size_t WS_MOD = WS_CTL + CTL_BYTES;
constexpr size_t WS_LB = WS_MOD + align_up((size_t)DEPTH * 5 * 6 * D * 4);
constexpr size_t WS_ROUTE_I = WS_LB + align_up((size_t)DEPTH * 2 * 1024 * 4);
constexpr size_t WS_ROUTE_G = WS_ROUTE_I + align_up((size_t)MTOK * 8);
constexpr size_t WS_SLOTTOK = WS_ROUTE_G + align_up((size_t)MTOK * 8);
constexpr size_t WS_PADBASE = WS_SLOTTOK + align_up((size_t)NEXP * MTOK * 4);
constexpr size_t WS_WIN = WS_PADBASE + align_up((size_t)DEPTH * 16 * 4);
constexpr size_t WS_WPG = WS_WIN + (size_t)DEPTH * INC * D * 2;
constexpr size_t WS_WBP = WS_WPG + (size_t)DEPTH * 1024 * 256 * 2;
constexpr size_t WS_WBH = WS_WBP + (size_t)DEPTH * D * 1024 * 2;
constexpr size_t WS_WOUT = WS_WBH + (size_t)DEPTH * D * 1024 * 2;
constexpr size_t WS_WE13 = WS_WOUT + (size_t)DEPTH * D * D * 2;
constexpr size_t WS_WE2 = WS_WE13 + (size_t)DEPTH * NEXP * 1024 * D * 2;
constexpr size_t WS_X = WS_WE2 + (size_t)DEPTH * NEXP * D * DEXP * 2;
constexpr size_t WS_H = WS_X + (size_t)MTOK * D * 4;
constexpr size_t WS_Z = WS_H + (size_t)MTOK * D * 2;
constexpr size_t WS_ACT = WS_Z;
constexpr size_t WS_Y2 = WS_ACT + (size_t)MAXSLOT * DEXP * 2;
constexpr size_t WS_PD = WS_Z + (size_t)MTOK * INC * 2;
constexpr size_t WS_P = WS_PD + (size_t)MTOK * 1024 * 2;
constexpr size_t WS_HG = WS_P + (size_t)MTOK * 1024 * 2;
constexpr size_t WS_O2 = WS_HG + (size_t)MTOK * 1024 * 2;
constexpr size_t WS_QSG = WS_O2 + (size_t)2 * MTOK * 1024 * 2;
constexpr size_t WS_SMID = WS_QSG + (size_t)64 * 3 * 17 * 17408;
constexpr size_t WS_CORRV = WS_SMID + (size_t)64 * 3 * 128 * 128 * 4;
constexpr size_t WS_TOTSEG = WS_CORRV + (size_t)64 * 3 * 17 * 128 * 4;
static_assert(WS_TOTSEG + (size_t)64 * 4 * 128 * 4 <= WS_O2 + (size_t)2 * MTOK * 1024 * 4, "scan hand-off buffers fit in the O2 region");
constexpr size_t WS_M1 = WS_O2 + (size_t)2 * MTOK * 1024 * 4;
constexpr size_t WS_MX = WS_M1 + (size_t)MTOK * D * 2;
constexpr size_t WS_G8 = WS_M1;
constexpr size_t WS_END = WS_MX + (size_t)MTOK * D * 2;
static_assert(WS_Y2 + (size_t)MAXSLOT * D * 2 <= WS_PD, "ACT|Y2 overlay fits in Z");

constexpr int CW_BAR = 4096;
constexpr int CW_CNT = 16384;

constexpr int LDS_STAGE = 131072;
constexpr int LDS_MISC = 149504;
constexpr int LDS_BYTES = LDS_MISC + 8192;

__device__ __forceinline__ unsigned f2bf(float f) { unsigned u = __builtin_bit_cast(unsigned, f); return (u + 0x7fffu + ((u >> 16) & 1u)) >> 16; }
typedef __bf16 bf16x2_t __attribute__((ext_vector_type(2)));
__device__ __forceinline__ unsigned pk2(float lo, float hi) { const f32x2 v = {lo, hi}; const bf16x2_t b = __builtin_convertvector(v, bf16x2_t); return __builtin_bit_cast(unsigned, b); }
__device__ __forceinline__ float bflo(unsigned w) { return __builtin_bit_cast(float, w << 16); }
__device__ __forceinline__ float bfhi(unsigned w) { return __builtin_bit_cast(float, w & 0xffff0000u); }
__device__ __forceinline__ float bf1(bf16_t h) { return __builtin_bit_cast(float, ((unsigned)h) << 16); }
__device__ __forceinline__ float fsigmoid(float x) { return __builtin_amdgcn_rcpf(1.f + __builtin_amdgcn_exp2f(-1.44269504f * x)); }
__device__ __forceinline__ float fsilu(float x) { return x * fsigmoid(x); }
__device__ __forceinline__ float lane_xor(float v, int o, int lane) { return __builtin_bit_cast(float, __builtin_amdgcn_ds_bpermute((lane ^ o) << 2, __builtin_bit_cast(int, v))); }
#define LDS_WAIT() asm volatile("s_waitcnt lgkmcnt(0)" ::: "memory")
#define VM_WAIT() asm volatile("s_waitcnt vmcnt(0)" ::: "memory")

__device__ __forceinline__ unsigned pk4_fp8(float a, float b, float c, float d) { int w = 0; w = __builtin_amdgcn_cvt_pk_fp8_f32(a, b, w, false); w = __builtin_amdgcn_cvt_pk_fp8_f32(c, d, w, true); return (unsigned)w; }
constexpr float Y8_SCALE = 16.f;
constexpr float HG8_SCALE = 4.f, ACT8_SCALE = 4.f;
#define XB_TMO      128
#define XB_XCNT(j)  (256  + 64 * (j))
#define XB_XSUB(j)  (1280 + 64 * (j))
#define XB_XGEN(j)  (2304 + 64 * (j))
#define XB_TOP      3328
#define XB_TOPGEN   3392
#define XCD_BAR_WORDS 3456
#define XB_SPIN_CAP (1u << 18)
__device__ __forceinline__ unsigned xb_ld(unsigned* p)              { return __hip_atomic_load(p, __ATOMIC_RELAXED, __HIP_MEMORY_SCOPE_AGENT); }
__device__ __forceinline__ unsigned xb_add(unsigned* p, unsigned v) { return __hip_atomic_fetch_add(p, v, __ATOMIC_RELAXED, __HIP_MEMORY_SCOPE_AGENT); }
__device__ __forceinline__ unsigned xb_xcc_id() { return (unsigned)__builtin_amdgcn_s_getreg((3 << 11) | 20) & 0xFu; }
#define XB_SPIN(cond, bar) do { unsigned _sp = 0; while (cond) { __builtin_amdgcn_s_sleep(1); \
    if ((++_sp & 255u) == 0u) { if (xb_ld(&(bar)[XB_TMO])) break; if (_sp > XB_SPIN_CAP) { atomicAdd(&(bar)[XB_TMO], 1u); break; } } } } while (0)
struct XcdBarrier { unsigned* bar; unsigned x; volatile LAS unsigned* st; };
__device__ __forceinline__ XcdBarrier xcd_barrier_post(unsigned* bar, volatile LAS unsigned* st) {
    XcdBarrier b; b.bar = bar; b.x = xb_xcc_id(); b.st = st;
    if (threadIdx.x == 0) (void)xb_add(&bar[XB_XCNT(b.x)], 1u);
    return b;
}
__device__ __forceinline__ void xcd_barrier_complete(unsigned* bar, unsigned x, unsigned& nloc, unsigned& nx) {
    const unsigned G = gridDim.x * gridDim.y * gridDim.z;
    unsigned sum, cnt, mine, sp = 0u;
    for (;;) {
        sum = 0u; cnt = 0u; mine = 0u;
#pragma unroll
        for (unsigned j = 0; j < 16; ++j) { const unsigned c = xb_ld(&bar[XB_XCNT(j)]); sum += c; cnt += (c > 0u) ? 1u : 0u; mine = (j == x) ? c : mine; }
        if (sum == G) break;
        __builtin_amdgcn_s_sleep(1);
        if ((++sp & 255u) == 0u) { if (xb_ld(&bar[XB_TMO])) break; if (sp > XB_SPIN_CAP) { atomicAdd(&bar[XB_TMO], 1u); break; } }
    }
    nloc = mine > 0u ? mine : 1u; nx = cnt > 0u ? cnt : 1u;
}
__device__ __forceinline__ void xcd_barrier(const XcdBarrier& b) {
    asm volatile("s_waitcnt vmcnt(0)" ::: "memory");
    __syncthreads();
    if (threadIdx.x == 0) {
        unsigned* bar = b.bar;
        __builtin_amdgcn_s_waitcnt(0);
        unsigned nloc = b.st[0], nx = b.st[1];
        if (nloc == 0u) { xcd_barrier_complete(bar, b.x, nloc, nx); b.st[0] = nloc; b.st[1] = nx; }
        const unsigned old = xb_add(&bar[XB_XSUB(b.x)], 1u);
        const unsigned gen = old / nloc;
        if (old + 1u == (gen + 1u) * nloc) {
            __builtin_amdgcn_fence(__ATOMIC_RELEASE, "agent");
            asm volatile("s_waitcnt vmcnt(0)" ::: "memory");
            const unsigned og = xb_add(&bar[XB_TOP], 1u);
            const unsigned tg = og / nx;
            if (og + 1u == (tg + 1u) * nx) xb_add(&bar[XB_TOPGEN], 1u);
            else XB_SPIN(xb_ld(&bar[XB_TOPGEN]) == tg, bar);
            __builtin_amdgcn_fence(__ATOMIC_ACQUIRE, "agent");
            xb_add(&bar[XB_XGEN(b.x)], 1u);
            asm volatile("s_waitcnt vmcnt(0)" ::: "memory");
        } else {
            XB_SPIN(xb_ld(&bar[XB_XGEN(b.x)]) == gen, bar);
            __builtin_amdgcn_fence(__ATOMIC_ACQUIRE, "agent");
            asm volatile("s_waitcnt vmcnt(0)" ::: "memory");
        }
    }
    __syncthreads();
}

namespace pg8 {
constexpr int BM = 256, BK = 64, HALF = 128, HTB = HALF * BK * 2, NXCD = 8, WGM = 8;
__host__ __device__ __forceinline__ int lds_byte(int r, int c) { const int st = (r >> 4) * 2 + (c >> 5), rr = r & 15, cc = c & 31, ob = rr * 64 + cc * 2; return st * 1024 + (ob ^ (((ob >> 9) & 1) << 5)); }
__host__ __device__ __forceinline__ void stage_rc(int b, int& R, int& C) { const int st = b / 1024, sb = b % 1024, swz = sb ^ (((sb >> 9) & 1) << 5); R = (st >> 1) * 16 + swz / 64; C = (st & 1) * 32 + (swz % 64) / 2; }
__host__ __device__ __forceinline__ int perm32(int rho) { const int n = rho >> 4, i = rho & 15; return 8 * (i >> 2) + 4 * n + (i & 3); }

struct Unit { int pm, pn; };

struct DenseOrder {
    static constexpr bool GATHER = false;
    int nM, nN, nwg, G, c, lda_b, acol_b;
    __device__ void init(int M, int N, int G_, int c_, int lda_b_, int acol_b_) { nM = M / BM; nN = N / BM; nwg = nM * nN; G = G_; c = c_; lda_b = lda_b_; acol_b = acol_b_; }
    __device__ __forceinline__ bool next(int i, Unit& u) const {
        const long L = (long)i * G + c; if (L >= nwg) return false;
        int wgid = (int)L; { const int q = nwg / NXCD, r = nwg % NXCD, xcd = wgid % NXCD, off = wgid / NXCD; wgid = (xcd < r ? xcd * (q + 1) : r * (q + 1) + (xcd - r) * q) + off; }
        const int nig = WGM * nN, gid = wgid / nig, fm = gid * WGM, gsz = (nM - fm) < WGM ? (nM - fm) : WGM;
        u.pm = fm + ((wgid % nig) % gsz); u.pn = (wgid % nig) / gsz; return true;
    }
    __device__ __forceinline__ size_t a_base(const Unit& u) const { return (size_t)u.pm * BM * lda_b + (size_t)u.pn * acol_b; }
    __device__ __forceinline__ void a_offs(const Unit&, unsigned (&)[2][2]) const {}
    __device__ __forceinline__ size_t b_off(const Unit& u, int ldb_b) const { return (size_t)u.pn * BM * ldb_b; }
};
template <bool GATHER_> struct MoeOrder {
    static constexpr bool GATHER = GATHER_;
    int nN, nunits, G, c, lda_b; const LAS int* tbl;
    const int* slottok; size_t b_estride;
    __device__ __forceinline__ bool next(int i, Unit& u) const {
        const int L = i * G + c; if (L >= nunits) return false;
        u.pm = L / nN; u.pn = L % nN; return true;
    }
    __device__ __forceinline__ size_t a_base(const Unit& u) const { return (size_t)u.pm * BM * lda_b; }
    __device__ __forceinline__ void a_offs(const Unit& u, unsigned (&v)[2][2]) const {
        const int e = __builtin_amdgcn_readfirstlane(tbl[64 + u.pm]), j0 = __builtin_amdgcn_readfirstlane((u.pm - tbl[16 + e]) * BM), cnt = __builtin_amdgcn_readfirstlane(tbl[e]);
#pragma unroll
        for (int i = 0; i < 2; ++i) { int R, C; stage_rc((int)threadIdx.x * 16 + i * 8192, R, C);
#pragma unroll
            for (int h = 0; h < 2; ++h) { const int j = j0 + h * HALF + R; const int tok = (j < cnt) ? slottok[(size_t)e * MTOK + j] : 0; v[h][i] = (unsigned)(tok * lda_b + C * 2); } }
    }
    __device__ __forceinline__ size_t b_off(const Unit& u, int ldb_b) const { const int e = __builtin_amdgcn_readfirstlane(tbl[64 + u.pm]); return (size_t)e * b_estride + (size_t)u.pn * BM * ldb_b; }
};

template <class Epi, class Sched, bool FP8 = false, bool SPLIT = false>
__device__ __forceinline__ void gemm_phase(LAS unsigned char* lds, const void* Abase, const int lda_b, const void* Bbase, const int Kb, const int ldb_b, const Sched& S, const Epi& E, const long dA = 0, const long dB = 0, const int nt1 = 0) {
    constexpr bool GA = Sched::GATHER;
    int tid_ = threadIdx.x; asm volatile("" : "+v"(tid_));
    const int tid = tid_, wid = __builtin_amdgcn_readfirstlane(tid >> 6), lane = tid & 63, wr = wid >> 2, wc = wid & 3, fr = lane & 15, fq = lane >> 4;
    const int nt = Kb / 128;
    unsigned voffA[2], voffB[2];
#pragma unroll
    for (int i = 0; i < 2; ++i) { int R, C; stage_rc(tid * 16 + i * 8192, R, C); const int Rb = Epi::PERM ? ((R & ~31) + perm32(R & 31)) : R; voffA[i] = (unsigned)(R * lda_b + C * 2); voffB[i] = (unsigned)(Rb * ldb_b + C * 2); }
    const size_t kstep = (size_t)(BK * 2);
    const size_t hstepA = (size_t)HALF * lda_b, hstepB = (size_t)HALF * ldb_b;
    const unsigned ldsw = (unsigned)wid * 1024u;
    const int aoff = lds_byte(wr * 64 + fr, fq * 8), boff = lds_byte(wc * 32 + fr, fq * 8);
#define PG8_SA(b, h) (((b) * 2 + (h)) * HTB)
#define PG8_SB(b, h) ((4 + (b) * 2 + (h)) * HTB)
#define PG8_STAGE2(bufoff, gbase, o0, o1) do { \
        __builtin_amdgcn_global_load_lds((const unsigned*)((const char*)(gbase) + (o0)), (LAS unsigned*)(lds + (bufoff) + ldsw), 16, 0, 0); \
        __builtin_amdgcn_global_load_lds((const unsigned*)((const char*)(gbase) + (o1)), (LAS unsigned*)(lds + (bufoff) + ldsw + 8192), 16, 0, 0); } while (0)
#define PG8_STAGEB(bufoff, gbase) PG8_STAGE2(bufoff, gbase, voffB[0], voffB[1])
#define PG8_STAGEA(bufoff, gbase, h, x0, x1) do { if constexpr (GA) PG8_STAGE2(bufoff, gbase, x0, x1); else PG8_STAGE2(bufoff, (gbase) + ((h) ? hstepA : (size_t)0), voffA[0], voffA[1]); } while (0)
#define PG8_LD32(dst, addr) do { const i32x4 lo_ = *(const LAS i32x4*)(lds + (addr)), hi_ = *(const LAS i32x4*)(lds + (addr) + 1024); dst = (i32x8){lo_[0], lo_[1], lo_[2], lo_[3], hi_[0], hi_[1], hi_[2], hi_[3]}; } while (0)
#define PG8_LDA(dst, b, h) do { _Pragma("unroll") for (int m = 0; m < 4; ++m) PG8_LD32(dst[m], PG8_SA(b, h) + aoff + m * 2048); } while (0)
#define PG8_LDB(dst, b, h) do { _Pragma("unroll") for (int n = 0; n < 2; ++n) PG8_LD32(dst[n], PG8_SB(b, h) + boff + n * 2048); } while (0)
#define PG8_HALF(v, k) __builtin_bit_cast(bf16x8, (i32x4){(v)[4 * (k)], (v)[4 * (k) + 1], (v)[4 * (k) + 2], (v)[4 * (k) + 3]})
#define PG8_MMA(ai, bj, At, Bt) do { __builtin_amdgcn_s_setprio(1); \
        if constexpr (FP8) { _Pragma("unroll") for (int m = 0; m < 4; ++m) _Pragma("unroll") for (int n = 0; n < 2; ++n) \
            asm volatile("v_mfma_scale_f32_16x16x128_f8f6f4 %0, %1, %2, %0, %3, %3 op_sel_hi:[0,0,0]" : "+v"(acc[ai][bj][m][n]) : "v"(Bt[n]), "v"(At[m]), "v"(one_scale)); } \
        else { _Pragma("unroll") for (int m = 0; m < 4; ++m) _Pragma("unroll") for (int n = 0; n < 2; ++n) _Pragma("unroll") for (int k = 0; k < 2; ++k) \
            acc[ai][bj][m][n] = __builtin_amdgcn_mfma_f32_16x16x32_bf16(PG8_HALF(Bt[n], k), PG8_HALF(At[m], k), acc[ai][bj][m][n], 0, 0, 0); } \
        __builtin_amdgcn_s_setprio(0); } while (0)
#define PG8_WAIT_V(n) asm volatile("s_waitcnt vmcnt(" #n ")" ::: "memory")
#define PG8_WAIT_L(n) asm volatile("s_waitcnt lgkmcnt(" #n ")" ::: "memory")
#define PG8_BAR __builtin_amdgcn_s_barrier()
#define PG8_SCHED __builtin_amdgcn_sched_barrier(0)
    Unit cur, nxt; int ui = 0;
    if (!S.next(0, cur)) return;
    f32x4 acc[2][2][4][2];
#pragma unroll
    for (int a = 0; a < 2; ++a)
#pragma unroll
        for (int b = 0; b < 2; ++b)
#pragma unroll
            for (int m = 0; m < 4; ++m)
#pragma unroll
                for (int n = 0; n < 2; ++n) acc[a][b][m][n] = (f32x4){0.f, 0.f, 0.f, 0.f};
    int one_scale = 0; if constexpr (FP8) asm volatile("v_mov_b32 %0, 0x7f7f7f7f" : "=v"(one_scale));
    i32x8 At[4], B0[2], B1[2];
    unsigned vA[2][2];
    if constexpr (GA) S.a_offs(cur, vA);
    const char* cA = (const char*)Abase + (GA ? (size_t)0 : S.a_base(cur));
    const char* cB = (const char*)Bbase + S.b_off(cur, ldb_b);
    PG8_STAGEB(PG8_SB(0, 0), cB); PG8_STAGEB(PG8_SB(0, 1), cB + hstepB); PG8_STAGEA(PG8_SA(0, 0), cA, 0, vA[0][0], vA[0][1]); PG8_STAGEA(PG8_SA(0, 1), cA, 1, vA[1][0], vA[1][1]);
    if (wr == 1) PG8_BAR;
    PG8_WAIT_V(2); PG8_BAR;
    PG8_STAGEB(PG8_SB(1, 0), cB + kstep); PG8_STAGEA(PG8_SA(1, 0), cA + kstep, 0, vA[0][0], vA[0][1]); PG8_STAGEB(PG8_SB(1, 1), cB + hstepB + kstep);
    PG8_WAIT_V(6); PG8_BAR;
    for (;;) {
        const bool has_next = S.next(ui + 1, nxt);
        const char* nA = (has_next && !GA) ? (const char*)Abase + S.a_base(nxt) : cA;
        const char* nB = has_next ? (const char*)Bbase + S.b_off(nxt, ldb_b) : cB;
_Pragma("nounroll")
        for (int t = 0; t < nt; t += 2) {
            const bool last = (t == nt - 2);
            const long sA1 = (SPLIT && t >= nt1) ? dA : 0, sA2 = (SPLIT && t + 2 >= nt1) ? dA : 0, sB2 = (SPLIT && t + 2 >= nt1) ? dB : 0;
            if constexpr (SPLIT) { if (t == nt1) { asm volatile("s_nop 15\n\ts_nop 15" ::: "memory"); int t3_ = threadIdx.x; asm volatile("" : "+v"(t3_)); const int l3_ = t3_ & 63; E.mid(acc, cur, wr, wc, l3_ & 15, l3_ >> 4); } }
            const char* a1 = cA + (size_t)(t + 1) * kstep + sA1;
            const char* a2 = last ? nA : cA + (size_t)(t + 2) * kstep + sA2; const char* b2 = last ? nB : cB + (size_t)(t + 2) * kstep + sB2;
            const char* a3 = a2 + kstep; const char* b3 = b2 + kstep;
            PG8_LDB(B0, 0, 0); PG8_LDB(B1, 0, 1); PG8_SCHED; PG8_LDA(At, 0, 0); PG8_STAGEA(PG8_SA(1, 1), a1, 1, vA[1][0], vA[1][1]);
            PG8_WAIT_V(8); PG8_WAIT_L(0); PG8_BAR; PG8_MMA(0, 0, At, B0); PG8_MMA(0, 1, At, B1); PG8_BAR; PG8_SCHED;
            if constexpr (GA) { if (last && has_next) S.a_offs(nxt, vA); }
            PG8_LDA(At, 0, 1); PG8_STAGEB(PG8_SB(0, 0), b2); PG8_STAGEB(PG8_SB(0, 1), b2 + hstepB); PG8_STAGEA(PG8_SA(0, 0), a2, 0, vA[0][0], vA[0][1]);
            PG8_WAIT_V(8); PG8_WAIT_L(0); PG8_BAR; PG8_MMA(1, 0, At, B0); PG8_MMA(1, 1, At, B1); PG8_BAR; PG8_SCHED;
            PG8_LDB(B0, 1, 0); PG8_LDB(B1, 1, 1); PG8_SCHED; PG8_LDA(At, 1, 0); PG8_STAGEA(PG8_SA(0, 1), a2, 1, vA[1][0], vA[1][1]);
            PG8_WAIT_V(8); PG8_WAIT_L(0); PG8_BAR; PG8_MMA(0, 0, At, B0); PG8_MMA(0, 1, At, B1); PG8_BAR; PG8_SCHED;
            PG8_LDA(At, 1, 1); PG8_STAGEB(PG8_SB(1, 0), b3); PG8_STAGEB(PG8_SB(1, 1), b3 + hstepB); PG8_STAGEA(PG8_SA(1, 0), a3, 0, vA[0][0], vA[0][1]);
            PG8_WAIT_V(8); PG8_WAIT_L(0); PG8_BAR; PG8_MMA(1, 0, At, B0); PG8_MMA(1, 1, At, B1); PG8_BAR; PG8_SCHED;
        }
        if constexpr (FP8) asm volatile("s_nop 15\n\ts_nop 15" ::: "memory");
        if (wr == 0) PG8_BAR;
        { int t2_ = threadIdx.x; asm volatile("" : "+v"(t2_)); const int l2_ = t2_ & 63; E(acc, cur, wr, wc, l2_ & 15, l2_ >> 4); }
        if (!has_next) break;
#pragma unroll
        for (int a = 0; a < 2; ++a)
#pragma unroll
            for (int b = 0; b < 2; ++b)
#pragma unroll
                for (int m = 0; m < 4; ++m)
#pragma unroll
                    for (int n = 0; n < 2; ++n) acc[a][b][m][n] = (f32x4){0.f, 0.f, 0.f, 0.f};
        cur = nxt; cA = nA; cB = nB; ++ui;
        if (wr == 1) PG8_BAR;
    }
    PG8_WAIT_V(0);
    PG8_BAR;
#undef PG8_SA
#undef PG8_SB
#undef PG8_STAGE2
#undef PG8_STAGEB
#undef PG8_STAGEA
#undef PG8_LDA
#undef PG8_LD32
#undef PG8_HALF
#undef PG8_LDB
#undef PG8_MMA
#undef PG8_WAIT_V
#undef PG8_WAIT_L
#undef PG8_BAR
#undef PG8_SCHED
}

typedef const f32x4 (&AccRef)[2][2][4][2];
__device__ __forceinline__ u32x4 pack8(const f32x4 v0, const f32x4 v1) { u32x4 w; w.x = pk2(v0[0], v0[1]); w.y = pk2(v0[2], v0[3]); w.z = pk2(v1[0], v1[1]); w.w = pk2(v1[2], v1[3]); return w; }
__device__ __forceinline__ void unpack8(const u32x4 w, f32x4& v0, f32x4& v1) { v0 = (f32x4){bflo(w.x), bfhi(w.x), bflo(w.y), bfhi(w.y)}; v1 = (f32x4){bflo(w.z), bfhi(w.z), bflo(w.w), bfhi(w.w)}; }

struct EpiIn {
    static constexpr bool PERM = true;
    bf16_t* Z; const float* lb; unsigned char* G8;
    __device__ __forceinline__ void operator()(AccRef acc, const Unit& u, int wr, int wc, int fr, int fq) const {
        constexpr float KS = 1.f / W8_SCALE, KE = -1.44269504f / W8_SCALE;
        const int row0 = u.pm * BM + wr * 64 + fr, colt = u.pn * BM, seg = colt >> 10, col0 = colt + wc * 32 + 8 * fq;
        const int mode = (seg == 0 || seg == 4) ? 0 : (seg == 1 || seg == 5) ? 1 : (seg == 2 || seg == 3) ? 2 : 3;
#pragma unroll
        for (int bj = 0; bj < 2; ++bj) {
            f32x4 l0 = (f32x4){0.f, 0.f, 0.f, 0.f}, l1 = l0;
            if (mode == 2) { l0 = *(const f32x4*)(lb + (col0 + bj * HALF - ZC_FF)); l1 = *(const f32x4*)(lb + (col0 + bj * HALF + 4 - ZC_FF)); }
#pragma unroll
            for (int ai = 0; ai < 2; ++ai)
#pragma unroll
                for (int m = 0; m < 4; ++m) { bf16_t* rowp = Z + (size_t)(row0 + ai * HALF + m * 16) * INC + col0 + bj * HALF;
                    f32x4 v0 = acc[ai][bj][m][0], v1 = acc[ai][bj][m][1];
                    if (mode == 0) { v0 = v0 * KS; v1 = v1 * KS; }
                    else { f32x4 s0, s1;
#pragma unroll
                        for (int j = 0; j < 4; ++j) { s0[j] = __builtin_amdgcn_rcpf(1.f + __builtin_amdgcn_exp2f(v0[j] * KE)); s1[j] = __builtin_amdgcn_rcpf(1.f + __builtin_amdgcn_exp2f(v1[j] * KE)); }
                        if (mode == 1) { v0 = v0 * KS * s0; v1 = v1 * KS * s1; }
                        else if (mode == 3) { unsigned w0 = 0u, w1 = 0u;
#pragma unroll
                            for (int j = 0; j < 4; ++j) { w0 = __builtin_amdgcn_cvt_pk_u8_f32(fmaxf(__builtin_rintf(s0[j] * 255.f), 1.f), j, w0); w1 = __builtin_amdgcn_cvt_pk_u8_f32(fmaxf(__builtin_rintf(s1[j] * 255.f), 1.f), j, w1); }
                            u32x2 o; o.x = w0; o.y = w1; *(u32x2*)(G8 + (size_t)(row0 + ai * HALF + m * 16) * 4096 + (col0 + bj * HALF - ZC_GP)) = o;
                            __builtin_amdgcn_sched_barrier(0); continue; }
                        else {
#pragma unroll
                            for (int j = 0; j < 4; ++j) { v0[j] = __builtin_amdgcn_logf(l0[j] + (1.f - l0[j]) * s0[j]); v1[j] = __builtin_amdgcn_logf(l1[j] + (1.f - l1[j]) * s1[j]); } } }
                    *(u32x4*)rowp = pack8(v0, v1);
                    __builtin_amdgcn_sched_barrier(0); } }
    }
};
struct EpiPool {
    static constexpr bool PERM = true;
    bf16_t* P; const float* scale;
    __device__ __forceinline__ void operator()(AccRef acc, const Unit& u, int wr, int wc, int fr, int fq) const {
        const int row0 = u.pm * BM + wr * 64 + fr, col0 = u.pn * BM + wc * 32 + 8 * fq;
        f32x4 sv[2][2];
#pragma unroll
        for (int bj = 0; bj < 2; ++bj)
#pragma unroll
            for (int n = 0; n < 2; ++n) sv[bj][n] = *(const f32x4*)(scale + col0 + bj * HALF + 4 * n);
#pragma unroll
        for (int ai = 0; ai < 2; ++ai)
#pragma unroll
            for (int m = 0; m < 4; ++m) { bf16_t* rowp = P + (size_t)(row0 + ai * HALF + m * 16) * DPOOL + col0;
#pragma unroll
                for (int bj = 0; bj < 2; ++bj) { const f32x4 r0 = acc[ai][bj][m][0] * sv[bj][0], r1 = acc[ai][bj][m][1] * sv[bj][1];
                    u32x2 o; o.x = pk4_fp8(r0[0], r0[1], r0[2], r0[3]); o.y = pk4_fp8(r1[0], r1[1], r1[2], r1[3]); *(u32x2*)((unsigned char*)P + (size_t)(row0 + ai * HALF + m * 16) * DPOOL + col0 + bj * HALF) = o; } }
    }
};
template <bool ADD, bool OUT8 = false> struct EpiGate {
    static constexpr bool PERM = true;
    bf16_t* O; const bf16_t* prev; const bf16_t* Z; int gcol; float ascale;
    __device__ __forceinline__ void operator()(AccRef acc, const Unit& u, int wr, int wc, int fr, int fq) const {
        const int row0 = u.pm * BM + wr * 64 + fr, col0 = u.pn * BM + wc * 32 + 8 * fq;
#pragma unroll
        for (int ai = 0; ai < 2; ++ai)
#pragma unroll
            for (int m = 0; m < 4; ++m) { const size_t row = (size_t)(row0 + ai * HALF + m * 16);
#pragma unroll
                for (int bj = 0; bj < 2; ++bj) {
                    const u32x4 gw = *(const u32x4*)(Z + row * INC + gcol + col0 + bj * HALF); f32x4 g0, g1; unpack8(gw, g0, g1);
                    f32x4 r0 = acc[ai][bj][m][0] * ascale * g0, r1 = acc[ai][bj][m][1] * ascale * g1;
                    if (ADD) { const u32x4 pw = *(const u32x4*)(prev + row * D + col0 + bj * HALF); f32x4 p0, p1; unpack8(pw, p0, p1); r0 += p0; r1 += p1; }
                    if (OUT8) { int w0 = 0, w1 = 0; w0 = __builtin_amdgcn_cvt_pk_fp8_f32(r0[0], r0[1], w0, false); w0 = __builtin_amdgcn_cvt_pk_fp8_f32(r0[2], r0[3], w0, true);
                        w1 = __builtin_amdgcn_cvt_pk_fp8_f32(r1[0], r1[1], w1, false); w1 = __builtin_amdgcn_cvt_pk_fp8_f32(r1[2], r1[3], w1, true);
                        u32x2 o; o.x = (unsigned)w0; o.y = (unsigned)w1; *(u32x2*)((unsigned char*)O + row * D + col0 + bj * HALF) = o; }
                    else *(u32x4*)(O + row * D + col0 + bj * HALF) = pack8(r0, r1); } }
    }
};
struct EpiGate2 {
    static constexpr bool PERM = true; static constexpr int NVM = 16;
    unsigned char* O; const unsigned char* G8; int gcol1, gcol2; float cratio, ascale;
    static __device__ __forceinline__ float ub(unsigned w, int j) { return (float)((w >> (8 * j)) & 0xffu); }
    __device__ __forceinline__ void mid(f32x4 (&acc)[2][2][4][2], const Unit& u, int wr, int wc, int fr, int fq) const {
        const int row0 = u.pm * BM + wr * 64 + fr, col0 = u.pn * BM + wc * 32 + 8 * fq;
#pragma unroll
        for (int ai = 0; ai < 2; ++ai)
#pragma unroll
            for (int m = 0; m < 4; ++m) { const size_t row = (size_t)(row0 + ai * HALF + m * 16);
#pragma unroll
                for (int bj = 0; bj < 2; ++bj) {
                    const u32x2 q1 = *(const u32x2*)(G8 + row * 4096 + gcol1 + col0 + bj * HALF), q2 = *(const u32x2*)(G8 + row * 4096 + gcol2 + col0 + bj * HALF);
#pragma unroll
                    for (int j = 0; j < 4; ++j) { acc[ai][bj][m][0][j] *= cratio * ub(q1.x, j) * __builtin_amdgcn_rcpf(ub(q2.x, j)); acc[ai][bj][m][1][j] *= cratio * ub(q1.y, j) * __builtin_amdgcn_rcpf(ub(q2.y, j)); } }
                }
    }
    __device__ __forceinline__ void operator()(AccRef acc, const Unit& u, int wr, int wc, int fr, int fq) const {
        const int row0 = u.pm * BM + wr * 64 + fr, col0 = u.pn * BM + wc * 32 + 8 * fq;
#pragma unroll
        for (int ai = 0; ai < 2; ++ai)
#pragma unroll
            for (int m = 0; m < 4; ++m) { const size_t row = (size_t)(row0 + ai * HALF + m * 16);
#pragma unroll
                for (int bj = 0; bj < 2; ++bj) {
                    const u32x2 q2 = *(const u32x2*)(G8 + row * 4096 + gcol2 + col0 + bj * HALF);
                    f32x4 r0, r1;
#pragma unroll
                    for (int j = 0; j < 4; ++j) { r0[j] = acc[ai][bj][m][0][j] * ascale * ub(q2.x, j); r1[j] = acc[ai][bj][m][1][j] * ascale * ub(q2.y, j); }
                    u32x2 o; o.x = pk4_fp8(r0[0], r0[1], r0[2], r0[3]); o.y = pk4_fp8(r1[0], r1[1], r1[2], r1[3]);
                    *(u32x2*)(O + row * D + col0 + bj * HALF) = o; } }
    }
};
struct EpiOut {
    static constexpr bool PERM = true;
    bf16_t* X; const void* src_lat; const void* src_ctx; bool src_f32; const float* modl; float ascale;
    __device__ __forceinline__ void operator()(AccRef acc, const Unit& u, int wr, int wc, int fr, int fq) const {
        const int row0 = u.pm * BM + wr * 64 + fr, col0 = u.pn * BM + wc * 32 + 8 * fq;
        const int mrow = u.pm < 64 ? (u.pm >> 4) : 4;
        const float* g = modl + (size_t)mrow * 6 * D + 2 * D;
        const bool lat = u.pm < 64;
#pragma unroll
        for (int bj = 0; bj < 2; ++bj) { const int col = col0 + bj * HALF;
            const f32x4 g0 = *(const f32x4*)(g + col) * ascale, g1 = *(const f32x4*)(g + col + 4) * ascale;
#pragma unroll
            for (int ai = 0; ai < 2; ++ai)
#pragma unroll
                for (int m = 0; m < 4; ++m) { const int row = row0 + ai * HALF + m * 16; f32x4 s0, s1;
                    if (src_f32) { const float* sp = (lat ? (const float*)src_lat + (size_t)row * D : (const float*)src_ctx + (size_t)(row - NLAT) * D) + col; s0 = *(const f32x4*)sp; s1 = *(const f32x4*)(sp + 4); }
                    else unpack8(*(const u32x4*)((const bf16_t*)src_lat + (size_t)row * D + col), s0, s1);
                    *(u32x4*)(X + (size_t)row * D + col) = pack8(s0 + g0 * acc[ai][bj][m][0], s1 + g1 * acc[ai][bj][m][1]); } }
    }
};
struct EpiMoe1 {
    static constexpr bool PERM = true;
    bf16_t* ACT;
    __device__ __forceinline__ void operator()(AccRef acc, const Unit& u, int wr, int wc, int fr, int fq) const {
        const int row0 = u.pm * BM + wr * 64 + fr, col0 = u.pn * HALF + wc * 32 + 8 * fq;
        constexpr float KS = 1.f / W8_SCALE, KB = ACT8_SCALE / W8_SCALE;
#pragma unroll
        for (int ai = 0; ai < 2; ++ai)
#pragma unroll
            for (int m = 0; m < 4; ++m) { f32x4 r[2];
#pragma unroll
                for (int n = 0; n < 2; ++n)
#pragma unroll
                    for (int j = 0; j < 4; ++j) r[n][j] = __builtin_amdgcn_fmed3f(fsilu(acc[ai][0][m][n][j] * KS) * (acc[ai][1][m][n][j] * KB), -440.f, 440.f);
                u32x2 o; o.x = pk4_fp8(r[0][0], r[0][1], r[0][2], r[0][3]); o.y = pk4_fp8(r[1][0], r[1][1], r[1][2], r[1][3]);
                *(u32x2*)((unsigned char*)ACT + (size_t)(row0 + ai * HALF + m * 16) * DEXP + col0) = o; }
    }
};
struct EpiNone {
    static constexpr bool PERM = true;
    __device__ __forceinline__ void operator()(AccRef acc, const Unit&, int, int, int, int) const {
#pragma unroll
        for (int ai = 0; ai < 2; ++ai)
#pragma unroll
            for (int bj = 0; bj < 2; ++bj)
#pragma unroll
                for (int m = 0; m < 4; ++m)
#pragma unroll
                    for (int n = 0; n < 2; ++n) asm volatile("" :: "v"(acc[ai][bj][m][n]));
    }
};
struct EpiY8 {
    static constexpr bool PERM = true; static constexpr int NVM = 16;
    unsigned char* O; int ldc; float ascale;
    __device__ __forceinline__ void operator()(AccRef acc, const Unit& u, int wr, int wc, int fr, int fq) const {
        const int row0 = u.pm * BM + wr * 64 + fr, col0 = u.pn * BM + wc * 32 + 8 * fq;
#pragma unroll
        for (int ai = 0; ai < 2; ++ai)
#pragma unroll
            for (int m = 0; m < 4; ++m) { unsigned char* rowp = O + (size_t)(row0 + ai * HALF + m * 16) * ldc + col0;
#pragma unroll
                for (int bj = 0; bj < 2; ++bj) { f32x4 r0, r1;
#pragma unroll
                    for (int j = 0; j < 4; ++j) { r0[j] = __builtin_amdgcn_fmed3f(acc[ai][bj][m][0][j] * ascale, -440.f, 440.f); r1[j] = __builtin_amdgcn_fmed3f(acc[ai][bj][m][1][j] * ascale, -440.f, 440.f); }
                    u32x2 o; o.x = pk4_fp8(r0[0], r0[1], r0[2], r0[3]); o.y = pk4_fp8(r1[0], r1[1], r1[2], r1[3]); *(u32x2*)(rowp + bj * HALF) = o; } }
    }
};
struct EpiPlain {
    static constexpr bool PERM = true;
    bf16_t* O; int ldc; float ascale;
    __device__ __forceinline__ void operator()(AccRef acc, const Unit& u, int wr, int wc, int fr, int fq) const {
        const int row0 = u.pm * BM + wr * 64 + fr, col0 = u.pn * BM + wc * 32 + 8 * fq;
#pragma unroll
        for (int ai = 0; ai < 2; ++ai)
#pragma unroll
            for (int m = 0; m < 4; ++m) { bf16_t* rowp = O + (size_t)(row0 + ai * HALF + m * 16) * ldc + col0;
#pragma unroll
                for (int bj = 0; bj < 2; ++bj) *(u32x4*)(rowp + bj * HALF) = pack8(acc[ai][bj][m][0] * ascale, acc[ai][bj][m][1] * ascale); }
    }
};
}

struct Args { const float* in[22]; float* out; unsigned char* ws; int ph_lo, ph_hi, rep, pad; };
enum { I_X = 0, I_C, I_CTX, I_CCTX, I_WADA, I_BADA, I_N1W, I_N2W, I_WIN, I_WPG, I_PSCALE, I_HGNW, I_LBLOG, I_WBP, I_WBH, I_WOUT, I_WROUTER, I_RBIAS, I_WE1, I_WE3, I_WE2, I_FNW };

struct Frame {
    LAS unsigned char* lds;
    int tid, lane, wave, G, gw, NGW;
    unsigned char* ws;
};

__device__ __forceinline__ void transpose_item(const float* W, int K, int N, int k0, int n0, bf16_t* WT, size_t dst_row0, LAS float* scr, int lane) {
    float wv[32];
#pragma unroll
    for (int i = 0; i < 32; ++i) { const int kk = 2 * i + (lane >> 5); wv[i] = __builtin_nontemporal_load(W + (size_t)(k0 + kk) * N + n0 + (lane & 31)); }
#pragma unroll
    for (int i = 0; i < 32; ++i) { const int kk = 2 * i + (lane >> 5); scr[kk * 33 + (lane & 31)] = wv[i]; }
    LDS_WAIT(); asm volatile("" ::: "memory");
    const int c = lane & 7;
#pragma unroll
    for (int j = 0; j < 4; ++j) { const int n = (lane >> 3) + 8 * j; const LAS float* s = scr + (8 * c) * 33 + n;
        u32x4 o; o.x = pk2(s[0 * 33], s[1 * 33]); o.y = pk2(s[2 * 33], s[3 * 33]); o.z = pk2(s[4 * 33], s[5 * 33]); o.w = pk2(s[6 * 33], s[7 * 33]);
        *(u32x4*)(WT + (dst_row0 + n) * K + k0 + 8 * c) = o; }
    LDS_WAIT(); asm volatile("" ::: "memory");
}
__device__ __forceinline__ void transpose_item_fp8(const float* W, int K, int N, int k0, int n0, unsigned char* WT, size_t dst_row0, LAS float* scr, int lane) {
    float wv[32];
#pragma unroll
    for (int i = 0; i < 32; ++i) { const int kk = 2 * i + (lane >> 5); wv[i] = __builtin_nontemporal_load(W + (size_t)(k0 + kk) * N + n0 + (lane & 31)); }
#pragma unroll
    for (int i = 0; i < 32; ++i) { const int kk = 2 * i + (lane >> 5); scr[kk * 33 + (lane & 31)] = wv[i] * W8_SCALE; }
    LDS_WAIT(); asm volatile("" ::: "memory");
    const int c = lane & 7;
#pragma unroll
    for (int j = 0; j < 4; ++j) { const int n = (lane >> 3) + 8 * j; const LAS float* sp = scr + (8 * c) * 33 + n;
        int w0 = 0, w1 = 0; w0 = __builtin_amdgcn_cvt_pk_fp8_f32(sp[0 * 33], sp[1 * 33], w0, false); w0 = __builtin_amdgcn_cvt_pk_fp8_f32(sp[2 * 33], sp[3 * 33], w0, true);
        w1 = __builtin_amdgcn_cvt_pk_fp8_f32(sp[4 * 33], sp[5 * 33], w1, false); w1 = __builtin_amdgcn_cvt_pk_fp8_f32(sp[6 * 33], sp[7 * 33], w1, true);
        u32x2 o; o.x = (unsigned)w0; o.y = (unsigned)w1;
        *(u32x2*)(WT + (dst_row0 + n) * K + k0 + 8 * c) = o; }
    LDS_WAIT(); asm volatile("" ::: "memory");
}
__device__ __forceinline__ void transpose_family(Frame& F, const float* W, int mats, int K, int N, bf16_t* WT, int mode, int& itbase, int it_lo, int it_step) {
    const int nblk = N / 32, kblk = K / 64, per = nblk * kblk, total = mats * per;
    LAS float* scr = (LAS float*)(F.lds + F.wave * 16384);
    int first = (it_lo - itbase) % it_step; if (first < 0) first += it_step;
    for (int it = first; it < total; it += it_step) {
        const int mat = it / per, r = it % per, kb = r / nblk, nb = r % nblk, n0 = 32 * nb, k0 = 64 * kb;
        size_t dst_row0; bf16_t* dstm;
        if (mode == 3) { transpose_item_fp8(W + (size_t)mat * K * N, K, N, k0, n0, (unsigned char*)WT + (size_t)mat * N * K, n0, scr, F.lane); continue; }
        if (mode == 4 || mode == 5) { transpose_item_fp8(W + (size_t)mat * K * N, K, N, k0, n0, (unsigned char*)WT + (size_t)mat * 1024 * K, (size_t)(n0 >> 7) * 256 + (mode == 5 ? 128 : 0) + (n0 & 127), scr, F.lane); continue; }
        if (mode == 0) { dstm = WT + (size_t)mat * N * K; dst_row0 = n0; }
        else { dstm = WT + (size_t)mat * 1024 * K; dst_row0 = (size_t)(n0 >> 7) * 256 + (mode == 2 ? 128 : 0) + (n0 & 127); }
        transpose_item(W + (size_t)mat * K * N, K, N, k0, n0, dstm, dst_row0, scr, F.lane);
    }
    itbase += total;
}

struct ConvJob { const float* src; unsigned char* dst; int N; };
__device__ __forceinline__ ConvJob conv_decode(const Args& a, unsigned char* ws, int L, int s, int lane) {
    const float* W; unsigned char* T; int K, N, t, map = 0, lk, ln;
    if (s < 20480) { t = s; W = a.in[I_WIN] + (size_t)L * D * INC; T = ws + WS_WIN + (size_t)L * INC * D; K = D; N = INC; lk = 7; ln = 8; }
    else if (s < 22528) { t = s - 20480; W = a.in[I_WBP] + (size_t)L * 1024 * D; T = ws + WS_WBP + (size_t)L * D * 1024; K = 1024; N = D; lk = 6; ln = 5; }
    else if (s < 24576) { t = s - 22528; W = a.in[I_WBH] + (size_t)L * 1024 * D; T = ws + WS_WBH + (size_t)L * D * 1024; K = 1024; N = D; lk = 6; ln = 5; }
    else if (s < 28672) { t = s - 24576; W = a.in[I_WOUT] + (size_t)L * D * D; T = ws + WS_WOUT + (size_t)L * D * D; K = D; N = D; lk = 7; ln = 5; }
    else if (s < 45056) { t = s - 28672; W = a.in[I_WE1] + (size_t)L * NEXP * D * DEXP; T = ws + WS_WE13 + (size_t)L * NEXP * 1024 * D; K = D; N = DEXP; map = 1; lk = 7; ln = 3; }
    else if (s < 61440) { t = s - 45056; W = a.in[I_WE3] + (size_t)L * NEXP * D * DEXP; T = ws + WS_WE13 + (size_t)L * NEXP * 1024 * D; K = D; N = DEXP; map = 2; lk = 7; ln = 3; }
    else { t = s - 61440; W = a.in[I_WE2] + (size_t)L * NEXP * DEXP * D; T = ws + WS_WE2 + (size_t)L * NEXP * D * DEXP; K = DEXP; N = D; lk = 5; ln = 5; }
    const int kb = t & ((1 << lk) - 1), nb = (t >> lk) & ((1 << ln) - 1), mat = t >> (lk + ln);
    const int n = nb * 64 + lane, k0 = kb * 16;
    const size_t drow = map ? (size_t)mat * 1024 + (size_t)(n >> 7) * 256 + (map == 2 ? 128 : 0) + (n & 127) : (size_t)mat * N + n;
    ConvJob J; J.src = W + (size_t)mat * K * N + (size_t)k0 * N + n; J.dst = T + drow * K + k0; J.N = N; return J;
}
constexpr int CONV_ITEMS = 77824;
__device__ __forceinline__ void convert_range(Frame& F, const Args& a, int L, int lo, int hi, int rank, int n) {
    if (rank < 0 || L >= DEPTH || F.G != 256) return;
    for (int s0 = lo + (rank * 8 + F.wave) * 2; s0 < hi; s0 += n * 16) {
        const bool has2 = s0 + 1 < hi;
        const ConvJob J0 = conv_decode(a, F.ws, L, s0, F.lane), J1 = conv_decode(a, F.ws, L, has2 ? s0 + 1 : s0, F.lane);
        float v0[16], v1[16];
#pragma unroll
        for (int i = 0; i < 16; ++i) { v0[i] = __builtin_nontemporal_load(J0.src + (size_t)i * J0.N); v1[i] = __builtin_nontemporal_load(J1.src + (size_t)i * J1.N); }
        u32x4 o; o.x = pk4_fp8(v0[0] * W8_SCALE, v0[1] * W8_SCALE, v0[2] * W8_SCALE, v0[3] * W8_SCALE); o.y = pk4_fp8(v0[4] * W8_SCALE, v0[5] * W8_SCALE, v0[6] * W8_SCALE, v0[7] * W8_SCALE);
        o.z = pk4_fp8(v0[8] * W8_SCALE, v0[9] * W8_SCALE, v0[10] * W8_SCALE, v0[11] * W8_SCALE); o.w = pk4_fp8(v0[12] * W8_SCALE, v0[13] * W8_SCALE, v0[14] * W8_SCALE, v0[15] * W8_SCALE);
        *(u32x4*)J0.dst = o;
        if (has2) { o.x = pk4_fp8(v1[0] * W8_SCALE, v1[1] * W8_SCALE, v1[2] * W8_SCALE, v1[3] * W8_SCALE); o.y = pk4_fp8(v1[4] * W8_SCALE, v1[5] * W8_SCALE, v1[6] * W8_SCALE, v1[7] * W8_SCALE);
            o.z = pk4_fp8(v1[8] * W8_SCALE, v1[9] * W8_SCALE, v1[10] * W8_SCALE, v1[11] * W8_SCALE); o.w = pk4_fp8(v1[12] * W8_SCALE, v1[13] * W8_SCALE, v1[14] * W8_SCALE, v1[15] * W8_SCALE);
            *(u32x4*)J1.dst = o; }
    }
}
__device__ __forceinline__ void idle_rank(int nunits, int G, int c, int& rank, int& n) {
    const int rem = nunits % G;
    if (rem == 0 || G - rem < 64) { rank = c; n = G; } else { rank = c >= rem ? c - rem : -1; n = G - rem; }
}

__device__ __forceinline__ void phase_prologue(Frame& F, const Args& a) {
    unsigned char* ws = F.ws;
    int itbase = 0; const int nl = (F.G == 256) ? 0 : DEPTH;
    convert_range(F, a, 0, 0, CONV_ITEMS, (int)blockIdx.x, F.G);
    transpose_family(F, a.in[I_WIN], nl, D, INC, (bf16_t*)(ws + WS_WIN), 3, itbase, F.gw, F.NGW);
    transpose_family(F, a.in[I_WPG], DEPTH * 4, 256, 256, (bf16_t*)(ws + WS_WPG), 0, itbase, F.gw, F.NGW);
    transpose_family(F, a.in[I_WBP], nl, 1024, D, (bf16_t*)(ws + WS_WBP), 3, itbase, F.gw, F.NGW);
    transpose_family(F, a.in[I_WBH], nl, 1024, D, (bf16_t*)(ws + WS_WBH), 3, itbase, F.gw, F.NGW);
    transpose_family(F, a.in[I_WOUT], nl, D, D, (bf16_t*)(ws + WS_WOUT), 3, itbase, F.gw, F.NGW);
    transpose_family(F, a.in[I_WE1], nl * NEXP, D, DEXP, (bf16_t*)(ws + WS_WE13), 4, itbase, F.gw, F.NGW);
    transpose_family(F, a.in[I_WE3], nl * NEXP, D, DEXP, (bf16_t*)(ws + WS_WE13), 5, itbase, F.gw, F.NGW);
    transpose_family(F, a.in[I_WE2], nl * NEXP, DEXP, D, (bf16_t*)(ws + WS_WE2), 3, itbase, F.gw, F.NGW);
    if (blockIdx.x == 0) {
        const float* lg = a.in[I_LBLOG]; float* LB = (float*)(ws + WS_LB);
        for (int i = F.tid; i < 2 * 1024; i += 512) { const int dir = i >> 10, ch = i & 1023;
            float l[DEPTH], mx = -1e30f;
#pragma unroll
            for (int j = 0; j < DEPTH; ++j) { l[j] = lg[((size_t)dir * DEPTH + j) * 1024 + ch]; mx = fmaxf(mx, l[j]); }
            float s = 0.f;
#pragma unroll
            for (int j = 0; j < DEPTH; ++j) { l[j] = __expf(l[j] - mx); s += l[j]; }
            float cum = 0.f;
#pragma unroll
            for (int j = 0; j < DEPTH; ++j) { if (j > 0) cum += l[j] / s; LB[((size_t)j * 2 + dir) * 1024 + ch] = cum; } }
    }
    __syncthreads();
    {
        LAS float* sv = (LAS float*)F.lds;
        LAS float* red = (LAS float*)(F.lds + 5 * D * 4);
        for (int i = F.tid; i < 5 * D; i += 512) { const int r = i / D, k = i % D; const float v = r < 4 ? a.in[I_C][r * D + k] : a.in[I_CCTX][k]; sv[i] = fsilu(v); }
        __syncthreads();
        const float* wada = a.in[I_WADA]; const float* bada = a.in[I_BADA]; float* MOD = (float*)(ws + WS_MOD);
        constexpr int JB = 6 * D / 192;
        const int cg = F.tid % 48, kg = F.tid / 48;
        for (int it = blockIdx.x; it < DEPTH * JB; it += F.G) {
            const int layer = it / JB, j0 = (it % JB) * 192;
            if (kg < 10) {
                const float* w = wada + (size_t)layer * D * 6 * D + j0 + 4 * cg;
                f32x4 acc[5];
#pragma unroll
                for (int r = 0; r < 5; ++r) acc[r] = (f32x4){0.f, 0.f, 0.f, 0.f};
#pragma unroll 8
                for (int k = kg; k < D; k += 10) { const f32x4 wv = *(const f32x4*)(w + (size_t)k * 6 * D);
#pragma unroll
                    for (int r = 0; r < 5; ++r) acc[r] += wv * sv[r * D + k]; }
#pragma unroll
                for (int r = 0; r < 5; ++r) *(LAS f32x4*)(red + (kg * 5 + r) * 192 + 4 * cg) = acc[r];
            }
            __syncthreads();
            for (int o = F.tid; o < 5 * 192; o += 512) { const int r = o / 192, jj = o % 192; float t = bada[(size_t)layer * 6 * D + j0 + jj];
#pragma unroll
                for (int q = 0; q < 10; ++q) t += red[(q * 5 + r) * 192 + jj];
                MOD[((size_t)layer * 5 + r) * 6 * D + j0 + jj] = t; }
            __syncthreads();
        }
    }
    __syncthreads();
}

__device__ __forceinline__ void wave_rows(const Frame& F, int M, int& r0, int& r1) { r0 = (int)(((unsigned)F.gw * (unsigned)M) / (unsigned)F.NGW); r1 = (int)(((unsigned)(F.gw + 1) * (unsigned)M) / (unsigned)F.NGW); }
__device__ __forceinline__ int mod_row(int r) { return r < NLAT ? (r >> 12) : 4; }

__device__ __forceinline__ void xrow_load(const bf16_t* X, int r, int lane, f32x4 (&x)[8]) { const u32x2* xr = (const u32x2*)(X + (size_t)r * D) + lane;
#pragma unroll
    for (int j = 0; j < 8; ++j) { const u32x2 w = xr[64 * j]; x[j] = (f32x4){bflo(w.x), bfhi(w.x), bflo(w.y), bfhi(w.y)}; } }
__device__ __forceinline__ void xrow_store(bf16_t* X, int r, int lane, const f32x4 (&x)[8]) { u32x2* xr = (u32x2*)(X + (size_t)r * D) + lane;
#pragma unroll
    for (int j = 0; j < 8; ++j) { u32x2 w; w.x = pk2(x[j][0], x[j][1]); w.y = pk2(x[j][2], x[j][3]); xr[64 * j] = w; } }
template <int NR>
__device__ __forceinline__ void moe_combine_rows(f32x4 (&x)[NR][8], const int (&r)[NR], int lane, const unsigned char* ws, int player, const float* mod5) {
    const int* pb = (const int*)(ws + WS_PADBASE) + player * 16; const unsigned char* Y2 = ws + WS_Y2;
    int2 ri[NR]; float2 rg[NR]; const unsigned* y0[NR]; const unsigned* y1[NR];
#pragma unroll
    for (int q = 0; q < NR; ++q) { ri[q] = ((const int2*)(ws + WS_ROUTE_I))[r[q]]; rg[q] = ((const float2*)(ws + WS_ROUTE_G))[r[q]]; }
#pragma unroll
    for (int q = 0; q < NR; ++q) { const int s0 = pb[ri[q].x >> 20] + (ri[q].x & 0xfffff), s1 = pb[ri[q].y >> 20] + (ri[q].y & 0xfffff);
        y0[q] = (const unsigned*)(Y2 + (size_t)s0 * D) + lane; y1[q] = (const unsigned*)(Y2 + (size_t)s1 * D) + lane; rg[q].x *= 1.f / Y8_SCALE; rg[q].y *= 1.f / Y8_SCALE; }
#pragma unroll
    for (int j = 0; j < 8; ++j) { const f32x4 g = *((const f32x4*)mod5 + 64 * j + lane);
#pragma unroll
        for (int q = 0; q < NR; ++q) { const unsigned a = y0[q][64 * j], b = y1[q][64 * j];
            const f32x2 a01 = __builtin_amdgcn_cvt_pk_f32_fp8((int)a, false), a23 = __builtin_amdgcn_cvt_pk_f32_fp8((int)a, true), b01 = __builtin_amdgcn_cvt_pk_f32_fp8((int)b, false), b23 = __builtin_amdgcn_cvt_pk_f32_fp8((int)b, true);
            const f32x4 ya = (f32x4){a01.x, a01.y, a23.x, a23.y}, yb = (f32x4){b01.x, b01.y, b23.x, b23.y};
            x[q][j] += g * (ya * rg[q].x + yb * rg[q].y); } }
}
__device__ __forceinline__ float row_sumsq(const f32x4 (&x)[8]) { float ss = 0.f;
#pragma unroll
    for (int j = 0; j < 8; ++j) ss += (x[j][0] * x[j][0] + x[j][1] * x[j][1]) + (x[j][2] * x[j][2] + x[j][3] * x[j][3]);
    return ss; }

__device__ __forceinline__ void phase_norm1(Frame& F, const Args& a, int layer, bool combine) {
    unsigned char* ws = F.ws; bf16_t* X = (bf16_t*)(ws + WS_X); bf16_t* H = (bf16_t*)(ws + WS_H);
    const float* MOD = (const float*)(ws + WS_MOD); const float* nw = a.in[I_N1W] + (size_t)layer * D;
    int r0, r1; wave_rows(F, MTOK, r0, r1);
    int curb = -1; f32x4 av[8], sv[8];
    for (int r = r0; r < r1;) {
        const int b = mod_row(r);
        const bool two = (r + 1 < r1) && (mod_row(r + 1) == b);
        const int rr[2] = {r, two ? r + 1 : r};
        if (b != curb) { curb = b; const float* m = MOD + ((size_t)layer * 5 + b) * 6 * D;
#pragma unroll
            for (int j = 0; j < 8; ++j) { const f32x4 w = *((const f32x4*)nw + 64 * j + F.lane), m1 = *((const f32x4*)(m + D) + 64 * j + F.lane); av[j] = w * (m1 + 1.f); sv[j] = *((const f32x4*)m + 64 * j + F.lane); } }
        f32x4 x[2][8];
#pragma unroll
        for (int q = 0; q < 2; ++q) {
            if (layer == 0) { const float* xs = rr[q] < NLAT ? a.in[I_X] + (size_t)rr[q] * D : a.in[I_CTX] + (size_t)(rr[q] - NLAT) * D;
                const f32x4* xr = (const f32x4*)xs + F.lane;
#pragma unroll
                for (int j = 0; j < 8; ++j) x[q][j] = xr[64 * j]; }
            else xrow_load(X, rr[q], F.lane, x[q]); }
        if (combine) { moe_combine_rows<2>(x, rr, F.lane, ws, layer - 1, MOD + ((size_t)(layer - 1) * 5 + b) * 6 * D + 5 * D);
#pragma unroll
            for (int q = 0; q < 2; ++q) if (q == 0 || two) xrow_store(X, rr[q], F.lane, x[q]); }
        float ss0 = row_sumsq(x[0]), ss1 = row_sumsq(x[1]);
#pragma unroll
        for (int o = 1; o < 64; o <<= 1) { ss0 += lane_xor(ss0, o, F.lane); ss1 += lane_xor(ss1, o, F.lane); }
        const float rs[2] = {1.0f / sqrtf(ss0 * (1.f / D) + EPS), 1.0f / sqrtf(ss1 * (1.f / D) + EPS)};
#pragma unroll
        for (int q = 0; q < 2; ++q) if (q == 0 || two) { unsigned* ho = (unsigned*)((unsigned char*)H + (size_t)rr[q] * D) + F.lane;
#pragma unroll
            for (int j = 0; j < 8; ++j) { const f32x4 h = x[q][j] * rs[q] * av[j] + sv[j]; int w = 0; w = __builtin_amdgcn_cvt_pk_fp8_f32(h[0], h[1], w, false); w = __builtin_amdgcn_cvt_pk_fp8_f32(h[2], h[3], w, true); ho[64 * j] = (unsigned)w; } }
        r += two ? 2 : 1;
    }
}

constexpr int RT_LCNT = LDS_MISC + 1024, RT_LBASE = LDS_MISC + 1088, RT_REC = LDS_MISC + 2048;
struct Route { int i1, i2; float g1, g2; };
__device__ __forceinline__ Route route_row(const float (&lg)[NEXP], const float* rbias) {
    float sc[NEXP], sel[NEXP];
#pragma unroll
    for (int e = 0; e < NEXP; ++e) { sc[e] = __builtin_amdgcn_rcpf(1.f + __builtin_amdgcn_exp2f(-1.44269504f * lg[e])); sel[e] = sc[e] + rbias[e]; }
    float gsc[4];
#pragma unroll
    for (int g = 0; g < 4; ++g) { float m1 = -1e30f, m2 = -1e30f;
#pragma unroll
        for (int i = 0; i < 4; ++i) { const float v = sel[g * 4 + i]; const bool c1 = v > m1, c2 = v > m2; m2 = c1 ? m1 : (c2 ? v : m2); m1 = c1 ? v : m1; }
        gsc[g] = m1 + m2; }
    int gbest = 0; float gbs = gsc[0];
#pragma unroll
    for (int g = 1; g < 4; ++g) { const bool c = gsc[g] > gbs; gbest = c ? g : gbest; gbs = c ? gsc[g] : gbs; }
    float sl[4], sx[4];
#pragma unroll
    for (int i = 0; i < 4; ++i) { sl[i] = gbest == 0 ? sel[i] : gbest == 1 ? sel[4 + i] : gbest == 2 ? sel[8 + i] : sel[12 + i]; sx[i] = gbest == 0 ? sc[i] : gbest == 1 ? sc[4 + i] : gbest == 2 ? sc[8 + i] : sc[12 + i]; }
    int i1 = 0, i2 = 0; float v1 = -1e30f, v2 = -1e30f, s1 = 0.f, s2 = 0.f;
#pragma unroll
    for (int i = 0; i < 4; ++i) { const float v = sl[i]; const bool c1 = v > v1, c2 = v > v2;
        i2 = c1 ? i1 : (c2 ? i : i2); s2 = c1 ? s1 : (c2 ? sx[i] : s2); v2 = c1 ? v1 : (c2 ? v : v2);
        i1 = c1 ? i : i1; s1 = c1 ? sx[i] : s1; v1 = c1 ? v : v1; }
    const float inv = __builtin_amdgcn_rcpf(s1 + s2);
    Route R; R.i1 = gbest * 4 + i1; R.i2 = gbest * 4 + i2; R.g1 = s1 * inv; R.g2 = s2 * inv; return R;
}
constexpr int RT_STRIDE = 4112;
constexpr int RT_WB = 0, RT_HT = 16 * RT_STRIDE, RT_PART = 32 * RT_STRIDE;
static_assert(RT_PART + 8192 <= LDS_MISC, "router LDS map");
__device__ __forceinline__ void phase_norm2_router(Frame& F, const Args& a, int layer, int Mrows, bool publish) {
    unsigned char* ws = F.ws; const bf16_t* X = (const bf16_t*)(ws + WS_X); bf16_t* H = (bf16_t*)(ws + WS_H);
    const float* MOD = (const float*)(ws + WS_MOD); const float* nw = a.in[I_N2W] + (size_t)layer * D;
    LAS unsigned char* L = F.lds;
    { const f32x4* wr4 = (const f32x4*)a.in[I_WROUTER];
#pragma unroll 1
      for (int i = 0; i < 2; ++i) { const int k = 2 * F.tid + 1024 * i; f32x4 wv[2][4];
#pragma unroll
          for (int h = 0; h < 2; ++h)
#pragma unroll
              for (int q = 0; q < 4; ++q) wv[h][q] = wr4[(size_t)(k + h) * 4 + q];
#pragma unroll
          for (int q = 0; q < 4; ++q)
#pragma unroll
              for (int ii = 0; ii < 4; ++ii) *(LAS unsigned*)(L + RT_WB + (4 * q + ii) * RT_STRIDE + k * 2) = pk2(wv[0][q][ii], wv[1][q][ii]); } }
    LAS unsigned* lcnt = (LAS unsigned*)(F.lds + RT_LCNT); LAS unsigned* lbase = (LAS unsigned*)(F.lds + RT_LBASE);
    if (F.tid < 16) lcnt[F.tid] = 0u;
    __syncthreads();
    const float* rbias = a.in[I_RBIAS];
    const int brow0 = 2 * (int)((blockIdx.x * (unsigned)(Mrows >> 1)) / (unsigned)F.G), brow1 = 2 * (int)(((blockIdx.x + 1) * (unsigned)(Mrows >> 1)) / (unsigned)F.G);
    const int nround = (brow1 - brow0 + 15) >> 4;
    const int fr = F.lane & 15, fq = F.lane >> 4;
#pragma unroll 1
    for (int t = 0; t < nround; ++t) {
        const int r = brow0 + 16 * t + 2 * F.wave;
        const bool v0 = r < brow1, v1 = r + 1 < brow1;
        const int rr[2] = {v0 ? r : brow0, v1 ? r + 1 : brow0};
        const int b = mod_row(rr[0]);
        const float* m = MOD + ((size_t)layer * 5 + b) * 6 * D;
        f32x4 x[2][8];
#pragma unroll
        for (int q = 0; q < 2; ++q) xrow_load(X, rr[q], F.lane, x[q]);
        float ss0 = row_sumsq(x[0]), ss1 = row_sumsq(x[1]);
#pragma unroll
        for (int o = 1; o < 64; o <<= 1) { ss0 += lane_xor(ss0, o, F.lane); ss1 += lane_xor(ss1, o, F.lane); }
        const float rs[2] = {1.0f / sqrtf(ss0 * (1.f / D) + EPS), 1.0f / sqrtf(ss1 * (1.f / D) + EPS)};
#pragma unroll
        for (int q = 0; q < 2; ++q) {
#pragma unroll
            for (int j = 0; j < 8; ++j) { const f32x4 w = *((const f32x4*)nw + 64 * j + F.lane), m4 = *((const f32x4*)(m + 4 * D) + 64 * j + F.lane), m3 = *((const f32x4*)(m + 3 * D) + 64 * j + F.lane);
                x[q][j] = x[q][j] * rs[q] * (w * (m4 + 1.f)) + m3; }
            if (q == 0 ? v0 : v1) { unsigned* ho = (unsigned*)((unsigned char*)H + (size_t)rr[q] * D) + F.lane;
#pragma unroll
                for (int j = 0; j < 8; ++j) ho[64 * j] = pk4_fp8(x[q][j][0], x[q][j][1], x[q][j][2], x[q][j][3]); }
            LAS unsigned char* hrow = L + RT_HT + (2 * F.wave + q) * RT_STRIDE + F.lane * 8;
#pragma unroll
            for (int j = 0; j < 8; ++j) { u32x2 w; w.x = pk2(x[q][j][0], x[q][j][1]); w.y = pk2(x[q][j][2], x[q][j][3]); *(LAS u32x2*)(hrow + j * 512) = w; } }
        __syncthreads();
        f32x4 acc = (f32x4){0.f, 0.f, 0.f, 0.f};
#pragma unroll
        for (int s = 0; s < 8; ++s) { const int kb = (256 * F.wave + 32 * s + 8 * fq) * 2;
            const bf16x8 wa = *(const LAS bf16x8*)(L + RT_WB + fr * RT_STRIDE + kb), hb = *(const LAS bf16x8*)(L + RT_HT + fr * RT_STRIDE + kb);
            acc = __builtin_amdgcn_mfma_f32_16x16x32_bf16(wa, hb, acc, 0, 0, 0); }
        *(LAS f32x4*)(L + RT_PART + F.wave * 1024 + fr * 64 + fq * 16) = acc;
        __syncthreads();
        if (F.lane < 2) { const int tr = 2 * F.wave + F.lane;
            f32x4 sg[4] = {(f32x4){0.f, 0.f, 0.f, 0.f}, (f32x4){0.f, 0.f, 0.f, 0.f}, (f32x4){0.f, 0.f, 0.f, 0.f}, (f32x4){0.f, 0.f, 0.f, 0.f}};
#pragma unroll
            for (int w8 = 0; w8 < 8; ++w8)
#pragma unroll
                for (int c = 0; c < 4; ++c) sg[c] += *(const LAS f32x4*)(L + RT_PART + w8 * 1024 + tr * 64 + c * 16);
            float lg[NEXP];
#pragma unroll
            for (int e = 0; e < NEXP; ++e) lg[e] = sg[e >> 2][e & 3];
            const Route R = route_row(lg, rbias); const int i1 = R.i1, i2 = R.i2; const float g1 = R.g1, g2 = R.g2;
            if ((F.lane == 0 ? v0 : v1) && publish) {
                const unsigned k1 = __hip_atomic_fetch_add(lcnt + i1, 1u, __ATOMIC_RELAXED, __HIP_MEMORY_SCOPE_WORKGROUP), k2 = __hip_atomic_fetch_add(lcnt + i2, 1u, __ATOMIC_RELAXED, __HIP_MEMORY_SCOPE_WORKGROUP);
                LAS unsigned* rec = (LAS unsigned*)(F.lds + RT_REC + (r + F.lane - brow0) * 32);
                rec[0] = (unsigned)i1; rec[1] = k1; rec[2] = (unsigned)i2; rec[3] = k2; rec[4] = __builtin_bit_cast(unsigned, g1); rec[5] = __builtin_bit_cast(unsigned, g2);
            } }
    }
    __syncthreads();
    if (F.tid < 16 && publish) { unsigned* cntw = (unsigned*)(ws + WS_CTL) + CW_CNT + layer * 1024; const unsigned n = lcnt[F.tid]; lbase[F.tid] = n ? atomicAdd(cntw + F.tid * 64, n) : 0u; }
    __syncthreads();
    if (F.tid < brow1 - brow0 && publish) { const int r = brow0 + F.tid; const LAS unsigned* rec = (const LAS unsigned*)(F.lds + RT_REC + F.tid * 32);
        const unsigned i1 = rec[0], i2 = rec[2], k1 = lbase[i1] + rec[1], k2 = lbase[i2] + rec[3];
        int* slottok = (int*)(ws + WS_SLOTTOK); slottok[(size_t)i1 * MTOK + k1] = r; slottok[(size_t)i2 * MTOK + k2] = r;
        ((int2*)(ws + WS_ROUTE_I))[r] = make_int2((int)((i1 << 20) | k1), (int)((i2 << 20) | k2));
        ((float2*)(ws + WS_ROUTE_G))[r] = make_float2(__builtin_bit_cast(float, rec[4]), __builtin_bit_cast(float, rec[5])); }
    __syncthreads();
}

__device__ __forceinline__ void phase_pooldiff(Frame& F, int Mrows) {
    unsigned char* ws = F.ws; const bf16_t* Z = (const bf16_t*)(ws + WS_Z); bf16_t* PD = (bf16_t*)(ws + WS_PD);
    LAS unsigned char* L = F.lds;
    const int cg = F.tid & 127, rq = F.tid >> 7, hw = 1 << (cg >> 5);
    const int ntile = NLAT / 64;
    for (int tile = blockIdx.x; tile < ntile; tile += F.G) {
        int base, Lrow, t0, nt;
        if (tile < NLAT / 64) { base = tile * 64; Lrow = 64; t0 = 0; nt = 64; }
        else { const int u = tile - NLAT / 64; base = NLAT + (u >> 3) * CTXL; Lrow = CTXL; t0 = (u & 7) * 32; nt = 32; }
        const int lo = max(t0 - 8, 0), hi = min(t0 + nt + 7, Lrow - 1), nrow = hi - lo + 1;
        u32x4 buf[16];
#pragma unroll
        for (int i = 0; i < 16; ++i) { const int sl = rq + 4 * i; buf[i] = (sl < nrow) ? *(const u32x4*)(Z + (size_t)(base + lo + sl) * INC + ZC_POOL + cg * 8) : (u32x4){0u, 0u, 0u, 0u}; }
#pragma unroll
        for (int i = 0; i < 16; ++i) { const int sl = rq + 4 * i; *(LAS u32x4*)(L + sl * 2048 + cg * 16) = buf[i]; }
        __syncthreads();
        for (int i = 0; i < nt / 4; ++i) { const int t = t0 + rq + 4 * i;
            const int wl = max(t - hw, 0), wh = min(t + hw - 1, Lrow - 1);
            float s[8] = {0.f, 0.f, 0.f, 0.f, 0.f, 0.f, 0.f, 0.f};
            for (int p = wl; p <= wh; ++p) { const u32x4 a = *(const LAS u32x4*)(L + (p - lo) * 2048 + cg * 16);
                s[0] += bflo(a.x); s[1] += bfhi(a.x); s[2] += bflo(a.y); s[3] += bfhi(a.y); s[4] += bflo(a.z); s[5] += bfhi(a.z); s[6] += bflo(a.w); s[7] += bfhi(a.w); }
            const float inv = 1.f / (float)(wh - wl + 1);
            const u32x4 a = *(const LAS u32x4*)(L + (t - lo) * 2048 + cg * 16);
            u32x4 o; o.x = pk2(s[0] * inv - bflo(a.x), s[1] * inv - bfhi(a.x)); o.y = pk2(s[2] * inv - bflo(a.y), s[3] * inv - bfhi(a.y));
            o.z = pk2(s[4] * inv - bflo(a.z), s[5] * inv - bfhi(a.z)); o.w = pk2(s[6] * inv - bflo(a.w), s[7] * inv - bfhi(a.w));
            *(u32x4*)(PD + (size_t)(base + t) * DPOOL + cg * 8) = o; }
        __syncthreads();
    }
    if (Mrows > NLAT) {
        const int cgl = F.tid & 15, rq2 = F.tid >> 4;
        for (int it = blockIdx.x; it < (NCTX / 32) * 8; it += F.G) {
            const int u = it >> 3, k = it & 7, cg2 = k * 16 + cgl, hw2 = 1 << (k >> 1);
            const int base = NLAT + (u >> 3) * CTXL, t0 = (u & 7) * 32;
            const int lo = max(t0 - 8, 0), hi = min(t0 + 32 + 7, CTXL - 1), nrow = hi - lo + 1;
            u32x4 buf[2];
#pragma unroll
            for (int i = 0; i < 2; ++i) { const int sl = rq2 + 32 * i; buf[i] = (sl < nrow) ? *(const u32x4*)(Z + (size_t)(base + lo + sl) * INC + ZC_POOL + cg2 * 8) : (u32x4){0u, 0u, 0u, 0u}; }
#pragma unroll
            for (int i = 0; i < 2; ++i) { const int sl = rq2 + 32 * i; *(LAS u32x4*)(L + sl * 2048 + cg2 * 16) = buf[i]; }
            __syncthreads();
            { const int t = t0 + rq2;
              const int wl = max(t - hw2, 0), wh = min(t + hw2 - 1, CTXL - 1);
              float s8[8] = {0.f, 0.f, 0.f, 0.f, 0.f, 0.f, 0.f, 0.f};
              for (int p = wl; p <= wh; ++p) { const u32x4 a = *(const LAS u32x4*)(L + (p - lo) * 2048 + cg2 * 16);
                  s8[0] += bflo(a.x); s8[1] += bfhi(a.x); s8[2] += bflo(a.y); s8[3] += bfhi(a.y); s8[4] += bflo(a.z); s8[5] += bfhi(a.z); s8[6] += bflo(a.w); s8[7] += bfhi(a.w); }
              const float inv = 1.f / (float)(wh - wl + 1);
              const u32x4 a = *(const LAS u32x4*)(L + (t - lo) * 2048 + cg2 * 16);
              u32x4 o; o.x = pk2(s8[0] * inv - bflo(a.x), s8[1] * inv - bfhi(a.x)); o.y = pk2(s8[2] * inv - bflo(a.y), s8[3] * inv - bfhi(a.y));
              o.z = pk2(s8[4] * inv - bflo(a.z), s8[5] * inv - bfhi(a.z)); o.w = pk2(s8[6] * inv - bflo(a.w), s8[7] * inv - bfhi(a.w));
              *(u32x4*)(PD + (size_t)(base + t) * DPOOL + cg2 * 8) = o; }
            __syncthreads();
        }
    }
}

constexpr int SC_QS = 0, SC_KS = 17408, SC_KST = 34816, SC_VT = 53248, SC_VEC = 71680;
constexpr int SC_ST = 73216, SC_TOT = SC_ST + 34816, SC_END = SC_TOT + 4096;
constexpr int SC_P272 = 272, SC_P144 = 144;
constexpr int SEG_CH = 17, NSEG = 4;
static_assert(SC_END <= LDS_MISC, "scan LDS map");
struct ScanCtx { const bf16_t* Z; bf16_t* O2; LAS unsigned char* L; unsigned char* qsg; float* corrv; float* smid; float* totseg; int tid, lane, w, fr, fq, rt, vp, b, h, seg, dir, colq, colf, colv; };
__device__ __forceinline__ void scan_row0(int b, int dir, int c, int& g0, int& sg) {
    if (c < 4) { const int t0 = 64 * c; g0 = NLAT + b * CTXL + (dir ? CTXL - 1 - t0 : t0); } else { const int t0 = 64 * (c - 4); g0 = b * SEQ + (dir ? SEQ - 1 - t0 : t0); }
    sg = dir ? -1 : 1;
}
__device__ __forceinline__ void scan_load_lf(const ScanCtx& C, int c, unsigned (&lfw)[8]) {
    int g0, sg; scan_row0(C.b, C.dir, c, g0, sg);
#pragma unroll
    for (int j = 0; j < 8; ++j) lfw[j] = *(const unsigned*)(C.Z + (size_t)(g0 + sg * (8 * C.w + j)) * INC + C.colf);
}
__device__ __forceinline__ void scan_load_qv(const ScanCtx& C, int c, unsigned (&qw)[8], unsigned (&vw)[8]) {
    int g0, sg; scan_row0(C.b, C.dir, c, g0, sg);
#pragma unroll
    for (int j = 0; j < 8; ++j) { const bf16_t* zr = C.Z + (size_t)(g0 + sg * (8 * C.w + j)) * INC; qw[j] = *(const unsigned*)(zr + C.colq); vw[j] = *(const unsigned*)(zr + C.colv); }
}
__device__ __forceinline__ void scan_p1(const ScanCtx& C, const unsigned (&lfw)[8]) {
    float a0 = 0.f, a1 = 0.f;
#pragma unroll
    for (int j = 0; j < 8; ++j) { a0 += bflo(lfw[j]); a1 += bfhi(lfw[j]); }
    *(LAS f32x2*)(C.L + SC_TOT + (C.w * 128 + 2 * C.lane) * 4) = (f32x2){a0, a1};
}
__device__ __forceinline__ void scan_p2(const ScanCtx& C, int cl, const unsigned (&lfw)[8], const unsigned (&qw)[8], const unsigned (&vw)[8], float& cum0, float& cum1) {
    LAS unsigned char* L = C.L; const int lane = C.lane, w = C.w;
    float c0[8], c1[8], l0[8], l1[8];
    { float a0 = 0.f, a1 = 0.f;
#pragma unroll
      for (int j = 0; j < 8; ++j) { l0[j] = bflo(lfw[j]); l1[j] = bfhi(lfw[j]); a0 += l0[j]; a1 += l1[j]; c0[j] = a0; c1[j] = a1; } }
    float P0 = 0.f, P1 = 0.f, r0 = 0.f, r1 = 0.f, bl0 = 0.f, bl1 = 0.f;
#pragma unroll
    for (int o = 0; o < 8; ++o) { const f32x2 t = *(const LAS f32x2*)(L + SC_TOT + (o * 128 + 2 * lane) * 4);
        if (o < w) { P0 += t.x; P1 += t.y; } if (o < 4) { r0 += t.x; r1 += t.y; } bl0 += t.x; bl1 += t.y; }
    float k0v[8], k1v[8]; const float P0r = P0 - r0, P1r = P1 - r1;
#pragma unroll
    for (int j = 0; j < 8; ++j) {
        const float d0 = __builtin_amdgcn_fmed3f(P0r + c0[j], -120.f, 120.f), d1 = __builtin_amdgcn_fmed3f(P1r + c1[j], -120.f, 120.f);
        const float E0 = __builtin_amdgcn_exp2f(d0), E1 = __builtin_amdgcn_exp2f(d1), I0 = __builtin_amdgcn_exp2f(-d0), I1 = __builtin_amdgcn_exp2f(-d1);
        const float f0 = __builtin_amdgcn_exp2f(l0[j]), f1 = __builtin_amdgcn_exp2f(l1[j]);
        const float q0 = bflo(qw[j]), q1 = bfhi(qw[j]);
        k0v[j] = (1.f - f0) * I0; k1v[j] = (1.f - f1) * I1;
        const int rho = 8 * w + j;
        *(LAS unsigned*)(L + SC_QS + rho * SC_P272 + 4 * lane) = pk2(q0 * E0, q1 * E1);
        *(LAS unsigned*)(L + SC_KS + rho * SC_P272 + 4 * lane) = pk2(k0v[j], k1v[j]);
    }
    { u32x4 t0, t1; t0.x = pk2(k0v[0], k0v[1]); t0.y = pk2(k0v[2], k0v[3]); t0.z = pk2(k0v[4], k0v[5]); t0.w = pk2(k0v[6], k0v[7]);
      t1.x = pk2(k1v[0], k1v[1]); t1.y = pk2(k1v[2], k1v[3]); t1.z = pk2(k1v[4], k1v[5]); t1.w = pk2(k1v[6], k1v[7]);
      *(LAS u32x4*)(L + SC_KST + (2 * lane) * SC_P144 + 16 * w) = t0; *(LAS u32x4*)(L + SC_KST + (2 * lane + 1) * SC_P144 + 16 * w) = t1; }
    if (w == 0) {
        LAS float* vec = (LAS float*)(L + SC_VEC);
        *(LAS f32x2*)(vec + 2 * lane) = (f32x2){__builtin_amdgcn_exp2f(fmaxf(r0, -120.f)), __builtin_amdgcn_exp2f(fmaxf(r1, -120.f))};
        *(LAS f32x2*)(vec + 128 + 2 * lane) = (f32x2){__builtin_amdgcn_exp2f(fmaxf(bl0, -120.f)), __builtin_amdgcn_exp2f(fmaxf(bl1, -120.f))};
        *(LAS f32x2*)(vec + 256 + 2 * lane) = (f32x2){__builtin_amdgcn_exp2f(fmaxf(bl0 - r0, -120.f)), __builtin_amdgcn_exp2f(fmaxf(bl1 - r1, -120.f))};
        if (C.seg >= 1) *(f32x2*)(C.corrv + cl * 128 + 2 * lane) = (f32x2){r0 + cum0, r1 + cum1};
    }
    cum0 += bl0; cum1 += bl1;
    { u32x4 t0, t1;
      t0.x = (vw[0] & 0xffffu) | (vw[1] << 16); t0.y = (vw[2] & 0xffffu) | (vw[3] << 16); t0.z = (vw[4] & 0xffffu) | (vw[5] << 16); t0.w = (vw[6] & 0xffffu) | (vw[7] << 16);
      t1.x = (vw[0] >> 16) | (vw[1] & 0xffff0000u); t1.y = (vw[2] >> 16) | (vw[3] & 0xffff0000u); t1.z = (vw[4] >> 16) | (vw[5] & 0xffff0000u); t1.w = (vw[6] >> 16) | (vw[7] & 0xffff0000u);
      *(LAS u32x4*)(L + SC_VT + (2 * lane) * SC_P144 + 16 * w) = t0; *(LAS u32x4*)(L + SC_VT + (2 * lane + 1) * SC_P144 + 16 * w) = t1; }
}
__device__ __forceinline__ void scan_c1(const ScanCtx& C, const f32x4 (&S)[2][4]) {
#pragma unroll
    for (int i = 0; i < 2; ++i) { const int k = ((C.w >> 1) * 2 + i) * 16 + 4 * C.fq;
        f32x4 r = *(const LAS f32x4*)(C.L + SC_TOT + k * 4);
#pragma unroll
        for (int o = 1; o < 4; ++o) r += *(const LAS f32x4*)(C.L + SC_TOT + (o * 128 + k) * 4);
        f32x4 e;
#pragma unroll
        for (int q = 0; q < 4; ++q) e[q] = __builtin_amdgcn_exp2f(fmaxf(r[q], -120.f));
#pragma unroll
        for (int u = 0; u < 4; ++u) { const int v = (4 * C.vp + u) * 16 + C.fr; const f32x4 sv = S[i][u] * e;
            u32x2 t; t.x = pk2(sv[0], sv[1]); t.y = pk2(sv[2], sv[3]); *(LAS u32x2*)(C.L + SC_ST + v * SC_P272 + k * 2) = t; } }
}
__device__ __forceinline__ void scan_c2(const ScanCtx& C, int c, f32x4 (&S)[2][4]) {
    LAS unsigned char* L = C.L; const int fr = C.fr, fq = C.fq, rt = C.rt, w = C.w;
    bf16x8 yq[4];
#pragma unroll
    for (int ks = 0; ks < 4; ++ks) yq[ks] = *(const LAS bf16x8*)(L + SC_QS + (rt * 16 + fr) * SC_P272 + (ks * 32 + fq * 8) * 2);
    f32x4 at[4];
#pragma unroll
    for (int st = 0; st < 4; ++st) { f32x4 a = (f32x4){0.f, 0.f, 0.f, 0.f};
        if (st <= rt) {
#pragma unroll
            for (int ks = 0; ks < 4; ++ks) { const bf16x8 x = *(const LAS bf16x8*)(L + SC_KS + (st * 16 + fr) * SC_P272 + (ks * 32 + fq * 8) * 2); a = __builtin_amdgcn_mfma_f32_16x16x32_bf16(x, yq[ks], a, 0, 0, 0); }
            if (st == rt) {
#pragma unroll
                for (int r = 0; r < 4; ++r) if (4 * fq + r > fr) a[r] = 0.f; } }
        at[st] = a; }
    u32x4 yw[2];
#pragma unroll
    for (int ks2 = 0; ks2 < 2; ++ks2) { yw[ks2].x = pk2(at[2 * ks2][0], at[2 * ks2][1]); yw[ks2].y = pk2(at[2 * ks2][2], at[2 * ks2][3]); yw[ks2].z = pk2(at[2 * ks2 + 1][0], at[2 * ks2 + 1][1]); yw[ks2].w = pk2(at[2 * ks2 + 1][2], at[2 * ks2 + 1][3]); }
    int g0, sg; scan_row0(C.b, C.dir, c, g0, sg);
#pragma unroll
    for (int u = 0; u < 4; ++u) { const int vt = 4 * C.vp + u; f32x4 o = (f32x4){0.f, 0.f, 0.f, 0.f};
#pragma unroll
        for (int ks = 0; ks < 4; ++ks) { const bf16x8 x = *(const LAS bf16x8*)(L + SC_ST + (vt * 16 + fr) * SC_P272 + (ks * 32 + fq * 8) * 2); o = __builtin_amdgcn_mfma_f32_16x16x32_bf16(x, yq[ks], o, 0, 0, 0); }
#pragma unroll
        for (int ks2 = 0; ks2 < 2; ++ks2) { if (2 * ks2 <= rt) {
            const u32x2 xa = *(const LAS u32x2*)(L + SC_VT + (vt * 16 + fr) * SC_P144 + (ks2 * 32 + 4 * fq) * 2), xb = *(const LAS u32x2*)(L + SC_VT + (vt * 16 + fr) * SC_P144 + (ks2 * 32 + 16 + 4 * fq) * 2);
            u32x4 xw; xw.x = xa.x; xw.y = xa.y; xw.z = xb.x; xw.w = xb.y;
            o = __builtin_amdgcn_mfma_f32_16x16x32_bf16(__builtin_bit_cast(bf16x8, xw), __builtin_bit_cast(bf16x8, yw[ks2]), o, 0, 0, 0); } }
        u32x2 ow; ow.x = pk2(o[0], o[1]); ow.y = pk2(o[2], o[3]);
        *(u32x2*)(C.O2 + ((size_t)C.dir * MTOK + (g0 + sg * (rt * 16 + fr))) * HGW + C.h * HDK + vt * 16 + 4 * fq) = ow;
        __builtin_amdgcn_sched_barrier(0); }
    bf16x8 xk[2][2];
#pragma unroll
    for (int i = 0; i < 2; ++i)
#pragma unroll
        for (int ks = 0; ks < 2; ++ks) xk[i][ks] = *(const LAS bf16x8*)(L + SC_KST + (((w >> 1) * 2 + i) * 16 + fr) * SC_P144 + (ks * 32 + fq * 8) * 2);
#pragma unroll
    for (int u = 0; u < 4; ++u) { bf16x8 yv[2];
#pragma unroll
        for (int ks = 0; ks < 2; ++ks) yv[ks] = *(const LAS bf16x8*)(L + SC_VT + ((4 * C.vp + u) * 16 + fr) * SC_P144 + (ks * 32 + fq * 8) * 2);
#pragma unroll
        for (int i = 0; i < 2; ++i) { f32x4 d = (f32x4){0.f, 0.f, 0.f, 0.f};
#pragma unroll
            for (int ks = 0; ks < 2; ++ks) d = __builtin_amdgcn_mfma_f32_16x16x32_bf16(xk[i][ks], yv[ks], d, 0, 0, 0);
            const int k = ((w >> 1) * 2 + i) * 16 + 4 * fq; const f32x4 ebl = *(const LAS f32x4*)(L + SC_VEC + (128 + k) * 4), ebr = *(const LAS f32x4*)(L + SC_VEC + (256 + k) * 4);
            S[i][u] = ebl * S[i][u] + ebr * d; }
        __builtin_amdgcn_sched_barrier(0); }
}
__device__ __forceinline__ void phase_scan_mfma(Frame& F) {
    ScanCtx C; C.Z = (const bf16_t*)(F.ws + WS_Z); C.O2 = (bf16_t*)(F.ws + WS_O2); C.L = F.lds;
    C.tid = F.tid; C.lane = F.lane; C.w = F.wave; C.fr = F.lane & 15; C.fq = F.lane >> 4; C.rt = F.wave >> 1; C.vp = F.wave & 1;
    for (int it = blockIdx.x; it < 64 * NSEG; it += F.G) {
        const int sbh = it >> 2; C.h = sbh & 7; C.b = (sbh >> 3) & 3; C.dir = sbh >> 5;
        C.seg = C.dir ? 3 - (it & 3) : (it & 3);
        C.qsg = F.ws + WS_QSG + (size_t)(sbh * 3 + (C.seg - 1)) * SEG_CH * 17408; C.corrv = (float*)(F.ws + WS_CORRV) + (size_t)(sbh * 3 + (C.seg - 1)) * SEG_CH * 128;
        C.smid = (float*)(F.ws + WS_SMID) + (size_t)(sbh * 3 + C.seg) * 128 * 128; C.totseg = (float*)(F.ws + WS_TOTSEG) + (size_t)(sbh * NSEG + C.seg) * 128;
        C.colq = ZC_Q + C.h * HDK + 2 * C.lane; C.colf = (C.dir == 0 ? ZC_FF : ZC_FB) + C.h * HDK + 2 * C.lane; C.colv = ZC_I + C.h * HDK + 2 * C.lane;
        f32x4 S[2][4];
#pragma unroll
        for (int i = 0; i < 2; ++i)
#pragma unroll
            for (int u = 0; u < 4; ++u) S[i][u] = (f32x4){0.f, 0.f, 0.f, 0.f};
        float cum0 = 0.f, cum1 = 0.f;
        unsigned lfW[8], qW[8], vW[8];
        const int c_lo = C.seg * SEG_CH;
        scan_load_lf(C, c_lo, lfW); scan_load_qv(C, c_lo, qW, vW);
        scan_p1(C, lfW);
        __syncthreads();
#define SC_STEP(cl) do { \
            scan_p2(C, (cl), lfW, qW, vW, cum0, cum1); scan_c1(C, S); \
            if ((cl) + 1 < SEG_CH) { scan_load_lf(C, c_lo + (cl) + 1, lfW); scan_load_qv(C, c_lo + (cl) + 1, qW, vW); } \
            __syncthreads(); \
            if (C.seg >= 1) { unsigned char* dst = C.qsg + (size_t)(cl) * 17408; const LAS unsigned char* src = C.L + SC_QS; for (int i_ = C.tid; i_ < 1088; i_ += 512) *(u32x4*)(dst + 16 * i_) = *(const LAS u32x4*)(src + 16 * i_); } \
            scan_c2(C, c_lo + (cl), S); \
            if ((cl) + 1 < SEG_CH) scan_p1(C, lfW); \
            __syncthreads(); } while (0)
        for (int cl = 0; cl < SEG_CH; ++cl) SC_STEP(cl);
#undef SC_STEP
        if (C.seg < 3) {
#pragma unroll
            for (int i = 0; i < 2; ++i)
#pragma unroll
                for (int u = 0; u < 4; ++u) *(f32x4*)(C.smid + ((4 * C.vp + u) * 16 + C.fr) * 128 + ((C.w >> 1) * 2 + i) * 16 + 4 * C.fq) = S[i][u]; }
        if (C.w == 0) *(f32x2*)(C.totseg + 2 * C.lane) = (f32x2){cum0, cum1};
        __syncthreads();
    }
}
__device__ __forceinline__ void phase_scan_fix(Frame& F) {
    unsigned char* ws = F.ws; bf16_t* O2 = (bf16_t*)(ws + WS_O2); LAS unsigned char* L = F.lds;
    LAS float* facv = (LAS float*)(L + 36864); LAS int* flg = (LAS int*)(L + 36864 + 512);
    const int w = F.wave, fr = F.lane & 15, fq = F.lane >> 4, rt = w >> 1, vp = w & 1;
    for (int item = blockIdx.x; item < 64 * 3; item += F.G) {
        const int j = 1 + item % 3, sbh = item / 3, dir = sbh >> 5, b = (sbh >> 3) & 3, h = sbh & 7;
        const int v = F.tid >> 2, k0 = (F.tid & 3) * 32;
        f32x4 sin[8];
        { const float* E = (const float*)(ws + WS_SMID) + ((size_t)(sbh * 3 + 0) * 128 + v) * 128 + k0;
#pragma unroll
          for (int i = 0; i < 8; ++i) sin[i] = *(const f32x4*)(E + 4 * i); }
        for (int jj = 1; jj < j; ++jj) { const float* E = (const float*)(ws + WS_SMID) + ((size_t)(sbh * 3 + jj) * 128 + v) * 128 + k0; const float* T = (const float*)(ws + WS_TOTSEG) + (size_t)(sbh * NSEG + jj) * 128 + k0;
#pragma unroll
            for (int i = 0; i < 8; ++i) { const f32x4 t = *(const f32x4*)(T + 4 * i); f32x4 d;
#pragma unroll
                for (int q = 0; q < 4; ++q) d[q] = __builtin_amdgcn_exp2f(fmaxf(t[q], -200.f));
                sin[i] = d * sin[i] + *(const f32x4*)(E + 4 * i); } }
        for (int cl = 0; cl < SEG_CH; ++cl) {
            if (F.tid == 0) flg[0] = 0;
            __syncthreads();
            if (F.tid < 128) { const float e = ((const float*)(ws + WS_CORRV))[((size_t)(sbh * 3 + (j - 1)) * SEG_CH + cl) * 128 + F.tid]; const float f = __builtin_amdgcn_exp2f(fmaxf(e, -200.f)); facv[F.tid] = f; if (f != 0.f) flg[0] = 1; }
            __syncthreads();
            if (flg[0] != 0) {
#pragma unroll
                for (int i = 0; i < 4; ++i) { const f32x4 a0 = sin[2 * i] * *(const LAS f32x4*)(facv + k0 + 8 * i), a1 = sin[2 * i + 1] * *(const LAS f32x4*)(facv + k0 + 8 * i + 4);
                    u32x4 o; o.x = pk2(a0[0], a0[1]); o.y = pk2(a0[2], a0[3]); o.z = pk2(a1[0], a1[1]); o.w = pk2(a1[2], a1[3]);
                    *(LAS u32x4*)(L + v * SC_P272 + (k0 + 8 * i) * 2) = o; }
                __syncthreads();
                const unsigned char* qs = ws + WS_QSG + ((size_t)(sbh * 3 + (j - 1)) * SEG_CH + cl) * 17408;
                bf16x8 yq[4];
#pragma unroll
                for (int ks = 0; ks < 4; ++ks) yq[ks] = *(const bf16x8*)(qs + (rt * 16 + fr) * SC_P272 + (ks * 32 + fq * 8) * 2);
                int g0, sg; scan_row0(b, dir, j * SEG_CH + cl, g0, sg);
#pragma unroll
                for (int u = 0; u < 4; ++u) { const int vt = 4 * vp + u; f32x4 o = (f32x4){0.f, 0.f, 0.f, 0.f};
#pragma unroll
                    for (int ks = 0; ks < 4; ++ks) { const bf16x8 x = *(const LAS bf16x8*)(L + (vt * 16 + fr) * SC_P272 + (ks * 32 + fq * 8) * 2); o = __builtin_amdgcn_mfma_f32_16x16x32_bf16(x, yq[ks], o, 0, 0, 0); }
                    u32x2* p = (u32x2*)(O2 + ((size_t)dir * MTOK + (g0 + sg * (rt * 16 + fr))) * HGW + h * HDK + vt * 16 + 4 * fq);
                    const u32x2 old = *p; u32x2 nw; nw.x = pk2(bflo(old.x) + o[0], bfhi(old.x) + o[1]); nw.y = pk2(bflo(old.y) + o[2], bfhi(old.y) + o[3]); *p = nw; }
            }
            __syncthreads();
        }
    }
}
__device__ __forceinline__ void phase_readout_naive(Frame& F, const Args& a, int layer, int Mrows) {
    unsigned char* ws = F.ws; const bf16_t* Z = (const bf16_t*)(ws + WS_Z); const float* O2 = (const float*)(ws + WS_O2); bf16_t* HG = (bf16_t*)(ws + WS_HG);
    const float* wn = a.in[I_HGNW] + (size_t)layer * HGW;
    int r0, r1;
    { const int G = F.G, extra = (Mrows / 256) * (DPOOL / 256) - G, c = (int)blockIdx.x;
      int b0, b1;
      if (extra > 0 && 2 * extra < G) { const int nb = (Mrows + extra * 36) / G, heavy = Mrows - (G - extra) * nb;
          if (c < extra) { b0 = (int)(((unsigned)c * (unsigned)heavy) / (unsigned)extra); b1 = (int)(((unsigned)(c + 1) * (unsigned)heavy) / (unsigned)extra); }
          else { b0 = heavy + (c - extra) * nb; b1 = b0 + nb; } }
      else { b0 = (int)(((unsigned)c * (unsigned)Mrows) / (unsigned)G); b1 = (int)(((unsigned)(c + 1) * (unsigned)Mrows) / (unsigned)G); }
      const int n = b1 - b0; r0 = b0 + (F.wave * n) / 8; r1 = b0 + ((F.wave + 1) * n) / 8; }
    const int c0 = F.lane * 16;
    float wv[16];
#pragma unroll
    for (int j = 0; j < 16; ++j) wv[j] = wn[c0 + j] * HG8_SCALE;
    for (int rb = r0; rb < r1; rb += 2) {
        const bool two = rb + 1 < r1; const int rr[2] = {rb, two ? rb + 1 : rb};
        u32x2 xw[2][4], yw[2][4]; u32x4 ga[2], gb[2];
#pragma unroll
        for (int q = 0; q < 2; ++q) {
#pragma unroll
            for (int j = 0; j < 4; ++j) { xw[q][j] = *(const u32x2*)((const bf16_t*)O2 + (size_t)rr[q] * HGW + c0 + 4 * j); yw[q][j] = *(const u32x2*)((const bf16_t*)O2 + ((size_t)MTOK + rr[q]) * HGW + c0 + 4 * j); }
            const u32x4* zp = (const u32x4*)(Z + (size_t)rr[q] * INC + ZC_OG + c0); ga[q] = zp[0]; gb[q] = zp[1]; }
#pragma unroll
        for (int q = 0; q < 2; ++q) { if (q == 0 || two) {
            float o[16]; float ss = 0.f;
#pragma unroll
            for (int j = 0; j < 4; ++j) { const f32x4 x = (f32x4){bflo(xw[q][j].x), bfhi(xw[q][j].x), bflo(xw[q][j].y), bfhi(xw[q][j].y)}, y = (f32x4){bflo(yw[q][j].x), bfhi(yw[q][j].x), bflo(yw[q][j].y), bfhi(yw[q][j].y)};
#pragma unroll
                for (int i = 0; i < 4; ++i) { o[4 * j + i] = x[i] + y[i]; ss += o[4 * j + i] * o[4 * j + i]; } }
            ss += lane_xor(ss, 1, F.lane); ss += lane_xor(ss, 2, F.lane); ss += lane_xor(ss, 4, F.lane);
            const float rs = 1.0f / sqrtf(ss * (1.f / HDK) + EPS);
            const float g[16] = {bflo(ga[q].x), bfhi(ga[q].x), bflo(ga[q].y), bfhi(ga[q].y), bflo(ga[q].z), bfhi(ga[q].z), bflo(ga[q].w), bfhi(ga[q].w), bflo(gb[q].x), bfhi(gb[q].x), bflo(gb[q].y), bfhi(gb[q].y), bflo(gb[q].z), bfhi(gb[q].z), bflo(gb[q].w), bfhi(gb[q].w)};
            float y[16];
#pragma unroll
            for (int j = 0; j < 16; ++j) y[j] = o[j] * rs * wv[j] * g[j];
            u32x4 o0; o0.x = pk4_fp8(y[0], y[1], y[2], y[3]); o0.y = pk4_fp8(y[4], y[5], y[6], y[7]); o0.z = pk4_fp8(y[8], y[9], y[10], y[11]); o0.w = pk4_fp8(y[12], y[13], y[14], y[15]);
            *(u32x4*)((unsigned char*)HG + (size_t)rr[q] * HGW + c0) = o0; } }
    }
}

__device__ __forceinline__ void phase_final(Frame& F, const Args& a) {
    unsigned char* ws = F.ws; const bf16_t* X = (const bf16_t*)(ws + WS_X); const float* MOD = (const float*)(ws + WS_MOD); const float* fw = a.in[I_FNW];
    int r0, r1; wave_rows(F, NLAT, r0, r1);
    for (int r = r0; r < r1;) {
        const bool two = (r + 1 < r1) && (mod_row(r + 1) == mod_row(r));
        const int rr[2] = {r, two ? r + 1 : r};
        f32x4 x[2][8];
#pragma unroll
        for (int q = 0; q < 2; ++q) xrow_load(X, rr[q], F.lane, x[q]);
        moe_combine_rows<2>(x, rr, F.lane, ws, DEPTH - 1, MOD + ((size_t)(DEPTH - 1) * 5 + mod_row(r)) * 6 * D + 5 * D);
        float ss0 = row_sumsq(x[0]), ss1 = row_sumsq(x[1]);
#pragma unroll
        for (int o = 1; o < 64; o <<= 1) { ss0 += lane_xor(ss0, o, F.lane); ss1 += lane_xor(ss1, o, F.lane); }
        const float rs[2] = {1.0f / sqrtf(ss0 * (1.f / D) + EPS), 1.0f / sqrtf(ss1 * (1.f / D) + EPS)};
#pragma unroll
        for (int q = 0; q < 2; ++q) if (q == 0 || two) { f32x4* o = (f32x4*)(a.out + (size_t)rr[q] * D) + F.lane;
#pragma unroll
            for (int j = 0; j < 8; ++j) o[64 * j] = x[q][j] * rs[q] * *((const f32x4*)fw + 64 * j + F.lane); }
        r += two ? 2 : 1;
    }
}

__device__ __forceinline__ int moe_tables(Frame& F, int layer) {
    LAS int* tbl = (LAS int*)(F.lds + LDS_MISC + 64);
    const unsigned* cntw = (const unsigned*)(F.ws + WS_CTL) + CW_CNT + layer * 1024;
    if (F.tid < NEXP) tbl[F.tid] = (int)__hip_atomic_load(cntw + F.tid * 64, __ATOMIC_RELAXED, __HIP_MEMORY_SCOPE_AGENT);
    __syncthreads();
    if (F.tid == 0) {
        int blk = 0;
#pragma unroll 1
        for (int e = 0; e < NEXP; ++e) { const int c = tbl[e]; const int nb = (c + 255) >> 8;
            tbl[16 + e] = blk; for (int j = 0; j < nb; ++j) tbl[64 + blk + j] = e;
            if (blockIdx.x == 0) ((int*)(F.ws + WS_PADBASE))[layer * 16 + e] = blk * 256;
            blk += nb; }
        tbl[32] = blk;
    }
    __syncthreads();
    return tbl[32];
}

constexpr int PH_PER_LAYER = 10;
constexpr int N_PHASES = 1 + DEPTH * PH_PER_LAYER + 1;

__global__ void __launch_bounds__(512, 2) mk_fwd(Args args) {
    extern __shared__ __attribute__((aligned(16))) unsigned char lds_raw[];
    Frame F;
    F.lds = (LAS unsigned char*)lds_raw;
    F.tid = threadIdx.x; F.lane = F.tid & 63; F.wave = __builtin_amdgcn_readfirstlane(F.tid >> 6);
    F.G = gridDim.x; F.gw = blockIdx.x * 8 + F.wave; F.NGW = F.G * 8; F.ws = args.ws;
    unsigned char* ws = args.ws;
    volatile LAS unsigned* misc = (volatile LAS unsigned*)(F.lds + LDS_MISC);
    if (F.tid < 16) misc[F.tid] = 0u;
    __syncthreads();
    const int lo = args.ph_lo, hi = args.ph_hi;
#if MK_ONE_LAUNCH
    XcdBarrier bar = xcd_barrier_post((unsigned*)(ws + WS_CTL) + CW_BAR, misc);
#define GRID_BAR() xcd_barrier(bar)
#else
#define GRID_BAR() do {} while (0)
#endif
#ifndef MK_PHMASK
#define MK_PHMASK 0xFFFF
#endif
#define PHON(b) ((MK_PHMASK >> (b)) & 1)
#ifndef MK_REPMASK
#define MK_REPMASK 0
#endif
#define REPS(b) (((args.rep >> (b)) & 1) + 1)
#define IN(k) (lo <= (k) && (k) < hi)
#define LAUNDER() do { int t_ = threadIdx.x; asm volatile("" : "+v"(t_)); F.tid = t_; F.lane = t_ & 63; unsigned char* w_ = args.ws; asm volatile("" : "+s"(w_)); F.ws = w_; ws = w_; } while (0)
#define SEAM(k) do { if (IN(k) && IN((k) + 1)) { GRID_BAR(); if ((args.rep >> 15) & 1) GRID_BAR(); } } while (0)

    if (PHON(0) && IN(0)) { LAUNDER(); for (int rep_ = 0; rep_ < REPS(0); ++rep_) { if (rep_) { VM_WAIT(); __syncthreads(); } phase_prologue(F, args); } }
    SEAM(0);

    for (int layer_ = 0; layer_ < DEPTH; ++layer_) {
        int layer = layer_; asm volatile("" : "+s"(layer));
        const int pb = 1 + layer * PH_PER_LAYER;
        const bool lastl = (layer == DEPTH - 1);
        const int Mr = lastl ? NLAT : MTOK;
        if (PHON(1) && IN(pb + 0)) { LAUNDER(); for (int rep_ = 0; rep_ < REPS(1); ++rep_) { if (rep_) { VM_WAIT(); __syncthreads(); } phase_norm1(F, args, layer, layer > 0 && rep_ == 0); } }
        SEAM(pb + 0);
        if (PHON(2) && IN(pb + 1)) { LAUNDER(); for (int rep_ = 0; rep_ < REPS(2); ++rep_) { if (rep_) { VM_WAIT(); __syncthreads(); }
            pg8::DenseOrder S; S.init(MTOK, INC, F.G, (int)blockIdx.x, D, 0);
            pg8::EpiIn E{(bf16_t*)(ws + WS_Z), (const float*)(ws + WS_LB) + (size_t)layer * 2 * 1024, ws + WS_G8};
            pg8::gemm_phase<pg8::EpiIn, pg8::DenseOrder, true>(F.lds, ws + WS_H, D, ws + WS_WIN + (size_t)layer * INC * D, D, D, S, E);
        } }
        SEAM(pb + 1);
        if (PHON(3) && IN(pb + 2)) { LAUNDER(); for (int rep_ = 0; rep_ < REPS(3); ++rep_) { if (rep_) { VM_WAIT(); __syncthreads(); } phase_pooldiff(F, Mr); __syncthreads(); } { VM_WAIT(); __syncthreads(); phase_scan_mfma(F); GRID_BAR(); LAUNDER(); phase_scan_fix(F); } }
        SEAM(pb + 2);
        if (PHON(4) && IN(pb + 3)) { LAUNDER(); for (int rep_ = 0; rep_ < REPS(4); ++rep_) { if (rep_) { VM_WAIT(); __syncthreads(); }
            pg8::DenseOrder S; S.init(Mr, DPOOL, F.G, (int)blockIdx.x, DPOOL * 2, 512);
            pg8::EpiPool E{(bf16_t*)(ws + WS_P), args.in[I_PSCALE] + (size_t)layer * DPOOL};
            pg8::gemm_phase(F.lds, ws + WS_PD, DPOOL * 2, ws + WS_WPG + (size_t)layer * 1024 * 256 * 2, 512, 512, S, E);
        } }
        if (PHON(4) && IN(pb + 3)) { VM_WAIT(); __syncthreads(); }
        if (PHON(5) && IN(pb + 4)) { LAUNDER(); for (int rep_ = 0; rep_ < REPS(5); ++rep_) { if (rep_) { VM_WAIT(); __syncthreads(); } phase_readout_naive(F, args, layer, Mr); } }
        SEAM(pb + 4);
        if (PHON(6) && IN(pb + 5)) { LAUNDER(); for (int rep_ = 0; rep_ < REPS(6); ++rep_) { if (rep_) { VM_WAIT(); __syncthreads(); }
            pg8::DenseOrder S; S.init(Mr, D, F.G, (int)blockIdx.x, 1024, 0);
            { pg8::EpiGate2 E{ws + WS_MX, ws + WS_G8, 0, ZC_GH - ZC_GP, HG8_SCALE, 1.f / (W8_SCALE * HG8_SCALE * 255.f)};
              pg8::gemm_phase<pg8::EpiGate2, pg8::DenseOrder, true, true>(F.lds, ws + WS_P, 1024, ws + WS_WBP + (size_t)layer * D * 1024, 2048, 1024, S, E,
                  (long)WS_HG - (long)WS_P - 8 * 128, (long)WS_WBH - (long)WS_WBP - 8 * 128, 8); }
            if (rep_ == 0) { int rk, nn; idle_rank((Mr / 256) * 8, F.G, (int)blockIdx.x, rk, nn); convert_range(F, args, layer + 1, 0, 36000, rk, nn); }
        } }
        SEAM(pb + 5);
        if (PHON(7) && IN(pb + 6)) { LAUNDER(); for (int rep_ = 0; rep_ < REPS(7); ++rep_) { if (rep_) { VM_WAIT(); __syncthreads(); }
            pg8::DenseOrder S; S.init(Mr, D, F.G, (int)blockIdx.x, D, 0);
            pg8::EpiOut E{(bf16_t*)(ws + (rep_ ? WS_O2 : WS_X)), layer == 0 ? (const void*)args.in[I_X] : (const void*)(ws + WS_X), layer == 0 ? (const void*)args.in[I_CTX] : (const void*)(ws + WS_X), layer == 0, (const float*)(ws + WS_MOD) + (size_t)layer * 5 * 6 * D, 1.f / W8_SCALE};
            pg8::gemm_phase<pg8::EpiOut, pg8::DenseOrder, true>(F.lds, ws + WS_MX, D, ws + WS_WOUT + (size_t)layer * D * D, D, D, S, E);
            if (rep_ == 0) { int rk, nn; idle_rank((Mr / 256) * 8, F.G, (int)blockIdx.x, rk, nn); convert_range(F, args, layer + 1, 36000, 52000, rk, nn); }
        } }
        SEAM(pb + 6);
        if (PHON(8) && IN(pb + 7)) { LAUNDER(); for (int rep_ = 0; rep_ < REPS(8); ++rep_) { if (rep_) { VM_WAIT(); __syncthreads(); } phase_norm2_router(F, args, layer, Mr, rep_ == 0); } }
        SEAM(pb + 7);
        if (PHON(9) && IN(pb + 8)) { LAUNDER(); for (int rep_ = 0; rep_ < REPS(9); ++rep_) { if (rep_) { VM_WAIT(); __syncthreads(); }
            const int nblk = moe_tables(F, layer);
            pg8::MoeOrder<true> S; S.nN = 4; S.nunits = nblk * 4; S.G = F.G; S.c = (int)blockIdx.x; S.lda_b = D; S.tbl = (const LAS int*)(F.lds + LDS_MISC + 64);
            S.slottok = (const int*)(ws + WS_SLOTTOK); S.b_estride = (size_t)1024 * D;
            pg8::EpiMoe1 E{(bf16_t*)(ws + WS_ACT)};
            pg8::gemm_phase<pg8::EpiMoe1, pg8::MoeOrder<true>, true>(F.lds, ws + WS_H, D, ws + WS_WE13 + (size_t)layer * NEXP * 1024 * D, D, D, S, E);
            if (rep_ == 0) { int rk, nn; idle_rank(nblk * 4, F.G, (int)blockIdx.x, rk, nn); convert_range(F, args, layer + 1, 52000, 70000, rk, nn); }
        } }
        SEAM(pb + 8);
        if (PHON(10) && IN(pb + 9)) { LAUNDER(); for (int rep_ = 0; rep_ < REPS(10); ++rep_) { if (rep_) { VM_WAIT(); __syncthreads(); }
            const int nblk = moe_tables(F, layer);
            pg8::MoeOrder<false> S; S.nN = 8; S.nunits = nblk * 8; S.G = F.G; S.c = (int)blockIdx.x; S.lda_b = DEXP; S.tbl = (const LAS int*)(F.lds + LDS_MISC + 64);
            S.slottok = nullptr; S.b_estride = (size_t)D * DEXP;
            pg8::EpiY8 E{ws + WS_Y2, D, Y8_SCALE / (W8_SCALE * ACT8_SCALE)};
            pg8::gemm_phase<pg8::EpiY8, pg8::MoeOrder<false>, true>(F.lds, ws + WS_ACT, DEXP, ws + WS_WE2 + (size_t)layer * NEXP * D * DEXP, DEXP, DEXP, S, E);
            if (rep_ == 0) { int rk, nn; idle_rank(nblk * 8, F.G, (int)blockIdx.x, rk, nn); convert_range(F, args, layer + 1, 70000, CONV_ITEMS, rk, nn); }
        } }
        SEAM(pb + 9);
    }
    if (PHON(11) && IN(N_PHASES - 1)) { LAUNDER(); for (int rep_ = 0; rep_ < REPS(11); ++rep_) { if (rep_) { VM_WAIT(); __syncthreads(); } phase_final(F, args); } }
#undef IN
#undef SEAM
}

extern "C" void kernel_launch(void* const* d_in, const int* in_sizes, int n_in, void* d_out, int out_size, void* d_ws, size_t ws_size, hipStream_t stream) {
    static int grid = 0;
    if (grid == 0) {
        if (n_in != 22 || out_size != NLAT * D || ws_size < WS_END) { fprintf(stderr, "kernel_launch: unexpected shapes (n_in %d out %d ws %zu need %zu)\n", n_in, out_size, ws_size, (size_t)WS_END); grid = -1; return; }
        int dev = 0, cus = 0, per_cu = 0;
        if (hipGetDevice(&dev) != hipSuccess || hipDeviceGetAttribute(&cus, hipDeviceAttributeMultiprocessorCount, dev) != hipSuccess) { grid = -1; return; }
        if (hipFuncSetAttribute((const void*)mk_fwd, hipFuncAttributeMaxDynamicSharedMemorySize, LDS_BYTES) != hipSuccess) { fprintf(stderr, "kernel_launch: hipFuncSetAttribute failed\n"); grid = -1; return; }
        if (hipOccupancyMaxActiveBlocksPerMultiprocessor(&per_cu, (const void*)mk_fwd, 512, LDS_BYTES) != hipSuccess || per_cu < 1) fprintf(stderr, "kernel_launch: occupancy query says %d\n", per_cu);
        (void)hipGetLastError();
        grid = cus;
    }
    if (grid < 0) return;
    (void)hipMemsetAsync((char*)d_ws + WS_CTL, 0, CTL_BYTES, stream);
    Args a{};
    for (int i = 0; i < 22; ++i) a.in[i] = (const float*)d_in[i];
    a.out = (float*)d_out; a.ws = (unsigned char*)d_ws; a.rep = MK_REPMASK; a.pad = 0;
#if MK_ONE_LAUNCH
    a.ph_lo = 0; a.ph_hi = N_PHASES;
    hipLaunchKernelGGL(mk_fwd, dim3(grid), dim3(512), LDS_BYTES, stream, a);
#else
    for (int p = 0; p < N_PHASES; ++p) { a.ph_lo = p; a.ph_hi = p + 1; hipLaunchKernelGGL(mk_fwd, dim3(grid), dim3(512), LDS_BYTES, stream, a); }
#endif
}
```

```cpp
#include <hip/hip_runtime.h>
#include <cstdio>
#include <cstdint>

#ifndef MK_ONE_LAUNCH
#define MK_ONE_LAUNCH 1
#endif

constexpr int D = 2048, NBATCH = 4, SEQ = 4096, DEPTH = 4, CTXL = 256;
constexpr int NLAT = NBATCH * SEQ, NCTX = NBATCH * CTXL, MTOK = NLAT + NCTX;
constexpr int DPOOL = 1024, HGW = 1024, NHEAD = 8, HDK = 128;
constexpr int INC = 10240;
constexpr int NEXP = 16, DEXP = 512;
constexpr int MAXSLOT = 38912;
constexpr float EPS = 1e-6f;
constexpr int ZC_POOL = 0, ZC_Q = 1024, ZC_FF = 2048, ZC_FB = 3072, ZC_I = 4096, ZC_OG = 5120, ZC_GP = 6144, ZC_GH = 8192;

#define GAS __attribute__((address_space(1)))
#define LAS __attribute__((address_space(3)))
typedef unsigned short bf16_t;
typedef short bf16x8 __attribute__((ext_vector_type(8)));
typedef float f32x4 __attribute__((ext_vector_type(4)));
typedef float f32x2 __attribute__((ext_vector_type(2)));
typedef unsigned u32x4 __attribute__((ext_vector_type(4)));
typedef unsigned u32x2 __attribute__((ext_vector_type(2)));
typedef int i32x4 __attribute__((ext_vector_type(4)));
typedef int i32x8 __attribute__((ext_vector_type(8)));
constexpr float W8_SCALE = 32.f;

constexpr size_t MiB = 1u << 20;
constexpr size_t align_up(size_t x) { return (x + 255) & ~(size_t)255; }
constexpr size_t WS_CTL = 0, CTL_BYTES = 1 * MiB;
constexpr size_t WS_MOD = WS_CTL + CTL_BYTES;
constexpr size_t WS_LB = WS_MOD + align_up((size_t)DEPTH * 5 * 6 * D * 4);
constexpr size_t WS_ROUTE_I = WS_LB + align_up((size_t)DEPTH * 2 * 1024 * 4);
constexpr size_t WS_ROUTE_G = WS_ROUTE_I + align_up((size_t)MTOK * 8);
constexpr size_t WS_SLOTTOK = WS_ROUTE_G + align_up((size_t)MTOK * 8);
constexpr size_t WS_PADBASE = WS_SLOTTOK + align_up((size_t)NEXP * MTOK * 4);
constexpr size_t WS_WIN = WS_PADBASE + align_up((size_t)DEPTH * 16 * 4);
constexpr size_t WS_WPG = WS_WIN + (size_t)DEPTH * INC * D * 2;
constexpr size_t WS_WBP = WS_WPG + (size_t)DEPTH * 1024 * 256 * 2;
constexpr size_t WS_WBH = WS_WBP + (size_t)DEPTH * D * 1024 * 2;
constexpr size_t WS_WOUT = WS_WBH + (size_t)DEPTH * D * 1024 * 2;
constexpr size_t WS_WE13 = WS_WOUT + (size_t)DEPTH * D * D * 2;
constexpr size_t WS_WE2 = WS_WE13 + (size_t)DEPTH * NEXP * 1024 * D * 2;
constexpr size_t WS_X = WS_WE2 + (size_t)DEPTH * NEXP * D * DEXP * 2;
constexpr size_t WS_H = WS_X + (size_t)MTOK * D * 4;
constexpr size_t WS_Z = WS_H + (size_t)MTOK * D * 2;
constexpr size_t WS_ACT = WS_Z;
constexpr size_t WS_Y2 = WS_ACT + (size_t)MAXSLOT * DEXP * 2;
constexpr size_t WS_PD = WS_Z + (size_t)MTOK * INC * 2;
constexpr size_t WS_P = WS_PD + (size_t)MTOK * 1024 * 2;
constexpr size_t WS_HG = WS_P + (size_t)MTOK * 1024 * 2;
constexpr size_t WS_O2 = WS_HG + (size_t)MTOK * 1024 * 2;
constexpr size_t WS_QSG = WS_O2 + (size_t)2 * MTOK * 1024 * 2;
constexpr size_t WS_SMID = WS_QSG + (size_t)64 * 3 * 17 * 17408;
constexpr size_t WS_CORRV = WS_SMID + (size_t)64 * 3 * 128 * 128 * 4;
constexpr size_t WS_TOTSEG = WS_CORRV + (size_t)64 * 3 * 17 * 128 * 4;
static_assert(WS_TOTSEG + (size_t)64 * 4 * 128 * 4 <= WS_O2 + (size_t)2 * MTOK * 1024 * 4, "scan hand-off buffers fit in the O2 region");
constexpr size_t WS_M1 = WS_O2 + (size_t)2 * MTOK * 1024 * 4;
constexpr size_t WS_MX = WS_M1 + (size_t)MTOK * D * 2;
constexpr size_t WS_G8 = WS_M1;
constexpr size_t WS_END = WS_MX + (size_t)MTOK * D * 2;
static_assert(WS_Y2 + (size_t)MAXSLOT * D * 2 <= WS_PD, "ACT|Y2 overlay fits in Z");

constexpr int CW_BAR = 4096;
constexpr int CW_CNT = 16384;

constexpr int LDS_STAGE = 131072;
constexpr int LDS_MISC = 149504;
constexpr int LDS_BYTES = LDS_MISC + 8192;

__device__ __forceinline__ unsigned f2bf(float f) { unsigned u = __builtin_bit_cast(unsigned, f); return (u + 0x7fffu + ((u >> 16) & 1u)) >> 16; }
typedef __bf16 bf16x2_t __attribute__((ext_vector_type(2)));
__device__ __forceinline__ unsigned pk2(float lo, float hi) { const f32x2 v = {lo, hi}; const bf16x2_t b = __builtin_convertvector(v, bf16x2_t); return __builtin_bit_cast(unsigned, b); }
__device__ __forceinline__ float bflo(unsigned w) { return __builtin_bit_cast(float, w << 16); }
__device__ __forceinline__ float bfhi(unsigned w) { return __builtin_bit_cast(float, w & 0xffff0000u); }
__device__ __forceinline__ float bf1(bf16_t h) { return __builtin_bit_cast(float, ((unsigned)h) << 16); }
__device__ __forceinline__ float fsigmoid(float x) { return __builtin_amdgcn_rcpf(1.f + __builtin_amdgcn_exp2f(-1.44269504f * x)); }
__device__ __forceinline__ float fsilu(float x) { return x * fsigmoid(x); }
__device__ __forceinline__ float lane_xor(float v, int o, int lane) { return __builtin_bit_cast(float, __builtin_amdgcn_ds_bpermute((lane ^ o) << 2, __builtin_bit_cast(int, v))); }
#define LDS_WAIT() asm volatile("s_waitcnt lgkmcnt(0)" ::: "memory")
#define VM_WAIT() asm volatile("s_waitcnt vmcnt(0)" ::: "memory")

__device__ __forceinline__ unsigned pk4_fp8(float a, float b, float c, float d) { int w = 0; w = __builtin_amdgcn_cvt_pk_fp8_f32(a, b, w, false); w = __builtin_amdgcn_cvt_pk_fp8_f32(c, d, w, true); return (unsigned)w; }
constexpr float Y8_SCALE = 16.f;
constexpr float HG8_SCALE = 4.f, ACT8_SCALE = 4.f;
#define XB_TMO      128
#define XB_XCNT(j)  (256  + 64 * (j))
#define XB_XSUB(j)  (1280 + 64 * (j))
#define XB_XGEN(j)  (2304 + 64 * (j))
#define XB_TOP      3328
#define XB_TOPGEN   3392
#define XCD_BAR_WORDS 3456
#define XB_SPIN_CAP (1u << 18)
__device__ __forceinline__ unsigned xb_ld(unsigned* p)              { return __hip_atomic_load(p, __ATOMIC_RELAXED, __HIP_MEMORY_SCOPE_AGENT); }
__device__ __forceinline__ unsigned xb_add(unsigned* p, unsigned v) { return __hip_atomic_fetch_add(p, v, __ATOMIC_RELAXED, __HIP_MEMORY_SCOPE_AGENT); }
__device__ __forceinline__ unsigned xb_xcc_id() { return (unsigned)__builtin_amdgcn_s_getreg((3 << 11) | 20) & 0xFu; }
#define XB_SPIN(cond, bar) do { unsigned _sp = 0; while (cond) { __builtin_amdgcn_s_sleep(1); \
    if ((++_sp & 255u) == 0u) { if (xb_ld(&(bar)[XB_TMO])) break; if (_sp > XB_SPIN_CAP) { atomicAdd(&(bar)[XB_TMO], 1u); break; } } } } while (0)
struct XcdBarrier { unsigned* bar; unsigned x; volatile LAS unsigned* st; };
__device__ __forceinline__ XcdBarrier xcd_barrier_post(unsigned* bar, volatile LAS unsigned* st) {
    XcdBarrier b; b.bar = bar; b.x = xb_xcc_id(); b.st = st;
    if (threadIdx.x == 0) (void)xb_add(&bar[XB_XCNT(b.x)], 1u);
    return b;
}
__device__ __forceinline__ void xcd_barrier_complete(unsigned* bar, unsigned x, unsigned& nloc, unsigned& nx) {
    const unsigned G = gridDim.x * gridDim.y * gridDim.z;
    unsigned sum, cnt, mine, sp = 0u;
    for (;;) {
        sum = 0u; cnt = 0u; mine = 0u;
#pragma unroll
        for (unsigned j = 0; j < 16; ++j) { const unsigned c = xb_ld(&bar[XB_XCNT(j)]); sum += c; cnt += (c > 0u) ? 1u : 0u; mine = (j == x) ? c : mine; }
        if (sum == G) break;
        __builtin_amdgcn_s_sleep(1);
        if ((++sp & 255u) == 0u) { if (xb_ld(&bar[XB_TMO])) break; if (sp > XB_SPIN_CAP) { atomicAdd(&bar[XB_TMO], 1u); break; } }
    }
    nloc = mine > 0u ? mine : 1u; nx = cnt > 0u ? cnt : 1u;
}
__device__ __forceinline__ void xcd_barrier(const XcdBarrier& b) {
    asm volatile("s_waitcnt vmcnt(0)" ::: "memory");
    __syncthreads();
    if (threadIdx.x == 0) {
        unsigned* bar = b.bar;
        __builtin_amdgcn_s_waitcnt(0);
        unsigned nloc = b.st[0], nx = b.st[1];
        if (nloc == 0u) { xcd_barrier_complete(bar, b.x, nloc, nx); b.st[0] = nloc; b.st[1] = nx; }
        const unsigned old = xb_add(&bar[XB_XSUB(b.x)], 1u);
        const unsigned gen = old / nloc;
        if (old + 1u == (gen + 1u) * nloc) {
            __builtin_amdgcn_fence(__ATOMIC_RELEASE, "agent");
            asm volatile("s_waitcnt vmcnt(0)" ::: "memory");
            const unsigned og = xb_add(&bar[XB_TOP], 1u);
            const unsigned tg = og / nx;
            if (og + 1u == (tg + 1u) * nx) xb_add(&bar[XB_TOPGEN], 1u);
            else XB_SPIN(xb_ld(&bar[XB_TOPGEN]) == tg, bar);
            __builtin_amdgcn_fence(__ATOMIC_ACQUIRE, "agent");
            xb_add(&bar[XB_XGEN(b.x)], 1u);
            asm volatile("s_waitcnt vmcnt(0)" ::: "memory");
        } else {
            XB_SPIN(xb_ld(&bar[XB_XGEN(b.x)]) == gen, bar);
            __builtin_amdgcn_fence(__ATOMIC_ACQUIRE, "agent");
            asm volatile("s_waitcnt vmcnt(0)" ::: "memory");
        }
    }
    __syncthreads();
}

namespace pg8 {
constexpr int BM = 256, BK = 64, HALF = 128, HTB = HALF * BK * 2, NXCD = 8, WGM = 8;
__host__ __device__ __forceinline__ int lds_byte(int r, int c) { const int st = (r >> 4) * 2 + (c >> 5), rr = r & 15, cc = c & 31, ob = rr * 64 + cc * 2; return st * 1024 + (ob ^ (((ob >> 9) & 1) << 5)); }
__host__ __device__ __forceinline__ void stage_rc(int b, int& R, int& C) { const int st = b / 1024, sb = b % 1024, swz = sb ^ (((sb >> 9) & 1) << 5); R = (st >> 1) * 16 + swz / 64; C = (st & 1) * 32 + (swz % 64) / 2; }
__host__ __device__ __forceinline__ int perm32(int rho) { const int n = rho >> 4, i = rho & 15; return 8 * (i >> 2) + 4 * n + (i & 3); }

struct Unit { int pm, pn; };

struct DenseOrder {
    static constexpr bool GATHER = false;
    int nM, nN, nwg, G, c, lda_b, acol_b;
    __device__ void init(int M, int N, int G_, int c_, int lda_b_, int acol_b_) { nM = M / BM; nN = N / BM; nwg = nM * nN; G = G_; c = c_; lda_b = lda_b_; acol_b = acol_b_; }
    __device__ __forceinline__ bool next(int i, Unit& u) const {
        const long L = (long)i * G + c; if (L >= nwg) return false;
        int wgid = (int)L; { const int q = nwg / NXCD, r = nwg % NXCD, xcd = wgid % NXCD, off = wgid / NXCD; wgid = (xcd < r ? xcd * (q + 1) : r * (q + 1) + (xcd - r) * q) + off; }
        const int nig = WGM * nN, gid = wgid / nig, fm = gid * WGM, gsz = (nM - fm) < WGM ? (nM - fm) : WGM;
        u.pm = fm + ((wgid % nig) % gsz); u.pn = (wgid % nig) / gsz; return true;
    }
    __device__ __forceinline__ size_t a_base(const Unit& u) const { return (size_t)u.pm * BM * lda_b + (size_t)u.pn * acol_b; }
    __device__ __forceinline__ void a_offs(const Unit&, unsigned (&)[2][2]) const {}
    __device__ __forceinline__ size_t b_off(const Unit& u, int ldb_b) const { return (size_t)u.pn * BM * ldb_b; }
};
template <bool GATHER_> struct MoeOrder {
    static constexpr bool GATHER = GATHER_;
    int nN, nunits, G, c, lda_b; const LAS int* tbl;
    const int* slottok; size_t b_estride;
    __device__ __forceinline__ bool next(int i, Unit& u) const {
        const int L = i * G + c; if (L >= nunits) return false;
        u.pm = L / nN; u.pn = L % nN; return true;
    }
    __device__ __forceinline__ size_t a_base(const Unit& u) const { return (size_t)u.pm * BM * lda_b; }
    __device__ __forceinline__ void a_offs(const Unit& u, unsigned (&v)[2][2]) const {
        const int e = __builtin_amdgcn_readfirstlane(tbl[64 + u.pm]), j0 = __builtin_amdgcn_readfirstlane((u.pm - tbl[16 + e]) * BM), cnt = __builtin_amdgcn_readfirstlane(tbl[e]);
#pragma unroll
        for (int i = 0; i < 2; ++i) { int R, C; stage_rc((int)threadIdx.x * 16 + i * 8192, R, C);
#pragma unroll
            for (int h = 0; h < 2; ++h) { const int j = j0 + h * HALF + R; const int tok = (j < cnt) ? slottok[(size_t)e * MTOK + j] : 0; v[h][i] = (unsigned)(tok * lda_b + C * 2); } }
    }
    __device__ __forceinline__ size_t b_off(const Unit& u, int ldb_b) const { const int e = __builtin_amdgcn_readfirstlane(tbl[64 + u.pm]); return (size_t)e * b_estride + (size_t)u.pn * BM * ldb_b; }
};

template <class Epi, class Sched, bool FP8 = false, bool SPLIT = false>
__device__ __forceinline__ void gemm_phase(LAS unsigned char* lds, const void* Abase, const int lda_b, const void* Bbase, const int Kb, const int ldb_b, const Sched& S, const Epi& E, const long dA = 0, const long dB = 0, const int nt1 = 0) {
    constexpr bool GA = Sched::GATHER;
    int tid_ = threadIdx.x; asm volatile("" : "+v"(tid_));
    const int tid = tid_, wid = __builtin_amdgcn_readfirstlane(tid >> 6), lane = tid & 63, wr = wid >> 2, wc = wid & 3, fr = lane & 15, fq = lane >> 4;
    const int nt = Kb / 128;
    unsigned voffA[2], voffB[2];
#pragma unroll
    for (int i = 0; i < 2; ++i) { int R, C; stage_rc(tid * 16 + i * 8192, R, C); const int Rb = Epi::PERM ? ((R & ~31) + perm32(R & 31)) : R; voffA[i] = (unsigned)(R * lda_b + C * 2); voffB[i] = (unsigned)(Rb * ldb_b + C * 2); }
    const size_t kstep = (size_t)(BK * 2);
    const size_t hstepA = (size_t)HALF * lda_b, hstepB = (size_t)HALF * ldb_b;
    const unsigned ldsw = (unsigned)wid * 1024u;
    const int aoff = lds_byte(wr * 64 + fr, fq * 8), boff = lds_byte(wc * 32 + fr, fq * 8);
#define PG8_SA(b, h) (((b) * 2 + (h)) * HTB)
#define PG8_SB(b, h) ((4 + (b) * 2 + (h)) * HTB)
#define PG8_STAGE2(bufoff, gbase, o0, o1) do { \
        __builtin_amdgcn_global_load_lds((const unsigned*)((const char*)(gbase) + (o0)), (LAS unsigned*)(lds + (bufoff) + ldsw), 16, 0, 0); \
        __builtin_amdgcn_global_load_lds((const unsigned*)((const char*)(gbase) + (o1)), (LAS unsigned*)(lds + (bufoff) + ldsw + 8192), 16, 0, 0); } while (0)
#define PG8_STAGEB(bufoff, gbase) PG8_STAGE2(bufoff, gbase, voffB[0], voffB[1])
#define PG8_STAGEA(bufoff, gbase, h, x0, x1) do { if constexpr (GA) PG8_STAGE2(bufoff, gbase, x0, x1); else PG8_STAGE2(bufoff, (gbase) + ((h) ? hstepA : (size_t)0), voffA[0], voffA[1]); } while (0)
#define PG8_LD32(dst, addr) do { const i32x4 lo_ = *(const LAS i32x4*)(lds + (addr)), hi_ = *(const LAS i32x4*)(lds + (addr) + 1024); dst = (i32x8){lo_[0], lo_[1], lo_[2], lo_[3], hi_[0], hi_[1], hi_[2], hi_[3]}; } while (0)
#define PG8_LDA(dst, b, h) do { _Pragma("unroll") for (int m = 0; m < 4; ++m) PG8_LD32(dst[m], PG8_SA(b, h) + aoff + m * 2048); } while (0)
#define PG8_LDB(dst, b, h) do { _Pragma("unroll") for (int n = 0; n < 2; ++n) PG8_LD32(dst[n], PG8_SB(b, h) + boff + n * 2048); } while (0)
#define PG8_HALF(v, k) __builtin_bit_cast(bf16x8, (i32x4){(v)[4 * (k)], (v)[4 * (k) + 1], (v)[4 * (k) + 2], (v)[4 * (k) + 3]})
#define PG8_MMA(ai, bj, At, Bt) do { __builtin_amdgcn_s_setprio(1); \
        if constexpr (FP8) { _Pragma("unroll") for (int m = 0; m < 4; ++m) _Pragma("unroll") for (int n = 0; n < 2; ++n) \
            asm volatile("v_mfma_scale_f32_16x16x128_f8f6f4 %0, %1, %2, %0, %3, %3 op_sel_hi:[0,0,0]" : "+v"(acc[ai][bj][m][n]) : "v"(Bt[n]), "v"(At[m]), "v"(one_scale)); } \
        else { _Pragma("unroll") for (int m = 0; m < 4; ++m) _Pragma("unroll") for (int n = 0; n < 2; ++n) _Pragma("unroll") for (int k = 0; k < 2; ++k) \
            acc[ai][bj][m][n] = __builtin_amdgcn_mfma_f32_16x16x32_bf16(PG8_HALF(Bt[n], k), PG8_HALF(At[m], k), acc[ai][bj][m][n], 0, 0, 0); } \
        __builtin_amdgcn_s_setprio(0); } while (0)
#define PG8_WAIT_V(n) asm volatile("s_waitcnt vmcnt(" #n ")" ::: "memory")
#define PG8_WAIT_L(n) asm volatile("s_waitcnt lgkmcnt(" #n ")" ::: "memory")
#define PG8_BAR __builtin_amdgcn_s_barrier()
#define PG8_SCHED __builtin_amdgcn_sched_barrier(0)
    Unit cur, nxt; int ui = 0;
    if (!S.next(0, cur)) return;
    f32x4 acc[2][2][4][2];
#pragma unroll
    for (int a = 0; a < 2; ++a)
#pragma unroll
        for (int b = 0; b < 2; ++b)
#pragma unroll
            for (int m = 0; m < 4; ++m)
#pragma unroll
                for (int n = 0; n < 2; ++n) acc[a][b][m][n] = (f32x4){0.f, 0.f, 0.f, 0.f};
    int one_scale = 0; if constexpr (FP8) asm volatile("v_mov_b32 %0, 0x7f7f7f7f" : "=v"(one_scale));
    i32x8 At[4], B0[2], B1[2];
    unsigned vA[2][2];
    if constexpr (GA) S.a_offs(cur, vA);
    const char* cA = (const char*)Abase + (GA ? (size_t)0 : S.a_base(cur));
    const char* cB = (const char*)Bbase + S.b_off(cur, ldb_b);
    PG8_STAGEB(PG8_SB(0, 0), cB); PG8_STAGEB(PG8_SB(0, 1), cB + hstepB); PG8_STAGEA(PG8_SA(0, 0), cA, 0, vA[0][0], vA[0][1]); PG8_STAGEA(PG8_SA(0, 1), cA, 1, vA[1][0], vA[1][1]);
    if (wr == 1) PG8_BAR;
    PG8_WAIT_V(2); PG8_BAR;
    PG8_STAGEB(PG8_SB(1, 0), cB + kstep); PG8_STAGEA(PG8_SA(1, 0), cA + kstep, 0, vA[0][0], vA[0][1]); PG8_STAGEB(PG8_SB(1, 1), cB + hstepB + kstep);
    PG8_WAIT_V(6); PG8_BAR;
    for (;;) {
        const bool has_next = S.next(ui + 1, nxt);
        const char* nA = (has_next && !GA) ? (const char*)Abase + S.a_base(nxt) : cA;
        const char* nB = has_next ? (const char*)Bbase + S.b_off(nxt, ldb_b) : cB;
_Pragma("nounroll")
        for (int t = 0; t < nt; t += 2) {
            const bool last = (t == nt - 2);
            const long sA1 = (SPLIT && t >= nt1) ? dA : 0, sA2 = (SPLIT && t + 2 >= nt1) ? dA : 0, sB2 = (SPLIT && t + 2 >= nt1) ? dB : 0;
            if constexpr (SPLIT) { if (t == nt1) { asm volatile("s_nop 15\n\ts_nop 15" ::: "memory"); int t3_ = threadIdx.x; asm volatile("" : "+v"(t3_)); const int l3_ = t3_ & 63; E.mid(acc, cur, wr, wc, l3_ & 15, l3_ >> 4); } }
            const char* a1 = cA + (size_t)(t + 1) * kstep + sA1;
            const char* a2 = last ? nA : cA + (size_t)(t + 2) * kstep + sA2; const char* b2 = last ? nB : cB + (size_t)(t + 2) * kstep + sB2;
            const char* a3 = a2 + kstep; const char* b3 = b2 + kstep;
            PG8_LDB(B0, 0, 0); PG8_LDB(B1, 0, 1); PG8_SCHED; PG8_LDA(At, 0, 0); PG8_STAGEA(PG8_SA(1, 1), a1, 1, vA[1][0], vA[1][1]);
            PG8_WAIT_V(8); PG8_WAIT_L(0); PG8_BAR; PG8_MMA(0, 0, At, B0); PG8_MMA(0, 1, At, B1); PG8_BAR; PG8_SCHED;
            if constexpr (GA) { if (last && has_next) S.a_offs(nxt, vA); }
            PG8_LDA(At, 0, 1); PG8_STAGEB(PG8_SB(0, 0), b2); PG8_STAGEB(PG8_SB(0, 1), b2 + hstepB); PG8_STAGEA(PG8_SA(0, 0), a2, 0, vA[0][0], vA[0][1]);
            PG8_WAIT_V(8); PG8_WAIT_L(0); PG8_BAR; PG8_MMA(1, 0, At, B0); PG8_MMA(1, 1, At, B1); PG8_BAR; PG8_SCHED;
            PG8_LDB(B0, 1, 0); PG8_LDB(B1, 1, 1); PG8_SCHED; PG8_LDA(At, 1, 0); PG8_STAGEA(PG8_SA(0, 1), a2, 1, vA[1][0], vA[1][1]);
            PG8_WAIT_V(8); PG8_WAIT_L(0); PG8_BAR; PG8_MMA(0, 0, At, B0); PG8_MMA(0, 1, At, B1); PG8_BAR; PG8_SCHED;
            PG8_LDA(At, 1, 1); PG8_STAGEB(PG8_SB(1, 0), b3); PG8_STAGEB(PG8_SB(1, 1), b3 + hstepB); PG8_STAGEA(PG8_SA(1, 0), a3, 0, vA[0][0], vA[0][1]);
            PG8_WAIT_V(8); PG8_WAIT_L(0); PG8_BAR; PG8_MMA(1, 0, At, B0); PG8_MMA(1, 1, At, B1); PG8_BAR; PG8_SCHED;
        }
        if constexpr (FP8) asm volatile("s_nop 15\n\ts_nop 15" ::: "memory");
        if (wr == 0) PG8_BAR;
        { int t2_ = threadIdx.x; asm volatile("" : "+v"(t2_)); const int l2_ = t2_ & 63; E(acc, cur, wr, wc, l2_ & 15, l2_ >> 4); }
        if (!has_next) break;
#pragma unroll
        for (int a = 0; a < 2; ++a)
#pragma unroll
            for (int b = 0; b < 2; ++b)
#pragma unroll
                for (int m = 0; m < 4; ++m)
#pragma unroll
                    for (int n = 0; n < 2; ++n) acc[a][b][m][n] = (f32x4){0.f, 0.f, 0.f, 0.f};
        cur = nxt; cA = nA; cB = nB; ++ui;
        if (wr == 1) PG8_BAR;
    }
    PG8_WAIT_V(0);
    PG8_BAR;
#undef PG8_SA
#undef PG8_SB
#undef PG8_STAGE2
#undef PG8_STAGEB
#undef PG8_STAGEA
#undef PG8_LDA
#undef PG8_LD32
#undef PG8_HALF
#undef PG8_LDB
#undef PG8_MMA
#undef PG8_WAIT_V
#undef PG8_WAIT_L
#undef PG8_BAR
#undef PG8_SCHED
}

typedef const f32x4 (&AccRef)[2][2][4][2];
__device__ __forceinline__ u32x4 pack8(const f32x4 v0, const f32x4 v1) { u32x4 w; w.x = pk2(v0[0], v0[1]); w.y = pk2(v0[2], v0[3]); w.z = pk2(v1[0], v1[1]); w.w = pk2(v1[2], v1[3]); return w; }
__device__ __forceinline__ void unpack8(const u32x4 w, f32x4& v0, f32x4& v1) { v0 = (f32x4){bflo(w.x), bfhi(w.x), bflo(w.y), bfhi(w.y)}; v1 = (f32x4){bflo(w.z), bfhi(w.z), bflo(w.w), bfhi(w.w)}; }

struct EpiIn {
    static constexpr bool PERM = true;
    bf16_t* Z; const float* lb; unsigned char* G8;
    __device__ __forceinline__ void operator()(AccRef acc, const Unit& u, int wr, int wc, int fr, int fq) const {
        constexpr float KS = 1.f / W8_SCALE, KE = -1.44269504f / W8_SCALE;
        const int row0 = u.pm * BM + wr * 64 + fr, colt = u.pn * BM, seg = colt >> 10, col0 = colt + wc * 32 + 8 * fq;
        const int mode = (seg == 0 || seg == 4) ? 0 : (seg == 1 || seg == 5) ? 1 : (seg == 2 || seg == 3) ? 2 : 3;
#pragma unroll
        for (int bj = 0; bj < 2; ++bj) {
            f32x4 l0 = (f32x4){0.f, 0.f, 0.f, 0.f}, l1 = l0;
            if (mode == 2) { l0 = *(const f32x4*)(lb + (col0 + bj * HALF - ZC_FF)); l1 = *(const f32x4*)(lb + (col0 + bj * HALF + 4 - ZC_FF)); }
#pragma unroll
            for (int ai = 0; ai < 2; ++ai)
#pragma unroll
                for (int m = 0; m < 4; ++m) { bf16_t* rowp = Z + (size_t)(row0 + ai * HALF + m * 16) * INC + col0 + bj * HALF;
                    f32x4 v0 = acc[ai][bj][m][0], v1 = acc[ai][bj][m][1];
                    if (mode == 0) { v0 = v0 * KS; v1 = v1 * KS; }
                    else { f32x4 s0, s1;
#pragma unroll
                        for (int j = 0; j < 4; ++j) { s0[j] = __builtin_amdgcn_rcpf(1.f + __builtin_amdgcn_exp2f(v0[j] * KE)); s1[j] = __builtin_amdgcn_rcpf(1.f + __builtin_amdgcn_exp2f(v1[j] * KE)); }
                        if (mode == 1) { v0 = v0 * KS * s0; v1 = v1 * KS * s1; }
                        else if (mode == 3) { unsigned w0 = 0u, w1 = 0u;
#pragma unroll
                            for (int j = 0; j < 4; ++j) { w0 = __builtin_amdgcn_cvt_pk_u8_f32(fmaxf(__builtin_rintf(s0[j] * 255.f), 1.f), j, w0); w1 = __builtin_amdgcn_cvt_pk_u8_f32(fmaxf(__builtin_rintf(s1[j] * 255.f), 1.f), j, w1); }
                            u32x2 o; o.x = w0; o.y = w1; *(u32x2*)(G8 + (size_t)(row0 + ai * HALF + m * 16) * 4096 + (col0 + bj * HALF - ZC_GP)) = o;
                            __builtin_amdgcn_sched_barrier(0); continue; }
                        else {
#pragma unroll
                            for (int j = 0; j < 4; ++j) { v0[j] = __builtin_amdgcn_logf(l0[j] + (1.f - l0[j]) * s0[j]); v1[j] = __builtin_amdgcn_logf(l1[j] + (1.f - l1[j]) * s1[j]); } } }
                    *(u32x4*)rowp = pack8(v0, v1);
                    __builtin_amdgcn_sched_barrier(0); } }
    }
};
struct EpiPool {
    static constexpr bool PERM = true;
    bf16_t* P; const float* scale;
    __device__ __forceinline__ void operator()(AccRef acc, const Unit& u, int wr, int wc, int fr, int fq) const {
        const int row0 = u.pm * BM + wr * 64 + fr, col0 = u.pn * BM + wc * 32 + 8 * fq;
        f32x4 sv[2][2];
#pragma unroll
        for (int bj = 0; bj < 2; ++bj)
#pragma unroll
            for (int n = 0; n < 2; ++n) sv[bj][n] = *(const f32x4*)(scale + col0 + bj * HALF + 4 * n);
#pragma unroll
        for (int ai = 0; ai < 2; ++ai)
#pragma unroll
            for (int m = 0; m < 4; ++m) { bf16_t* rowp = P + (size_t)(row0 + ai * HALF + m * 16) * DPOOL + col0;
#pragma unroll
                for (int bj = 0; bj < 2; ++bj) { const f32x4 r0 = acc[ai][bj][m][0] * sv[bj][0], r1 = acc[ai][bj][m][1] * sv[bj][1];
                    u32x2 o; o.x = pk4_fp8(r0[0], r0[1], r0[2], r0[3]); o.y = pk4_fp8(r1[0], r1[1], r1[2], r1[3]); *(u32x2*)((unsigned char*)P + (size_t)(row0 + ai * HALF + m * 16) * DPOOL + col0 + bj * HALF) = o; } }
    }
};
template <bool ADD, bool OUT8 = false> struct EpiGate {
    static constexpr bool PERM = true;
    bf16_t* O; const bf16_t* prev; const bf16_t* Z; int gcol; float ascale;
    __device__ __forceinline__ void operator()(AccRef acc, const Unit& u, int wr, int wc, int fr, int fq) const {
        const int row0 = u.pm * BM + wr * 64 + fr, col0 = u.pn * BM + wc * 32 + 8 * fq;
#pragma unroll
        for (int ai = 0; ai < 2; ++ai)
#pragma unroll
            for (int m = 0; m < 4; ++m) { const size_t row = (size_t)(row0 + ai * HALF + m * 16);
#pragma unroll
                for (int bj = 0; bj < 2; ++bj) {
                    const u32x4 gw = *(const u32x4*)(Z + row * INC + gcol + col0 + bj * HALF); f32x4 g0, g1; unpack8(gw, g0, g1);
                    f32x4 r0 = acc[ai][bj][m][0] * ascale * g0, r1 = acc[ai][bj][m][1] * ascale * g1;
                    if (ADD) { const u32x4 pw = *(const u32x4*)(prev + row * D + col0 + bj * HALF); f32x4 p0, p1; unpack8(pw, p0, p1); r0 += p0; r1 += p1; }
                    if (OUT8) { int w0 = 0, w1 = 0; w0 = __builtin_amdgcn_cvt_pk_fp8_f32(r0[0], r0[1], w0, false); w0 = __builtin_amdgcn_cvt_pk_fp8_f32(r0[2], r0[3], w0, true);
                        w1 = __builtin_amdgcn_cvt_pk_fp8_f32(r1[0], r1[1], w1, false); w1 = __builtin_amdgcn_cvt_pk_fp8_f32(r1[2], r1[3], w1, true);
                        u32x2 o; o.x = (unsigned)w0; o.y = (unsigned)w1; *(u32x2*)((unsigned char*)O + row * D + col0 + bj * HALF) = o; }
                    else *(u32x4*)(O + row * D + col0 + bj * HALF) = pack8(r0, r1); } }
    }
};
struct EpiGate2 {
    static constexpr bool PERM = true; static constexpr int NVM = 16;
    unsigned char* O; const unsigned char* G8; int gcol1, gcol2; float cratio, ascale;
    static __device__ __forceinline__ float ub(unsigned w, int j) { return (float)((w >> (8 * j)) & 0xffu); }
    __device__ __forceinline__ void mid(f32x4 (&acc)[2][2][4][2], const Unit& u, int wr, int wc, int fr, int fq) const {
        const int row0 = u.pm * BM + wr * 64 + fr, col0 = u.pn * BM + wc * 32 + 8 * fq;
#pragma unroll
        for (int ai = 0; ai < 2; ++ai)
#pragma unroll
            for (int m = 0; m < 4; ++m) { const size_t row = (size_t)(row0 + ai * HALF + m * 16);
#pragma unroll
                for (int bj = 0; bj < 2; ++bj) {
                    const u32x2 q1 = *(const u32x2*)(G8 + row * 4096 + gcol1 + col0 + bj * HALF), q2 = *(const u32x2*)(G8 + row * 4096 + gcol2 + col0 + bj * HALF);
#pragma unroll
                    for (int j = 0; j < 4; ++j) { acc[ai][bj][m][0][j] *= cratio * ub(q1.x, j) * __builtin_amdgcn_rcpf(ub(q2.x, j)); acc[ai][bj][m][1][j] *= cratio * ub(q1.y, j) * __builtin_amdgcn_rcpf(ub(q2.y, j)); } }
                }
    }
    __device__ __forceinline__ void operator()(AccRef acc, const Unit& u, int wr, int wc, int fr, int fq) const {
        const int row0 = u.pm * BM + wr * 64 + fr, col0 = u.pn * BM + wc * 32 + 8 * fq;
#pragma unroll
        for (int ai = 0; ai < 2; ++ai)
#pragma unroll
            for (int m = 0; m < 4; ++m) { const size_t row = (size_t)(row0 + ai * HALF + m * 16);
#pragma unroll
                for (int bj = 0; bj < 2; ++bj) {
                    const u32x2 q2 = *(const u32x2*)(G8 + row * 4096 + gcol2 + col0 + bj * HALF);
                    f32x4 r0, r1;
#pragma unroll
                    for (int j = 0; j < 4; ++j) { r0[j] = acc[ai][bj][m][0][j] * ascale * ub(q2.x, j); r1[j] = acc[ai][bj][m][1][j] * ascale * ub(q2.y, j); }
                    u32x2 o; o.x = pk4_fp8(r0[0], r0[1], r0[2], r0[3]); o.y = pk4_fp8(r1[0], r1[1], r1[2], r1[3]);
                    *(u32x2*)(O + row * D + col0 + bj * HALF) = o; } }
    }
};
struct EpiOut {
    static constexpr bool PERM = true;
    bf16_t* X; const void* src_lat; const void* src_ctx; bool src_f32; const float* modl; float ascale;
    __device__ __forceinline__ void operator()(AccRef acc, const Unit& u, int wr, int wc, int fr, int fq) const {
        const int row0 = u.pm * BM + wr * 64 + fr, col0 = u.pn * BM + wc * 32 + 8 * fq;
        const int mrow = u.pm < 64 ? (u.pm >> 4) : 4;
        const float* g = modl + (size_t)mrow * 6 * D + 2 * D;
        const bool lat = u.pm < 64;
#pragma unroll
        for (int bj = 0; bj < 2; ++bj) { const int col = col0 + bj * HALF;
            const f32x4 g0 = *(const f32x4*)(g + col) * ascale, g1 = *(const f32x4*)(g + col + 4) * ascale;
#pragma unroll
            for (int ai = 0; ai < 2; ++ai)
#pragma unroll
                for (int m = 0; m < 4; ++m) { const int row = row0 + ai * HALF + m * 16; f32x4 s0, s1;
                    if (src_f32) { const float* sp = (lat ? (const float*)src_lat + (size_t)row * D : (const float*)src_ctx + (size_t)(row - NLAT) * D) + col; s0 = *(const f32x4*)sp; s1 = *(const f32x4*)(sp + 4); }
                    else unpack8(*(const u32x4*)((const bf16_t*)src_lat + (size_t)row * D + col), s0, s1);
                    *(u32x4*)(X + (size_t)row * D + col) = pack8(s0 + g0 * acc[ai][bj][m][0], s1 + g1 * acc[ai][bj][m][1]); } }
    }
};
struct EpiMoe1 {
    static constexpr bool PERM = true;
    bf16_t* ACT;
    __device__ __forceinline__ void operator()(AccRef acc, const Unit& u, int wr, int wc, int fr, int fq) const {
        const int row0 = u.pm * BM + wr * 64 + fr, col0 = u.pn * HALF + wc * 32 + 8 * fq;
        constexpr float KS = 1.f / W8_SCALE, KB = ACT8_SCALE / W8_SCALE;
#pragma unroll
        for (int ai = 0; ai < 2; ++ai)
#pragma unroll
            for (int m = 0; m < 4; ++m) { f32x4 r[2];
#pragma unroll
                for (int n = 0; n < 2; ++n)
#pragma unroll
                    for (int j = 0; j < 4; ++j) r[n][j] = __builtin_amdgcn_fmed3f(fsilu(acc[ai][0][m][n][j] * KS) * (acc[ai][1][m][n][j] * KB), -440.f, 440.f);
                u32x2 o; o.x = pk4_fp8(r[0][0], r[0][1], r[0][2], r[0][3]); o.y = pk4_fp8(r[1][0], r[1][1], r[1][2], r[1][3]);
                *(u32x2*)((unsigned char*)ACT + (size_t)(row0 + ai * HALF + m * 16) * DEXP + col0) = o; }
    }
};
struct EpiNone {
    static constexpr bool PERM = true;
    __device__ __forceinline__ void operator()(AccRef acc, const Unit&, int, int, int, int) const {
#pragma unroll
        for (int ai = 0; ai < 2; ++ai)
#pragma unroll
            for (int bj = 0; bj < 2; ++bj)
#pragma unroll
                for (int m = 0; m < 4; ++m)
#pragma unroll
                    for (int n = 0; n < 2; ++n) asm volatile("" :: "v"(acc[ai][bj][m][n]));
    }
};
struct EpiY8 {
    static constexpr bool PERM = true; static constexpr int NVM = 16;
    unsigned char* O; int ldc; float ascale;
    __device__ __forceinline__ void operator()(AccRef acc, const Unit& u, int wr, int wc, int fr, int fq) const {
        const int row0 = u.pm * BM + wr * 64 + fr, col0 = u.pn * BM + wc * 32 + 8 * fq;
#pragma unroll
        for (int ai = 0; ai < 2; ++ai)
#pragma unroll
            for (int m = 0; m < 4; ++m) { unsigned char* rowp = O + (size_t)(row0 + ai * HALF + m * 16) * ldc + col0;
#pragma unroll
                for (int bj = 0; bj < 2; ++bj) { f32x4 r0, r1;
#pragma unroll
                    for (int j = 0; j < 4; ++j) { r0[j] = __builtin_amdgcn_fmed3f(acc[ai][bj][m][0][j] * ascale, -440.f, 440.f); r1[j] = __builtin_amdgcn_fmed3f(acc[ai][bj][m][1][j] * ascale, -440.f, 440.f); }
                    u32x2 o; o.x = pk4_fp8(r0[0], r0[1], r0[2], r0[3]); o.y = pk4_fp8(r1[0], r1[1], r1[2], r1[3]); *(u32x2*)(rowp + bj * HALF) = o; } }
    }
};
struct EpiPlain {
    static constexpr bool PERM = true;
    bf16_t* O; int ldc; float ascale;
    __device__ __forceinline__ void operator()(AccRef acc, const Unit& u, int wr, int wc, int fr, int fq) const {
        const int row0 = u.pm * BM + wr * 64 + fr, col0 = u.pn * BM + wc * 32 + 8 * fq;
#pragma unroll
        for (int ai = 0; ai < 2; ++ai)
#pragma unroll
            for (int m = 0; m < 4; ++m) { bf16_t* rowp = O + (size_t)(row0 + ai * HALF + m * 16) * ldc + col0;
#pragma unroll
                for (int bj = 0; bj < 2; ++bj) *(u32x4*)(rowp + bj * HALF) = pack8(acc[ai][bj][m][0] * ascale, acc[ai][bj][m][1] * ascale); }
    }
};
}

struct Args { const float* in[22]; float* out; unsigned char* ws; int ph_lo, ph_hi, rep, pad; };
enum { I_X = 0, I_C, I_CTX, I_CCTX, I_WADA, I_BADA, I_N1W, I_N2W, I_WIN, I_WPG, I_PSCALE, I_HGNW, I_LBLOG, I_WBP, I_WBH, I_WOUT, I_WROUTER, I_RBIAS, I_WE1, I_WE3, I_WE2, I_FNW };

struct Frame {
    LAS unsigned char* lds;
    int tid, lane, wave, G, gw, NGW;
    unsigned char* ws;
};

__device__ __forceinline__ void transpose_item(const float* W, int K, int N, int k0, int n0, bf16_t* WT, size_t dst_row0, LAS float* scr, int lane) {
    float wv[32];
#pragma unroll
    for (int i = 0; i < 32; ++i) { const int kk = 2 * i + (lane >> 5); wv[i] = __builtin_nontemporal_load(W + (size_t)(k0 + kk) * N + n0 + (lane & 31)); }
#pragma unroll
    for (int i = 0; i < 32; ++i) { const int kk = 2 * i + (lane >> 5); scr[kk * 33 + (lane & 31)] = wv[i]; }
    LDS_WAIT(); asm volatile("" ::: "memory");
    const int c = lane & 7;
#pragma unroll
    for (int j = 0; j < 4; ++j) { const int n = (lane >> 3) + 8 * j; const LAS float* s = scr + (8 * c) * 33 + n;
        u32x4 o; o.x = pk2(s[0 * 33], s[1 * 33]); o.y = pk2(s[2 * 33], s[3 * 33]); o.z = pk2(s[4 * 33], s[5 * 33]); o.w = pk2(s[6 * 33], s[7 * 33]);
        *(u32x4*)(WT + (dst_row0 + n) * K + k0 + 8 * c) = o; }
    LDS_WAIT(); asm volatile("" ::: "memory");
}
__device__ __forceinline__ void transpose_item_fp8(const float* W, int K, int N, int k0, int n0, unsigned char* WT, size_t dst_row0, LAS float* scr, int lane) {
    float wv[32];
#pragma unroll
    for (int i = 0; i < 32; ++i) { const int kk = 2 * i + (lane >> 5); wv[i] = __builtin_nontemporal_load(W + (size_t)(k0 + kk) * N + n0 + (lane & 31)); }
#pragma unroll
    for (int i = 0; i < 32; ++i) { const int kk = 2 * i + (lane >> 5); scr[kk * 33 + (lane & 31)] = wv[i] * W8_SCALE; }
    LDS_WAIT(); asm volatile("" ::: "memory");
    const int c = lane & 7;
#pragma unroll
    for (int j = 0; j < 4; ++j) { const int n = (lane >> 3) + 8 * j; const LAS float* sp = scr + (8 * c) * 33 + n;
        int w0 = 0, w1 = 0; w0 = __builtin_amdgcn_cvt_pk_fp8_f32(sp[0 * 33], sp[1 * 33], w0, false); w0 = __builtin_amdgcn_cvt_pk_fp8_f32(sp[2 * 33], sp[3 * 33], w0, true);
        w1 = __builtin_amdgcn_cvt_pk_fp8_f32(sp[4 * 33], sp[5 * 33], w1, false); w1 = __builtin_amdgcn_cvt_pk_fp8_f32(sp[6 * 33], sp[7 * 33], w1, true);
        u32x2 o; o.x = (unsigned)w0; o.y = (unsigned)w1;
        *(u32x2*)(WT + (dst_row0 + n) * K + k0 + 8 * c) = o; }
    LDS_WAIT(); asm volatile("" ::: "memory");
}
__device__ __forceinline__ void transpose_family(Frame& F, const float* W, int mats, int K, int N, bf16_t* WT, int mode, int& itbase, int it_lo, int it_step) {
    const int nblk = N / 32, kblk = K / 64, per = nblk * kblk, total = mats * per;
    LAS float* scr = (LAS float*)(F.lds + F.wave * 16384);
    int first = (it_lo - itbase) % it_step; if (first < 0) first += it_step;
    for (int it = first; it < total; it += it_step) {
        const int mat = it / per, r = it % per, kb = r / nblk, nb = r % nblk, n0 = 32 * nb, k0 = 64 * kb;
        size_t dst_row0; bf16_t* dstm;
        if (mode == 3) { transpose_item_fp8(W + (size_t)mat * K * N, K, N, k0, n0, (unsigned char*)WT + (size_t)mat * N * K, n0, scr, F.lane); continue; }
        if (mode == 4 || mode == 5) { transpose_item_fp8(W + (size_t)mat * K * N, K, N, k0, n0, (unsigned char*)WT + (size_t)mat * 1024 * K, (size_t)(n0 >> 7) * 256 + (mode == 5 ? 128 : 0) + (n0 & 127), scr, F.lane); continue; }
        if (mode == 0) { dstm = WT + (size_t)mat * N * K; dst_row0 = n0; }
        else { dstm = WT + (size_t)mat * 1024 * K; dst_row0 = (size_t)(n0 >> 7) * 256 + (mode == 2 ? 128 : 0) + (n0 & 127); }
        transpose_item(W + (size_t)mat * K * N, K, N, k0, n0, dstm, dst_row0, scr, F.lane);
    }
    itbase += total;
}

struct ConvJob { const float* src; unsigned char* dst; int N; };
__device__ __forceinline__ ConvJob conv_decode(const Args& a, unsigned char* ws, int L, int s, int lane) {
    const float* W; unsigned char* T; int K, N, t, map = 0, lk, ln;
    if (s < 20480) { t = s; W = a.in[I_WIN] + (size_t)L * D * INC; T = ws + WS_WIN + (size_t)L * INC * D; K = D; N = INC; lk = 7; ln = 8; }
    else if (s < 22528) { t = s - 20480; W = a.in[I_WBP] + (size_t)L * 1024 * D; T = ws + WS_WBP + (size_t)L * D * 1024; K = 1024; N = D; lk = 6; ln = 5; }
    else if (s < 24576) { t = s - 22528; W = a.in[I_WBH] + (size_t)L * 1024 * D; T = ws + WS_WBH + (size_t)L * D * 1024; K = 1024; N = D; lk = 6; ln = 5; }
    else if (s < 28672) { t = s - 24576; W = a.in[I_WOUT] + (size_t)L * D * D; T = ws + WS_WOUT + (size_t)L * D * D; K = D; N = D; lk = 7; ln = 5; }
    else if (s < 45056) { t = s - 28672; W = a.in[I_WE1] + (size_t)L * NEXP * D * DEXP; T = ws + WS_WE13 + (size_t)L * NEXP * 1024 * D; K = D; N = DEXP; map = 1; lk = 7; ln = 3; }
    else if (s < 61440) { t = s - 45056; W = a.in[I_WE3] + (size_t)L * NEXP * D * DEXP; T = ws + WS_WE13 + (size_t)L * NEXP * 1024 * D; K = D; N = DEXP; map = 2; lk = 7; ln = 3; }
    else { t = s - 61440; W = a.in[I_WE2] + (size_t)L * NEXP * DEXP * D; T = ws + WS_WE2 + (size_t)L * NEXP * D * DEXP; K = DEXP; N = D; lk = 5; ln = 5; }
    const int kb = t & ((1 << lk) - 1), nb = (t >> lk) & ((1 << ln) - 1), mat = t >> (lk + ln);
    const int n = nb * 64 + lane, k0 = kb * 16;
    const size_t drow = map ? (size_t)mat * 1024 + (size_t)(n >> 7) * 256 + (map == 2 ? 128 : 0) + (n & 127) : (size_t)mat * N + n;
    ConvJob J; J.src = W + (size_t)mat * K * N + (size_t)k0 * N + n; J.dst = T + drow * K + k0; J.N = N; return J;
}
__device__ __forceinline__ void conv_pool_item(const Args& a, unsigned char* ws, int L, int s, int lane) {
    const int kb = s & 127, nb = s >> 7, k0 = kb * 16, g = nb >> 2, d0 = (nb & 3) * 64, fr = lane & 15, fq = lane >> 4;
    const float* Win = a.in[I_WIN] + (size_t)L * D * INC + (size_t)(k0 + fr) * INC + g * 256 + 8 * fq;
    const float* Wpg = a.in[I_WPG] + ((size_t)(L * 4 + g) * 256 + 8 * fq) * 256 + d0 + fr;
    f32x4 acc[4];
#pragma unroll
    for (int nt = 0; nt < 4; ++nt) acc[nt] = (f32x4){0.f, 0.f, 0.f, 0.f};
#pragma unroll 2
    for (int ks = 0; ks < 8; ++ks) {
        const f32x4 a0 = *(const f32x4*)(Win + 32 * ks), a1 = *(const f32x4*)(Win + 32 * ks + 4);
        u32x4 aw; aw.x = pk2(a0[0], a0[1]); aw.y = pk2(a0[2], a0[3]); aw.z = pk2(a1[0], a1[1]); aw.w = pk2(a1[2], a1[3]);
#pragma unroll
        for (int nt = 0; nt < 4; ++nt) { float b[8];
#pragma unroll
            for (int t = 0; t < 8; ++t) b[t] = Wpg[(size_t)(32 * ks + t) * 256 + 16 * nt];
            u32x4 bw; bw.x = pk2(b[0], b[1]); bw.y = pk2(b[2], b[3]); bw.z = pk2(b[4], b[5]); bw.w = pk2(b[6], b[7]);
            acc[nt] = __builtin_amdgcn_mfma_f32_16x16x32_bf16(__builtin_bit_cast(bf16x8, aw), __builtin_bit_cast(bf16x8, bw), acc[nt], 0, 0, 0); } }
    unsigned char* T = ws + WS_WIN + (size_t)L * INC * D;
#pragma unroll
    for (int nt = 0; nt < 4; ++nt) { const int n = g * 256 + d0 + 16 * nt + fr; const float sc = a.in[I_PSCALE][(size_t)L * DPOOL + n] * W8_SCALE;
        *(unsigned*)(T + (size_t)n * D + k0 + 4 * fq) = pk4_fp8(acc[nt][0] * sc, acc[nt][1] * sc, acc[nt][2] * sc, acc[nt][3] * sc); }
}
constexpr int CP_PITCH = 264;
__device__ __forceinline__ void conv_pool_item_lds(const Args& a, unsigned char* ws, LAS unsigned char* lds, int L, int s, int lane) {
    const int kb = s & 127, nb = s >> 7, k0 = kb * 16, g = nb >> 2, d0 = (nb & 3) * 64, fr = lane & 15, fq = lane >> 4;
    const float* Win = a.in[I_WIN] + (size_t)L * D * INC + (size_t)(k0 + fr) * INC + g * 256 + 8 * fq;
    f32x4 av[16];
#pragma unroll
    for (int i = 0; i < 16; ++i) av[i] = __builtin_nontemporal_load((const f32x4*)(Win + 4 * i + (i >> 1) * 24));
    f32x4 acc[4];
#pragma unroll
    for (int nt = 0; nt < 4; ++nt) acc[nt] = (f32x4){0.f, 0.f, 0.f, 0.f};
#pragma unroll
    for (int ks = 0; ks < 8; ++ks) {
        u32x4 aw; aw.x = pk2(av[2 * ks][0], av[2 * ks][1]); aw.y = pk2(av[2 * ks][2], av[2 * ks][3]); aw.z = pk2(av[2 * ks + 1][0], av[2 * ks + 1][1]); aw.w = pk2(av[2 * ks + 1][2], av[2 * ks + 1][3]);
#pragma unroll
        for (int nt = 0; nt < 4; ++nt) { const bf16x8 bw = *(const LAS bf16x8*)(lds + ((16 * nt + fr) * CP_PITCH + 32 * ks + 8 * fq) * 2);
            acc[nt] = __builtin_amdgcn_mfma_f32_16x16x32_bf16(__builtin_bit_cast(bf16x8, aw), bw, acc[nt], 0, 0, 0); } }
    unsigned char* T = ws + WS_WIN + (size_t)L * INC * D;
#pragma unroll
    for (int nt = 0; nt < 4; ++nt) { const int n = g * 256 + d0 + 16 * nt + fr; const float sc = a.in[I_PSCALE][(size_t)L * DPOOL + n] * W8_SCALE;
        *(unsigned*)(T + (size_t)n * D + k0 + 4 * fq) = pk4_fp8(acc[nt][0] * sc, acc[nt][1] * sc, acc[nt][2] * sc, acc[nt][3] * sc); }
}
constexpr int CONV_ITEMS = 77824;
__device__ __forceinline__ void convert_range(Frame& F, const Args& a, int L, int lo, int hi, int rank, int n) {
    if (rank < 0 || L >= DEPTH) return;
    const bool pool_lds = (lo == 0) && (n >= 128) && (hi >= 2048), pool_wg = pool_lds && (rank * 16 < 2048);
    if (pool_wg) { const int nb = (rank * 16) >> 7, g = nb >> 2, d0 = (nb & 3) * 64, d = F.tid & 63;
        const float* Wp = a.in[I_WPG] + (size_t)(L * 4 + g) * 256 * 256 + d0 + d;
        __syncthreads();
        float wv[32];
#pragma unroll
        for (int i = 0; i < 16; ++i) { const int c = 2 * ((F.tid >> 6) + 8 * i); wv[2 * i] = Wp[(size_t)c * 256]; wv[2 * i + 1] = Wp[(size_t)(c + 1) * 256]; }
#pragma unroll
        for (int i = 0; i < 16; ++i) { const int c = 2 * ((F.tid >> 6) + 8 * i); *(LAS unsigned*)(F.lds + (d * CP_PITCH + c) * 2) = pk2(wv[2 * i], wv[2 * i + 1]); }
        __syncthreads(); }
    for (int s0 = lo + (rank * 8 + F.wave) * 2; s0 < hi; s0 += n * 16) {
        const bool has2 = s0 + 1 < hi;
        if (s0 < 2048) { if (pool_lds) { conv_pool_item_lds(a, F.ws, F.lds, L, s0, F.lane); if (has2) conv_pool_item_lds(a, F.ws, F.lds, L, s0 + 1, F.lane); }
                         else { conv_pool_item(a, F.ws, L, s0, F.lane); if (has2) conv_pool_item(a, F.ws, L, s0 + 1, F.lane); }
                         continue; }
        const ConvJob J0 = conv_decode(a, F.ws, L, s0, F.lane), J1 = conv_decode(a, F.ws, L, has2 ? s0 + 1 : s0, F.lane);
        float v0[16], v1[16];
#pragma unroll
        for (int i = 0; i < 16; ++i) { v0[i] = __builtin_nontemporal_load(J0.src + (size_t)i * J0.N); v1[i] = __builtin_nontemporal_load(J1.src + (size_t)i * J1.N); }
        u32x4 o; o.x = pk4_fp8(v0[0] * W8_SCALE, v0[1] * W8_SCALE, v0[2] * W8_SCALE, v0[3] * W8_SCALE); o.y = pk4_fp8(v0[4] * W8_SCALE, v0[5] * W8_SCALE, v0[6] * W8_SCALE, v0[7] * W8_SCALE);
        o.z = pk4_fp8(v0[8] * W8_SCALE, v0[9] * W8_SCALE, v0[10] * W8_SCALE, v0[11] * W8_SCALE); o.w = pk4_fp8(v0[12] * W8_SCALE, v0[13] * W8_SCALE, v0[14] * W8_SCALE, v0[15] * W8_SCALE);
        *(u32x4*)J0.dst = o;
        if (has2) { o.x = pk4_fp8(v1[0] * W8_SCALE, v1[1] * W8_SCALE, v1[2] * W8_SCALE, v1[3] * W8_SCALE); o.y = pk4_fp8(v1[4] * W8_SCALE, v1[5] * W8_SCALE, v1[6] * W8_SCALE, v1[7] * W8_SCALE);
            o.z = pk4_fp8(v1[8] * W8_SCALE, v1[9] * W8_SCALE, v1[10] * W8_SCALE, v1[11] * W8_SCALE); o.w = pk4_fp8(v1[12] * W8_SCALE, v1[13] * W8_SCALE, v1[14] * W8_SCALE, v1[15] * W8_SCALE);
            *(u32x4*)J1.dst = o; }
    }
}
__device__ __forceinline__ void idle_rank(int nunits, int G, int c, int& rank, int& n) {
    const int rem = nunits % G;
    if (rem == 0 || G - rem < 64) { rank = c; n = G; } else { rank = c >= rem ? c - rem : -1; n = G - rem; }
}

__device__ __forceinline__ void phase_prologue(Frame& F, const Args& a) {
    unsigned char* ws = F.ws;
    convert_range(F, a, 0, 0, CONV_ITEMS, (int)blockIdx.x, F.G);
    if (blockIdx.x == 0) {
        const float* lg = a.in[I_LBLOG]; float* LB = (float*)(ws + WS_LB);
        for (int i = F.tid; i < 2 * 1024; i += 512) { const int dir = i >> 10, ch = i & 1023;
            float l[DEPTH], mx = -1e30f;
#pragma unroll
            for (int j = 0; j < DEPTH; ++j) { l[j] = lg[((size_t)dir * DEPTH + j) * 1024 + ch]; mx = fmaxf(mx, l[j]); }
            float s = 0.f;
#pragma unroll
            for (int j = 0; j < DEPTH; ++j) { l[j] = __expf(l[j] - mx); s += l[j]; }
            float cum = 0.f;
#pragma unroll
            for (int j = 0; j < DEPTH; ++j) { if (j > 0) cum += l[j] / s; LB[((size_t)j * 2 + dir) * 1024 + ch] = cum; } }
    }
    __syncthreads();
    {
        LAS float* sv = (LAS float*)F.lds;
        LAS float* red = (LAS float*)(F.lds + 5 * D * 4);
        for (int i = F.tid; i < 5 * D; i += 512) { const int r = i / D, k = i % D; const float v = r < 4 ? a.in[I_C][r * D + k] : a.in[I_CCTX][k]; sv[i] = fsilu(v); }
        __syncthreads();
        const float* wada = a.in[I_WADA]; const float* bada = a.in[I_BADA]; float* MOD = (float*)(ws + WS_MOD);
        constexpr int JB = 6 * D / 192;
        const int cg = F.tid % 48, kg = F.tid / 48;
        for (int it = blockIdx.x; it < DEPTH * JB; it += F.G) {
            const int layer = it / JB, j0 = (it % JB) * 192;
            if (kg < 10) {
                const float* w = wada + (size_t)layer * D * 6 * D + j0 + 4 * cg;
                f32x4 acc[5];
#pragma unroll
                for (int r = 0; r < 5; ++r) acc[r] = (f32x4){0.f, 0.f, 0.f, 0.f};
#pragma unroll 8
                for (int k = kg; k < D; k += 10) { const f32x4 wv = *(const f32x4*)(w + (size_t)k * 6 * D);
#pragma unroll
                    for (int r = 0; r < 5; ++r) acc[r] += wv * sv[r * D + k]; }
#pragma unroll
                for (int r = 0; r < 5; ++r) *(LAS f32x4*)(red + (kg * 5 + r) * 192 + 4 * cg) = acc[r];
            }
            __syncthreads();
            for (int o = F.tid; o < 5 * 192; o += 512) { const int r = o / 192, jj = o % 192; float t = bada[(size_t)layer * 6 * D + j0 + jj];
#pragma unroll
                for (int q = 0; q < 10; ++q) t += red[(q * 5 + r) * 192 + jj];
                MOD[((size_t)layer * 5 + r) * 6 * D + j0 + jj] = t; }
            __syncthreads();
        }
    }
    __syncthreads();
}

__device__ __forceinline__ void wave_rows(const Frame& F, int M, int& r0, int& r1) { r0 = (int)(((unsigned)F.gw * (unsigned)M) / (unsigned)F.NGW); r1 = (int)(((unsigned)(F.gw + 1) * (unsigned)M) / (unsigned)F.NGW); }
__device__ __forceinline__ int mod_row(int r) { return r < NLAT ? (r >> 12) : 4; }

__device__ __forceinline__ void xrow_load(const bf16_t* X, int r, int lane, f32x4 (&x)[8]) { const u32x2* xr = (const u32x2*)(X + (size_t)r * D) + lane;
#pragma unroll
    for (int j = 0; j < 8; ++j) { const u32x2 w = xr[64 * j]; x[j] = (f32x4){bflo(w.x), bfhi(w.x), bflo(w.y), bfhi(w.y)}; } }
__device__ __forceinline__ void xrow_store(bf16_t* X, int r, int lane, const f32x4 (&x)[8]) { u32x2* xr = (u32x2*)(X + (size_t)r * D) + lane;
#pragma unroll
    for (int j = 0; j < 8; ++j) { u32x2 w; w.x = pk2(x[j][0], x[j][1]); w.y = pk2(x[j][2], x[j][3]); xr[64 * j] = w; } }
template <int NR>
__device__ __forceinline__ void moe_combine_rows(f32x4 (&x)[NR][8], const int (&r)[NR], int lane, const unsigned char* ws, int player, const float* mod5) {
    const int* pb = (const int*)(ws + WS_PADBASE) + player * 16; const unsigned char* Y2 = ws + WS_Y2;
    int2 ri[NR]; float2 rg[NR]; const unsigned* y0[NR]; const unsigned* y1[NR];
#pragma unroll
    for (int q = 0; q < NR; ++q) { ri[q] = ((const int2*)(ws + WS_ROUTE_I))[r[q]]; rg[q] = ((const float2*)(ws + WS_ROUTE_G))[r[q]]; }
#pragma unroll
    for (int q = 0; q < NR; ++q) { const int s0 = pb[ri[q].x >> 20] + (ri[q].x & 0xfffff), s1 = pb[ri[q].y >> 20] + (ri[q].y & 0xfffff);
        y0[q] = (const unsigned*)(Y2 + (size_t)s0 * D) + lane; y1[q] = (const unsigned*)(Y2 + (size_t)s1 * D) + lane; rg[q].x *= 1.f / Y8_SCALE; rg[q].y *= 1.f / Y8_SCALE; }
#pragma unroll
    for (int j = 0; j < 8; ++j) { const f32x4 g = *((const f32x4*)mod5 + 64 * j + lane);
#pragma unroll
        for (int q = 0; q < NR; ++q) { const unsigned a = y0[q][64 * j], b = y1[q][64 * j];
            const f32x2 a01 = __builtin_amdgcn_cvt_pk_f32_fp8((int)a, false), a23 = __builtin_amdgcn_cvt_pk_f32_fp8((int)a, true), b01 = __builtin_amdgcn_cvt_pk_f32_fp8((int)b, false), b23 = __builtin_amdgcn_cvt_pk_f32_fp8((int)b, true);
            const f32x4 ya = (f32x4){a01.x, a01.y, a23.x, a23.y}, yb = (f32x4){b01.x, b01.y, b23.x, b23.y};
            x[q][j] += g * (ya * rg[q].x + yb * rg[q].y); } }
}
__device__ __forceinline__ float row_sumsq(const f32x4 (&x)[8]) { float ss = 0.f;
#pragma unroll
    for (int j = 0; j < 8; ++j) ss += (x[j][0] * x[j][0] + x[j][1] * x[j][1]) + (x[j][2] * x[j][2] + x[j][3] * x[j][3]);
    return ss; }

__device__ __forceinline__ void phase_norm1(Frame& F, const Args& a, int layer, bool combine) {
    unsigned char* ws = F.ws; bf16_t* X = (bf16_t*)(ws + WS_X); bf16_t* H = (bf16_t*)(ws + WS_H);
    const float* MOD = (const float*)(ws + WS_MOD); const float* nw = a.in[I_N1W] + (size_t)layer * D;
    int r0, r1; wave_rows(F, MTOK, r0, r1);
    int curb = -1; f32x4 av[8], sv[8];
    for (int r = r0; r < r1;) {
        const int b = mod_row(r);
        const bool two = (r + 1 < r1) && (mod_row(r + 1) == b);
        const int rr[2] = {r, two ? r + 1 : r};
        if (b != curb) { curb = b; const float* m = MOD + ((size_t)layer * 5 + b) * 6 * D;
#pragma unroll
            for (int j = 0; j < 8; ++j) { const f32x4 w = *((const f32x4*)nw + 64 * j + F.lane), m1 = *((const f32x4*)(m + D) + 64 * j + F.lane); av[j] = w * (m1 + 1.f); sv[j] = *((const f32x4*)m + 64 * j + F.lane); } }
        f32x4 x[2][8];
#pragma unroll
        for (int q = 0; q < 2; ++q) {
            if (layer == 0) { const float* xs = rr[q] < NLAT ? a.in[I_X] + (size_t)rr[q] * D : a.in[I_CTX] + (size_t)(rr[q] - NLAT) * D;
                const f32x4* xr = (const f32x4*)xs + F.lane;
#pragma unroll
                for (int j = 0; j < 8; ++j) x[q][j] = xr[64 * j]; }
            else xrow_load(X, rr[q], F.lane, x[q]); }
        if (combine) { moe_combine_rows<2>(x, rr, F.lane, ws, layer - 1, MOD + ((size_t)(layer - 1) * 5 + b) * 6 * D + 5 * D);
#pragma unroll
            for (int q = 0; q < 2; ++q) if (q == 0 || two) xrow_store(X, rr[q], F.lane, x[q]); }
        float ss0 = row_sumsq(x[0]), ss1 = row_sumsq(x[1]);
#pragma unroll
        for (int o = 1; o < 64; o <<= 1) { ss0 += lane_xor(ss0, o, F.lane); ss1 += lane_xor(ss1, o, F.lane); }
        const float rs[2] = {1.0f / sqrtf(ss0 * (1.f / D) + EPS), 1.0f / sqrtf(ss1 * (1.f / D) + EPS)};
#pragma unroll
        for (int q = 0; q < 2; ++q) if (q == 0 || two) { unsigned* ho = (unsigned*)((unsigned char*)H + (size_t)rr[q] * D) + F.lane;
#pragma unroll
            for (int j = 0; j < 8; ++j) { const f32x4 h = x[q][j] * rs[q] * av[j] + sv[j]; int w = 0; w = __builtin_amdgcn_cvt_pk_fp8_f32(h[0], h[1], w, false); w = __builtin_amdgcn_cvt_pk_fp8_f32(h[2], h[3], w, true); ho[64 * j] = (unsigned)w; } }
        r += two ? 2 : 1;
    }
}

constexpr int RT_LCNT = LDS_MISC + 1024, RT_LBASE = LDS_MISC + 1088, RT_REC = LDS_MISC + 2048;
struct Route { int i1, i2; float g1, g2; };
__device__ __forceinline__ Route route_row(const float (&lg)[NEXP], const float* rbias) {
    float sc[NEXP], sel[NEXP];
#pragma unroll
    for (int e = 0; e < NEXP; ++e) { sc[e] = __builtin_amdgcn_rcpf(1.f + __builtin_amdgcn_exp2f(-1.44269504f * lg[e])); sel[e] = sc[e] + rbias[e]; }
    float gsc[4];
#pragma unroll
    for (int g = 0; g < 4; ++g) { float m1 = -1e30f, m2 = -1e30f;
#pragma unroll
        for (int i = 0; i < 4; ++i) { const float v = sel[g * 4 + i]; const bool c1 = v > m1, c2 = v > m2; m2 = c1 ? m1 : (c2 ? v : m2); m1 = c1 ? v : m1; }
        gsc[g] = m1 + m2; }
    int gbest = 0; float gbs = gsc[0];
#pragma unroll
    for (int g = 1; g < 4; ++g) { const bool c = gsc[g] > gbs; gbest = c ? g : gbest; gbs = c ? gsc[g] : gbs; }
    float sl[4], sx[4];
#pragma unroll
    for (int i = 0; i < 4; ++i) { sl[i] = gbest == 0 ? sel[i] : gbest == 1 ? sel[4 + i] : gbest == 2 ? sel[8 + i] : sel[12 + i]; sx[i] = gbest == 0 ? sc[i] : gbest == 1 ? sc[4 + i] : gbest == 2 ? sc[8 + i] : sc[12 + i]; }
    int i1 = 0, i2 = 0; float v1 = -1e30f, v2 = -1e30f, s1 = 0.f, s2 = 0.f;
#pragma unroll
    for (int i = 0; i < 4; ++i) { const float v = sl[i]; const bool c1 = v > v1, c2 = v > v2;
        i2 = c1 ? i1 : (c2 ? i : i2); s2 = c1 ? s1 : (c2 ? sx[i] : s2); v2 = c1 ? v1 : (c2 ? v : v2);
        i1 = c1 ? i : i1; s1 = c1 ? sx[i] : s1; v1 = c1 ? v : v1; }
    const float inv = __builtin_amdgcn_rcpf(s1 + s2);
    Route R; R.i1 = gbest * 4 + i1; R.i2 = gbest * 4 + i2; R.g1 = s1 * inv; R.g2 = s2 * inv; return R;
}
constexpr int RT_STRIDE = 4112;
constexpr int RT_WB = 0, RT_HT = 16 * RT_STRIDE, RT_PART = 32 * RT_STRIDE;
static_assert(RT_PART + 8192 <= LDS_MISC, "router LDS map");
__device__ __forceinline__ void phase_norm2_router(Frame& F, const Args& a, int layer, int Mrows, bool publish) {
    unsigned char* ws = F.ws; const bf16_t* X = (const bf16_t*)(ws + WS_X); bf16_t* H = (bf16_t*)(ws + WS_H);
    const float* MOD = (const float*)(ws + WS_MOD); const float* nw = a.in[I_N2W] + (size_t)layer * D;
    LAS unsigned char* L = F.lds;
    { const f32x4* wr4 = (const f32x4*)a.in[I_WROUTER];
#pragma unroll 1
      for (int i = 0; i < 2; ++i) { const int k = 2 * F.tid + 1024 * i; f32x4 wv[2][4];
#pragma unroll
          for (int h = 0; h < 2; ++h)
#pragma unroll
              for (int q = 0; q < 4; ++q) wv[h][q] = wr4[(size_t)(k + h) * 4 + q];
#pragma unroll
          for (int q = 0; q < 4; ++q)
#pragma unroll
              for (int ii = 0; ii < 4; ++ii) *(LAS unsigned*)(L + RT_WB + (4 * q + ii) * RT_STRIDE + k * 2) = pk2(wv[0][q][ii], wv[1][q][ii]); } }
    LAS unsigned* lcnt = (LAS unsigned*)(F.lds + RT_LCNT); LAS unsigned* lbase = (LAS unsigned*)(F.lds + RT_LBASE);
    if (F.tid < 16) lcnt[F.tid] = 0u;
    __syncthreads();
    const float* rbias = a.in[I_RBIAS];
    const int brow0 = 2 * (int)((blockIdx.x * (unsigned)(Mrows >> 1)) / (unsigned)F.G), brow1 = 2 * (int)(((blockIdx.x + 1) * (unsigned)(Mrows >> 1)) / (unsigned)F.G);
    const int nround = (brow1 - brow0 + 15) >> 4;
    const int fr = F.lane & 15, fq = F.lane >> 4;
#pragma unroll 1
    for (int t = 0; t < nround; ++t) {
        const int r = brow0 + 16 * t + 2 * F.wave;
        const bool v0 = r < brow1, v1 = r + 1 < brow1;
        const int rr[2] = {v0 ? r : brow0, v1 ? r + 1 : brow0};
        const int b = mod_row(rr[0]);
        const float* m = MOD + ((size_t)layer * 5 + b) * 6 * D;
        f32x4 x[2][8];
#pragma unroll
        for (int q = 0; q < 2; ++q) xrow_load(X, rr[q], F.lane, x[q]);
        float ss0 = row_sumsq(x[0]), ss1 = row_sumsq(x[1]);
#pragma unroll
        for (int o = 1; o < 64; o <<= 1) { ss0 += lane_xor(ss0, o, F.lane); ss1 += lane_xor(ss1, o, F.lane); }
        const float rs[2] = {1.0f / sqrtf(ss0 * (1.f / D) + EPS), 1.0f / sqrtf(ss1 * (1.f / D) + EPS)};
#pragma unroll
        for (int q = 0; q < 2; ++q) {
#pragma unroll
            for (int j = 0; j < 8; ++j) { const f32x4 w = *((const f32x4*)nw + 64 * j + F.lane), m4 = *((const f32x4*)(m + 4 * D) + 64 * j + F.lane), m3 = *((const f32x4*)(m + 3 * D) + 64 * j + F.lane);
                x[q][j] = x[q][j] * rs[q] * (w * (m4 + 1.f)) + m3; }
            if (q == 0 ? v0 : v1) { unsigned* ho = (unsigned*)((unsigned char*)H + (size_t)rr[q] * D) + F.lane;
#pragma unroll
                for (int j = 0; j < 8; ++j) ho[64 * j] = pk4_fp8(x[q][j][0], x[q][j][1], x[q][j][2], x[q][j][3]); }
            LAS unsigned char* hrow = L + RT_HT + (2 * F.wave + q) * RT_STRIDE + F.lane * 8;
#pragma unroll
            for (int j = 0; j < 8; ++j) { u32x2 w; w.x = pk2(x[q][j][0], x[q][j][1]); w.y = pk2(x[q][j][2], x[q][j][3]); *(LAS u32x2*)(hrow + j * 512) = w; } }
        __syncthreads();
        f32x4 acc = (f32x4){0.f, 0.f, 0.f, 0.f};
#pragma unroll
        for (int s = 0; s < 8; ++s) { const int kb = (256 * F.wave + 32 * s + 8 * fq) * 2;
            const bf16x8 wa = *(const LAS bf16x8*)(L + RT_WB + fr * RT_STRIDE + kb), hb = *(const LAS bf16x8*)(L + RT_HT + fr * RT_STRIDE + kb);
            acc = __builtin_amdgcn_mfma_f32_16x16x32_bf16(wa, hb, acc, 0, 0, 0); }
        *(LAS f32x4*)(L + RT_PART + F.wave * 1024 + fr * 64 + fq * 16) = acc;
        __syncthreads();
        if (F.lane < 2) { const int tr = 2 * F.wave + F.lane;
            f32x4 sg[4] = {(f32x4){0.f, 0.f, 0.f, 0.f}, (f32x4){0.f, 0.f, 0.f, 0.f}, (f32x4){0.f, 0.f, 0.f, 0.f}, (f32x4){0.f, 0.f, 0.f, 0.f}};
#pragma unroll
            for (int w8 = 0; w8 < 8; ++w8)
#pragma unroll
                for (int c = 0; c < 4; ++c) sg[c] += *(const LAS f32x4*)(L + RT_PART + w8 * 1024 + tr * 64 + c * 16);
            float lg[NEXP];
#pragma unroll
            for (int e = 0; e < NEXP; ++e) lg[e] = sg[e >> 2][e & 3];
            const Route R = route_row(lg, rbias); const int i1 = R.i1, i2 = R.i2; const float g1 = R.g1, g2 = R.g2;
            if ((F.lane == 0 ? v0 : v1) && publish) {
                const unsigned k1 = __hip_atomic_fetch_add(lcnt + i1, 1u, __ATOMIC_RELAXED, __HIP_MEMORY_SCOPE_WORKGROUP), k2 = __hip_atomic_fetch_add(lcnt + i2, 1u, __ATOMIC_RELAXED, __HIP_MEMORY_SCOPE_WORKGROUP);
                LAS unsigned* rec = (LAS unsigned*)(F.lds + RT_REC + (r + F.lane - brow0) * 32);
                rec[0] = (unsigned)i1; rec[1] = k1; rec[2] = (unsigned)i2; rec[3] = k2; rec[4] = __builtin_bit_cast(unsigned, g1); rec[5] = __builtin_bit_cast(unsigned, g2);
            } }
    }
    __syncthreads();
    if (F.tid < 16 && publish) { unsigned* cntw = (unsigned*)(ws + WS_CTL) + CW_CNT + layer * 1024; const unsigned n = lcnt[F.tid]; lbase[F.tid] = n ? atomicAdd(cntw + F.tid * 64, n) : 0u; }
    __syncthreads();
    if (F.tid < brow1 - brow0 && publish) { const int r = brow0 + F.tid; const LAS unsigned* rec = (const LAS unsigned*)(F.lds + RT_REC + F.tid * 32);
        const unsigned i1 = rec[0], i2 = rec[2], k1 = lbase[i1] + rec[1], k2 = lbase[i2] + rec[3];
        int* slottok = (int*)(ws + WS_SLOTTOK); slottok[(size_t)i1 * MTOK + k1] = r; slottok[(size_t)i2 * MTOK + k2] = r;
        ((int2*)(ws + WS_ROUTE_I))[r] = make_int2((int)((i1 << 20) | k1), (int)((i2 << 20) | k2));
        ((float2*)(ws + WS_ROUTE_G))[r] = make_float2(__builtin_bit_cast(float, rec[4]), __builtin_bit_cast(float, rec[5])); }
    __syncthreads();
}

__device__ __forceinline__ void phase_pooldiff(Frame& F, int Mrows) {
    unsigned char* ws = F.ws; const bf16_t* Z = (const bf16_t*)(ws + WS_Z); unsigned char* P8 = ws + WS_P;
    LAS unsigned char* L = F.lds;
    const int cg = F.tid & 127, rq = F.tid >> 7, hw = 1 << (cg >> 5);
    const int ntile = NLAT / 64;
    for (int tile = blockIdx.x; tile < ntile; tile += F.G) {
        int base, Lrow, t0, nt;
        if (tile < NLAT / 64) { base = tile * 64; Lrow = 64; t0 = 0; nt = 64; }
        else { const int u = tile - NLAT / 64; base = NLAT + (u >> 3) * CTXL; Lrow = CTXL; t0 = (u & 7) * 32; nt = 32; }
        const int lo = max(t0 - 8, 0), hi = min(t0 + nt + 7, Lrow - 1), nrow = hi - lo + 1;
        u32x4 buf[16];
#pragma unroll
        for (int i = 0; i < 16; ++i) { const int sl = rq + 4 * i; buf[i] = (sl < nrow) ? *(const u32x4*)(Z + (size_t)(base + lo + sl) * INC + ZC_POOL + cg * 8) : (u32x4){0u, 0u, 0u, 0u}; }
#pragma unroll
        for (int i = 0; i < 16; ++i) { const int sl = rq + 4 * i; *(LAS u32x4*)(L + sl * 2048 + cg * 16) = buf[i]; }
        __syncthreads();
        for (int i = 0; i < nt / 4; ++i) { const int t = t0 + rq + 4 * i;
            const int wl = max(t - hw, 0), wh = min(t + hw - 1, Lrow - 1);
            float s[8] = {0.f, 0.f, 0.f, 0.f, 0.f, 0.f, 0.f, 0.f};
            for (int p = wl; p <= wh; ++p) { const u32x4 a = *(const LAS u32x4*)(L + (p - lo) * 2048 + cg * 16);
                s[0] += bflo(a.x); s[1] += bfhi(a.x); s[2] += bflo(a.y); s[3] += bfhi(a.y); s[4] += bflo(a.z); s[5] += bfhi(a.z); s[6] += bflo(a.w); s[7] += bfhi(a.w); }
            const float inv = 1.f / (float)(wh - wl + 1);
            const u32x4 a = *(const LAS u32x4*)(L + (t - lo) * 2048 + cg * 16);
            u32x2 o; o.x = pk4_fp8(s[0] * inv - bflo(a.x), s[1] * inv - bfhi(a.x), s[2] * inv - bflo(a.y), s[3] * inv - bfhi(a.y));
            o.y = pk4_fp8(s[4] * inv - bflo(a.z), s[5] * inv - bfhi(a.z), s[6] * inv - bflo(a.w), s[7] * inv - bfhi(a.w));
            *(u32x2*)(P8 + (size_t)(base + t) * DPOOL + cg * 8) = o; }
        __syncthreads();
    }
    if (Mrows > NLAT) {
        const int cgl = F.tid & 15, rq2 = F.tid >> 4;
        for (int it = blockIdx.x; it < (NCTX / 32) * 8; it += F.G) {
            const int u = it >> 3, k = it & 7, cg2 = k * 16 + cgl, hw2 = 1 << (k >> 1);
            const int base = NLAT + (u >> 3) * CTXL, t0 = (u & 7) * 32;
            const int lo = max(t0 - 8, 0), hi = min(t0 + 32 + 7, CTXL - 1), nrow = hi - lo + 1;
            u32x4 buf[2];
#pragma unroll
            for (int i = 0; i < 2; ++i) { const int sl = rq2 + 32 * i; buf[i] = (sl < nrow) ? *(const u32x4*)(Z + (size_t)(base + lo + sl) * INC + ZC_POOL + cg2 * 8) : (u32x4){0u, 0u, 0u, 0u}; }
#pragma unroll
            for (int i = 0; i < 2; ++i) { const int sl = rq2 + 32 * i; *(LAS u32x4*)(L + sl * 2048 + cg2 * 16) = buf[i]; }
            __syncthreads();
            { const int t = t0 + rq2;
              const int wl = max(t - hw2, 0), wh = min(t + hw2 - 1, CTXL - 1);
              float s8[8] = {0.f, 0.f, 0.f, 0.f, 0.f, 0.f, 0.f, 0.f};
              for (int p = wl; p <= wh; ++p) { const u32x4 a = *(const LAS u32x4*)(L + (p - lo) * 2048 + cg2 * 16);
                  s8[0] += bflo(a.x); s8[1] += bfhi(a.x); s8[2] += bflo(a.y); s8[3] += bfhi(a.y); s8[4] += bflo(a.z); s8[5] += bfhi(a.z); s8[6] += bflo(a.w); s8[7] += bfhi(a.w); }
              const float inv = 1.f / (float)(wh - wl + 1);
              const u32x4 a = *(const LAS u32x4*)(L + (t - lo) * 2048 + cg2 * 16);
              u32x2 o; o.x = pk4_fp8(s8[0] * inv - bflo(a.x), s8[1] * inv - bfhi(a.x), s8[2] * inv - bflo(a.y), s8[3] * inv - bfhi(a.y));
              o.y = pk4_fp8(s8[4] * inv - bflo(a.z), s8[5] * inv - bfhi(a.z), s8[6] * inv - bflo(a.w), s8[7] * inv - bfhi(a.w));
              *(u32x2*)(P8 + (size_t)(base + t) * DPOOL + cg2 * 8) = o; }
            __syncthreads();
        }
    }
}

constexpr int SC_QS = 0, SC_KS = 17408, SC_KST = 34816, SC_VT = 53248, SC_VEC = 71680;
constexpr int SC_ST = 73216, SC_TOT = SC_ST + 34816, SC_END = SC_TOT + 4096;
constexpr int SC_P272 = 272, SC_P144 = 144;
constexpr int SEG_CH = 17, NSEG = 4;
static_assert(SC_END <= LDS_MISC, "scan LDS map");
struct ScanCtx { const bf16_t* Z; bf16_t* O2; LAS unsigned char* L; unsigned char* qsg; float* corrv; float* smid; float* totseg; int tid, lane, w, fr, fq, rt, vp, b, h, seg, dir, colq, colf, colv; };
__device__ __forceinline__ void scan_row0(int b, int dir, int c, int& g0, int& sg) {
    if (c < 4) { const int t0 = 64 * c; g0 = NLAT + b * CTXL + (dir ? CTXL - 1 - t0 : t0); } else { const int t0 = 64 * (c - 4); g0 = b * SEQ + (dir ? SEQ - 1 - t0 : t0); }
    sg = dir ? -1 : 1;
}
__device__ __forceinline__ void scan_load_lf(const ScanCtx& C, int c, unsigned (&lfw)[8]) {
    int g0, sg; scan_row0(C.b, C.dir, c, g0, sg);
#pragma unroll
    for (int j = 0; j < 8; ++j) lfw[j] = *(const unsigned*)(C.Z + (size_t)(g0 + sg * (8 * C.w + j)) * INC + C.colf);
}
__device__ __forceinline__ void scan_load_qv(const ScanCtx& C, int c, unsigned (&qw)[8], unsigned (&vw)[8]) {
    int g0, sg; scan_row0(C.b, C.dir, c, g0, sg);
#pragma unroll
    for (int j = 0; j < 8; ++j) { const bf16_t* zr = C.Z + (size_t)(g0 + sg * (8 * C.w + j)) * INC; qw[j] = *(const unsigned*)(zr + C.colq); vw[j] = *(const unsigned*)(zr + C.colv); }
}
__device__ __forceinline__ void scan_p1(const ScanCtx& C, const unsigned (&lfw)[8]) {
    float a0 = 0.f, a1 = 0.f;
#pragma unroll
    for (int j = 0; j < 8; ++j) { a0 += bflo(lfw[j]); a1 += bfhi(lfw[j]); }
    *(LAS f32x2*)(C.L + SC_TOT + (C.w * 128 + 2 * C.lane) * 4) = (f32x2){a0, a1};
}
__device__ __forceinline__ void scan_p2(const ScanCtx& C, int cl, const unsigned (&lfw)[8], const unsigned (&qw)[8], const unsigned (&vw)[8], float& cum0, float& cum1) {
    LAS unsigned char* L = C.L; const int lane = C.lane, w = C.w;
    float c0[8], c1[8], l0[8], l1[8];
    { float a0 = 0.f, a1 = 0.f;
#pragma unroll
      for (int j = 0; j < 8; ++j) { l0[j] = bflo(lfw[j]); l1[j] = bfhi(lfw[j]); a0 += l0[j]; a1 += l1[j]; c0[j] = a0; c1[j] = a1; } }
    float P0 = 0.f, P1 = 0.f, r0 = 0.f, r1 = 0.f, bl0 = 0.f, bl1 = 0.f;
#pragma unroll
    for (int o = 0; o < 8; ++o) { const f32x2 t = *(const LAS f32x2*)(L + SC_TOT + (o * 128 + 2 * lane) * 4);
        if (o < w) { P0 += t.x; P1 += t.y; } if (o < 4) { r0 += t.x; r1 += t.y; } bl0 += t.x; bl1 += t.y; }
    float k0v[8], k1v[8]; const float P0r = P0 - r0, P1r = P1 - r1;
#pragma unroll
    for (int j = 0; j < 8; ++j) {
        const float d0 = __builtin_amdgcn_fmed3f(P0r + c0[j], -120.f, 120.f), d1 = __builtin_amdgcn_fmed3f(P1r + c1[j], -120.f, 120.f);
        const float E0 = __builtin_amdgcn_exp2f(d0), E1 = __builtin_amdgcn_exp2f(d1), I0 = __builtin_amdgcn_exp2f(-d0), I1 = __builtin_amdgcn_exp2f(-d1);
        const float f0 = __builtin_amdgcn_exp2f(l0[j]), f1 = __builtin_amdgcn_exp2f(l1[j]);
        const float q0 = bflo(qw[j]), q1 = bfhi(qw[j]);
        k0v[j] = (1.f - f0) * I0; k1v[j] = (1.f - f1) * I1;
        const int rho = 8 * w + j;
        *(LAS unsigned*)(L + SC_QS + rho * SC_P272 + 4 * lane) = pk2(q0 * E0, q1 * E1);
        *(LAS unsigned*)(L + SC_KS + rho * SC_P272 + 4 * lane) = pk2(k0v[j], k1v[j]);
    }
    { u32x4 t0, t1; t0.x = pk2(k0v[0], k0v[1]); t0.y = pk2(k0v[2], k0v[3]); t0.z = pk2(k0v[4], k0v[5]); t0.w = pk2(k0v[6], k0v[7]);
      t1.x = pk2(k1v[0], k1v[1]); t1.y = pk2(k1v[2], k1v[3]); t1.z = pk2(k1v[4], k1v[5]); t1.w = pk2(k1v[6], k1v[7]);
      *(LAS u32x4*)(L + SC_KST + (2 * lane) * SC_P144 + 16 * w) = t0; *(LAS u32x4*)(L + SC_KST + (2 * lane + 1) * SC_P144 + 16 * w) = t1; }
    if (w == 0) {
        LAS float* vec = (LAS float*)(L + SC_VEC);
        *(LAS f32x2*)(vec + 2 * lane) = (f32x2){__builtin_amdgcn_exp2f(fmaxf(r0, -120.f)), __builtin_amdgcn_exp2f(fmaxf(r1, -120.f))};
        *(LAS f32x2*)(vec + 128 + 2 * lane) = (f32x2){__builtin_amdgcn_exp2f(fmaxf(bl0, -120.f)), __builtin_amdgcn_exp2f(fmaxf(bl1, -120.f))};
        *(LAS f32x2*)(vec + 256 + 2 * lane) = (f32x2){__builtin_amdgcn_exp2f(fmaxf(bl0 - r0, -120.f)), __builtin_amdgcn_exp2f(fmaxf(bl1 - r1, -120.f))};
        if (C.seg >= 1) *(f32x2*)(C.corrv + cl * 128 + 2 * lane) = (f32x2){r0 + cum0, r1 + cum1};
    }
    cum0 += bl0; cum1 += bl1;
    { u32x4 t0, t1;
      t0.x = (vw[0] & 0xffffu) | (vw[1] << 16); t0.y = (vw[2] & 0xffffu) | (vw[3] << 16); t0.z = (vw[4] & 0xffffu) | (vw[5] << 16); t0.w = (vw[6] & 0xffffu) | (vw[7] << 16);
      t1.x = (vw[0] >> 16) | (vw[1] & 0xffff0000u); t1.y = (vw[2] >> 16) | (vw[3] & 0xffff0000u); t1.z = (vw[4] >> 16) | (vw[5] & 0xffff0000u); t1.w = (vw[6] >> 16) | (vw[7] & 0xffff0000u);
      *(LAS u32x4*)(L + SC_VT + (2 * lane) * SC_P144 + 16 * w) = t0; *(LAS u32x4*)(L + SC_VT + (2 * lane + 1) * SC_P144 + 16 * w) = t1; }
}
__device__ __forceinline__ void scan_c1(const ScanCtx& C, const f32x4 (&S)[2][4]) {
#pragma unroll
    for (int i = 0; i < 2; ++i) { const int k = ((C.w >> 1) * 2 + i) * 16 + 4 * C.fq;
        f32x4 r = *(const LAS f32x4*)(C.L + SC_TOT + k * 4);
#pragma unroll
        for (int o = 1; o < 4; ++o) r += *(const LAS f32x4*)(C.L + SC_TOT + (o * 128 + k) * 4);
        f32x4 e;
#pragma unroll
        for (int q = 0; q < 4; ++q) e[q] = __builtin_amdgcn_exp2f(fmaxf(r[q], -120.f));
#pragma unroll
        for (int u = 0; u < 4; ++u) { const int v = (4 * C.vp + u) * 16 + C.fr; const f32x4 sv = S[i][u] * e;
            u32x2 t; t.x = pk2(sv[0], sv[1]); t.y = pk2(sv[2], sv[3]); *(LAS u32x2*)(C.L + SC_ST + v * SC_P272 + k * 2) = t; } }
}
__device__ __forceinline__ void scan_c2(const ScanCtx& C, int c, f32x4 (&S)[2][4]) {
    LAS unsigned char* L = C.L; const int fr = C.fr, fq = C.fq, rt = C.rt, w = C.w;
    bf16x8 yq[4];
#pragma unroll
    for (int ks = 0; ks < 4; ++ks) yq[ks] = *(const LAS bf16x8*)(L + SC_QS + (rt * 16 + fr) * SC_P272 + (ks * 32 + fq * 8) * 2);
    f32x4 at[4];
#pragma unroll
    for (int st = 0; st < 4; ++st) { f32x4 a = (f32x4){0.f, 0.f, 0.f, 0.f};
        if (st <= rt) {
#pragma unroll
            for (int ks = 0; ks < 4; ++ks) { const bf16x8 x = *(const LAS bf16x8*)(L + SC_KS + (st * 16 + fr) * SC_P272 + (ks * 32 + fq * 8) * 2); a = __builtin_amdgcn_mfma_f32_16x16x32_bf16(x, yq[ks], a, 0, 0, 0); }
            if (st == rt) {
#pragma unroll
                for (int r = 0; r < 4; ++r) if (4 * fq + r > fr) a[r] = 0.f; } }
        at[st] = a; }
    u32x4 yw[2];
#pragma unroll
    for (int ks2 = 0; ks2 < 2; ++ks2) { yw[ks2].x = pk2(at[2 * ks2][0], at[2 * ks2][1]); yw[ks2].y = pk2(at[2 * ks2][2], at[2 * ks2][3]); yw[ks2].z = pk2(at[2 * ks2 + 1][0], at[2 * ks2 + 1][1]); yw[ks2].w = pk2(at[2 * ks2 + 1][2], at[2 * ks2 + 1][3]); }
    int g0, sg; scan_row0(C.b, C.dir, c, g0, sg);
#pragma unroll
    for (int u = 0; u < 4; ++u) { const int vt = 4 * C.vp + u; f32x4 o = (f32x4){0.f, 0.f, 0.f, 0.f};
#pragma unroll
        for (int ks = 0; ks < 4; ++ks) { const bf16x8 x = *(const LAS bf16x8*)(L + SC_ST + (vt * 16 + fr) * SC_P272 + (ks * 32 + fq * 8) * 2); o = __builtin_amdgcn_mfma_f32_16x16x32_bf16(x, yq[ks], o, 0, 0, 0); }
#pragma unroll
        for (int ks2 = 0; ks2 < 2; ++ks2) { if (2 * ks2 <= rt) {
            const u32x2 xa = *(const LAS u32x2*)(L + SC_VT + (vt * 16 + fr) * SC_P144 + (ks2 * 32 + 4 * fq) * 2), xb = *(const LAS u32x2*)(L + SC_VT + (vt * 16 + fr) * SC_P144 + (ks2 * 32 + 16 + 4 * fq) * 2);
            u32x4 xw; xw.x = xa.x; xw.y = xa.y; xw.z = xb.x; xw.w = xb.y;
            o = __builtin_amdgcn_mfma_f32_16x16x32_bf16(__builtin_bit_cast(bf16x8, xw), __builtin_bit_cast(bf16x8, yw[ks2]), o, 0, 0, 0); } }
        u32x2 ow; ow.x = pk2(o[0], o[1]); ow.y = pk2(o[2], o[3]);
        *(u32x2*)(C.O2 + ((size_t)C.dir * MTOK + (g0 + sg * (rt * 16 + fr))) * HGW + C.h * HDK + vt * 16 + 4 * fq) = ow;
        __builtin_amdgcn_sched_barrier(0); }
    bf16x8 xk[2][2];
#pragma unroll
    for (int i = 0; i < 2; ++i)
#pragma unroll
        for (int ks = 0; ks < 2; ++ks) xk[i][ks] = *(const LAS bf16x8*)(L + SC_KST + (((w >> 1) * 2 + i) * 16 + fr) * SC_P144 + (ks * 32 + fq * 8) * 2);
#pragma unroll
    for (int u = 0; u < 4; ++u) { bf16x8 yv[2];
#pragma unroll
        for (int ks = 0; ks < 2; ++ks) yv[ks] = *(const LAS bf16x8*)(L + SC_VT + ((4 * C.vp + u) * 16 + fr) * SC_P144 + (ks * 32 + fq * 8) * 2);
#pragma unroll
        for (int i = 0; i < 2; ++i) { f32x4 d = (f32x4){0.f, 0.f, 0.f, 0.f};
#pragma unroll
            for (int ks = 0; ks < 2; ++ks) d = __builtin_amdgcn_mfma_f32_16x16x32_bf16(xk[i][ks], yv[ks], d, 0, 0, 0);
            const int k = ((w >> 1) * 2 + i) * 16 + 4 * fq; const f32x4 ebl = *(const LAS f32x4*)(L + SC_VEC + (128 + k) * 4), ebr = *(const LAS f32x4*)(L + SC_VEC + (256 + k) * 4);
            S[i][u] = ebl * S[i][u] + ebr * d; }
        __builtin_amdgcn_sched_barrier(0); }
}
__device__ __forceinline__ void phase_scan_mfma(Frame& F) {
    ScanCtx C; C.Z = (const bf16_t*)(F.ws + WS_Z); C.O2 = (bf16_t*)(F.ws + WS_O2); C.L = F.lds;
    C.tid = F.tid; C.lane = F.lane; C.w = F.wave; C.fr = F.lane & 15; C.fq = F.lane >> 4; C.rt = F.wave >> 1; C.vp = F.wave & 1;
    for (int it = blockIdx.x; it < 64 * NSEG; it += F.G) {
        const int sbh = it >> 2; C.h = sbh & 7; C.b = (sbh >> 3) & 3; C.dir = sbh >> 5;
        C.seg = C.dir ? 3 - (it & 3) : (it & 3);
        C.qsg = F.ws + WS_QSG + (size_t)(sbh * 3 + (C.seg - 1)) * SEG_CH * 17408; C.corrv = (float*)(F.ws + WS_CORRV) + (size_t)(sbh * 3 + (C.seg - 1)) * SEG_CH * 128;
        C.smid = (float*)(F.ws + WS_SMID) + (size_t)(sbh * 3 + C.seg) * 128 * 128; C.totseg = (float*)(F.ws + WS_TOTSEG) + (size_t)(sbh * NSEG + C.seg) * 128;
        C.colq = ZC_Q + C.h * HDK + 2 * C.lane; C.colf = (C.dir == 0 ? ZC_FF : ZC_FB) + C.h * HDK + 2 * C.lane; C.colv = ZC_I + C.h * HDK + 2 * C.lane;
        f32x4 S[2][4];
#pragma unroll
        for (int i = 0; i < 2; ++i)
#pragma unroll
            for (int u = 0; u < 4; ++u) S[i][u] = (f32x4){0.f, 0.f, 0.f, 0.f};
        float cum0 = 0.f, cum1 = 0.f;
        unsigned lfW[8], qW[8], vW[8];
        const int c_lo = C.seg * SEG_CH;
        scan_load_lf(C, c_lo, lfW); scan_load_qv(C, c_lo, qW, vW);
        scan_p1(C, lfW);
        __syncthreads();
#define SC_STEP(cl) do { \
            scan_p2(C, (cl), lfW, qW, vW, cum0, cum1); scan_c1(C, S); \
            if ((cl) + 1 < SEG_CH) { scan_load_lf(C, c_lo + (cl) + 1, lfW); scan_load_qv(C, c_lo + (cl) + 1, qW, vW); } \
            __syncthreads(); \
            if (C.seg >= 1) { unsigned char* dst = C.qsg + (size_t)(cl) * 17408; const LAS unsigned char* src = C.L + SC_QS; for (int i_ = C.tid; i_ < 1088; i_ += 512) *(u32x4*)(dst + 16 * i_) = *(const LAS u32x4*)(src + 16 * i_); } \
            scan_c2(C, c_lo + (cl), S); \
            if ((cl) + 1 < SEG_CH) scan_p1(C, lfW); \
            __syncthreads(); } while (0)
        for (int cl = 0; cl < SEG_CH; ++cl) SC_STEP(cl);
#undef SC_STEP
        if (C.seg < 3) {
#pragma unroll
            for (int i = 0; i < 2; ++i)
#pragma unroll
                for (int u = 0; u < 4; ++u) *(f32x4*)(C.smid + ((4 * C.vp + u) * 16 + C.fr) * 128 + ((C.w >> 1) * 2 + i) * 16 + 4 * C.fq) = S[i][u]; }
        if (C.w == 0) *(f32x2*)(C.totseg + 2 * C.lane) = (f32x2){cum0, cum1};
        __syncthreads();
    }
}
__device__ __forceinline__ void phase_scan_fix(Frame& F) {
    unsigned char* ws = F.ws; bf16_t* O2 = (bf16_t*)(ws + WS_O2); LAS unsigned char* L = F.lds;
    LAS float* facv = (LAS float*)(L + 36864); LAS int* flg = (LAS int*)(L + 36864 + 512);
    const int w = F.wave, fr = F.lane & 15, fq = F.lane >> 4, rt = w >> 1, vp = w & 1;
    for (int item = blockIdx.x; item < 64 * 3; item += F.G) {
        const int j = 1 + item % 3, sbh = item / 3, dir = sbh >> 5, b = (sbh >> 3) & 3, h = sbh & 7;
        const int v = F.tid >> 2, k0 = (F.tid & 3) * 32;
        f32x4 sin[8];
        { const float* E = (const float*)(ws + WS_SMID) + ((size_t)(sbh * 3 + 0) * 128 + v) * 128 + k0;
#pragma unroll
          for (int i = 0; i < 8; ++i) sin[i] = *(const f32x4*)(E + 4 * i); }
        for (int jj = 1; jj < j; ++jj) { const float* E = (const float*)(ws + WS_SMID) + ((size_t)(sbh * 3 + jj) * 128 + v) * 128 + k0; const float* T = (const float*)(ws + WS_TOTSEG) + (size_t)(sbh * NSEG + jj) * 128 + k0;
#pragma unroll
            for (int i = 0; i < 8; ++i) { const f32x4 t = *(const f32x4*)(T + 4 * i); f32x4 d;
#pragma unroll
                for (int q = 0; q < 4; ++q) d[q] = __builtin_amdgcn_exp2f(fmaxf(t[q], -200.f));
                sin[i] = d * sin[i] + *(const f32x4*)(E + 4 * i); } }
        for (int cl = 0; cl < SEG_CH; ++cl) {
            if (F.tid == 0) flg[0] = 0;
            __syncthreads();
            if (F.tid < 128) { const float e = ((const float*)(ws + WS_CORRV))[((size_t)(sbh * 3 + (j - 1)) * SEG_CH + cl) * 128 + F.tid]; const float f = __builtin_amdgcn_exp2f(fmaxf(e, -200.f)); facv[F.tid] = f; if (f != 0.f) flg[0] = 1; }
            __syncthreads();
            if (flg[0] != 0) {
#pragma unroll
                for (int i = 0; i < 4; ++i) { const f32x4 a0 = sin[2 * i] * *(const LAS f32x4*)(facv + k0 + 8 * i), a1 = sin[2 * i + 1] * *(const LAS f32x4*)(facv + k0 + 8 * i + 4);
                    u32x4 o; o.x = pk2(a0[0], a0[1]); o.y = pk2(a0[2], a0[3]); o.z = pk2(a1[0], a1[1]); o.w = pk2(a1[2], a1[3]);
                    *(LAS u32x4*)(L + v * SC_P272 + (k0 + 8 * i) * 2) = o; }
                __syncthreads();
                const unsigned char* qs = ws + WS_QSG + ((size_t)(sbh * 3 + (j - 1)) * SEG_CH + cl) * 17408;
                bf16x8 yq[4];
#pragma unroll
                for (int ks = 0; ks < 4; ++ks) yq[ks] = *(const bf16x8*)(qs + (rt * 16 + fr) * SC_P272 + (ks * 32 + fq * 8) * 2);
                int g0, sg; scan_row0(b, dir, j * SEG_CH + cl, g0, sg);
#pragma unroll
                for (int u = 0; u < 4; ++u) { const int vt = 4 * vp + u; f32x4 o = (f32x4){0.f, 0.f, 0.f, 0.f};
#pragma unroll
                    for (int ks = 0; ks < 4; ++ks) { const bf16x8 x = *(const LAS bf16x8*)(L + (vt * 16 + fr) * SC_P272 + (ks * 32 + fq * 8) * 2); o = __builtin_amdgcn_mfma_f32_16x16x32_bf16(x, yq[ks], o, 0, 0, 0); }
                    u32x2* p = (u32x2*)(O2 + ((size_t)dir * MTOK + (g0 + sg * (rt * 16 + fr))) * HGW + h * HDK + vt * 16 + 4 * fq);
                    const u32x2 old = *p; u32x2 nw; nw.x = pk2(bflo(old.x) + o[0], bfhi(old.x) + o[1]); nw.y = pk2(bflo(old.y) + o[2], bfhi(old.y) + o[3]); *p = nw; }
            }
            __syncthreads();
        }
    }
}
__device__ __forceinline__ void phase_readout_naive(Frame& F, const Args& a, int layer, int Mrows) {
    unsigned char* ws = F.ws; const bf16_t* Z = (const bf16_t*)(ws + WS_Z); const float* O2 = (const float*)(ws + WS_O2); bf16_t* HG = (bf16_t*)(ws + WS_HG);
    const float* wn = a.in[I_HGNW] + (size_t)layer * HGW;
    int r0, r1; wave_rows(F, Mrows, r0, r1);
    const int c0 = F.lane * 16;
    float wv[16];
#pragma unroll
    for (int j = 0; j < 16; ++j) wv[j] = wn[c0 + j] * HG8_SCALE;
    for (int rb = r0; rb < r1; rb += 2) {
        const bool two = rb + 1 < r1; const int rr[2] = {rb, two ? rb + 1 : rb};
        u32x2 xw[2][4], yw[2][4]; u32x4 ga[2], gb[2];
#pragma unroll
        for (int q = 0; q < 2; ++q) {
#pragma unroll
            for (int j = 0; j < 4; ++j) { xw[q][j] = *(const u32x2*)((const bf16_t*)O2 + (size_t)rr[q] * HGW + c0 + 4 * j); yw[q][j] = *(const u32x2*)((const bf16_t*)O2 + ((size_t)MTOK + rr[q]) * HGW + c0 + 4 * j); }
            const u32x4* zp = (const u32x4*)(Z + (size_t)rr[q] * INC + ZC_OG + c0); ga[q] = zp[0]; gb[q] = zp[1]; }
#pragma unroll
        for (int q = 0; q < 2; ++q) { if (q == 0 || two) {
            float o[16]; float ss = 0.f;
#pragma unroll
            for (int j = 0; j < 4; ++j) { const f32x4 x = (f32x4){bflo(xw[q][j].x), bfhi(xw[q][j].x), bflo(xw[q][j].y), bfhi(xw[q][j].y)}, y = (f32x4){bflo(yw[q][j].x), bfhi(yw[q][j].x), bflo(yw[q][j].y), bfhi(yw[q][j].y)};
#pragma unroll
                for (int i = 0; i < 4; ++i) { o[4 * j + i] = x[i] + y[i]; ss += o[4 * j + i] * o[4 * j + i]; } }
            ss += lane_xor(ss, 1, F.lane); ss += lane_xor(ss, 2, F.lane); ss += lane_xor(ss, 4, F.lane);
            const float rs = 1.0f / sqrtf(ss * (1.f / HDK) + EPS);
            const float g[16] = {bflo(ga[q].x), bfhi(ga[q].x), bflo(ga[q].y), bfhi(ga[q].y), bflo(ga[q].z), bfhi(ga[q].z), bflo(ga[q].w), bfhi(ga[q].w), bflo(gb[q].x), bfhi(gb[q].x), bflo(gb[q].y), bfhi(gb[q].y), bflo(gb[q].z), bfhi(gb[q].z), bflo(gb[q].w), bfhi(gb[q].w)};
            float y[16];
#pragma unroll
            for (int j = 0; j < 16; ++j) y[j] = o[j] * rs * wv[j] * g[j];
            u32x4 o0; o0.x = pk4_fp8(y[0], y[1], y[2], y[3]); o0.y = pk4_fp8(y[4], y[5], y[6], y[7]); o0.z = pk4_fp8(y[8], y[9], y[10], y[11]); o0.w = pk4_fp8(y[12], y[13], y[14], y[15]);
            *(u32x4*)((unsigned char*)HG + (size_t)rr[q] * HGW + c0) = o0; } }
    }
}

__device__ __forceinline__ void phase_final(Frame& F, const Args& a) {
    unsigned char* ws = F.ws; const bf16_t* X = (const bf16_t*)(ws + WS_X); const float* MOD = (const float*)(ws + WS_MOD); const float* fw = a.in[I_FNW];
    int r0, r1; wave_rows(F, NLAT, r0, r1);
    for (int r = r0; r < r1;) {
        const bool two = (r + 1 < r1) && (mod_row(r + 1) == mod_row(r));
        const int rr[2] = {r, two ? r + 1 : r};
        f32x4 x[2][8];
#pragma unroll
        for (int q = 0; q < 2; ++q) xrow_load(X, rr[q], F.lane, x[q]);
        moe_combine_rows<2>(x, rr, F.lane, ws, DEPTH - 1, MOD + ((size_t)(DEPTH - 1) * 5 + mod_row(r)) * 6 * D + 5 * D);
        float ss0 = row_sumsq(x[0]), ss1 = row_sumsq(x[1]);
#pragma unroll
        for (int o = 1; o < 64; o <<= 1) { ss0 += lane_xor(ss0, o, F.lane); ss1 += lane_xor(ss1, o, F.lane); }
        const float rs[2] = {1.0f / sqrtf(ss0 * (1.f / D) + EPS), 1.0f / sqrtf(ss1 * (1.f / D) + EPS)};
#pragma unroll
        for (int q = 0; q < 2; ++q) if (q == 0 || two) { f32x4* o = (f32x4*)(a.out + (size_t)rr[q] * D) + F.lane;
#pragma unroll
            for (int j = 0; j < 8; ++j) o[64 * j] = x[q][j] * rs[q] * *((const f32x4*)fw + 64 * j + F.lane); }
        r += two ? 2 : 1;
    }
}

__device__ __forceinline__ int moe_tables(Frame& F, int layer) {
    LAS int* tbl = (LAS int*)(F.lds + LDS_MISC + 64);
    const unsigned* cntw = (const unsigned*)(F.ws + WS_CTL) + CW_CNT + layer * 1024;
    if (F.tid < NEXP) tbl[F.tid] = (int)__hip_atomic_load(cntw + F.tid * 64, __ATOMIC_RELAXED, __HIP_MEMORY_SCOPE_AGENT);
    __syncthreads();
    if (F.tid == 0) {
        int blk = 0;
#pragma unroll 1
        for (int e = 0; e < NEXP; ++e) { const int c = tbl[e]; const int nb = (c + 255) >> 8;
            tbl[16 + e] = blk; for (int j = 0; j < nb; ++j) tbl[64 + blk + j] = e;
            if (blockIdx.x == 0) ((int*)(F.ws + WS_PADBASE))[layer * 16 + e] = blk * 256;
            blk += nb; }
        tbl[32] = blk;
    }
    __syncthreads();
    return tbl[32];
}

constexpr int PH_PER_LAYER = 10;
constexpr int N_PHASES = 1 + DEPTH * PH_PER_LAYER + 1;

__global__ void __launch_bounds__(512, 2) mk_fwd(Args args) {
    extern __shared__ __attribute__((aligned(16))) unsigned char lds_raw[];
    Frame F;
    F.lds = (LAS unsigned char*)lds_raw;
    F.tid = threadIdx.x; F.lane = F.tid & 63; F.wave = __builtin_amdgcn_readfirstlane(F.tid >> 6);
    F.G = gridDim.x; F.gw = blockIdx.x * 8 + F.wave; F.NGW = F.G * 8; F.ws = args.ws;
    unsigned char* ws = args.ws;
    volatile LAS unsigned* misc = (volatile LAS unsigned*)(F.lds + LDS_MISC);
    if (F.tid < 16) misc[F.tid] = 0u;
    __syncthreads();
    const int lo = args.ph_lo, hi = args.ph_hi;
#if MK_ONE_LAUNCH
    XcdBarrier bar = xcd_barrier_post((unsigned*)(ws + WS_CTL) + CW_BAR, misc);
#define GRID_BAR() xcd_barrier(bar)
#else
#define GRID_BAR() do {} while (0)
#endif
#ifndef MK_PHMASK
#define MK_PHMASK 0xFFFF
#endif
#define PHON(b) ((MK_PHMASK >> (b)) & 1)
#ifndef MK_REPMASK
#define MK_REPMASK 0
#endif
#define REPS(b) (((args.rep >> (b)) & 1) + 1)
#define IN(k) (lo <= (k) && (k) < hi)
#define LAUNDER() do { int t_ = threadIdx.x; asm volatile("" : "+v"(t_)); F.tid = t_; F.lane = t_ & 63; unsigned char* w_ = args.ws; asm volatile("" : "+s"(w_)); F.ws = w_; ws = w_; } while (0)
#define SEAM(k) do { if (IN(k) && IN((k) + 1)) { GRID_BAR(); if ((args.rep >> 15) & 1) GRID_BAR(); } } while (0)

    if (PHON(0) && IN(0)) { LAUNDER(); for (int rep_ = 0; rep_ < REPS(0); ++rep_) { if (rep_) { VM_WAIT(); __syncthreads(); } phase_prologue(F, args); } }
    SEAM(0);

    for (int layer_ = 0; layer_ < DEPTH; ++layer_) {
        int layer = layer_; asm volatile("" : "+s"(layer));
        const int pb = 1 + layer * PH_PER_LAYER;
        const bool lastl = (layer == DEPTH - 1);
        const int Mr = lastl ? NLAT : MTOK;
        if (PHON(1) && IN(pb + 0)) { LAUNDER(); for (int rep_ = 0; rep_ < REPS(1); ++rep_) { if (rep_) { VM_WAIT(); __syncthreads(); } phase_norm1(F, args, layer, layer > 0 && rep_ == 0); } }
        SEAM(pb + 0);
        if (PHON(2) && IN(pb + 1)) { LAUNDER(); for (int rep_ = 0; rep_ < REPS(2); ++rep_) { if (rep_) { VM_WAIT(); __syncthreads(); }
            pg8::DenseOrder S; S.init(MTOK, INC, F.G, (int)blockIdx.x, D, 0);
            pg8::EpiIn E{(bf16_t*)(ws + WS_Z), (const float*)(ws + WS_LB) + (size_t)layer * 2 * 1024, ws + WS_G8};
            pg8::gemm_phase<pg8::EpiIn, pg8::DenseOrder, true>(F.lds, ws + WS_H, D, ws + WS_WIN + (size_t)layer * INC * D, D, D, S, E);
        } }
        SEAM(pb + 1);
        if (PHON(3) && IN(pb + 2)) { LAUNDER(); for (int rep_ = 0; rep_ < REPS(3); ++rep_) { if (rep_) { VM_WAIT(); __syncthreads(); } phase_pooldiff(F, Mr); __syncthreads(); } { VM_WAIT(); __syncthreads(); phase_scan_mfma(F); GRID_BAR(); LAUNDER(); phase_scan_fix(F); } }
        SEAM(pb + 2);
        if (PHON(5) && IN(pb + 4)) { LAUNDER(); for (int rep_ = 0; rep_ < REPS(5); ++rep_) { if (rep_) { VM_WAIT(); __syncthreads(); } phase_readout_naive(F, args, layer, Mr); } }
        SEAM(pb + 4);
        if (PHON(6) && IN(pb + 5)) { LAUNDER(); for (int rep_ = 0; rep_ < REPS(6); ++rep_) { if (rep_) { VM_WAIT(); __syncthreads(); }
            pg8::DenseOrder S; S.init(Mr, D, F.G, (int)blockIdx.x, 1024, 0);
            { pg8::EpiGate2 E{ws + WS_MX, ws + WS_G8, 0, ZC_GH - ZC_GP, HG8_SCALE, 1.f / (W8_SCALE * HG8_SCALE * 255.f)};
              pg8::gemm_phase<pg8::EpiGate2, pg8::DenseOrder, true, true>(F.lds, ws + WS_P, 1024, ws + WS_WBP + (size_t)layer * D * 1024, 2048, 1024, S, E,
                  (long)WS_HG - (long)WS_P - 8 * 128, (long)WS_WBH - (long)WS_WBP - 8 * 128, 8); }
            if (rep_ == 0) { LAUNDER(); int rk, nn; idle_rank((Mr / 256) * 8, F.G, (int)blockIdx.x, rk, nn); convert_range(F, args, layer + 1, 0, 36000, rk, nn); }
        } }
        SEAM(pb + 5);
        if (PHON(7) && IN(pb + 6)) { LAUNDER(); for (int rep_ = 0; rep_ < REPS(7); ++rep_) { if (rep_) { VM_WAIT(); __syncthreads(); }
            pg8::DenseOrder S; S.init(Mr, D, F.G, (int)blockIdx.x, D, 0);
            pg8::EpiOut E{(bf16_t*)(ws + (rep_ ? WS_O2 : WS_X)), layer == 0 ? (const void*)args.in[I_X] : (const void*)(ws + WS_X), layer == 0 ? (const void*)args.in[I_CTX] : (const void*)(ws + WS_X), layer == 0, (const float*)(ws + WS_MOD) + (size_t)layer * 5 * 6 * D, 1.f / W8_SCALE};
            pg8::gemm_phase<pg8::EpiOut, pg8::DenseOrder, true>(F.lds, ws + WS_MX, D, ws + WS_WOUT + (size_t)layer * D * D, D, D, S, E);
            if (rep_ == 0) { int rk, nn; idle_rank((Mr / 256) * 8, F.G, (int)blockIdx.x, rk, nn); convert_range(F, args, layer + 1, 36000, 52000, rk, nn); }
        } }
        SEAM(pb + 6);
        if (PHON(8) && IN(pb + 7)) { LAUNDER(); for (int rep_ = 0; rep_ < REPS(8); ++rep_) { if (rep_) { VM_WAIT(); __syncthreads(); } phase_norm2_router(F, args, layer, Mr, rep_ == 0); } }
        SEAM(pb + 7);
        if (PHON(9) && IN(pb + 8)) { LAUNDER(); for (int rep_ = 0; rep_ < REPS(9); ++rep_) { if (rep_) { VM_WAIT(); __syncthreads(); }
            const int nblk = moe_tables(F, layer);
            pg8::MoeOrder<true> S; S.nN = 4; S.nunits = nblk * 4; S.G = F.G; S.c = (int)blockIdx.x; S.lda_b = D; S.tbl = (const LAS int*)(F.lds + LDS_MISC + 64);
            S.slottok = (const int*)(ws + WS_SLOTTOK); S.b_estride = (size_t)1024 * D;
            pg8::EpiMoe1 E{(bf16_t*)(ws + WS_ACT)};
            pg8::gemm_phase<pg8::EpiMoe1, pg8::MoeOrder<true>, true>(F.lds, ws + WS_H, D, ws + WS_WE13 + (size_t)layer * NEXP * 1024 * D, D, D, S, E);
            if (rep_ == 0) { int rk, nn; idle_rank(nblk * 4, F.G, (int)blockIdx.x, rk, nn); convert_range(F, args, layer + 1, 52000, 70000, rk, nn); }
        } }
        SEAM(pb + 8);
        if (PHON(10) && IN(pb + 9)) { LAUNDER(); for (int rep_ = 0; rep_ < REPS(10); ++rep_) { if (rep_) { VM_WAIT(); __syncthreads(); }
            const int nblk = moe_tables(F, layer);
            pg8::MoeOrder<false> S; S.nN = 8; S.nunits = nblk * 8; S.G = F.G; S.c = (int)blockIdx.x; S.lda_b = DEXP; S.tbl = (const LAS int*)(F.lds + LDS_MISC + 64);
            S.slottok = nullptr; S.b_estride = (size_t)D * DEXP;
            pg8::EpiY8 E{ws + WS_Y2, D, Y8_SCALE / (W8_SCALE * ACT8_SCALE)};
            pg8::gemm_phase<pg8::EpiY8, pg8::MoeOrder<false>, true>(F.lds, ws + WS_ACT, DEXP, ws + WS_WE2 + (size_t)layer * NEXP * D * DEXP, DEXP, DEXP, S, E);
            if (rep_ == 0) { int rk, nn; idle_rank(nblk * 8, F.G, (int)blockIdx.x, rk, nn); convert_range(F, args, layer + 1, 70000, CONV_ITEMS, rk, nn); }
        } }
        SEAM(pb + 9);
    }
    if (PHON(11) && IN(N_PHASES - 1)) { LAUNDER(); for (int rep_ = 0; rep_ < REPS(11); ++rep_) { if (rep_) { VM_WAIT(); __syncthreads(); } phase_final(F, args); } }
#undef IN
#undef SEAM
}

extern "C" void kernel_launch(void* const* d_in, const int* in_sizes, int n_in, void* d_out, int out_size, void* d_ws, size_t ws_size, hipStream_t stream) {
    static int grid = 0;
    if (grid == 0) {
        if (n_in != 22 || out_size != NLAT * D || ws_size < WS_END) { fprintf(stderr, "kernel_launch: unexpected shapes (n_in %d out %d ws %zu need %zu)\n", n_in, out_size, ws_size, (size_t)WS_END); grid = -1; return; }
        int dev = 0, cus = 0, per_cu = 0;
        if (hipGetDevice(&dev) != hipSuccess || hipDeviceGetAttribute(&cus, hipDeviceAttributeMultiprocessorCount, dev) != hipSuccess) { grid = -1; return; }
        if (hipFuncSetAttribute((const void*)mk_fwd, hipFuncAttributeMaxDynamicSharedMemorySize, LDS_BYTES) != hipSuccess) { fprintf(stderr, "kernel_launch: hipFuncSetAttribute failed\n"); grid = -1; return; }
        if (hipOccupancyMaxActiveBlocksPerMultiprocessor(&per_cu, (const void*)mk_fwd, 512, LDS_BYTES) != hipSuccess || per_cu < 1) fprintf(stderr, "kernel_launch: occupancy query says %d\n", per_cu);
        (void)hipGetLastError();
        grid = cus;
    }
    if (grid < 0) return;
    (void)hipMemsetAsync((char*)d_ws + WS_CTL, 0, CTL_BYTES, stream);
    Args a{};
    for (int i = 0; i < 22; ++i) a.in[i] = (const float*)d_in[i];
    a.out = (float*)d_out; a.ws = (unsigned char*)d_ws; a.rep = MK_REPMASK; a.pad = 0;
#if MK_ONE_LAUNCH
    a.ph_lo = 0; a.ph_hi = N_PHASES;
    hipLaunchKernelGGL(mk_fwd, dim3(grid), dim3(512), LDS_BYTES, stream, a);
#else
    for (int p = 0; p < N_PHASES; ++p) { a.ph_lo = p; a.ph_hi = p + 1; hipLaunchKernelGGL(mk_fwd, dim3(grid), dim3(512), LDS_BYTES, stream, a); }
#endif
}
```

```cpp
#include <hip/hip_runtime.h>
#include <cstdio>
#include <cstdint>

#ifndef MK_ONE_LAUNCH
#define MK_ONE_LAUNCH 1
#endif

constexpr int D = 2048, NBATCH = 4, SEQ = 4096, DEPTH = 4, CTXL = 256;
constexpr int NLAT = NBATCH * SEQ, NCTX = NBATCH * CTXL, MTOK = NLAT + NCTX;
constexpr int DPOOL = 1024, HGW = 1024, NHEAD = 8, HDK = 128;
constexpr int INC = 10240;
constexpr int NEXP = 16, DEXP = 512;
constexpr int MAXSLOT = 38912;
constexpr float EPS = 1e-6f;
constexpr int ZC_POOL = 0, ZC_Q = 1024, ZC_FF = 2048, ZC_FB = 3072, ZC_I = 4096, ZC_OG = 5120, ZC_GP = 6144, ZC_GH = 8192;

#define GAS __attribute__((address_space(1)))
#define LAS __attribute__((address_space(3)))
typedef unsigned short bf16_t;
typedef short bf16x8 __attribute__((ext_vector_type(8)));
typedef float f32x4 __attribute__((ext_vector_type(4)));
typedef float f32x2 __attribute__((ext_vector_type(2)));
typedef unsigned u32x4 __attribute__((ext_vector_type(4)));
typedef unsigned u32x2 __attribute__((ext_vector_type(2)));
typedef int i32x4 __attribute__((ext_vector_type(4)));
typedef int i32x8 __attribute__((ext_vector_type(8)));
constexpr float W8_SCALE = 32.f;

constexpr size_t MiB = 1u << 20;
constexpr size_t align_up(size_t x) { return (x + 255) & ~(size_t)255; }
constexpr size_t WS_CTL = 0, CTL_BYTES = 1 * MiB;
constexpr size_t WS_MOD = WS_CTL + CTL_BYTES;
constexpr size_t WS_LB = WS_MOD + align_up((size_t)DEPTH * 5 * 6 * D * 4);
constexpr size_t WS_ROUTE_I = WS_LB + align_up((size_t)DEPTH * 2 * 1024 * 4);
constexpr size_t WS_ROUTE_G = WS_ROUTE_I + align_up((size_t)MTOK * 8);
constexpr size_t WS_SLOTTOK = WS_ROUTE_G + align_up((size_t)MTOK * 8);
constexpr size_t WS_PADBASE = WS_SLOTTOK + align_up((size_t)NEXP * MTOK * 4);
constexpr size_t WS_WIN = WS_PADBASE + align_up((size_t)DEPTH * 16 * 4);
constexpr size_t WS_WPG = WS_WIN + (size_t)DEPTH * INC * D * 2;
constexpr size_t WS_WBP = WS_WPG + (size_t)DEPTH * 1024 * 256 * 2;
constexpr size_t WS_WBH = WS_WBP + (size_t)DEPTH * D * 1024 * 2;
constexpr size_t WS_WOUT = WS_WBH + (size_t)DEPTH * D * 1024 * 2;
constexpr size_t WS_WE13 = WS_WOUT + (size_t)DEPTH * D * D * 2;
constexpr size_t WS_WE2 = WS_WE13 + (size_t)DEPTH * NEXP * 1024 * D * 2;
constexpr size_t WS_X = WS_WE2 + (size_t)DEPTH * NEXP * D * DEXP * 2;
constexpr size_t WS_H = WS_X + (size_t)MTOK * D * 4;
constexpr size_t WS_Z = WS_H + (size_t)MTOK * D * 2;
constexpr size_t WS_ACT = WS_Z;
constexpr size_t WS_Y2 = WS_ACT + (size_t)MAXSLOT * DEXP * 2;
constexpr size_t WS_PD = WS_Z + (size_t)MTOK * INC * 2;
constexpr size_t WS_P = WS_PD + (size_t)MTOK * 1024 * 2;
constexpr size_t WS_HG = WS_P + (size_t)MTOK * 1024 * 2;
constexpr size_t WS_O2 = WS_HG + (size_t)MTOK * 1024 * 2;
constexpr size_t WS_QSG = WS_O2 + (size_t)2 * MTOK * 1024 * 2;
constexpr size_t WS_SMID = WS_QSG + (size_t)64 * 3 * 17 * 17408;
constexpr size_t WS_CORRV = WS_SMID + (size_t)64 * 3 * 128 * 128 * 4;
constexpr size_t WS_TOTSEG = WS_CORRV + (size_t)64 * 3 * 17 * 128 * 4;
static_assert(WS_TOTSEG + (size_t)64 * 4 * 128 * 4 <= WS_O2 + (size_t)2 * MTOK * 1024 * 4, "scan hand-off buffers fit in the O2 region");
constexpr size_t WS_M1 = WS_O2 + (size_t)2 * MTOK * 1024 * 4;
constexpr size_t WS_MX = WS_M1 + (size_t)MTOK * D * 2;
constexpr size_t WS_G8 = WS_M1;
constexpr size_t WS_END = WS_MX + (size_t)MTOK * D * 2;
static_assert(WS_Y2 + (size_t)MAXSLOT * D * 2 <= WS_PD, "ACT|Y2 overlay fits in Z");

constexpr int CW_BAR = 4096;
constexpr int CW_CNT = 16384;

constexpr int LDS_STAGE = 131072;
constexpr int LDS_MISC = 149504;
constexpr int LDS_BYTES = LDS_MISC + 8192;

__device__ __forceinline__ unsigned f2bf(float f) { unsigned u = __builtin_bit_cast(unsigned, f); return (u + 0x7fffu + ((u >> 16) & 1u)) >> 16; }
typedef __bf16 bf16x2_t __attribute__((ext_vector_type(2)));
__device__ __forceinline__ unsigned pk2(float lo, float hi) { const f32x2 v = {lo, hi}; const bf16x2_t b = __builtin_convertvector(v, bf16x2_t); return __builtin_bit_cast(unsigned, b); }
__device__ __forceinline__ float bflo(unsigned w) { return __builtin_bit_cast(float, w << 16); }
__device__ __forceinline__ float bfhi(unsigned w) { return __builtin_bit_cast(float, w & 0xffff0000u); }
__device__ __forceinline__ float bf1(bf16_t h) { return __builtin_bit_cast(float, ((unsigned)h) << 16); }
__device__ __forceinline__ float fsigmoid(float x) { return __builtin_amdgcn_rcpf(1.f + __builtin_amdgcn_exp2f(-1.44269504f * x)); }
__device__ __forceinline__ float fsilu(float x) { return x * fsigmoid(x); }
__device__ __forceinline__ float lane_xor(float v, int o, int lane) { return __builtin_bit_cast(float, __builtin_amdgcn_ds_bpermute((lane ^ o) << 2, __builtin_bit_cast(int, v))); }
#define LDS_WAIT() asm volatile("s_waitcnt lgkmcnt(0)" ::: "memory")
#define VM_WAIT() asm volatile("s_waitcnt vmcnt(0)" ::: "memory")

__device__ __forceinline__ unsigned pk4_fp8(float a, float b, float c, float d) { int w = 0; w = __builtin_amdgcn_cvt_pk_fp8_f32(a, b, w, false); w = __builtin_amdgcn_cvt_pk_fp8_f32(c, d, w, true); return (unsigned)w; }
constexpr float Y8_SCALE = 16.f;
constexpr float HG8_SCALE = 4.f, ACT8_SCALE = 4.f;
#define XB_TMO      128
#define XB_XCNT(j)  (256  + 64 * (j))
#define XB_XSUB(j)  (1280 + 64 * (j))
#define XB_XGEN(j)  (2304 + 64 * (j))
#define XB_TOP      3328
#define XB_TOPGEN   3392
#define XCD_BAR_WORDS 3456
#define XB_SPIN_CAP (1u << 18)
__device__ __forceinline__ unsigned xb_ld(unsigned* p)              { return __hip_atomic_load(p, __ATOMIC_RELAXED, __HIP_MEMORY_SCOPE_AGENT); }
__device__ __forceinline__ unsigned xb_add(unsigned* p, unsigned v) { return __hip_atomic_fetch_add(p, v, __ATOMIC_RELAXED, __HIP_MEMORY_SCOPE_AGENT); }
__device__ __forceinline__ unsigned xb_xcc_id() { return (unsigned)__builtin_amdgcn_s_getreg((3 << 11) | 20) & 0xFu; }
#define XB_SPIN(cond, bar) do { unsigned _sp = 0; while (cond) { __builtin_amdgcn_s_sleep(1); \
    if ((++_sp & 255u) == 0u) { if (xb_ld(&(bar)[XB_TMO])) break; if (_sp > XB_SPIN_CAP) { atomicAdd(&(bar)[XB_TMO], 1u); break; } } } } while (0)
struct XcdBarrier { unsigned* bar; unsigned x; volatile LAS unsigned* st; };
__device__ __forceinline__ XcdBarrier xcd_barrier_post(unsigned* bar, volatile LAS unsigned* st) {
    XcdBarrier b; b.bar = bar; b.x = xb_xcc_id(); b.st = st;
    if (threadIdx.x == 0) (void)xb_add(&bar[XB_XCNT(b.x)], 1u);
    return b;
}
__device__ __forceinline__ void xcd_barrier_complete(unsigned* bar, unsigned x, unsigned& nloc, unsigned& nx) {
    const unsigned G = gridDim.x * gridDim.y * gridDim.z;
    unsigned sum, cnt, mine, sp = 0u;
    for (;;) {
        sum = 0u; cnt = 0u; mine = 0u;
        unsigned cv[16];
#pragma unroll
        for (unsigned j = 0; j < 16; ++j) cv[j] = xb_ld(&bar[XB_XCNT(j)]);
#pragma unroll
        for (unsigned j = 0; j < 16; ++j) { const unsigned c = cv[j]; sum += c; cnt += (c > 0u) ? 1u : 0u; mine = (j == x) ? c : mine; }
        if (sum == G) break;
        __builtin_amdgcn_s_sleep(1);
        if ((++sp & 255u) == 0u) { if (xb_ld(&bar[XB_TMO])) break; if (sp > XB_SPIN_CAP) { atomicAdd(&bar[XB_TMO], 1u); break; } }
    }
    nloc = mine > 0u ? mine : 1u; nx = cnt > 0u ? cnt : 1u;
}
__device__ __forceinline__ void xcd_barrier(const XcdBarrier& b) {
    asm volatile("s_waitcnt vmcnt(0)" ::: "memory");
    __syncthreads();
    if (threadIdx.x == 0) {
        unsigned* bar = b.bar;
        __builtin_amdgcn_s_waitcnt(0);
        unsigned nloc = b.st[0], nx = b.st[1];
        if (nloc == 0u) { xcd_barrier_complete(bar, b.x, nloc, nx); b.st[0] = nloc; b.st[1] = nx; }
        const unsigned old = xb_add(&bar[XB_XSUB(b.x)], 1u);
        const unsigned gen = old / nloc;
        if (old + 1u == (gen + 1u) * nloc) {
            __builtin_amdgcn_fence(__ATOMIC_RELEASE, "agent");
            asm volatile("s_waitcnt vmcnt(0)" ::: "memory");
            const unsigned og = xb_add(&bar[XB_TOP], 1u);
            const unsigned tg = og / nx;
            if (og + 1u == (tg + 1u) * nx) xb_add(&bar[XB_TOPGEN], 1u);
            else XB_SPIN(xb_ld(&bar[XB_TOPGEN]) == tg, bar);
            __builtin_amdgcn_fence(__ATOMIC_ACQUIRE, "agent");
            xb_add(&bar[XB_XGEN(b.x)], 1u);
            asm volatile("s_waitcnt vmcnt(0)" ::: "memory");
        } else {
            XB_SPIN(xb_ld(&bar[XB_XGEN(b.x)]) == gen, bar);
            __builtin_amdgcn_fence(__ATOMIC_ACQUIRE, "agent");
            asm volatile("s_waitcnt vmcnt(0)" ::: "memory");
        }
    }
    __syncthreads();
}

namespace pg8 {
constexpr int BM = 256, BK = 64, HALF = 128, HTB = HALF * BK * 2, NXCD = 8, WGM = 8;
__host__ __device__ __forceinline__ int lds_byte(int r, int c) { const int st = (r >> 4) * 2 + (c >> 5), rr = r & 15, cc = c & 31, ob = rr * 64 + cc * 2; return st * 1024 + (ob ^ (((ob >> 9) & 1) << 5)); }
__host__ __device__ __forceinline__ void stage_rc(int b, int& R, int& C) { const int st = b / 1024, sb = b % 1024, swz = sb ^ (((sb >> 9) & 1) << 5); R = (st >> 1) * 16 + swz / 64; C = (st & 1) * 32 + (swz % 64) / 2; }
__host__ __device__ __forceinline__ int perm32(int rho) { const int n = rho >> 4, i = rho & 15; return 8 * (i >> 2) + 4 * n + (i & 3); }

struct Unit { int pm, pn; };

struct DenseOrder {
    static constexpr bool GATHER = false;
    int nM, nN, nwg, G, c, lda_b, acol_b;
    __device__ void init(int M, int N, int G_, int c_, int lda_b_, int acol_b_) { nM = M / BM; nN = N / BM; nwg = nM * nN; G = G_; c = c_; lda_b = lda_b_; acol_b = acol_b_; }
    __device__ __forceinline__ bool next(int i, Unit& u) const {
        const long L = (long)i * G + c; if (L >= nwg) return false;
        int wgid = (int)L; { const int q = nwg / NXCD, r = nwg % NXCD, xcd = wgid % NXCD, off = wgid / NXCD; wgid = (xcd < r ? xcd * (q + 1) : r * (q + 1) + (xcd - r) * q) + off; }
        const int nig = WGM * nN, gid = wgid / nig, fm = gid * WGM, gsz = (nM - fm) < WGM ? (nM - fm) : WGM;
        u.pm = fm + ((wgid % nig) % gsz); u.pn = (wgid % nig) / gsz; return true;
    }
    __device__ __forceinline__ size_t a_base(const Unit& u) const { return (size_t)u.pm * BM * lda_b + (size_t)u.pn * acol_b; }
    __device__ __forceinline__ void a_offs(const Unit&, unsigned (&)[2][2]) const {}
    __device__ __forceinline__ size_t b_off(const Unit& u, int ldb_b) const { return (size_t)u.pn * BM * ldb_b; }
};
template <bool GATHER_> struct MoeOrder {
    static constexpr bool GATHER = GATHER_;
    int nN, nunits, G, c, lda_b; const LAS int* tbl;
    const int* slottok; size_t b_estride;
    __device__ __forceinline__ bool next(int i, Unit& u) const {
        const int L = i * G + c; if (L >= nunits) return false;
        u.pm = L / nN; u.pn = L % nN; return true;
    }
    __device__ __forceinline__ size_t a_base(const Unit& u) const { return (size_t)u.pm * BM * lda_b; }
    __device__ __forceinline__ void a_offs(const Unit& u, unsigned (&v)[2][2]) const {
        const int e = __builtin_amdgcn_readfirstlane(tbl[64 + u.pm]), j0 = __builtin_amdgcn_readfirstlane((u.pm - tbl[16 + e]) * BM), cnt = __builtin_amdgcn_readfirstlane(tbl[e]);
        int tk[2][2];
#pragma unroll
        for (int i = 0; i < 2; ++i) { int R, C; stage_rc((int)threadIdx.x * 16 + i * 8192, R, C);
#pragma unroll
            for (int h = 0; h < 2; ++h) { const int j = j0 + h * HALF + R; tk[h][i] = slottok[(size_t)e * MTOK + min(j, max(cnt - 1, 0))]; } }
#pragma unroll
        for (int i = 0; i < 2; ++i) { int R, C; stage_rc((int)threadIdx.x * 16 + i * 8192, R, C);
#pragma unroll
            for (int h = 0; h < 2; ++h) { const int j = j0 + h * HALF + R; const int tok = (j < cnt) ? tk[h][i] : 0; v[h][i] = (unsigned)(tok * lda_b + C * 2); } }
    }
    __device__ __forceinline__ size_t b_off(const Unit& u, int ldb_b) const { const int e = __builtin_amdgcn_readfirstlane(tbl[64 + u.pm]); return (size_t)e * b_estride + (size_t)u.pn * BM * ldb_b; }
};

template <class Epi, class Sched, bool FP8 = false, bool SPLIT = false>
__device__ __forceinline__ void gemm_phase(LAS unsigned char* lds, const void* Abase, const int lda_b, const void* Bbase, const int Kb, const int ldb_b, const Sched& S, const Epi& E, const long dA = 0, const long dB = 0, const int nt1 = 0) {
    constexpr bool GA = Sched::GATHER;
    int tid_ = threadIdx.x; asm volatile("" : "+v"(tid_));
    const int tid = tid_, wid = __builtin_amdgcn_readfirstlane(tid >> 6), lane = tid & 63, wr = wid >> 2, wc = wid & 3, fr = lane & 15, fq = lane >> 4;
    const int nt = Kb / 128;
    unsigned voffA[2], voffB[2];
#pragma unroll
    for (int i = 0; i < 2; ++i) { int R, C; stage_rc(tid * 16 + i * 8192, R, C); const int Rb = Epi::PERM ? ((R & ~31) + perm32(R & 31)) : R; voffA[i] = (unsigned)(R * lda_b + C * 2); voffB[i] = (unsigned)(Rb * ldb_b + C * 2); }
    const size_t kstep = (size_t)(BK * 2);
    const size_t hstepA = (size_t)HALF * lda_b, hstepB = (size_t)HALF * ldb_b;
    const unsigned ldsw = (unsigned)wid * 1024u;
    const int aoff = lds_byte(wr * 64 + fr, fq * 8), boff = lds_byte(wc * 32 + fr, fq * 8);
#define PG8_SA(b, h) (((b) * 2 + (h)) * HTB)
#define PG8_SB(b, h) ((4 + (b) * 2 + (h)) * HTB)
#define PG8_STAGE2(bufoff, gbase, o0, o1) do { \
        __builtin_amdgcn_global_load_lds((const unsigned*)((const char*)(gbase) + (o0)), (LAS unsigned*)(lds + (bufoff) + ldsw), 16, 0, 0); \
        __builtin_amdgcn_global_load_lds((const unsigned*)((const char*)(gbase) + (o1)), (LAS unsigned*)(lds + (bufoff) + ldsw + 8192), 16, 0, 0); } while (0)
#define PG8_STAGEB(bufoff, gbase) PG8_STAGE2(bufoff, gbase, voffB[0], voffB[1])
#define PG8_STAGEA(bufoff, gbase, h, x0, x1) do { if constexpr (GA) PG8_STAGE2(bufoff, gbase, x0, x1); else PG8_STAGE2(bufoff, (gbase) + ((h) ? hstepA : (size_t)0), voffA[0], voffA[1]); } while (0)
#define PG8_LD32(dst, addr) do { const i32x4 lo_ = *(const LAS i32x4*)(lds + (addr)), hi_ = *(const LAS i32x4*)(lds + (addr) + 1024); dst = (i32x8){lo_[0], lo_[1], lo_[2], lo_[3], hi_[0], hi_[1], hi_[2], hi_[3]}; } while (0)
#define PG8_LDA(dst, b, h) do { _Pragma("unroll") for (int m = 0; m < 4; ++m) PG8_LD32(dst[m], PG8_SA(b, h) + aoff + m * 2048); } while (0)
#define PG8_LDB(dst, b, h) do { _Pragma("unroll") for (int n = 0; n < 2; ++n) PG8_LD32(dst[n], PG8_SB(b, h) + boff + n * 2048); } while (0)
#define PG8_HALF(v, k) __builtin_bit_cast(bf16x8, (i32x4){(v)[4 * (k)], (v)[4 * (k) + 1], (v)[4 * (k) + 2], (v)[4 * (k) + 3]})
#define PG8_MMA(ai, bj, At, Bt) do { __builtin_amdgcn_s_setprio(1); \
        if constexpr (FP8) { _Pragma("unroll") for (int m = 0; m < 4; ++m) _Pragma("unroll") for (int n = 0; n < 2; ++n) \
            asm volatile("v_mfma_scale_f32_16x16x128_f8f6f4 %0, %1, %2, %0, %3, %3 op_sel_hi:[0,0,0]" : "+v"(acc[ai][bj][m][n]) : "v"(Bt[n]), "v"(At[m]), "v"(one_scale)); } \
        else { _Pragma("unroll") for (int m = 0; m < 4; ++m) _Pragma("unroll") for (int n = 0; n < 2; ++n) _Pragma("unroll") for (int k = 0; k < 2; ++k) \
            acc[ai][bj][m][n] = __builtin_amdgcn_mfma_f32_16x16x32_bf16(PG8_HALF(Bt[n], k), PG8_HALF(At[m], k), acc[ai][bj][m][n], 0, 0, 0); } \
        __builtin_amdgcn_s_setprio(0); } while (0)
#define PG8_WAIT_V(n) asm volatile("s_waitcnt vmcnt(" #n ")" ::: "memory")
#define PG8_WAIT_L(n) asm volatile("s_waitcnt lgkmcnt(" #n ")" ::: "memory")
#define PG8_BAR __builtin_amdgcn_s_barrier()
#define PG8_SCHED __builtin_amdgcn_sched_barrier(0)
    Unit cur, nxt; int ui = 0;
    if (!S.next(0, cur)) return;
    f32x4 acc[2][2][4][2];
#pragma unroll
    for (int a = 0; a < 2; ++a)
#pragma unroll
        for (int b = 0; b < 2; ++b)
#pragma unroll
            for (int m = 0; m < 4; ++m)
#pragma unroll
                for (int n = 0; n < 2; ++n) acc[a][b][m][n] = (f32x4){0.f, 0.f, 0.f, 0.f};
    int one_scale = 0; if constexpr (FP8) asm volatile("v_mov_b32 %0, 0x7f7f7f7f" : "=v"(one_scale));
    i32x8 At[4], B0[2], B1[2];
    unsigned vA[2][2];
    if constexpr (GA) S.a_offs(cur, vA);
    const char* cA = (const char*)Abase + (GA ? (size_t)0 : S.a_base(cur));
    const char* cB = (const char*)Bbase + S.b_off(cur, ldb_b);
    PG8_STAGEB(PG8_SB(0, 0), cB); PG8_STAGEB(PG8_SB(0, 1), cB + hstepB); PG8_STAGEA(PG8_SA(0, 0), cA, 0, vA[0][0], vA[0][1]); PG8_STAGEA(PG8_SA(0, 1), cA, 1, vA[1][0], vA[1][1]);
    if (wr == 1) PG8_BAR;
    PG8_WAIT_V(2); PG8_BAR;
    PG8_STAGEB(PG8_SB(1, 0), cB + kstep); PG8_STAGEA(PG8_SA(1, 0), cA + kstep, 0, vA[0][0], vA[0][1]); PG8_STAGEB(PG8_SB(1, 1), cB + hstepB + kstep);
    PG8_WAIT_V(6); PG8_BAR;
    for (;;) {
        const bool has_next = S.next(ui + 1, nxt);
        const char* nA = (has_next && !GA) ? (const char*)Abase + S.a_base(nxt) : cA;
        const char* nB = has_next ? (const char*)Bbase + S.b_off(nxt, ldb_b) : cB;
_Pragma("nounroll")
        for (int t = 0; t < nt; t += 2) {
            const bool last = (t == nt - 2);
            const long sA1 = (SPLIT && t >= nt1) ? dA : 0, sA2 = (SPLIT && t + 2 >= nt1) ? dA : 0, sB2 = (SPLIT && t + 2 >= nt1) ? dB : 0;
            if constexpr (SPLIT) { if (t == nt1) { asm volatile("s_nop 15\n\ts_nop 15" ::: "memory"); int t3_ = threadIdx.x; asm volatile("" : "+v"(t3_)); const int l3_ = t3_ & 63; E.mid(acc, cur, wr, wc, l3_ & 15, l3_ >> 4); } }
            const char* a1 = cA + (size_t)(t + 1) * kstep + sA1;
            const char* a2 = last ? nA : cA + (size_t)(t + 2) * kstep + sA2; const char* b2 = last ? nB : cB + (size_t)(t + 2) * kstep + sB2;
            const char* a3 = a2 + kstep; const char* b3 = b2 + kstep;
            PG8_LDB(B0, 0, 0); PG8_LDB(B1, 0, 1); PG8_SCHED; PG8_LDA(At, 0, 0); PG8_STAGEA(PG8_SA(1, 1), a1, 1, vA[1][0], vA[1][1]);
            PG8_WAIT_V(8); PG8_WAIT_L(0); PG8_BAR; PG8_MMA(0, 0, At, B0); PG8_MMA(0, 1, At, B1); PG8_BAR; PG8_SCHED;
            if constexpr (GA) { if (last && has_next) S.a_offs(nxt, vA); }
            PG8_LDA(At, 0, 1); PG8_STAGEB(PG8_SB(0, 0), b2); PG8_STAGEB(PG8_SB(0, 1), b2 + hstepB); PG8_STAGEA(PG8_SA(0, 0), a2, 0, vA[0][0], vA[0][1]);
            PG8_WAIT_V(8); PG8_WAIT_L(0); PG8_BAR; PG8_MMA(1, 0, At, B0); PG8_MMA(1, 1, At, B1); PG8_BAR; PG8_SCHED;
            PG8_LDB(B0, 1, 0); PG8_LDB(B1, 1, 1); PG8_SCHED; PG8_LDA(At, 1, 0); PG8_STAGEA(PG8_SA(0, 1), a2, 1, vA[1][0], vA[1][1]);
            PG8_WAIT_V(8); PG8_WAIT_L(0); PG8_BAR; PG8_MMA(0, 0, At, B0); PG8_MMA(0, 1, At, B1); PG8_BAR; PG8_SCHED;
            PG8_LDA(At, 1, 1); PG8_STAGEB(PG8_SB(1, 0), b3); PG8_STAGEB(PG8_SB(1, 1), b3 + hstepB); PG8_STAGEA(PG8_SA(1, 0), a3, 0, vA[0][0], vA[0][1]);
            PG8_WAIT_V(8); PG8_WAIT_L(0); PG8_BAR; PG8_MMA(1, 0, At, B0); PG8_MMA(1, 1, At, B1); PG8_BAR; PG8_SCHED;
        }
        if constexpr (FP8) asm volatile("s_nop 15\n\ts_nop 15" ::: "memory");
        if (wr == 0) PG8_BAR;
        { int t2_ = threadIdx.x; asm volatile("" : "+v"(t2_)); const int l2_ = t2_ & 63; E(acc, cur, wr, wc, l2_ & 15, l2_ >> 4); }
        if (!has_next) break;
#pragma unroll
        for (int a = 0; a < 2; ++a)
#pragma unroll
            for (int b = 0; b < 2; ++b)
#pragma unroll
                for (int m = 0; m < 4; ++m)
#pragma unroll
                    for (int n = 0; n < 2; ++n) acc[a][b][m][n] = (f32x4){0.f, 0.f, 0.f, 0.f};
        cur = nxt; cA = nA; cB = nB; ++ui;
        if (wr == 1) PG8_BAR;
    }
    PG8_WAIT_V(0);
    PG8_BAR;
#undef PG8_SA
#undef PG8_SB
#undef PG8_STAGE2
#undef PG8_STAGEB
#undef PG8_STAGEA
#undef PG8_LDA
#undef PG8_LD32
#undef PG8_HALF
#undef PG8_LDB
#undef PG8_MMA
#undef PG8_WAIT_V
#undef PG8_WAIT_L
#undef PG8_BAR
#undef PG8_SCHED
}

typedef const f32x4 (&AccRef)[2][2][4][2];
__device__ __forceinline__ u32x4 pack8(const f32x4 v0, const f32x4 v1) { u32x4 w; w.x = pk2(v0[0], v0[1]); w.y = pk2(v0[2], v0[3]); w.z = pk2(v1[0], v1[1]); w.w = pk2(v1[2], v1[3]); return w; }
__device__ __forceinline__ void unpack8(const u32x4 w, f32x4& v0, f32x4& v1) { v0 = (f32x4){bflo(w.x), bfhi(w.x), bflo(w.y), bfhi(w.y)}; v1 = (f32x4){bflo(w.z), bfhi(w.z), bflo(w.w), bfhi(w.w)}; }

struct EpiIn {
    static constexpr bool PERM = true;
    bf16_t* Z; const float* lb; unsigned char* G8;
    __device__ __forceinline__ void operator()(AccRef acc, const Unit& u, int wr, int wc, int fr, int fq) const {
        constexpr float KS = 1.f / W8_SCALE, KE = -1.44269504f / W8_SCALE;
        const int row0 = u.pm * BM + wr * 64 + fr, colt = u.pn * BM, seg = colt >> 10, col0 = colt + wc * 32 + 8 * fq;
        const int mode = (seg == 0 || seg == 4) ? 0 : (seg == 1 || seg == 5) ? 1 : (seg == 2 || seg == 3) ? 2 : 3;
#pragma unroll
        for (int bj = 0; bj < 2; ++bj) {
            f32x4 l0 = (f32x4){0.f, 0.f, 0.f, 0.f}, l1 = l0;
            if (mode == 2) { l0 = *(const f32x4*)(lb + (col0 + bj * HALF - ZC_FF)); l1 = *(const f32x4*)(lb + (col0 + bj * HALF + 4 - ZC_FF)); }
#pragma unroll
            for (int ai = 0; ai < 2; ++ai)
#pragma unroll
                for (int m = 0; m < 4; ++m) { bf16_t* rowp = Z + (size_t)(row0 + ai * HALF + m * 16) * INC + col0 + bj * HALF;
                    f32x4 v0 = acc[ai][bj][m][0], v1 = acc[ai][bj][m][1];
                    if (mode == 0) { v0 = v0 * KS; v1 = v1 * KS; }
                    else { f32x4 s0, s1;
#pragma unroll
                        for (int j = 0; j < 4; ++j) { s0[j] = __builtin_amdgcn_rcpf(1.f + __builtin_amdgcn_exp2f(v0[j] * KE)); s1[j] = __builtin_amdgcn_rcpf(1.f + __builtin_amdgcn_exp2f(v1[j] * KE)); }
                        if (mode == 1) { v0 = v0 * KS * s0; v1 = v1 * KS * s1; }
                        else if (mode == 3) { unsigned w0 = 0u, w1 = 0u;
#pragma unroll
                            for (int j = 0; j < 4; ++j) { w0 = __builtin_amdgcn_cvt_pk_u8_f32(fmaxf(__builtin_rintf(s0[j] * 255.f), 1.f), j, w0); w1 = __builtin_amdgcn_cvt_pk_u8_f32(fmaxf(__builtin_rintf(s1[j] * 255.f), 1.f), j, w1); }
                            u32x2 o; o.x = w0; o.y = w1; *(u32x2*)(G8 + (size_t)(row0 + ai * HALF + m * 16) * 4096 + (col0 + bj * HALF - ZC_GP)) = o;
                            __builtin_amdgcn_sched_barrier(0); continue; }
                        else {
#pragma unroll
                            for (int j = 0; j < 4; ++j) { v0[j] = __builtin_amdgcn_logf(l0[j] + (1.f - l0[j]) * s0[j]); v1[j] = __builtin_amdgcn_logf(l1[j] + (1.f - l1[j]) * s1[j]); } } }
                    *(u32x4*)rowp = pack8(v0, v1);
                    __builtin_amdgcn_sched_barrier(0); } }
    }
};
struct EpiPool {
    static constexpr bool PERM = true;
    bf16_t* P; const float* scale;
    __device__ __forceinline__ void operator()(AccRef acc, const Unit& u, int wr, int wc, int fr, int fq) const {
        const int row0 = u.pm * BM + wr * 64 + fr, col0 = u.pn * BM + wc * 32 + 8 * fq;
        f32x4 sv[2][2];
#pragma unroll
        for (int bj = 0; bj < 2; ++bj)
#pragma unroll
            for (int n = 0; n < 2; ++n) sv[bj][n] = *(const f32x4*)(scale + col0 + bj * HALF + 4 * n);
#pragma unroll
        for (int ai = 0; ai < 2; ++ai)
#pragma unroll
            for (int m = 0; m < 4; ++m) { bf16_t* rowp = P + (size_t)(row0 + ai * HALF + m * 16) * DPOOL + col0;
#pragma unroll
                for (int bj = 0; bj < 2; ++bj) { const f32x4 r0 = acc[ai][bj][m][0] * sv[bj][0], r1 = acc[ai][bj][m][1] * sv[bj][1];
                    u32x2 o; o.x = pk4_fp8(r0[0], r0[1], r0[2], r0[3]); o.y = pk4_fp8(r1[0], r1[1], r1[2], r1[3]); *(u32x2*)((unsigned char*)P + (size_t)(row0 + ai * HALF + m * 16) * DPOOL + col0 + bj * HALF) = o; } }
    }
};
template <bool ADD, bool OUT8 = false> struct EpiGate {
    static constexpr bool PERM = true;
    bf16_t* O; const bf16_t* prev; const bf16_t* Z; int gcol; float ascale;
    __device__ __forceinline__ void operator()(AccRef acc, const Unit& u, int wr, int wc, int fr, int fq) const {
        const int row0 = u.pm * BM + wr * 64 + fr, col0 = u.pn * BM + wc * 32 + 8 * fq;
#pragma unroll
        for (int ai = 0; ai < 2; ++ai)
#pragma unroll
            for (int m = 0; m < 4; ++m) { const size_t row = (size_t)(row0 + ai * HALF + m * 16);
#pragma unroll
                for (int bj = 0; bj < 2; ++bj) {
                    const u32x4 gw = *(const u32x4*)(Z + row * INC + gcol + col0 + bj * HALF); f32x4 g0, g1; unpack8(gw, g0, g1);
                    f32x4 r0 = acc[ai][bj][m][0] * ascale * g0, r1 = acc[ai][bj][m][1] * ascale * g1;
                    if (ADD) { const u32x4 pw = *(const u32x4*)(prev + row * D + col0 + bj * HALF); f32x4 p0, p1; unpack8(pw, p0, p1); r0 += p0; r1 += p1; }
                    if (OUT8) { int w0 = 0, w1 = 0; w0 = __builtin_amdgcn_cvt_pk_fp8_f32(r0[0], r0[1], w0, false); w0 = __builtin_amdgcn_cvt_pk_fp8_f32(r0[2], r0[3], w0, true);
                        w1 = __builtin_amdgcn_cvt_pk_fp8_f32(r1[0], r1[1], w1, false); w1 = __builtin_amdgcn_cvt_pk_fp8_f32(r1[2], r1[3], w1, true);
                        u32x2 o; o.x = (unsigned)w0; o.y = (unsigned)w1; *(u32x2*)((unsigned char*)O + row * D + col0 + bj * HALF) = o; }
                    else *(u32x4*)(O + row * D + col0 + bj * HALF) = pack8(r0, r1); } }
    }
};
struct EpiGate2 {
    static constexpr bool PERM = true; static constexpr int NVM = 16;
    unsigned char* O; const unsigned char* G8; int gcol1, gcol2; float cratio, ascale;
    static __device__ __forceinline__ float ub(unsigned w, int j) { return (float)((w >> (8 * j)) & 0xffu); }
    __device__ __forceinline__ void mid(f32x4 (&acc)[2][2][4][2], const Unit& u, int wr, int wc, int fr, int fq) const {
        const int row0 = u.pm * BM + wr * 64 + fr, col0 = u.pn * BM + wc * 32 + 8 * fq;
#pragma unroll
        for (int ai = 0; ai < 2; ++ai) {
            u32x2 q1[4][2], q2[4][2];
#pragma unroll
            for (int m = 0; m < 4; ++m) { const unsigned char* gp = G8 + (size_t)(row0 + ai * HALF + m * 16) * 4096 + col0;
#pragma unroll
                for (int bj = 0; bj < 2; ++bj) { q1[m][bj] = *(const u32x2*)(gp + gcol1 + bj * HALF); q2[m][bj] = *(const u32x2*)(gp + gcol2 + bj * HALF); } }
            __builtin_amdgcn_sched_barrier(0);
#pragma unroll
            for (int m = 0; m < 4; ++m)
#pragma unroll
                for (int bj = 0; bj < 2; ++bj)
#pragma unroll
                    for (int j = 0; j < 4; ++j) { acc[ai][bj][m][0][j] *= cratio * ub(q1[m][bj].x, j) * __builtin_amdgcn_rcpf(ub(q2[m][bj].x, j)); acc[ai][bj][m][1][j] *= cratio * ub(q1[m][bj].y, j) * __builtin_amdgcn_rcpf(ub(q2[m][bj].y, j)); }
            __builtin_amdgcn_sched_barrier(0);
        }
    }
    __device__ __forceinline__ void operator()(AccRef acc, const Unit& u, int wr, int wc, int fr, int fq) const {
        const int row0 = u.pm * BM + wr * 64 + fr, col0 = u.pn * BM + wc * 32 + 8 * fq;
        u32x2 q2[2][4][2];
#pragma unroll
        for (int ai = 0; ai < 2; ++ai)
#pragma unroll
            for (int m = 0; m < 4; ++m) { const unsigned char* gp = G8 + (size_t)(row0 + ai * HALF + m * 16) * 4096 + gcol2 + col0;
#pragma unroll
                for (int bj = 0; bj < 2; ++bj) q2[ai][m][bj] = *(const u32x2*)(gp + bj * HALF); }
        __builtin_amdgcn_sched_barrier(0);
#pragma unroll
        for (int ai = 0; ai < 2; ++ai)
#pragma unroll
            for (int m = 0; m < 4; ++m) { const size_t row = (size_t)(row0 + ai * HALF + m * 16);
#pragma unroll
                for (int bj = 0; bj < 2; ++bj) {
                    f32x4 r0, r1;
#pragma unroll
                    for (int j = 0; j < 4; ++j) { r0[j] = acc[ai][bj][m][0][j] * ascale * ub(q2[ai][m][bj].x, j); r1[j] = acc[ai][bj][m][1][j] * ascale * ub(q2[ai][m][bj].y, j); }
                    u32x2 o; o.x = pk4_fp8(r0[0], r0[1], r0[2], r0[3]); o.y = pk4_fp8(r1[0], r1[1], r1[2], r1[3]);
                    *(u32x2*)(O + row * D + col0 + bj * HALF) = o; } }
    }
};
struct EpiOut {
    static constexpr bool PERM = true;
    bf16_t* X; const void* src_lat; const void* src_ctx; bool src_f32; const float* modl; float ascale;
    __device__ __forceinline__ void operator()(AccRef acc, const Unit& u, int wr, int wc, int fr, int fq) const {
        const int row0 = u.pm * BM + wr * 64 + fr, col0 = u.pn * BM + wc * 32 + 8 * fq;
        const int mrow = u.pm < 64 ? (u.pm >> 4) : 4;
        const float* g = modl + (size_t)mrow * 6 * D + 2 * D;
        const bool lat = u.pm < 64;
#pragma unroll
        for (int bj = 0; bj < 2; ++bj) { const int col = col0 + bj * HALF;
            const f32x4 g0 = *(const f32x4*)(g + col) * ascale, g1 = *(const f32x4*)(g + col + 4) * ascale;
            if (src_f32) {
#pragma unroll
                for (int ai = 0; ai < 2; ++ai) { f32x4 s0[4], s1[4];
#pragma unroll
                    for (int m = 0; m < 4; ++m) { const int row = row0 + ai * HALF + m * 16;
                        const float* sp = (lat ? (const float*)src_lat + (size_t)row * D : (const float*)src_ctx + (size_t)(row - NLAT) * D) + col; s0[m] = *(const f32x4*)sp; s1[m] = *(const f32x4*)(sp + 4); }
                    __builtin_amdgcn_sched_barrier(0);
#pragma unroll
                    for (int m = 0; m < 4; ++m) { const int row = row0 + ai * HALF + m * 16;
                        *(u32x4*)(X + (size_t)row * D + col) = pack8(s0[m] + g0 * acc[ai][bj][m][0], s1[m] + g1 * acc[ai][bj][m][1]); }
                    __builtin_amdgcn_sched_barrier(0); } }
            else { u32x4 rw[2][4];
#pragma unroll
                for (int ai = 0; ai < 2; ++ai)
#pragma unroll
                    for (int m = 0; m < 4; ++m) rw[ai][m] = *(const u32x4*)((const bf16_t*)src_lat + (size_t)(row0 + ai * HALF + m * 16) * D + col);
                __builtin_amdgcn_sched_barrier(0);
#pragma unroll
                for (int ai = 0; ai < 2; ++ai)
#pragma unroll
                    for (int m = 0; m < 4; ++m) { const int row = row0 + ai * HALF + m * 16; f32x4 s0, s1; unpack8(rw[ai][m], s0, s1);
                        *(u32x4*)(X + (size_t)row * D + col) = pack8(s0 + g0 * acc[ai][bj][m][0], s1 + g1 * acc[ai][bj][m][1]); }
                __builtin_amdgcn_sched_barrier(0); } }
    }
};
struct EpiMoe1 {
    static constexpr bool PERM = true;
    bf16_t* ACT;
    __device__ __forceinline__ void operator()(AccRef acc, const Unit& u, int wr, int wc, int fr, int fq) const {
        const int row0 = u.pm * BM + wr * 64 + fr, col0 = u.pn * HALF + wc * 32 + 8 * fq;
        constexpr float KS = 1.f / W8_SCALE, KB = ACT8_SCALE / W8_SCALE;
#pragma unroll
        for (int ai = 0; ai < 2; ++ai)
#pragma unroll
            for (int m = 0; m < 4; ++m) { f32x4 r[2];
#pragma unroll
                for (int n = 0; n < 2; ++n)
#pragma unroll
                    for (int j = 0; j < 4; ++j) r[n][j] = __builtin_amdgcn_fmed3f(fsilu(acc[ai][0][m][n][j] * KS) * (acc[ai][1][m][n][j] * KB), -440.f, 440.f);
                u32x2 o; o.x = pk4_fp8(r[0][0], r[0][1], r[0][2], r[0][3]); o.y = pk4_fp8(r[1][0], r[1][1], r[1][2], r[1][3]);
                *(u32x2*)((unsigned char*)ACT + (size_t)(row0 + ai * HALF + m * 16) * DEXP + col0) = o; }
    }
};
struct EpiNone {
    static constexpr bool PERM = true;
    __device__ __forceinline__ void operator()(AccRef acc, const Unit&, int, int, int, int) const {
#pragma unroll
        for (int ai = 0; ai < 2; ++ai)
#pragma unroll
            for (int bj = 0; bj < 2; ++bj)
#pragma unroll
                for (int m = 0; m < 4; ++m)
#pragma unroll
                    for (int n = 0; n < 2; ++n) asm volatile("" :: "v"(acc[ai][bj][m][n]));
    }
};
struct EpiY8 {
    static constexpr bool PERM = true; static constexpr int NVM = 16;
    unsigned char* O; int ldc; float ascale;
    __device__ __forceinline__ void operator()(AccRef acc, const Unit& u, int wr, int wc, int fr, int fq) const {
        const int row0 = u.pm * BM + wr * 64 + fr, col0 = u.pn * BM + wc * 32 + 8 * fq;
#pragma unroll
        for (int ai = 0; ai < 2; ++ai)
#pragma unroll
            for (int m = 0; m < 4; ++m) { unsigned char* rowp = O + (size_t)(row0 + ai * HALF + m * 16) * ldc + col0;
#pragma unroll
                for (int bj = 0; bj < 2; ++bj) { f32x4 r0, r1;
#pragma unroll
                    for (int j = 0; j < 4; ++j) { r0[j] = __builtin_amdgcn_fmed3f(acc[ai][bj][m][0][j] * ascale, -440.f, 440.f); r1[j] = __builtin_amdgcn_fmed3f(acc[ai][bj][m][1][j] * ascale, -440.f, 440.f); }
                    u32x2 o; o.x = pk4_fp8(r0[0], r0[1], r0[2], r0[3]); o.y = pk4_fp8(r1[0], r1[1], r1[2], r1[3]); *(u32x2*)(rowp + bj * HALF) = o; } }
    }
};
struct EpiPlain {
    static constexpr bool PERM = true;
    bf16_t* O; int ldc; float ascale;
    __device__ __forceinline__ void operator()(AccRef acc, const Unit& u, int wr, int wc, int fr, int fq) const {
        const int row0 = u.pm * BM + wr * 64 + fr, col0 = u.pn * BM + wc * 32 + 8 * fq;
#pragma unroll
        for (int ai = 0; ai < 2; ++ai)
#pragma unroll
            for (int m = 0; m < 4; ++m) { bf16_t* rowp = O + (size_t)(row0 + ai * HALF + m * 16) * ldc + col0;
#pragma unroll
                for (int bj = 0; bj < 2; ++bj) *(u32x4*)(rowp + bj * HALF) = pack8(acc[ai][bj][m][0] * ascale, acc[ai][bj][m][1] * ascale); }
    }
};
}

struct Args { const float* in[22]; float* out; unsigned char* ws; int ph_lo, ph_hi, rep, pad; };
enum { I_X = 0, I_C, I_CTX, I_CCTX, I_WADA, I_BADA, I_N1W, I_N2W, I_WIN, I_WPG, I_PSCALE, I_HGNW, I_LBLOG, I_WBP, I_WBH, I_WOUT, I_WROUTER, I_RBIAS, I_WE1, I_WE3, I_WE2, I_FNW };

struct Frame {
    LAS unsigned char* lds;
    int tid, lane, wave, G, gw, NGW;
    unsigned char* ws;
};

__device__ __forceinline__ void transpose_item(const float* W, int K, int N, int k0, int n0, bf16_t* WT, size_t dst_row0, LAS float* scr, int lane) {
    float wv[32];
#pragma unroll
    for (int i = 0; i < 32; ++i) { const int kk = 2 * i + (lane >> 5); wv[i] = __builtin_nontemporal_load(W + (size_t)(k0 + kk) * N + n0 + (lane & 31)); }
#pragma unroll
    for (int i = 0; i < 32; ++i) { const int kk = 2 * i + (lane >> 5); scr[kk * 33 + (lane & 31)] = wv[i]; }
    LDS_WAIT(); asm volatile("" ::: "memory");
    const int c = lane & 7;
#pragma unroll
    for (int j = 0; j < 4; ++j) { const int n = (lane >> 3) + 8 * j; const LAS float* s = scr + (8 * c) * 33 + n;
        u32x4 o; o.x = pk2(s[0 * 33], s[1 * 33]); o.y = pk2(s[2 * 33], s[3 * 33]); o.z = pk2(s[4 * 33], s[5 * 33]); o.w = pk2(s[6 * 33], s[7 * 33]);
        *(u32x4*)(WT + (dst_row0 + n) * K + k0 + 8 * c) = o; }
    LDS_WAIT(); asm volatile("" ::: "memory");
}
__device__ __forceinline__ void transpose_item_fp8(const float* W, int K, int N, int k0, int n0, unsigned char* WT, size_t dst_row0, LAS float* scr, int lane) {
    float wv[32];
#pragma unroll
    for (int i = 0; i < 32; ++i) { const int kk = 2 * i + (lane >> 5); wv[i] = __builtin_nontemporal_load(W + (size_t)(k0 + kk) * N + n0 + (lane & 31)); }
#pragma unroll
    for (int i = 0; i < 32; ++i) { const int kk = 2 * i + (lane >> 5); scr[kk * 33 + (lane & 31)] = wv[i] * W8_SCALE; }
    LDS_WAIT(); asm volatile("" ::: "memory");
    const int c = lane & 7;
#pragma unroll
    for (int j = 0; j < 4; ++j) { const int n = (lane >> 3) + 8 * j; const LAS float* sp = scr + (8 * c) * 33 + n;
        int w0 = 0, w1 = 0; w0 = __builtin_amdgcn_cvt_pk_fp8_f32(sp[0 * 33], sp[1 * 33], w0, false); w0 = __builtin_amdgcn_cvt_pk_fp8_f32(sp[2 * 33], sp[3 * 33], w0, true);
        w1 = __builtin_amdgcn_cvt_pk_fp8_f32(sp[4 * 33], sp[5 * 33], w1, false); w1 = __builtin_amdgcn_cvt_pk_fp8_f32(sp[6 * 33], sp[7 * 33], w1, true);
        u32x2 o; o.x = (unsigned)w0; o.y = (unsigned)w1;
        *(u32x2*)(WT + (dst_row0 + n) * K + k0 + 8 * c) = o; }
    LDS_WAIT(); asm volatile("" ::: "memory");
}
__device__ __forceinline__ void transpose_family(Frame& F, const float* W, int mats, int K, int N, bf16_t* WT, int mode, int& itbase, int it_lo, int it_step) {
    const int nblk = N / 32, kblk = K / 64, per = nblk * kblk, total = mats * per;
    LAS float* scr = (LAS float*)(F.lds + F.wave * 16384);
    int first = (it_lo - itbase) % it_step; if (first < 0) first += it_step;
    for (int it = first; it < total; it += it_step) {
        const int mat = it / per, r = it % per, kb = r / nblk, nb = r % nblk, n0 = 32 * nb, k0 = 64 * kb;
        size_t dst_row0; bf16_t* dstm;
        if (mode == 3) { transpose_item_fp8(W + (size_t)mat * K * N, K, N, k0, n0, (unsigned char*)WT + (size_t)mat * N * K, n0, scr, F.lane); continue; }
        if (mode == 4 || mode == 5) { transpose_item_fp8(W + (size_t)mat * K * N, K, N, k0, n0, (unsigned char*)WT + (size_t)mat * 1024 * K, (size_t)(n0 >> 7) * 256 + (mode == 5 ? 128 : 0) + (n0 & 127), scr, F.lane); continue; }
        if (mode == 0) { dstm = WT + (size_t)mat * N * K; dst_row0 = n0; }
        else { dstm = WT + (size_t)mat * 1024 * K; dst_row0 = (size_t)(n0 >> 7) * 256 + (mode == 2 ? 128 : 0) + (n0 & 127); }
        transpose_item(W + (size_t)mat * K * N, K, N, k0, n0, dstm, dst_row0, scr, F.lane);
    }
    itbase += total;
}

struct ConvJob { const float* src; unsigned char* dst; int N; };
__device__ __forceinline__ ConvJob conv_decode(const Args& a, unsigned char* ws, int L, int s, int lane) {
    const float* W; unsigned char* T; int K, N, t, map = 0, lk, ln;
    if (s < 20480) { t = s; W = a.in[I_WIN] + (size_t)L * D * INC; T = ws + WS_WIN + (size_t)L * INC * D; K = D; N = INC; lk = 7; ln = 8; }
    else if (s < 22528) { t = s - 20480; W = a.in[I_WBP] + (size_t)L * 1024 * D; T = ws + WS_WBP + (size_t)L * D * 1024; K = 1024; N = D; lk = 6; ln = 5; }
    else if (s < 24576) { t = s - 22528; W = a.in[I_WBH] + (size_t)L * 1024 * D; T = ws + WS_WBH + (size_t)L * D * 1024; K = 1024; N = D; lk = 6; ln = 5; }
    else if (s < 28672) { t = s - 24576; W = a.in[I_WOUT] + (size_t)L * D * D; T = ws + WS_WOUT + (size_t)L * D * D; K = D; N = D; lk = 7; ln = 5; }
    else if (s < 45056) { t = s - 28672; W = a.in[I_WE1] + (size_t)L * NEXP * D * DEXP; T = ws + WS_WE13 + (size_t)L * NEXP * 1024 * D; K = D; N = DEXP; map = 1; lk = 7; ln = 3; }
    else if (s < 61440) { t = s - 45056; W = a.in[I_WE3] + (size_t)L * NEXP * D * DEXP; T = ws + WS_WE13 + (size_t)L * NEXP * 1024 * D; K = D; N = DEXP; map = 2; lk = 7; ln = 3; }
    else { t = s - 61440; W = a.in[I_WE2] + (size_t)L * NEXP * DEXP * D; T = ws + WS_WE2 + (size_t)L * NEXP * D * DEXP; K = DEXP; N = D; lk = 5; ln = 5; }
    const int kb = t & ((1 << lk) - 1), nb = (t >> lk) & ((1 << ln) - 1), mat = t >> (lk + ln);
    const int n = nb * 64 + lane, k0 = kb * 16;
    const size_t drow = map ? (size_t)mat * 1024 + (size_t)(n >> 7) * 256 + (map == 2 ? 128 : 0) + (n & 127) : (size_t)mat * N + n;
    ConvJob J; J.src = W + (size_t)mat * K * N + (size_t)k0 * N + n; J.dst = T + drow * K + k0; J.N = N; return J;
}
__device__ __forceinline__ void conv_pool_item(const Args& a, unsigned char* ws, int L, int s, int lane) {
    const int kb = s & 127, nb = s >> 7, k0 = kb * 16, g = nb >> 2, d0 = (nb & 3) * 64, fr = lane & 15, fq = lane >> 4;
    const float* Win = a.in[I_WIN] + (size_t)L * D * INC + (size_t)(k0 + fr) * INC + g * 256 + 8 * fq;
    const float* Wpg = a.in[I_WPG] + ((size_t)(L * 4 + g) * 256 + 8 * fq) * 256 + d0 + fr;
    f32x4 acc[4];
#pragma unroll
    for (int nt = 0; nt < 4; ++nt) acc[nt] = (f32x4){0.f, 0.f, 0.f, 0.f};
#pragma unroll 2
    for (int ks = 0; ks < 8; ++ks) {
        const f32x4 a0 = *(const f32x4*)(Win + 32 * ks), a1 = *(const f32x4*)(Win + 32 * ks + 4);
        u32x4 aw; aw.x = pk2(a0[0], a0[1]); aw.y = pk2(a0[2], a0[3]); aw.z = pk2(a1[0], a1[1]); aw.w = pk2(a1[2], a1[3]);
#pragma unroll
        for (int nt = 0; nt < 4; ++nt) { float b[8];
#pragma unroll
            for (int t = 0; t < 8; ++t) b[t] = Wpg[(size_t)(32 * ks + t) * 256 + 16 * nt];
            u32x4 bw; bw.x = pk2(b[0], b[1]); bw.y = pk2(b[2], b[3]); bw.z = pk2(b[4], b[5]); bw.w = pk2(b[6], b[7]);
            acc[nt] = __builtin_amdgcn_mfma_f32_16x16x32_bf16(__builtin_bit_cast(bf16x8, aw), __builtin_bit_cast(bf16x8, bw), acc[nt], 0, 0, 0); } }
    unsigned char* T = ws + WS_WIN + (size_t)L * INC * D;
#pragma unroll
    for (int nt = 0; nt < 4; ++nt) { const int n = g * 256 + d0 + 16 * nt + fr; const float sc = a.in[I_PSCALE][(size_t)L * DPOOL + n] * W8_SCALE;
        *(unsigned*)(T + (size_t)n * D + k0 + 4 * fq) = pk4_fp8(acc[nt][0] * sc, acc[nt][1] * sc, acc[nt][2] * sc, acc[nt][3] * sc); }
}
constexpr int CP_PITCH = 264;
__device__ __forceinline__ void conv_pool_item_lds(const Args& a, unsigned char* ws, LAS unsigned char* lds, int L, int s, int lane) {
    const int kb = s & 127, nb = s >> 7, k0 = kb * 16, g = nb >> 2, d0 = (nb & 3) * 64, fr = lane & 15, fq = lane >> 4;
    const float* Win = a.in[I_WIN] + (size_t)L * D * INC + (size_t)(k0 + fr) * INC + g * 256 + 8 * fq;
    f32x4 av[16];
#pragma unroll
    for (int i = 0; i < 16; ++i) av[i] = __builtin_nontemporal_load((const f32x4*)(Win + 4 * i + (i >> 1) * 24));
    f32x4 acc[4];
#pragma unroll
    for (int nt = 0; nt < 4; ++nt) acc[nt] = (f32x4){0.f, 0.f, 0.f, 0.f};
#pragma unroll
    for (int ks = 0; ks < 8; ++ks) {
        u32x4 aw; aw.x = pk2(av[2 * ks][0], av[2 * ks][1]); aw.y = pk2(av[2 * ks][2], av[2 * ks][3]); aw.z = pk2(av[2 * ks + 1][0], av[2 * ks + 1][1]); aw.w = pk2(av[2 * ks + 1][2], av[2 * ks + 1][3]);
#pragma unroll
        for (int nt = 0; nt < 4; ++nt) { const bf16x8 bw = *(const LAS bf16x8*)(lds + ((16 * nt + fr) * CP_PITCH + 32 * ks + 8 * fq) * 2);
            acc[nt] = __builtin_amdgcn_mfma_f32_16x16x32_bf16(__builtin_bit_cast(bf16x8, aw), bw, acc[nt], 0, 0, 0); } }
    unsigned char* T = ws + WS_WIN + (size_t)L * INC * D;
    float scv[4];
#pragma unroll
    for (int nt = 0; nt < 4; ++nt) scv[nt] = a.in[I_PSCALE][(size_t)L * DPOOL + g * 256 + d0 + 16 * nt + fr];
#pragma unroll
    for (int nt = 0; nt < 4; ++nt) { const int n = g * 256 + d0 + 16 * nt + fr; const float sc = scv[nt] * W8_SCALE;
        *(unsigned*)(T + (size_t)n * D + k0 + 4 * fq) = pk4_fp8(acc[nt][0] * sc, acc[nt][1] * sc, acc[nt][2] * sc, acc[nt][3] * sc); }
}
constexpr int CONV_ITEMS = 77824;
__device__ __forceinline__ void convert_range(Frame& F, const Args& a, int L, int lo, int hi, int rank, int n) {
    if (rank < 0 || L >= DEPTH) return;
    const bool pool_lds = (lo == 0) && (n >= 128) && (hi >= 2048), pool_wg = pool_lds && (rank * 16 < 2048);
    if (pool_wg) { const int nb = (rank * 16) >> 7, g = nb >> 2, d0 = (nb & 3) * 64, d = F.tid & 63;
        const float* Wp = a.in[I_WPG] + (size_t)(L * 4 + g) * 256 * 256 + d0 + d;
        __syncthreads();
        float wv[32];
#pragma unroll
        for (int i = 0; i < 16; ++i) { const int c = 2 * ((F.tid >> 6) + 8 * i); wv[2 * i] = Wp[(size_t)c * 256]; wv[2 * i + 1] = Wp[(size_t)(c + 1) * 256]; }
#pragma unroll
        for (int i = 0; i < 16; ++i) { const int c = 2 * ((F.tid >> 6) + 8 * i); *(LAS unsigned*)(F.lds + (d * CP_PITCH + c) * 2) = pk2(wv[2 * i], wv[2 * i + 1]); }
        __syncthreads(); }
    for (int s0 = lo + (rank * 8 + F.wave) * 2; s0 < hi; s0 += n * 16) {
        const bool has2 = s0 + 1 < hi;
        if (s0 < 2048) { if (pool_lds) { conv_pool_item_lds(a, F.ws, F.lds, L, s0, F.lane); if (has2) conv_pool_item_lds(a, F.ws, F.lds, L, s0 + 1, F.lane); }
                         else { conv_pool_item(a, F.ws, L, s0, F.lane); if (has2) conv_pool_item(a, F.ws, L, s0 + 1, F.lane); }
                         continue; }
        const ConvJob J0 = conv_decode(a, F.ws, L, s0, F.lane), J1 = conv_decode(a, F.ws, L, has2 ? s0 + 1 : s0, F.lane);
        float v0[16], v1[16];
#pragma unroll
        for (int i = 0; i < 16; ++i) { v0[i] = __builtin_nontemporal_load(J0.src + (size_t)i * J0.N); v1[i] = __builtin_nontemporal_load(J1.src + (size_t)i * J1.N); }
        u32x4 o; o.x = pk4_fp8(v0[0] * W8_SCALE, v0[1] * W8_SCALE, v0[2] * W8_SCALE, v0[3] * W8_SCALE); o.y = pk4_fp8(v0[4] * W8_SCALE, v0[5] * W8_SCALE, v0[6] * W8_SCALE, v0[7] * W8_SCALE);
        o.z = pk4_fp8(v0[8] * W8_SCALE, v0[9] * W8_SCALE, v0[10] * W8_SCALE, v0[11] * W8_SCALE); o.w = pk4_fp8(v0[12] * W8_SCALE, v0[13] * W8_SCALE, v0[14] * W8_SCALE, v0[15] * W8_SCALE);
        *(u32x4*)J0.dst = o;
        if (has2) { o.x = pk4_fp8(v1[0] * W8_SCALE, v1[1] * W8_SCALE, v1[2] * W8_SCALE, v1[3] * W8_SCALE); o.y = pk4_fp8(v1[4] * W8_SCALE, v1[5] * W8_SCALE, v1[6] * W8_SCALE, v1[7] * W8_SCALE);
            o.z = pk4_fp8(v1[8] * W8_SCALE, v1[9] * W8_SCALE, v1[10] * W8_SCALE, v1[11] * W8_SCALE); o.w = pk4_fp8(v1[12] * W8_SCALE, v1[13] * W8_SCALE, v1[14] * W8_SCALE, v1[15] * W8_SCALE);
            *(u32x4*)J1.dst = o; }
    }
}
__device__ __forceinline__ void idle_rank(int nunits, int G, int c, int& rank, int& n) {
    const int rem = nunits % G;
    if (rem == 0 || G - rem < 64) { rank = c; n = G; } else { rank = c >= rem ? c - rem : -1; n = G - rem; }
}

template <int NCG, int NKP>
__device__ __forceinline__ void adaln_layer(Frame& F, const Args& a, int layer, int rank, int n) {
    static_assert(NCG * NKP <= 512, "thread layout");
    if (rank < 0 || layer >= DEPTH) return;
    constexpr int NC = 4 * NCG, NIT = 6 * D / NC;
    if (rank >= NIT) return;
    LAS float* sv = (LAS float*)F.lds;
    LAS float* red = (LAS float*)(F.lds + 5 * D * 4);
    __syncthreads();
    for (int i = F.tid; i < 5 * D; i += 512) { const int r = i / D, k = i % D; const float v = r < 4 ? a.in[I_C][r * D + k] : a.in[I_CCTX][k]; sv[i] = fsilu(v); }
    __syncthreads();
    const float* wada = a.in[I_WADA]; const float* bada = a.in[I_BADA]; float* MOD = (float*)(F.ws + WS_MOD);
    const int cg = F.tid % NCG, kg = F.tid / NCG;
    for (int it = rank; it < NIT; it += n) {
        const int j0 = it * NC;
        if (kg < NKP) {
            const float* w = wada + (size_t)layer * D * 6 * D + j0 + 4 * cg;
            f32x4 acc[5];
#pragma unroll
            for (int r = 0; r < 5; ++r) acc[r] = (f32x4){0.f, 0.f, 0.f, 0.f};
#pragma unroll 1
            for (int k = kg; k < D; k += NKP * 16) {
                f32x4 wv[16];
#pragma unroll
                for (int u = 0; u < 16; ++u) { const int kk = k + NKP * u; wv[u] = kk < D ? *(const f32x4*)(w + (size_t)kk * 6 * D) : (f32x4){0.f, 0.f, 0.f, 0.f}; }
                __builtin_amdgcn_sched_barrier(0);
#pragma unroll
                for (int hh = 0; hh < 2; ++hh) { float svv[8][5];
#pragma unroll
                    for (int u = 0; u < 8; ++u) { const int kk = min(k + NKP * (8 * hh + u), D - 1);
#pragma unroll
                        for (int r = 0; r < 5; ++r) svv[u][r] = sv[r * D + kk]; }
                    __builtin_amdgcn_sched_barrier(0);
#pragma unroll
                    for (int u = 0; u < 8; ++u)
#pragma unroll
                        for (int r = 0; r < 5; ++r) acc[r] += wv[8 * hh + u] * svv[u][r];
                    __builtin_amdgcn_sched_barrier(0); } }
#pragma unroll
            for (int r = 0; r < 5; ++r) *(LAS f32x4*)(red + (kg * 5 + r) * NC + 4 * cg) = acc[r];
        }
        __syncthreads();
        for (int o = F.tid; o < 5 * NC; o += 512) { const int r = o / NC, jj = o % NC; float t = bada[(size_t)layer * 6 * D + j0 + jj];
#pragma unroll 8
            for (int q = 0; q < NKP; ++q) t += red[(q * 5 + r) * NC + jj];
            MOD[((size_t)layer * 5 + r) * 6 * D + j0 + jj] = t; }
        __syncthreads();
    }
}

__device__ __forceinline__ void phase_prologue(Frame& F, const Args& a) {
    unsigned char* ws = F.ws;
    convert_range(F, a, 0, 0, CONV_ITEMS, (int)blockIdx.x, F.G);
    if (blockIdx.x == 0) {
        const float* lg = a.in[I_LBLOG]; float* LB = (float*)(ws + WS_LB);
        for (int i = F.tid; i < 2 * 1024; i += 512) { const int dir = i >> 10, ch = i & 1023;
            float l[DEPTH], mx = -1e30f;
#pragma unroll
            for (int j = 0; j < DEPTH; ++j) { l[j] = lg[((size_t)dir * DEPTH + j) * 1024 + ch]; mx = fmaxf(mx, l[j]); }
            float s = 0.f;
#pragma unroll
            for (int j = 0; j < DEPTH; ++j) { l[j] = __expf(l[j] - mx); s += l[j]; }
            float cum = 0.f;
#pragma unroll
            for (int j = 0; j < DEPTH; ++j) { if (j > 0) cum += l[j] / s; LB[((size_t)j * 2 + dir) * 1024 + ch] = cum; } }
    }
    __syncthreads();
    { int t_ = threadIdx.x; asm volatile("" : "+v"(t_)); F.tid = t_; F.lane = t_ & 63; }
    if (F.G == 256) adaln_layer<12, 42>(F, a, 0, (int)blockIdx.x, F.G);
    else for (int l = 0; l < DEPTH; ++l) adaln_layer<12, 42>(F, a, l, (int)blockIdx.x, F.G);
    __syncthreads();
}

__device__ __forceinline__ void wave_rows(const Frame& F, int M, int& r0, int& r1) { r0 = (int)(((unsigned)F.gw * (unsigned)M) / (unsigned)F.NGW); r1 = (int)(((unsigned)(F.gw + 1) * (unsigned)M) / (unsigned)F.NGW); }
__device__ __forceinline__ int mod_row(int r) { return r < NLAT ? (r >> 12) : 4; }

__device__ __forceinline__ void xrow_load(const bf16_t* X, int r, int lane, f32x4 (&x)[8]) { const u32x2* xr = (const u32x2*)(X + (size_t)r * D) + lane;
#pragma unroll
    for (int j = 0; j < 8; ++j) { const u32x2 w = xr[64 * j]; x[j] = (f32x4){bflo(w.x), bfhi(w.x), bflo(w.y), bfhi(w.y)}; } }
__device__ __forceinline__ void xrow_store(bf16_t* X, int r, int lane, const f32x4 (&x)[8]) { u32x2* xr = (u32x2*)(X + (size_t)r * D) + lane;
#pragma unroll
    for (int j = 0; j < 8; ++j) { u32x2 w; w.x = pk2(x[j][0], x[j][1]); w.y = pk2(x[j][2], x[j][3]); xr[64 * j] = w; } }
template <int NR>
__device__ __forceinline__ void moe_combine_rows(f32x4 (&x)[NR][8], const int (&r)[NR], int lane, const unsigned char* ws, int player, const float* mod5) {
    const int* pb = (const int*)(ws + WS_PADBASE) + player * 16; const unsigned char* Y2 = ws + WS_Y2;
    int2 ri[NR]; float2 rg[NR]; const unsigned* y0[NR]; const unsigned* y1[NR];
    const int pbv = pb[lane & 15];
#pragma unroll
    for (int q = 0; q < NR; ++q) { ri[q] = ((const int2*)(ws + WS_ROUTE_I))[r[q]]; rg[q] = ((const float2*)(ws + WS_ROUTE_G))[r[q]]; }
#pragma unroll
    for (int q = 0; q < NR; ++q) { const int e0 = __builtin_amdgcn_readfirstlane(ri[q].x >> 20), e1 = __builtin_amdgcn_readfirstlane(ri[q].y >> 20);
        const int s0 = __builtin_amdgcn_readlane(pbv, e0) + (ri[q].x & 0xfffff), s1 = __builtin_amdgcn_readlane(pbv, e1) + (ri[q].y & 0xfffff);
        y0[q] = (const unsigned*)(Y2 + (size_t)s0 * D) + lane; y1[q] = (const unsigned*)(Y2 + (size_t)s1 * D) + lane; rg[q].x *= 1.f / Y8_SCALE; rg[q].y *= 1.f / Y8_SCALE; }
    unsigned ya_[NR][8], yb_[NR][8]; f32x4 g[8];
#pragma unroll
    for (int j = 0; j < 8; ++j) {
#pragma unroll
        for (int q = 0; q < NR; ++q) { ya_[q][j] = y0[q][64 * j]; yb_[q][j] = y1[q][64 * j]; }
        g[j] = *((const f32x4*)mod5 + 64 * j + lane); }
    __builtin_amdgcn_sched_barrier(0);
#pragma unroll
    for (int j = 0; j < 8; ++j) {
#pragma unroll
        for (int q = 0; q < NR; ++q) { const unsigned a = ya_[q][j], b = yb_[q][j];
            const f32x2 a01 = __builtin_amdgcn_cvt_pk_f32_fp8((int)a, false), a23 = __builtin_amdgcn_cvt_pk_f32_fp8((int)a, true), b01 = __builtin_amdgcn_cvt_pk_f32_fp8((int)b, false), b23 = __builtin_amdgcn_cvt_pk_f32_fp8((int)b, true);
            const f32x4 ya = (f32x4){a01.x, a01.y, a23.x, a23.y}, yb = (f32x4){b01.x, b01.y, b23.x, b23.y};
            x[q][j] += g[j] * (ya * rg[q].x + yb * rg[q].y); } }
}
__device__ __forceinline__ float row_sumsq(const f32x4 (&x)[8]) { float ss = 0.f;
#pragma unroll
    for (int j = 0; j < 8; ++j) ss += (x[j][0] * x[j][0] + x[j][1] * x[j][1]) + (x[j][2] * x[j][2] + x[j][3] * x[j][3]);
    return ss; }

__device__ __forceinline__ void phase_norm1(Frame& F, const Args& a, int layer, bool combine) {
    unsigned char* ws = F.ws; bf16_t* X = (bf16_t*)(ws + WS_X); bf16_t* H = (bf16_t*)(ws + WS_H);
    const float* MOD = (const float*)(ws + WS_MOD); const float* nw = a.in[I_N1W] + (size_t)layer * D;
    int r0, r1; wave_rows(F, MTOK, r0, r1);
    int curb = -1; f32x4 av[8], sv[8];
    for (int r = r0; r < r1;) {
        const int b = mod_row(r);
        const bool two = (r + 1 < r1) && (mod_row(r + 1) == b);
        const int rr[2] = {r, two ? r + 1 : r};
        if (b != curb) { curb = b; const float* m = MOD + ((size_t)layer * 5 + b) * 6 * D;
#pragma unroll
            for (int j = 0; j < 8; ++j) { av[j] = *((const f32x4*)nw + 64 * j + F.lane); sv[j] = *((const f32x4*)(m + D) + 64 * j + F.lane); }
            f32x4 m0_[8];
#pragma unroll
            for (int j = 0; j < 8; ++j) m0_[j] = *((const f32x4*)m + 64 * j + F.lane);
            __builtin_amdgcn_sched_barrier(0);
#pragma unroll
            for (int j = 0; j < 8; ++j) { av[j] = av[j] * (sv[j] + 1.f); sv[j] = m0_[j]; } }
        f32x4 x[2][8];
#pragma unroll
        for (int q = 0; q < 2; ++q) {
            if (layer == 0) { const float* xs = rr[q] < NLAT ? a.in[I_X] + (size_t)rr[q] * D : a.in[I_CTX] + (size_t)(rr[q] - NLAT) * D;
                const f32x4* xr = (const f32x4*)xs + F.lane;
#pragma unroll
                for (int j = 0; j < 8; ++j) x[q][j] = xr[64 * j]; }
            else xrow_load(X, rr[q], F.lane, x[q]); }
        if (combine) { moe_combine_rows<2>(x, rr, F.lane, ws, layer - 1, MOD + ((size_t)(layer - 1) * 5 + b) * 6 * D + 5 * D);
#pragma unroll
            for (int q = 0; q < 2; ++q) if (q == 0 || two) xrow_store(X, rr[q], F.lane, x[q]); }
        float ss0 = row_sumsq(x[0]), ss1 = row_sumsq(x[1]);
#pragma unroll
        for (int o = 1; o < 64; o <<= 1) { ss0 += lane_xor(ss0, o, F.lane); ss1 += lane_xor(ss1, o, F.lane); }
        const float rs[2] = {1.0f / sqrtf(ss0 * (1.f / D) + EPS), 1.0f / sqrtf(ss1 * (1.f / D) + EPS)};
#pragma unroll
        for (int q = 0; q < 2; ++q) if (q == 0 || two) { unsigned* ho = (unsigned*)((unsigned char*)H + (size_t)rr[q] * D) + F.lane;
#pragma unroll
            for (int j = 0; j < 8; ++j) { const f32x4 h = x[q][j] * rs[q] * av[j] + sv[j]; int w = 0; w = __builtin_amdgcn_cvt_pk_fp8_f32(h[0], h[1], w, false); w = __builtin_amdgcn_cvt_pk_fp8_f32(h[2], h[3], w, true); ho[64 * j] = (unsigned)w; } }
        r += two ? 2 : 1;
    }
}

constexpr int RT_LCNT = LDS_MISC + 1024, RT_LBASE = LDS_MISC + 1088, RT_REC = LDS_MISC + 2048;
struct Route { int i1, i2; float g1, g2; };
__device__ __forceinline__ Route route_row(const float (&lg)[NEXP], const float* rbias) {
    float sc[NEXP], sel[NEXP];
#pragma unroll
    for (int e = 0; e < NEXP; ++e) { sc[e] = __builtin_amdgcn_rcpf(1.f + __builtin_amdgcn_exp2f(-1.44269504f * lg[e])); sel[e] = sc[e] + rbias[e]; }
    float gsc[4];
#pragma unroll
    for (int g = 0; g < 4; ++g) { float m1 = -1e30f, m2 = -1e30f;
#pragma unroll
        for (int i = 0; i < 4; ++i) { const float v = sel[g * 4 + i]; const bool c1 = v > m1, c2 = v > m2; m2 = c1 ? m1 : (c2 ? v : m2); m1 = c1 ? v : m1; }
        gsc[g] = m1 + m2; }
    int gbest = 0; float gbs = gsc[0];
#pragma unroll
    for (int g = 1; g < 4; ++g) { const bool c = gsc[g] > gbs; gbest = c ? g : gbest; gbs = c ? gsc[g] : gbs; }
    float sl[4], sx[4];
#pragma unroll
    for (int i = 0; i < 4; ++i) { sl[i] = gbest == 0 ? sel[i] : gbest == 1 ? sel[4 + i] : gbest == 2 ? sel[8 + i] : sel[12 + i]; sx[i] = gbest == 0 ? sc[i] : gbest == 1 ? sc[4 + i] : gbest == 2 ? sc[8 + i] : sc[12 + i]; }
    int i1 = 0, i2 = 0; float v1 = -1e30f, v2 = -1e30f, s1 = 0.f, s2 = 0.f;
#pragma unroll
    for (int i = 0; i < 4; ++i) { const float v = sl[i]; const bool c1 = v > v1, c2 = v > v2;
        i2 = c1 ? i1 : (c2 ? i : i2); s2 = c1 ? s1 : (c2 ? sx[i] : s2); v2 = c1 ? v1 : (c2 ? v : v2);
        i1 = c1 ? i : i1; s1 = c1 ? sx[i] : s1; v1 = c1 ? v : v1; }
    const float inv = __builtin_amdgcn_rcpf(s1 + s2);
    Route R; R.i1 = gbest * 4 + i1; R.i2 = gbest * 4 + i2; R.g1 = s1 * inv; R.g2 = s2 * inv; return R;
}
constexpr int RT_STRIDE = 4112;
constexpr int RT_WB = 0, RT_HT = 16 * RT_STRIDE, RT_PART = 32 * RT_STRIDE;
static_assert(RT_PART + 8192 <= LDS_MISC, "router LDS map");
__device__ __forceinline__ void router_prefill(Frame& F, const Args& a) {
    LAS unsigned char* L = F.lds;
    __syncthreads();
    { const f32x4* wr4 = (const f32x4*)a.in[I_WROUTER];
#pragma unroll 1
      for (int i = 0; i < 2; ++i) { const int k = 2 * F.tid + 1024 * i; f32x4 wv[2][4];
#pragma unroll
          for (int h = 0; h < 2; ++h)
#pragma unroll
              for (int q = 0; q < 4; ++q) wv[h][q] = wr4[(size_t)(k + h) * 4 + q];
#pragma unroll
          for (int q = 0; q < 4; ++q)
#pragma unroll
              for (int ii = 0; ii < 4; ++ii) *(LAS unsigned*)(L + RT_WB + (4 * q + ii) * RT_STRIDE + k * 2) = pk2(wv[0][q][ii], wv[1][q][ii]); } }
    if (F.tid < 16) ((LAS unsigned*)(F.lds + RT_LCNT))[F.tid] = 0u;
}
__device__ __forceinline__ void phase_norm2_router(Frame& F, const Args& a, int layer, int Mrows, bool publish, bool prefilled) {
    unsigned char* ws = F.ws; const bf16_t* X = (const bf16_t*)(ws + WS_X); bf16_t* H = (bf16_t*)(ws + WS_H);
    const float* MOD = (const float*)(ws + WS_MOD); const float* nw = a.in[I_N2W] + (size_t)layer * D;
    LAS unsigned char* L = F.lds;
    if (!prefilled) router_prefill(F, a);
    LAS unsigned* lcnt = (LAS unsigned*)(F.lds + RT_LCNT); LAS unsigned* lbase = (LAS unsigned*)(F.lds + RT_LBASE);
    __syncthreads();
    const float* rbias = a.in[I_RBIAS];
    const int brow0 = 2 * (int)((blockIdx.x * (unsigned)(Mrows >> 1)) / (unsigned)F.G), brow1 = 2 * (int)(((blockIdx.x + 1) * (unsigned)(Mrows >> 1)) / (unsigned)F.G);
    const int nround = (brow1 - brow0 + 15) >> 4;
    const int fr = F.lane & 15, fq = F.lane >> 4;
    int curb = -1; f32x4 av[8], sv[8];
#pragma unroll 1
    for (int t = 0; t < nround; ++t) {
        const int r = brow0 + 16 * t + 2 * F.wave;
        const bool v0 = r < brow1, v1 = r + 1 < brow1;
        const int rr[2] = {v0 ? r : brow0, v1 ? r + 1 : brow0};
        const int b = mod_row(rr[0]);
        if (b != curb) { curb = b; const float* m = MOD + ((size_t)layer * 5 + b) * 6 * D;
            f32x4 w_[8], m4_[8];
#pragma unroll
            for (int j = 0; j < 8; ++j) { w_[j] = *((const f32x4*)nw + 64 * j + F.lane); m4_[j] = *((const f32x4*)(m + 4 * D) + 64 * j + F.lane); sv[j] = *((const f32x4*)(m + 3 * D) + 64 * j + F.lane); }
#pragma unroll
            for (int j = 0; j < 8; ++j) av[j] = w_[j] * (m4_[j] + 1.f); }
        f32x4 x[2][8];
#pragma unroll
        for (int q = 0; q < 2; ++q) xrow_load(X, rr[q], F.lane, x[q]);
        float ss0 = row_sumsq(x[0]), ss1 = row_sumsq(x[1]);
#pragma unroll
        for (int o = 1; o < 64; o <<= 1) { ss0 += lane_xor(ss0, o, F.lane); ss1 += lane_xor(ss1, o, F.lane); }
        const float rs[2] = {1.0f / sqrtf(ss0 * (1.f / D) + EPS), 1.0f / sqrtf(ss1 * (1.f / D) + EPS)};
#pragma unroll
        for (int q = 0; q < 2; ++q) {
#pragma unroll
            for (int j = 0; j < 8; ++j) x[q][j] = x[q][j] * rs[q] * av[j] + sv[j];
            if (q == 0 ? v0 : v1) { unsigned* ho = (unsigned*)((unsigned char*)H + (size_t)rr[q] * D) + F.lane;
#pragma unroll
                for (int j = 0; j < 8; ++j) ho[64 * j] = pk4_fp8(x[q][j][0], x[q][j][1], x[q][j][2], x[q][j][3]); }
            LAS unsigned char* hrow = L + RT_HT + (2 * F.wave + q) * RT_STRIDE + F.lane * 8;
#pragma unroll
            for (int j = 0; j < 8; ++j) { u32x2 w; w.x = pk2(x[q][j][0], x[q][j][1]); w.y = pk2(x[q][j][2], x[q][j][3]); *(LAS u32x2*)(hrow + j * 512) = w; } }
        __syncthreads();
        f32x4 acc = (f32x4){0.f, 0.f, 0.f, 0.f};
#pragma unroll
        for (int s = 0; s < 8; ++s) { const int kb = (256 * F.wave + 32 * s + 8 * fq) * 2;
            const bf16x8 wa = *(const LAS bf16x8*)(L + RT_WB + fr * RT_STRIDE + kb), hb = *(const LAS bf16x8*)(L + RT_HT + fr * RT_STRIDE + kb);
            acc = __builtin_amdgcn_mfma_f32_16x16x32_bf16(wa, hb, acc, 0, 0, 0); }
        *(LAS f32x4*)(L + RT_PART + F.wave * 1024 + fr * 64 + fq * 16) = acc;
        __syncthreads();
        if (F.lane < 2) { const int tr = 2 * F.wave + F.lane;
            f32x4 sg[4] = {(f32x4){0.f, 0.f, 0.f, 0.f}, (f32x4){0.f, 0.f, 0.f, 0.f}, (f32x4){0.f, 0.f, 0.f, 0.f}, (f32x4){0.f, 0.f, 0.f, 0.f}};
#pragma unroll
            for (int w8 = 0; w8 < 8; ++w8)
#pragma unroll
                for (int c = 0; c < 4; ++c) sg[c] += *(const LAS f32x4*)(L + RT_PART + w8 * 1024 + tr * 64 + c * 16);
            float lg[NEXP];
#pragma unroll
            for (int e = 0; e < NEXP; ++e) lg[e] = sg[e >> 2][e & 3];
            const Route R = route_row(lg, rbias); const int i1 = R.i1, i2 = R.i2; const float g1 = R.g1, g2 = R.g2;
            if ((F.lane == 0 ? v0 : v1) && publish) {
                const unsigned k1 = __hip_atomic_fetch_add(lcnt + i1, 1u, __ATOMIC_RELAXED, __HIP_MEMORY_SCOPE_WORKGROUP), k2 = __hip_atomic_fetch_add(lcnt + i2, 1u, __ATOMIC_RELAXED, __HIP_MEMORY_SCOPE_WORKGROUP);
                LAS unsigned* rec = (LAS unsigned*)(F.lds + RT_REC + (r + F.lane - brow0) * 32);
                rec[0] = (unsigned)i1; rec[1] = k1; rec[2] = (unsigned)i2; rec[3] = k2; rec[4] = __builtin_bit_cast(unsigned, g1); rec[5] = __builtin_bit_cast(unsigned, g2);
            } }
    }
    __syncthreads();
    if (F.tid < 16 && publish) { unsigned* cntw = (unsigned*)(ws + WS_CTL) + CW_CNT + layer * 1024; const unsigned n = lcnt[F.tid]; lbase[F.tid] = n ? atomicAdd(cntw + F.tid * 64, n) : 0u; }
    __syncthreads();
    if (F.tid < brow1 - brow0 && publish) { const int r = brow0 + F.tid; const LAS unsigned* rec = (const LAS unsigned*)(F.lds + RT_REC + F.tid * 32);
        const unsigned i1 = rec[0], i2 = rec[2], k1 = lbase[i1] + rec[1], k2 = lbase[i2] + rec[3];
        int* slottok = (int*)(ws + WS_SLOTTOK); slottok[(size_t)i1 * MTOK + k1] = r; slottok[(size_t)i2 * MTOK + k2] = r;
        ((int2*)(ws + WS_ROUTE_I))[r] = make_int2((int)((i1 << 20) | k1), (int)((i2 << 20) | k2));
        ((float2*)(ws + WS_ROUTE_G))[r] = make_float2(__builtin_bit_cast(float, rec[4]), __builtin_bit_cast(float, rec[5])); }
    __syncthreads();
}

__device__ __forceinline__ void phase_pooldiff(Frame& F, int Mrows) {
    unsigned char* ws = F.ws; const bf16_t* Z = (const bf16_t*)(ws + WS_Z); unsigned char* P8 = ws + WS_P;
    LAS unsigned char* L = F.lds;
    const int cg = F.tid & 127, rq = F.tid >> 7, hw = 1 << (cg >> 5);
    const int ntile = NLAT / 64;
    for (int tile = blockIdx.x; tile < ntile; tile += F.G) {
        int base, Lrow, t0, nt;
        if (tile < NLAT / 64) { base = tile * 64; Lrow = 64; t0 = 0; nt = 64; }
        else { const int u = tile - NLAT / 64; base = NLAT + (u >> 3) * CTXL; Lrow = CTXL; t0 = (u & 7) * 32; nt = 32; }
        const int lo = max(t0 - 8, 0), hi = min(t0 + nt + 7, Lrow - 1), nrow = hi - lo + 1;
        u32x4 buf[16];
#pragma unroll
        for (int i = 0; i < 16; ++i) { const int sl = rq + 4 * i; buf[i] = (sl < nrow) ? *(const u32x4*)(Z + (size_t)(base + lo + sl) * INC + ZC_POOL + cg * 8) : (u32x4){0u, 0u, 0u, 0u}; }
#pragma unroll
        for (int i = 0; i < 16; ++i) { const int sl = rq + 4 * i; *(LAS u32x4*)(L + sl * 2048 + cg * 16) = buf[i]; }
        __syncthreads();
        { const int per = nt / 4; int t = t0 + rq * per;
          int wl = max(t - hw, 0), wh = min(t + hw - 1, Lrow - 1);
          float s[8] = {0.f, 0.f, 0.f, 0.f, 0.f, 0.f, 0.f, 0.f};
#pragma unroll
          for (int pp = 0; pp < 16; ++pp) { const int p = min(wl + pp, wh); const float fm = (wl + pp <= wh) ? 1.f : 0.f;
              const u32x4 a = *(const LAS u32x4*)(L + (p - lo) * 2048 + cg * 16);
              s[0] += fm * bflo(a.x); s[1] += fm * bfhi(a.x); s[2] += fm * bflo(a.y); s[3] += fm * bfhi(a.y); s[4] += fm * bflo(a.z); s[5] += fm * bfhi(a.z); s[6] += fm * bflo(a.w); s[7] += fm * bfhi(a.w); }
          for (int i = 0; i < per; ++i, ++t) {
              if (i) { const int nwl = max(t - hw, 0), nwh = min(t + hw - 1, Lrow - 1);
                  const u32x4 e = *(const LAS u32x4*)(L + (nwh - lo) * 2048 + cg * 16), q = *(const LAS u32x4*)(L + (wl - lo) * 2048 + cg * 16);
                  const float fe = nwh > wh ? 1.f : 0.f, fq2 = nwl > wl ? 1.f : 0.f;
                  s[0] += fe * bflo(e.x) - fq2 * bflo(q.x); s[1] += fe * bfhi(e.x) - fq2 * bfhi(q.x); s[2] += fe * bflo(e.y) - fq2 * bflo(q.y); s[3] += fe * bfhi(e.y) - fq2 * bfhi(q.y);
                  s[4] += fe * bflo(e.z) - fq2 * bflo(q.z); s[5] += fe * bfhi(e.z) - fq2 * bfhi(q.z); s[6] += fe * bflo(e.w) - fq2 * bflo(q.w); s[7] += fe * bfhi(e.w) - fq2 * bfhi(q.w);
                  wl = nwl; wh = nwh; }
              const float inv = __builtin_amdgcn_rcpf((float)(wh - wl + 1));
              const u32x4 a = *(const LAS u32x4*)(L + (t - lo) * 2048 + cg * 16);
              u32x2 o; o.x = pk4_fp8(s[0] * inv - bflo(a.x), s[1] * inv - bfhi(a.x), s[2] * inv - bflo(a.y), s[3] * inv - bfhi(a.y));
              o.y = pk4_fp8(s[4] * inv - bflo(a.z), s[5] * inv - bfhi(a.z), s[6] * inv - bflo(a.w), s[7] * inv - bfhi(a.w));
              *(u32x2*)(P8 + (size_t)(base + t) * DPOOL + cg * 8) = o; } }
        __syncthreads();
    }
    if (Mrows > NLAT) {
        const int cgl = F.tid & 15, rq2 = F.tid >> 4;
        for (int it = blockIdx.x; it < (NCTX / 32) * 8; it += F.G) {
            const int u = it >> 3, k = it & 7, cg2 = k * 16 + cgl, hw2 = 1 << (k >> 1);
            const int base = NLAT + (u >> 3) * CTXL, t0 = (u & 7) * 32;
            const int lo = max(t0 - 8, 0), hi = min(t0 + 32 + 7, CTXL - 1), nrow = hi - lo + 1;
            u32x4 buf[2];
#pragma unroll
            for (int i = 0; i < 2; ++i) { const int sl = rq2 + 32 * i; buf[i] = (sl < nrow) ? *(const u32x4*)(Z + (size_t)(base + lo + sl) * INC + ZC_POOL + cg2 * 8) : (u32x4){0u, 0u, 0u, 0u}; }
#pragma unroll
            for (int i = 0; i < 2; ++i) { const int sl = rq2 + 32 * i; *(LAS u32x4*)(L + sl * 2048 + cg2 * 16) = buf[i]; }
            __syncthreads();
            { const int t = t0 + rq2;
              const int wl = max(t - hw2, 0), wh = min(t + hw2 - 1, CTXL - 1);
              float s8[8] = {0.f, 0.f, 0.f, 0.f, 0.f, 0.f, 0.f, 0.f};
              for (int p = wl; p <= wh; ++p) { const u32x4 a = *(const LAS u32x4*)(L + (p - lo) * 2048 + cg2 * 16);
                  s8[0] += bflo(a.x); s8[1] += bfhi(a.x); s8[2] += bflo(a.y); s8[3] += bfhi(a.y); s8[4] += bflo(a.z); s8[5] += bfhi(a.z); s8[6] += bflo(a.w); s8[7] += bfhi(a.w); }
              const float inv = 1.f / (float)(wh - wl + 1);
              const u32x4 a = *(const LAS u32x4*)(L + (t - lo) * 2048 + cg2 * 16);
              u32x2 o; o.x = pk4_fp8(s8[0] * inv - bflo(a.x), s8[1] * inv - bfhi(a.x), s8[2] * inv - bflo(a.y), s8[3] * inv - bfhi(a.y));
              o.y = pk4_fp8(s8[4] * inv - bflo(a.z), s8[5] * inv - bfhi(a.z), s8[6] * inv - bflo(a.w), s8[7] * inv - bfhi(a.w));
              *(u32x2*)(P8 + (size_t)(base + t) * DPOOL + cg2 * 8) = o; }
            __syncthreads();
        }
    }
}

constexpr int SC_QS = 0, SC_KS = 17408, SC_KST = 34816, SC_VT = 53248, SC_VEC = 71680;
constexpr int SC_ST = 73216, SC_TOT = SC_ST + 34816, SC_END = SC_TOT + 4096;
constexpr int SC_P272 = 272, SC_P144 = 144;
constexpr int SEG_CH = 17, NSEG = 4;
static_assert(SC_END <= LDS_MISC, "scan LDS map");
struct ScanCtx { const bf16_t* Z; bf16_t* O2; LAS unsigned char* L; unsigned char* qsg; float* corrv; float* smid; float* totseg; int tid, lane, w, fr, fq, rt, vp, b, h, seg, dir, colq, colf, colv; };
__device__ __forceinline__ void scan_row0(int b, int dir, int c, int& g0, int& sg) {
    if (c < 4) { const int t0 = 64 * c; g0 = NLAT + b * CTXL + (dir ? CTXL - 1 - t0 : t0); } else { const int t0 = 64 * (c - 4); g0 = b * SEQ + (dir ? SEQ - 1 - t0 : t0); }
    sg = dir ? -1 : 1;
}
__device__ __forceinline__ void scan_load_lf(const ScanCtx& C, int c, unsigned (&lfw)[8]) {
    int g0, sg; scan_row0(C.b, C.dir, c, g0, sg);
#pragma unroll
    for (int j = 0; j < 8; ++j) lfw[j] = *(const unsigned*)(C.Z + (size_t)(g0 + sg * (8 * C.w + j)) * INC + C.colf);
}
__device__ __forceinline__ void scan_load_qv(const ScanCtx& C, int c, unsigned (&qw)[8], unsigned (&vw)[8]) {
    int g0, sg; scan_row0(C.b, C.dir, c, g0, sg);
#pragma unroll
    for (int j = 0; j < 8; ++j) { const bf16_t* zr = C.Z + (size_t)(g0 + sg * (8 * C.w + j)) * INC; qw[j] = *(const unsigned*)(zr + C.colq); vw[j] = *(const unsigned*)(zr + C.colv); }
}
__device__ __forceinline__ void scan_p1(const ScanCtx& C, const unsigned (&lfw)[8]) {
    float a0 = 0.f, a1 = 0.f;
#pragma unroll
    for (int j = 0; j < 8; ++j) { a0 += bflo(lfw[j]); a1 += bfhi(lfw[j]); }
    *(LAS f32x2*)(C.L + SC_TOT + (C.w * 128 + 2 * C.lane) * 4) = (f32x2){a0, a1};
}
__device__ __forceinline__ void scan_p2(const ScanCtx& C, int cl, const unsigned (&lfw)[8], const unsigned (&qw)[8], const unsigned (&vw)[8], float& cum0, float& cum1) {
    LAS unsigned char* L = C.L; const int lane = C.lane, w = C.w;
    float c0[8], c1[8], l0[8], l1[8];
    { float a0 = 0.f, a1 = 0.f;
#pragma unroll
      for (int j = 0; j < 8; ++j) { l0[j] = bflo(lfw[j]); l1[j] = bfhi(lfw[j]); a0 += l0[j]; a1 += l1[j]; c0[j] = a0; c1[j] = a1; } }
    float P0 = 0.f, P1 = 0.f, r0 = 0.f, r1 = 0.f, bl0 = 0.f, bl1 = 0.f;
#pragma unroll
    for (int o = 0; o < 8; ++o) { const f32x2 t = *(const LAS f32x2*)(L + SC_TOT + (o * 128 + 2 * lane) * 4);
        if (o < w) { P0 += t.x; P1 += t.y; } if (o < 4) { r0 += t.x; r1 += t.y; } bl0 += t.x; bl1 += t.y; }
    float k0v[8], k1v[8]; const float P0r = P0 - r0, P1r = P1 - r1;
#pragma unroll
    for (int j = 0; j < 8; ++j) {
        const float d0 = __builtin_amdgcn_fmed3f(P0r + c0[j], -120.f, 120.f), d1 = __builtin_amdgcn_fmed3f(P1r + c1[j], -120.f, 120.f);
        const float E0 = __builtin_amdgcn_exp2f(d0), E1 = __builtin_amdgcn_exp2f(d1), I0 = __builtin_amdgcn_exp2f(-d0), I1 = __builtin_amdgcn_exp2f(-d1);
        const float f0 = __builtin_amdgcn_exp2f(l0[j]), f1 = __builtin_amdgcn_exp2f(l1[j]);
        const float q0 = bflo(qw[j]), q1 = bfhi(qw[j]);
        k0v[j] = (1.f - f0) * I0; k1v[j] = (1.f - f1) * I1;
        const int rho = 8 * w + j;
        *(LAS unsigned*)(L + SC_QS + rho * SC_P272 + 4 * lane) = pk2(q0 * E0, q1 * E1);
        *(LAS unsigned*)(L + SC_KS + rho * SC_P272 + 4 * lane) = pk2(k0v[j], k1v[j]);
    }
    { u32x4 t0, t1; t0.x = pk2(k0v[0], k0v[1]); t0.y = pk2(k0v[2], k0v[3]); t0.z = pk2(k0v[4], k0v[5]); t0.w = pk2(k0v[6], k0v[7]);
      t1.x = pk2(k1v[0], k1v[1]); t1.y = pk2(k1v[2], k1v[3]); t1.z = pk2(k1v[4], k1v[5]); t1.w = pk2(k1v[6], k1v[7]);
      *(LAS u32x4*)(L + SC_KST + (2 * lane) * SC_P144 + 16 * w) = t0; *(LAS u32x4*)(L + SC_KST + (2 * lane + 1) * SC_P144 + 16 * w) = t1; }
    if (w == 0) {
        LAS float* vec = (LAS float*)(L + SC_VEC);
        *(LAS f32x2*)(vec + 2 * lane) = (f32x2){__builtin_amdgcn_exp2f(fmaxf(r0, -120.f)), __builtin_amdgcn_exp2f(fmaxf(r1, -120.f))};
        *(LAS f32x2*)(vec + 128 + 2 * lane) = (f32x2){__builtin_amdgcn_exp2f(fmaxf(bl0, -120.f)), __builtin_amdgcn_exp2f(fmaxf(bl1, -120.f))};
        *(LAS f32x2*)(vec + 256 + 2 * lane) = (f32x2){__builtin_amdgcn_exp2f(fmaxf(bl0 - r0, -120.f)), __builtin_amdgcn_exp2f(fmaxf(bl1 - r1, -120.f))};
        if (C.seg >= 1) *(f32x2*)(C.corrv + cl * 128 + 2 * lane) = (f32x2){r0 + cum0, r1 + cum1};
    }
    cum0 += bl0; cum1 += bl1;
    { u32x4 t0, t1;
      t0.x = (vw[0] & 0xffffu) | (vw[1] << 16); t0.y = (vw[2] & 0xffffu) | (vw[3] << 16); t0.z = (vw[4] & 0xffffu) | (vw[5] << 16); t0.w = (vw[6] & 0xffffu) | (vw[7] << 16);
      t1.x = (vw[0] >> 16) | (vw[1] & 0xffff0000u); t1.y = (vw[2] >> 16) | (vw[3] & 0xffff0000u); t1.z = (vw[4] >> 16) | (vw[5] & 0xffff0000u); t1.w = (vw[6] >> 16) | (vw[7] & 0xffff0000u);
      *(LAS u32x4*)(L + SC_VT + (2 * lane) * SC_P144 + 16 * w) = t0; *(LAS u32x4*)(L + SC_VT + (2 * lane + 1) * SC_P144 + 16 * w) = t1; }
}
__device__ __forceinline__ void scan_c1(const ScanCtx& C, const f32x4 (&S)[2][4]) {
#pragma unroll
    for (int i = 0; i < 2; ++i) { const int k = ((C.w >> 1) * 2 + i) * 16 + 4 * C.fq;
        f32x4 r = *(const LAS f32x4*)(C.L + SC_TOT + k * 4);
#pragma unroll
        for (int o = 1; o < 4; ++o) r += *(const LAS f32x4*)(C.L + SC_TOT + (o * 128 + k) * 4);
        f32x4 e;
#pragma unroll
        for (int q = 0; q < 4; ++q) e[q] = __builtin_amdgcn_exp2f(fmaxf(r[q], -120.f));
#pragma unroll
        for (int u = 0; u < 4; ++u) { const int v = (4 * C.vp + u) * 16 + C.fr; const f32x4 sv = S[i][u] * e;
            u32x2 t; t.x = pk2(sv[0], sv[1]); t.y = pk2(sv[2], sv[3]); *(LAS u32x2*)(C.L + SC_ST + v * SC_P272 + k * 2) = t; } }
}
__device__ __forceinline__ void scan_c2(const ScanCtx& C, int c, f32x4 (&S)[2][4]) {
    LAS unsigned char* L = C.L; const int fr = C.fr, fq = C.fq, rt = C.rt, w = C.w;
    bf16x8 yq[4];
#pragma unroll
    for (int ks = 0; ks < 4; ++ks) yq[ks] = *(const LAS bf16x8*)(L + SC_QS + (rt * 16 + fr) * SC_P272 + (ks * 32 + fq * 8) * 2);
    f32x4 at[4];
#pragma unroll
    for (int st = 0; st < 4; ++st) { f32x4 a = (f32x4){0.f, 0.f, 0.f, 0.f};
        if (st <= rt) {
            bf16x8 xs[4];
#pragma unroll
            for (int ks = 0; ks < 4; ++ks) xs[ks] = *(const LAS bf16x8*)(L + SC_KS + (st * 16 + fr) * SC_P272 + (ks * 32 + fq * 8) * 2);
            __builtin_amdgcn_sched_barrier(0);
#pragma unroll
            for (int ks = 0; ks < 4; ++ks) a = __builtin_amdgcn_mfma_f32_16x16x32_bf16(xs[ks], yq[ks], a, 0, 0, 0);
            if (st == rt) {
#pragma unroll
                for (int r = 0; r < 4; ++r) if (4 * fq + r > fr) a[r] = 0.f; } }
        at[st] = a; }
    u32x4 yw[2];
#pragma unroll
    for (int ks2 = 0; ks2 < 2; ++ks2) { yw[ks2].x = pk2(at[2 * ks2][0], at[2 * ks2][1]); yw[ks2].y = pk2(at[2 * ks2][2], at[2 * ks2][3]); yw[ks2].z = pk2(at[2 * ks2 + 1][0], at[2 * ks2 + 1][1]); yw[ks2].w = pk2(at[2 * ks2 + 1][2], at[2 * ks2 + 1][3]); }
    int g0, sg; scan_row0(C.b, C.dir, c, g0, sg);
#pragma unroll
    for (int u = 0; u < 4; ++u) { const int vt = 4 * C.vp + u; f32x4 o = (f32x4){0.f, 0.f, 0.f, 0.f};
        bf16x8 xs[4]; u32x2 xa[2], xb[2];
#pragma unroll
        for (int ks = 0; ks < 4; ++ks) xs[ks] = *(const LAS bf16x8*)(L + SC_ST + (vt * 16 + fr) * SC_P272 + (ks * 32 + fq * 8) * 2);
#pragma unroll
        for (int ks2 = 0; ks2 < 2; ++ks2) { xa[ks2] = *(const LAS u32x2*)(L + SC_VT + (vt * 16 + fr) * SC_P144 + (ks2 * 32 + 4 * fq) * 2); xb[ks2] = *(const LAS u32x2*)(L + SC_VT + (vt * 16 + fr) * SC_P144 + (ks2 * 32 + 16 + 4 * fq) * 2); }
        __builtin_amdgcn_sched_barrier(0);
#pragma unroll
        for (int ks = 0; ks < 4; ++ks) o = __builtin_amdgcn_mfma_f32_16x16x32_bf16(xs[ks], yq[ks], o, 0, 0, 0);
#pragma unroll
        for (int ks2 = 0; ks2 < 2; ++ks2) { if (2 * ks2 <= rt) {
            u32x4 xw; xw.x = xa[ks2].x; xw.y = xa[ks2].y; xw.z = xb[ks2].x; xw.w = xb[ks2].y;
            o = __builtin_amdgcn_mfma_f32_16x16x32_bf16(__builtin_bit_cast(bf16x8, xw), __builtin_bit_cast(bf16x8, yw[ks2]), o, 0, 0, 0); } }
        u32x2 ow; ow.x = pk2(o[0], o[1]); ow.y = pk2(o[2], o[3]);
        *(u32x2*)(C.O2 + ((size_t)C.dir * MTOK + (g0 + sg * (rt * 16 + fr))) * HGW + C.h * HDK + vt * 16 + 4 * fq) = ow;
        __builtin_amdgcn_sched_barrier(0); }
    bf16x8 xk[2][2];
#pragma unroll
    for (int i = 0; i < 2; ++i)
#pragma unroll
        for (int ks = 0; ks < 2; ++ks) xk[i][ks] = *(const LAS bf16x8*)(L + SC_KST + (((w >> 1) * 2 + i) * 16 + fr) * SC_P144 + (ks * 32 + fq * 8) * 2);
#pragma unroll
    for (int u = 0; u < 4; ++u) { bf16x8 yv[2];
#pragma unroll
        for (int ks = 0; ks < 2; ++ks) yv[ks] = *(const LAS bf16x8*)(L + SC_VT + ((4 * C.vp + u) * 16 + fr) * SC_P144 + (ks * 32 + fq * 8) * 2);
#pragma unroll
        for (int i = 0; i < 2; ++i) { f32x4 d = (f32x4){0.f, 0.f, 0.f, 0.f};
#pragma unroll
            for (int ks = 0; ks < 2; ++ks) d = __builtin_amdgcn_mfma_f32_16x16x32_bf16(xk[i][ks], yv[ks], d, 0, 0, 0);
            const int k = ((w >> 1) * 2 + i) * 16 + 4 * fq; const f32x4 ebl = *(const LAS f32x4*)(L + SC_VEC + (128 + k) * 4), ebr = *(const LAS f32x4*)(L + SC_VEC + (256 + k) * 4);
            S[i][u] = ebl * S[i][u] + ebr * d; }
        __builtin_amdgcn_sched_barrier(0); }
}
__device__ __forceinline__ void phase_scan_mfma(Frame& F) {
    ScanCtx C; C.Z = (const bf16_t*)(F.ws + WS_Z); C.O2 = (bf16_t*)(F.ws + WS_O2); C.L = F.lds;
    C.tid = F.tid; C.lane = F.lane; C.w = F.wave; C.fr = F.lane & 15; C.fq = F.lane >> 4; C.rt = F.wave >> 1; C.vp = F.wave & 1;
    for (int it = blockIdx.x; it < 64 * NSEG; it += F.G) {
        const int sbh = it >> 2; C.h = sbh & 7; C.b = (sbh >> 3) & 3; C.dir = sbh >> 5;
        C.seg = C.dir ? 3 - (it & 3) : (it & 3);
        C.qsg = F.ws + WS_QSG + (size_t)(sbh * 3 + (C.seg - 1)) * SEG_CH * 17408; C.corrv = (float*)(F.ws + WS_CORRV) + (size_t)(sbh * 3 + (C.seg - 1)) * SEG_CH * 128;
        C.smid = (float*)(F.ws + WS_SMID) + (size_t)(sbh * 3 + C.seg) * 128 * 128; C.totseg = (float*)(F.ws + WS_TOTSEG) + (size_t)(sbh * NSEG + C.seg) * 128;
        C.colq = ZC_Q + C.h * HDK + 2 * C.lane; C.colf = (C.dir == 0 ? ZC_FF : ZC_FB) + C.h * HDK + 2 * C.lane; C.colv = ZC_I + C.h * HDK + 2 * C.lane;
        f32x4 S[2][4];
#pragma unroll
        for (int i = 0; i < 2; ++i)
#pragma unroll
            for (int u = 0; u < 4; ++u) S[i][u] = (f32x4){0.f, 0.f, 0.f, 0.f};
        float cum0 = 0.f, cum1 = 0.f;
        unsigned lfW[8], qW[8], vW[8];
        const int c_lo = C.seg * SEG_CH;
        scan_load_lf(C, c_lo, lfW); scan_load_qv(C, c_lo, qW, vW);
        scan_p1(C, lfW);
        __syncthreads();
#define SC_STEP(cl) do { \
            scan_p2(C, (cl), lfW, qW, vW, cum0, cum1); scan_c1(C, S); \
            if ((cl) + 1 < SEG_CH) { scan_load_lf(C, c_lo + (cl) + 1, lfW); scan_load_qv(C, c_lo + (cl) + 1, qW, vW); } \
            __syncthreads(); \
            if (C.seg >= 1) { unsigned char* dst = C.qsg + (size_t)(cl) * 17408; const LAS unsigned char* src = C.L + SC_QS; for (int i_ = C.tid; i_ < 1088; i_ += 512) *(u32x4*)(dst + 16 * i_) = *(const LAS u32x4*)(src + 16 * i_); } \
            scan_c2(C, c_lo + (cl), S); \
            if ((cl) + 1 < SEG_CH) scan_p1(C, lfW); \
            __syncthreads(); } while (0)
        for (int cl = 0; cl < SEG_CH; ++cl) SC_STEP(cl);
#undef SC_STEP
        if (C.seg < 3) {
#pragma unroll
            for (int i = 0; i < 2; ++i)
#pragma unroll
                for (int u = 0; u < 4; ++u) *(f32x4*)(C.smid + ((4 * C.vp + u) * 16 + C.fr) * 128 + ((C.w >> 1) * 2 + i) * 16 + 4 * C.fq) = S[i][u]; }
        if (C.w == 0) *(f32x2*)(C.totseg + 2 * C.lane) = (f32x2){cum0, cum1};
        __syncthreads();
    }
}
__device__ __forceinline__ void phase_scan_fix(Frame& F) {
    unsigned char* ws = F.ws; bf16_t* O2 = (bf16_t*)(ws + WS_O2); LAS unsigned char* L = F.lds;
    LAS float* facv = (LAS float*)(L + 36864); LAS int* flg = (LAS int*)(L + 36864 + 512);
    const int w = F.wave, fr = F.lane & 15, fq = F.lane >> 4, rt = w >> 1, vp = w & 1;
    for (int item = blockIdx.x; item < 64 * 3; item += F.G) {
        const int j = 1 + item % 3, sbh = item / 3, dir = sbh >> 5, b = (sbh >> 3) & 3, h = sbh & 7;
        const int v = F.tid >> 2, k0 = (F.tid & 3) * 32;
        f32x4 sin[8];
        { const float* E = (const float*)(ws + WS_SMID) + ((size_t)(sbh * 3 + 0) * 128 + v) * 128 + k0;
#pragma unroll
          for (int i = 0; i < 8; ++i) sin[i] = *(const f32x4*)(E + 4 * i); }
        for (int jj = 1; jj < j; ++jj) { const float* E = (const float*)(ws + WS_SMID) + ((size_t)(sbh * 3 + jj) * 128 + v) * 128 + k0; const float* T = (const float*)(ws + WS_TOTSEG) + (size_t)(sbh * NSEG + jj) * 128 + k0;
            f32x4 tv[8], ev[8];
#pragma unroll
            for (int i = 0; i < 8; ++i) { tv[i] = *(const f32x4*)(T + 4 * i); ev[i] = *(const f32x4*)(E + 4 * i); }
            __builtin_amdgcn_sched_barrier(0);
#pragma unroll
            for (int i = 0; i < 8; ++i) { f32x4 d;
#pragma unroll
                for (int q = 0; q < 4; ++q) d[q] = __builtin_amdgcn_exp2f(fmaxf(tv[i][q], -200.f));
                sin[i] = d * sin[i] + ev[i]; } }
        for (int cl = 0; cl < SEG_CH; ++cl) {
            if (F.tid == 0) flg[0] = 0;
            __syncthreads();
            if (F.tid < 128) { const float e = ((const float*)(ws + WS_CORRV))[((size_t)(sbh * 3 + (j - 1)) * SEG_CH + cl) * 128 + F.tid]; const float f = __builtin_amdgcn_exp2f(fmaxf(e, -200.f)); facv[F.tid] = f; if (f != 0.f) flg[0] = 1; }
            __syncthreads();
            if (flg[0] != 0) {
#pragma unroll
                for (int i = 0; i < 4; ++i) { const f32x4 a0 = sin[2 * i] * *(const LAS f32x4*)(facv + k0 + 8 * i), a1 = sin[2 * i + 1] * *(const LAS f32x4*)(facv + k0 + 8 * i + 4);
                    u32x4 o; o.x = pk2(a0[0], a0[1]); o.y = pk2(a0[2], a0[3]); o.z = pk2(a1[0], a1[1]); o.w = pk2(a1[2], a1[3]);
                    *(LAS u32x4*)(L + v * SC_P272 + (k0 + 8 * i) * 2) = o; }
                __syncthreads();
                const unsigned char* qs = ws + WS_QSG + ((size_t)(sbh * 3 + (j - 1)) * SEG_CH + cl) * 17408;
                bf16x8 yq[4];
#pragma unroll
                for (int ks = 0; ks < 4; ++ks) yq[ks] = *(const bf16x8*)(qs + (rt * 16 + fr) * SC_P272 + (ks * 32 + fq * 8) * 2);
                int g0, sg; scan_row0(b, dir, j * SEG_CH + cl, g0, sg);
                u32x2 oldw[4];
#pragma unroll
                for (int u = 0; u < 4; ++u) oldw[u] = *(const u32x2*)(O2 + ((size_t)dir * MTOK + (g0 + sg * (rt * 16 + fr))) * HGW + h * HDK + (4 * vp + u) * 16 + 4 * fq);
#pragma unroll
                for (int u = 0; u < 4; ++u) { const int vt = 4 * vp + u; f32x4 o = (f32x4){0.f, 0.f, 0.f, 0.f}; bf16x8 xs[4];
#pragma unroll
                    for (int ks = 0; ks < 4; ++ks) xs[ks] = *(const LAS bf16x8*)(L + (vt * 16 + fr) * SC_P272 + (ks * 32 + fq * 8) * 2);
                    __builtin_amdgcn_sched_barrier(0);
#pragma unroll
                    for (int ks = 0; ks < 4; ++ks) o = __builtin_amdgcn_mfma_f32_16x16x32_bf16(xs[ks], yq[ks], o, 0, 0, 0);
                    u32x2* p = (u32x2*)(O2 + ((size_t)dir * MTOK + (g0 + sg * (rt * 16 + fr))) * HGW + h * HDK + vt * 16 + 4 * fq);
                    const u32x2 old = oldw[u]; u32x2 nw; nw.x = pk2(bflo(old.x) + o[0], bfhi(old.x) + o[1]); nw.y = pk2(bflo(old.y) + o[2], bfhi(old.y) + o[3]); *p = nw; }
            }
            __syncthreads();
        }
    }
}
__device__ __forceinline__ void phase_readout_naive(Frame& F, const Args& a, int layer, int Mrows) {
    unsigned char* ws = F.ws; const bf16_t* Z = (const bf16_t*)(ws + WS_Z); const float* O2 = (const float*)(ws + WS_O2); bf16_t* HG = (bf16_t*)(ws + WS_HG);
    const float* wn = a.in[I_HGNW] + (size_t)layer * HGW;
    int r0, r1; wave_rows(F, Mrows, r0, r1);
    const int c0 = F.lane * 16;
    float wv[16];
#pragma unroll
    for (int j = 0; j < 16; ++j) wv[j] = wn[c0 + j] * HG8_SCALE;
    for (int rb = r0; rb < r1; rb += 4) {
        int rr[4]; bool ok[4];
#pragma unroll
        for (int q = 0; q < 4; ++q) { ok[q] = rb + q < r1; rr[q] = ok[q] ? rb + q : rb; }
        u32x4 xw[4][2], yw[4][2], ga[4], gb[4];
#pragma unroll
        for (int q = 0; q < 4; ++q) {
            const u32x4* xp = (const u32x4*)((const bf16_t*)O2 + (size_t)rr[q] * HGW + c0); const u32x4* yp = (const u32x4*)((const bf16_t*)O2 + ((size_t)MTOK + rr[q]) * HGW + c0);
            xw[q][0] = xp[0]; xw[q][1] = xp[1]; yw[q][0] = yp[0]; yw[q][1] = yp[1];
            const u32x4* zp = (const u32x4*)(Z + (size_t)rr[q] * INC + ZC_OG + c0); ga[q] = zp[0]; gb[q] = zp[1]; }
        __builtin_amdgcn_sched_barrier(0);
#pragma unroll
        for (int q = 0; q < 4; ++q) { if (ok[q]) {
            float o[16]; float ss = 0.f;
#pragma unroll
            for (int j = 0; j < 2; ++j) { f32x4 x0, x1, y0, y1; pg8::unpack8(xw[q][j], x0, x1); pg8::unpack8(yw[q][j], y0, y1);
#pragma unroll
                for (int i = 0; i < 4; ++i) { o[8 * j + i] = x0[i] + y0[i]; o[8 * j + 4 + i] = x1[i] + y1[i]; ss += o[8 * j + i] * o[8 * j + i] + o[8 * j + 4 + i] * o[8 * j + 4 + i]; } }
            ss += lane_xor(ss, 1, F.lane); ss += lane_xor(ss, 2, F.lane); ss += lane_xor(ss, 4, F.lane);
            const float rs = 1.0f / sqrtf(ss * (1.f / HDK) + EPS);
            f32x4 g4[4]; pg8::unpack8(ga[q], g4[0], g4[1]); pg8::unpack8(gb[q], g4[2], g4[3]);
            float y[16];
#pragma unroll
            for (int j = 0; j < 16; ++j) y[j] = o[j] * rs * wv[j] * g4[j >> 2][j & 3];
            u32x4 o0; o0.x = pk4_fp8(y[0], y[1], y[2], y[3]); o0.y = pk4_fp8(y[4], y[5], y[6], y[7]); o0.z = pk4_fp8(y[8], y[9], y[10], y[11]); o0.w = pk4_fp8(y[12], y[13], y[14], y[15]);
            *(u32x4*)((unsigned char*)HG + (size_t)rr[q] * HGW + c0) = o0; } }
    }
}

__device__ __forceinline__ void phase_final(Frame& F, const Args& a) {
    unsigned char* ws = F.ws; const bf16_t* X = (const bf16_t*)(ws + WS_X); const float* MOD = (const float*)(ws + WS_MOD); const float* fw = a.in[I_FNW];
    int r0, r1; wave_rows(F, NLAT, r0, r1);
    f32x4 fwv[8];
#pragma unroll
    for (int j = 0; j < 8; ++j) fwv[j] = *((const f32x4*)fw + 64 * j + F.lane);
    for (int r = r0; r < r1;) {
        const bool two = (r + 1 < r1) && (mod_row(r + 1) == mod_row(r));
        const int rr[2] = {r, two ? r + 1 : r};
        f32x4 x[2][8];
#pragma unroll
        for (int q = 0; q < 2; ++q) xrow_load(X, rr[q], F.lane, x[q]);
        moe_combine_rows<2>(x, rr, F.lane, ws, DEPTH - 1, MOD + ((size_t)(DEPTH - 1) * 5 + mod_row(r)) * 6 * D + 5 * D);
        float ss0 = row_sumsq(x[0]), ss1 = row_sumsq(x[1]);
#pragma unroll
        for (int o = 1; o < 64; o <<= 1) { ss0 += lane_xor(ss0, o, F.lane); ss1 += lane_xor(ss1, o, F.lane); }
        const float rs[2] = {1.0f / sqrtf(ss0 * (1.f / D) + EPS), 1.0f / sqrtf(ss1 * (1.f / D) + EPS)};
#pragma unroll
        for (int q = 0; q < 2; ++q) if (q == 0 || two) { f32x4* o = (f32x4*)(a.out + (size_t)rr[q] * D) + F.lane;
#pragma unroll
            for (int j = 0; j < 8; ++j) o[64 * j] = x[q][j] * rs[q] * fwv[j]; }
        r += two ? 2 : 1;
    }
}

__device__ __forceinline__ int moe_tables(Frame& F, int layer) {
    LAS int* tbl = (LAS int*)(F.lds + LDS_MISC + 64);
    const unsigned* cntw = (const unsigned*)(F.ws + WS_CTL) + CW_CNT + layer * 1024;
    int t_ = F.tid; asm volatile("" : "+v"(t_));
    if (t_ < NEXP) tbl[t_] = (int)__hip_atomic_load(cntw + t_ * 64, __ATOMIC_RELAXED, __HIP_MEMORY_SCOPE_AGENT);
    __syncthreads();
    if (F.tid == 0) {
        int blk = 0;
#pragma unroll 1
        for (int e = 0; e < NEXP; ++e) { const int c = tbl[e]; const int nb = (c + 255) >> 8;
            tbl[16 + e] = blk; for (int j = 0; j < nb; ++j) tbl[64 + blk + j] = e;
            if (blockIdx.x == 0) ((int*)(F.ws + WS_PADBASE))[layer * 16 + e] = blk * 256;
            blk += nb; }
        tbl[32] = blk;
    }
    __syncthreads();
    return tbl[32];
}

constexpr int PH_PER_LAYER = 10;
constexpr int N_PHASES = 1 + DEPTH * PH_PER_LAYER + 1;

__global__ void __launch_bounds__(512, 2) mk_fwd(Args args) {
    extern __shared__ __attribute__((aligned(16))) unsigned char lds_raw[];
    Frame F;
    F.lds = (LAS unsigned char*)lds_raw;
    F.tid = threadIdx.x; F.lane = F.tid & 63; F.wave = __builtin_amdgcn_readfirstlane(F.tid >> 6);
    F.G = gridDim.x; F.gw = blockIdx.x * 8 + F.wave; F.NGW = F.G * 8; F.ws = args.ws;
    unsigned char* ws = args.ws;
    volatile LAS unsigned* misc = (volatile LAS unsigned*)(F.lds + LDS_MISC);
    if (F.tid < 16) misc[F.tid] = 0u;
    __syncthreads();
    const int lo = args.ph_lo, hi = args.ph_hi;
#if MK_ONE_LAUNCH
    XcdBarrier bar = xcd_barrier_post((unsigned*)(ws + WS_CTL) + CW_BAR, misc);
#define GRID_BAR() xcd_barrier(bar)
#else
#define GRID_BAR() do {} while (0)
#endif
#ifndef MK_PHMASK
#define MK_PHMASK 0xFFFF
#endif
#define PHON(b) ((MK_PHMASK >> (b)) & 1)
#ifndef MK_REPMASK
#define MK_REPMASK 0
#endif
#define REPS(b) (((args.rep >> (b)) & 1) + 1)
#define IN(k) (lo <= (k) && (k) < hi)
#define LAUNDER() do { int t_ = threadIdx.x; asm volatile("" : "+v"(t_)); F.tid = t_; F.lane = t_ & 63; unsigned char* w_ = args.ws; asm volatile("" : "+s"(w_)); F.ws = w_; ws = w_; } while (0)
#define SEAM(k) do { if (IN(k) && IN((k) + 1)) { GRID_BAR(); if ((args.rep >> 15) & 1) GRID_BAR(); } } while (0)

    if (PHON(0) && IN(0)) { LAUNDER(); for (int rep_ = 0; rep_ < REPS(0); ++rep_) { if (rep_) { VM_WAIT(); __syncthreads(); } phase_prologue(F, args); } }
    SEAM(0);

    for (int layer_ = 0; layer_ < DEPTH; ++layer_) {
        int layer = layer_; asm volatile("" : "+s"(layer));
        const int pb = 1 + layer * PH_PER_LAYER;
        const bool lastl = (layer == DEPTH - 1);
        const int Mr = lastl ? NLAT : MTOK;
        if (PHON(1) && IN(pb + 0)) { LAUNDER(); for (int rep_ = 0; rep_ < REPS(1); ++rep_) { if (rep_) { VM_WAIT(); __syncthreads(); } phase_norm1(F, args, layer, layer > 0 && rep_ == 0); } }
        SEAM(pb + 0);
        if (PHON(2) && IN(pb + 1)) { LAUNDER(); for (int rep_ = 0; rep_ < REPS(2); ++rep_) { if (rep_) { VM_WAIT(); __syncthreads(); }
            pg8::DenseOrder S; S.init(MTOK, INC, F.G, (int)blockIdx.x, D, 0);
            pg8::EpiIn E{(bf16_t*)(ws + WS_Z), (const float*)(ws + WS_LB) + (size_t)layer * 2 * 1024, ws + WS_G8};
            pg8::gemm_phase<pg8::EpiIn, pg8::DenseOrder, true>(F.lds, ws + WS_H, D, ws + WS_WIN + (size_t)layer * INC * D, D, D, S, E);
        } }
        SEAM(pb + 1);
        if (PHON(3) && IN(pb + 2)) { LAUNDER(); for (int rep_ = 0; rep_ < REPS(3); ++rep_) { if (rep_) { VM_WAIT(); __syncthreads(); } phase_pooldiff(F, Mr); __syncthreads(); } { VM_WAIT(); __syncthreads(); phase_scan_mfma(F); GRID_BAR(); LAUNDER(); phase_scan_fix(F); } }
        SEAM(pb + 2);
        if (PHON(5) && IN(pb + 4)) { LAUNDER(); for (int rep_ = 0; rep_ < REPS(5); ++rep_) { if (rep_) { VM_WAIT(); __syncthreads(); } phase_readout_naive(F, args, layer, Mr); } }
        SEAM(pb + 4);
        if (PHON(6) && IN(pb + 5)) { LAUNDER(); for (int rep_ = 0; rep_ < REPS(6); ++rep_) { if (rep_) { VM_WAIT(); __syncthreads(); }
            pg8::DenseOrder S; S.init(Mr, D, F.G, (int)blockIdx.x, 1024, 0);
            { pg8::EpiGate2 E{ws + WS_MX, ws + WS_G8, 0, ZC_GH - ZC_GP, HG8_SCALE, 1.f / (W8_SCALE * HG8_SCALE * 255.f)};
              pg8::gemm_phase<pg8::EpiGate2, pg8::DenseOrder, true, true>(F.lds, ws + WS_P, 1024, ws + WS_WBP + (size_t)layer * D * 1024, 2048, 1024, S, E,
                  (long)WS_HG - (long)WS_P - 8 * 128, (long)WS_WBH - (long)WS_WBP - 8 * 128, 8); }
            if (rep_ == 0) { LAUNDER(); int rk, nn; idle_rank((Mr / 256) * 8, F.G, (int)blockIdx.x, rk, nn); convert_range(F, args, layer + 1, 0, 36000, rk, nn); }
        } }
        SEAM(pb + 5);
        if (PHON(7) && IN(pb + 6)) { LAUNDER(); for (int rep_ = 0; rep_ < REPS(7); ++rep_) { if (rep_) { VM_WAIT(); __syncthreads(); }
            pg8::DenseOrder S; S.init(Mr, D, F.G, (int)blockIdx.x, D, 0);
            pg8::EpiOut E{(bf16_t*)(ws + (rep_ ? WS_O2 : WS_X)), layer == 0 ? (const void*)args.in[I_X] : (const void*)(ws + WS_X), layer == 0 ? (const void*)args.in[I_CTX] : (const void*)(ws + WS_X), layer == 0, (const float*)(ws + WS_MOD) + (size_t)layer * 5 * 6 * D, 1.f / W8_SCALE};
            pg8::gemm_phase<pg8::EpiOut, pg8::DenseOrder, true>(F.lds, ws + WS_MX, D, ws + WS_WOUT + (size_t)layer * D * D, D, D, S, E);
            if (rep_ == 0) { int rk, nn; idle_rank((Mr / 256) * 8, F.G, (int)blockIdx.x, rk, nn); convert_range(F, args, layer + 1, 36000, 52000, rk, nn);
                              if (F.G == 256) { LAUNDER(); adaln_layer<16, 32>(F, args, layer + 1, rk, nn); } }
        } }
        if (PHON(8) && IN(pb + 6) && IN(pb + 7)) { LAUNDER(); router_prefill(F, args); }
        SEAM(pb + 6);
        if (PHON(8) && IN(pb + 7)) { LAUNDER(); for (int rep_ = 0; rep_ < REPS(8); ++rep_) { if (rep_) { VM_WAIT(); __syncthreads(); } phase_norm2_router(F, args, layer, Mr, rep_ == 0, rep_ == 0 && IN(pb + 6)); } }
        SEAM(pb + 7);
        if (PHON(9) && IN(pb + 8)) { for (int rep_ = 0; rep_ < REPS(9); ++rep_) { if (rep_) { VM_WAIT(); __syncthreads(); } LAUNDER();
            const int nblk = moe_tables(F, layer);
            pg8::MoeOrder<true> S; S.nN = 4; S.nunits = nblk * 4; S.G = F.G; S.c = (int)blockIdx.x; S.lda_b = D; S.tbl = (const LAS int*)(F.lds + LDS_MISC + 64);
            S.slottok = (const int*)(ws + WS_SLOTTOK); S.b_estride = (size_t)1024 * D;
            pg8::EpiMoe1 E{(bf16_t*)(ws + WS_ACT)};
            pg8::gemm_phase<pg8::EpiMoe1, pg8::MoeOrder<true>, true>(F.lds, ws + WS_H, D, ws + WS_WE13 + (size_t)layer * NEXP * 1024 * D, D, D, S, E);
            if (rep_ == 0) { int rk, nn; idle_rank(nblk * 4, F.G, (int)blockIdx.x, rk, nn); convert_range(F, args, layer + 1, 52000, 70000, rk, nn); }
        } }
        SEAM(pb + 8);
        if (PHON(10) && IN(pb + 9)) { for (int rep_ = 0; rep_ < REPS(10); ++rep_) { if (rep_) { VM_WAIT(); __syncthreads(); } LAUNDER();
            const int nblk = moe_tables(F, layer);
            pg8::MoeOrder<false> S; S.nN = 8; S.nunits = nblk * 8; S.G = F.G; S.c = (int)blockIdx.x; S.lda_b = DEXP; S.tbl = (const LAS int*)(F.lds + LDS_MISC + 64);
            S.slottok = nullptr; S.b_estride = (size_t)D * DEXP;
            pg8::EpiY8 E{ws + WS_Y2, D, Y8_SCALE / (W8_SCALE * ACT8_SCALE)};
            pg8::gemm_phase<pg8::EpiY8, pg8::MoeOrder<false>, true>(F.lds, ws + WS_ACT, DEXP, ws + WS_WE2 + (size_t)layer * NEXP * D * DEXP, DEXP, DEXP, S, E);
            if (rep_ == 0) { int rk, nn; idle_rank(nblk * 8, F.G, (int)blockIdx.x, rk, nn); convert_range(F, args, layer + 1, 70000, CONV_ITEMS, rk, nn); }
        } }
        SEAM(pb + 9);
    }
    if (PHON(11) && IN(N_PHASES - 1)) { LAUNDER(); for (int rep_ = 0; rep_ < REPS(11); ++rep_) { if (rep_) { VM_WAIT(); __syncthreads(); } phase_final(F, args); } }
#undef IN
#undef SEAM
}

extern "C" void kernel_launch(void* const* d_in, const int* in_sizes, int n_in, void* d_out, int out_size, void* d_ws, size_t ws_size, hipStream_t stream) {
    static int grid = 0;
    if (grid == 0) {
        if (n_in != 22 || out_size != NLAT * D || ws_size < WS_END) { fprintf(stderr, "kernel_launch: unexpected shapes (n_in %d out %d ws %zu need %zu)\n", n_in, out_size, ws_size, (size_t)WS_END); grid = -1; return; }
        int dev = 0, cus = 0, per_cu = 0;
        if (hipGetDevice(&dev) != hipSuccess || hipDeviceGetAttribute(&cus, hipDeviceAttributeMultiprocessorCount, dev) != hipSuccess) { grid = -1; return; }
        if (hipFuncSetAttribute((const void*)mk_fwd, hipFuncAttributeMaxDynamicSharedMemorySize, LDS_BYTES) != hipSuccess) { fprintf(stderr, "kernel_launch: hipFuncSetAttribute failed\n"); grid = -1; return; }
        if (hipOccupancyMaxActiveBlocksPerMultiprocessor(&per_cu, (const void*)mk_fwd, 512, LDS_BYTES) != hipSuccess || per_cu < 1) fprintf(stderr, "kernel_launch: occupancy query says %d\n", per_cu);
        (void)hipGetLastError();
        grid = cus;
    }
    if (grid < 0) return;
    (void)hipMemsetAsync((char*)d_ws + WS_CTL, 0, CTL_BYTES, stream);
    Args a{};
    for (int i = 0; i < 22; ++i) a.in[i] = (const float*)d_in[i];
    a.out = (float*)d_out; a.ws = (unsigned char*)d_ws; a.rep = MK_REPMASK; a.pad = 0;
#if MK_ONE_LAUNCH
    a.ph_lo = 0; a.ph_hi = N_PHASES;
    hipLaunchKernelGGL(mk_fwd, dim3(grid), dim3(512), LDS_BYTES, stream, a);
#else
    for (int p = 0; p < N_PHASES; ++p) { a.ph_lo = p; a.ph_hi = p + 1; hipLaunchKernelGGL(mk_fwd, dim3(grid), dim3(512), LDS_BYTES, stream, a); }
#endif
}
```
